# Optimizing an MI355X kernel written in HIP

```python
import math
import jax, jax.numpy as jnp
from jax import lax
import numpy as np

D_MODEL = 1024
BATCH = 8
SEQ = 2048
DEPTH = 1
DEC_BATCH = 128
DEC_SEQ = 8
PAST_LEN = 16384
PAGE_SIZE = 128

EPS = 1e-6
D_FF = ((8 * D_MODEL // 3 + 127) // 128) * 128
GLA_WIDTH = D_MODEL // 2
GLA_HEADS = 4
GLA_DV = GLA_WIDTH // GLA_HEADS
GLA_DK = GLA_DV // 2
GLA_QK_WIDTH = GLA_HEADS * GLA_DK
GLA_GATE_RANK = 16
GLA_TAU = 16.0
GLA_CHUNK = 16
S5_WIDTH = D_MODEL - GLA_WIDTH
S5_P = 16
S5_GROUPS = S5_WIDTH // S5_P
S5_N = 64
S5_DT_MIN = 0.001
S5_DT_MAX = 0.1
MIX_WIDTH = GLA_WIDTH + S5_WIDTH
CROSS_HEADS = 4
CROSS_DH = D_MODEL // CROSS_HEADS
MEM_LEN = 256
IN_SIZES = (GLA_QK_WIDTH, GLA_QK_WIDTH, GLA_WIDTH, GLA_GATE_RANK, GLA_WIDTH, S5_WIDTH)
IN_WIDTH = sum(IN_SIZES)
SPLIT_POINTS = tuple(int(s) for s in np.cumsum(IN_SIZES)[:-1])

kernel_name = "hymba_gla_s5_macaron_decode_step"


def rms_norm(x, g):
    xf = x.astype(jnp.float32)
    y = xf * lax.rsqrt(jnp.mean(xf * xf, axis=-1, keepdims=True) + EPS)
    return (y * g.astype(jnp.float32)).astype(x.dtype)


def swiglu(x, w_gu, w_down):
    g, u = jnp.split(x @ w_gu, 2, axis=-1)
    return (jax.nn.silu(g) * u) @ w_down


def gla_recurrence(q, k, v, log_a, s0):
    bsz, t, h, _ = q.shape
    dv = v.shape[-1]
    n_chunks = -(-t // GLA_CHUNK)
    pad = n_chunks * GLA_CHUNK - t

    def to_chunks(a):
        a = jnp.pad(a, ((0, 0), (0, pad), (0, 0), (0, 0)))
        return a.reshape(bsz, n_chunks, GLA_CHUNK, h, a.shape[-1]).transpose(1, 0, 3, 2, 4)

    qc, kc, vc, lc = to_chunks(q), to_chunks(k), to_chunks(v), to_chunks(log_a)
    bc = jnp.cumsum(lc, axis=3)
    causal = jnp.tril(jnp.ones((GLA_CHUNK, GLA_CHUNK), dtype=bool))[:, :, None]

    def step(s, inp):
        qi, ki, vi, bi = inp
        o_inter = jnp.einsum('bhtd,bhde->bhte', qi * jnp.exp(bi), s)
        rel = bi[:, :, :, None, :] - bi[:, :, None, :, :]
        decay = jnp.exp(jnp.where(causal, rel, -jnp.inf))
        scores = jnp.einsum('bhtd,bhsd,bhtsd->bhts', qi, ki, decay)
        o_intra = jnp.einsum('bhts,bhse->bhte', scores, vi)
        b_last = bi[:, :, -1:, :]
        s_new = jnp.exp(b_last[:, :, 0, :])[..., None] * s + jnp.einsum(
            'bhsd,bhse->bhde', ki * jnp.exp(b_last - bi), vi)
        return s_new, o_inter + o_intra

    s_final, o = lax.scan(step, s0, (qc, kc, vc, bc))
    o = o.transpose(1, 0, 3, 2, 4).reshape(bsz, n_chunks * GLA_CHUNK, h, dv)[:, :t]
    return o, s_final


def s5_discretise(lambda_re, lambda_im, log_dt, b_re, b_im):
    lr = lambda_re.astype(jnp.float32)
    li = lambda_im.astype(jnp.float32)
    dt = jnp.exp(log_dt.astype(jnp.float32))[:, None]
    mag = jnp.exp(dt * lr)
    ab_re = mag * jnp.cos(dt * li)
    ab_im = mag * jnp.sin(dt * li)
    den = lr * lr + li * li
    coef_re = ((ab_re - 1.0) * lr + ab_im * li) / den
    coef_im = (ab_im * lr - (ab_re - 1.0) * li) / den
    br = b_re.astype(jnp.float32)
    bi = b_im.astype(jnp.float32)
    bb_re = coef_re[..., None] * br - coef_im[..., None] * bi
    bb_im = coef_re[..., None] * bi + coef_im[..., None] * br
    return ab_re, ab_im, bb_re, bb_im


def complex_affine_combine(e1, e2):
    a1r, a1i, b1r, b1i = e1
    a2r, a2i, b2r, b2i = e2
    return (a2r * a1r - a2i * a1i,
            a2r * a1i + a2i * a1r,
            a2r * b1r - a2i * b1i + b2r,
            a2r * b1i + a2i * b1r + b2i)


def s5_mixer(u, x0_re, x0_im, lambda_re, lambda_im, log_dt, b_re, b_im, c_re, c_im, d_skip, w_glu, b_glu):
    ab_re, ab_im, bb_re, bb_im = s5_discretise(lambda_re, lambda_im, log_dt, b_re, b_im)
    bu_re = jnp.einsum('btgp,gnp->btgn', u, bb_re)
    bu_im = jnp.einsum('btgp,gnp->btgn', u, bb_im)
    first_re = bu_re[:, :1] + (ab_re * x0_re - ab_im * x0_im)[:, None]
    first_im = bu_im[:, :1] + (ab_re * x0_im + ab_im * x0_re)[:, None]
    bu_re = jnp.concatenate([first_re, bu_re[:, 1:]], axis=1)
    bu_im = jnp.concatenate([first_im, bu_im[:, 1:]], axis=1)
    a_re = jnp.broadcast_to(ab_re, bu_re.shape)
    a_im = jnp.broadcast_to(ab_im, bu_im.shape)
    _, _, xr, xi = lax.associative_scan(complex_affine_combine, (a_re, a_im, bu_re, bu_im), axis=1)
    y = (jnp.einsum('btgn,gpn->btgp', xr, c_re.astype(jnp.float32))
         - jnp.einsum('btgn,gpn->btgp', xi, c_im.astype(jnp.float32))
         + d_skip.astype(jnp.float32) * u)
    z = jax.nn.gelu(y)
    out = z * jax.nn.sigmoid(jnp.einsum('btgp,gpq->btgq', z, w_glu.astype(jnp.float32))
                             + b_glu.astype(jnp.float32))
    return out, xr[:, -1], xi[:, -1]


def memory_kv(mem, g_mem, w_ckv):
    bsz = mem.shape[0]
    k, v = jnp.split(rms_norm(mem, g_mem) @ w_ckv, 2, axis=-1)
    return (k.reshape(bsz, MEM_LEN, CROSS_HEADS, CROSS_DH),
            v.reshape(bsz, MEM_LEN, CROSS_HEADS, CROSS_DH))


def cross_attend(xn, mem_k, mem_v, w_cq, w_co):
    bsz, t, _ = xn.shape
    q = (xn @ w_cq).reshape(bsz, t, CROSS_HEADS, CROSS_DH)
    s = jnp.einsum('bthd,bmhd->bhtm', q, mem_k).astype(jnp.float32) * (CROSS_DH ** -0.5)
    p = jax.nn.softmax(s, axis=-1).astype(mem_v.dtype)
    o = jnp.einsum('bhtm,bmhd->bthd', p, mem_v).reshape(bsz, t, D_MODEL)
    return o @ w_co


def trunk_layer(x, s_gla0, s5_re0, s5_im0, mem_k, mem_v, w):
    bsz, t, _ = x.shape
    f32 = jnp.float32
    h = x + 0.5 * swiglu(rms_norm(x, w['g_ffn1']), w['w_ffn1_gu'], w['w_ffn1_down'])
    u = rms_norm(h, w['g_mix'])
    q, k, v, zg, r, us5 = jnp.split(u @ w['w_in'], SPLIT_POINTS, axis=-1)
    q = q.reshape(bsz, t, GLA_HEADS, GLA_DK).astype(f32) * (GLA_DK ** -0.5)
    k = k.reshape(bsz, t, GLA_HEADS, GLA_DK).astype(f32)
    v = v.reshape(bsz, t, GLA_HEADS, GLA_DV).astype(f32)
    log_a = jax.nn.log_sigmoid(zg.astype(f32) @ w['w_gla_gate'].astype(f32)
                               + w['b_gla_gate'].astype(f32)) / GLA_TAU
    log_a = log_a.reshape(bsz, t, GLA_HEADS, GLA_DK)
    o, s_gla = gla_recurrence(q, k, v, log_a, s_gla0.astype(f32))
    o = rms_norm(o, w['g_gla_out']) * jax.nn.silu(r.reshape(bsz, t, GLA_HEADS, GLA_DV).astype(f32))
    o_s5, s5_re, s5_im = s5_mixer(
        us5.reshape(bsz, t, S5_GROUPS, S5_P).astype(f32), s5_re0.astype(f32), s5_im0.astype(f32),
        w['s5_lambda_re'], w['s5_lambda_im'], w['s5_log_dt'], w['s5_b_re'], w['s5_b_im'],
        w['s5_c_re'], w['s5_c_im'], w['s5_d'], w['s5_w_glu'], w['s5_b_glu'])
    mix = jnp.concatenate([o.reshape(bsz, t, GLA_WIDTH), o_s5.reshape(bsz, t, S5_WIDTH)], axis=-1)
    h = h + mix.astype(x.dtype) @ w['w_out']
    h = h + cross_attend(rms_norm(h, w['g_cross']), mem_k, mem_v, w['w_cq'], w['w_co'])
    h = h + 0.5 * swiglu(rms_norm(h, w['g_ffn2']), w['w_ffn2_gu'], w['w_ffn2_down'])
    return h, s_gla, s5_re, s5_im


def setup_inputs(seed: int = 0) -> dict:
    key = jax.random.key(seed)
    ks = iter(jax.random.split(key, 48))
    f32 = jnp.float32

    def nrm(shape, scale):
        return jax.random.normal(next(ks), shape, f32) * scale

    def gain(shape):
        return jnp.ones(shape, f32) + nrm(shape, 0.02)

    L = DEPTH
    inp = {}
    inp['x_prompt'] = nrm((BATCH, SEQ, D_MODEL), 1.0)
    inp['x_sample'] = nrm((DEC_BATCH, DEC_SEQ, D_MODEL), 1.0)
    inp['state_gla'] = nrm((L, DEC_BATCH, GLA_HEADS, GLA_DK, GLA_DV), 1.0)
    inp['state_s5_re'] = nrm((L, DEC_BATCH, S5_GROUPS, S5_N), 0.1)
    inp['state_s5_im'] = nrm((L, DEC_BATCH, S5_GROUPS, S5_N), 0.1)
    inp['cache_mem_k'] = nrm((L, DEC_BATCH, MEM_LEN, CROSS_HEADS, CROSS_DH), 1.0)
    inp['cache_mem_v'] = nrm((L, DEC_BATCH, MEM_LEN, CROSS_HEADS, CROSS_DH), 1.0)
    inp['mem_prompt'] = nrm((BATCH, MEM_LEN, D_MODEL), 1.0)
    inp['g_ffn1'] = gain((L, D_MODEL))
    inp['w_ffn1_gu'] = nrm((L, D_MODEL, 2 * D_FF), D_MODEL ** -0.5)
    inp['w_ffn1_down'] = nrm((L, D_FF, D_MODEL), D_FF ** -0.5)
    inp['g_mix'] = gain((L, D_MODEL))
    inp['w_in'] = nrm((L, D_MODEL, IN_WIDTH), D_MODEL ** -0.5)
    inp['w_gla_gate'] = nrm((L, GLA_GATE_RANK, GLA_QK_WIDTH), GLA_GATE_RANK ** -0.5)
    inp['b_gla_gate'] = nrm((L, GLA_QK_WIDTH), 0.1)
    inp['g_gla_out'] = gain((L, GLA_DV))
    inp['s5_lambda_re'] = -0.5 + nrm((L, S5_GROUPS, S5_N), 0.01)
    inp['s5_lambda_im'] = (math.pi * jnp.broadcast_to(jnp.arange(S5_N, dtype=f32), (L, S5_GROUPS, S5_N))
                           + nrm((L, S5_GROUPS, S5_N), 0.01))
    inp['s5_log_dt'] = jax.random.uniform(next(ks), (L, S5_GROUPS), f32,
                                          math.log(S5_DT_MIN), math.log(S5_DT_MAX))
    inp['s5_b_re'] = nrm((L, S5_GROUPS, S5_N, S5_P), (2.0 * S5_P) ** -0.5)
    inp['s5_b_im'] = nrm((L, S5_GROUPS, S5_N, S5_P), (2.0 * S5_P) ** -0.5)
    inp['s5_c_re'] = nrm((L, S5_GROUPS, S5_P, S5_N), (2.0 * S5_N) ** -0.5)
    inp['s5_c_im'] = nrm((L, S5_GROUPS, S5_P, S5_N), (2.0 * S5_N) ** -0.5)
    inp['s5_d'] = nrm((L, S5_GROUPS, S5_P), 1.0)
    inp['s5_w_glu'] = nrm((L, S5_GROUPS, S5_P, S5_P), S5_P ** -0.5)
    inp['s5_b_glu'] = nrm((L, S5_GROUPS, S5_P), 0.1)
    inp['w_out'] = nrm((L, MIX_WIDTH, D_MODEL), MIX_WIDTH ** -0.5)
    inp['g_cross'] = gain((L, D_MODEL))
    inp['g_mem'] = gain((L, D_MODEL))
    inp['w_cq'] = nrm((L, D_MODEL, D_MODEL), D_MODEL ** -0.5)
    inp['w_ckv'] = nrm((L, D_MODEL, 2 * D_MODEL), D_MODEL ** -0.5)
    inp['w_co'] = nrm((L, D_MODEL, D_MODEL), D_MODEL ** -0.5)
    inp['g_ffn2'] = gain((L, D_MODEL))
    inp['w_ffn2_gu'] = nrm((L, D_MODEL, 2 * D_FF), D_MODEL ** -0.5)
    inp['w_ffn2_down'] = nrm((L, D_FF, D_MODEL), D_FF ** -0.5)
    inp['g_final'] = gain((D_MODEL,))
    return inp


def reference(x_prompt, x_sample, state_gla, state_s5_re, state_s5_im, cache_mem_k, cache_mem_v,
              mem_prompt, g_ffn1, w_ffn1_gu, w_ffn1_down, g_mix, w_in, w_gla_gate, b_gla_gate,
              g_gla_out, s5_lambda_re, s5_lambda_im, s5_log_dt, s5_b_re, s5_b_im, s5_c_re, s5_c_im,
              s5_d, s5_w_glu, s5_b_glu, w_out, g_cross, g_mem, w_cq, w_ckv, w_co, g_ffn2,
              w_ffn2_gu, w_ffn2_down, g_final):
    bp = x_prompt.shape[0]
    f32 = jnp.float32
    hp, hs = x_prompt, x_sample
    gla_p, re_p, im_p, mk_p, mv_p = [], [], [], [], []
    gla_s, re_s, im_s = [], [], []
    for l in range(DEPTH):
        w = {
            'g_ffn1': g_ffn1[l], 'w_ffn1_gu': w_ffn1_gu[l], 'w_ffn1_down': w_ffn1_down[l],
            'g_mix': g_mix[l], 'w_in': w_in[l], 'w_gla_gate': w_gla_gate[l], 'b_gla_gate': b_gla_gate[l],
            'g_gla_out': g_gla_out[l], 's5_lambda_re': s5_lambda_re[l], 's5_lambda_im': s5_lambda_im[l],
            's5_log_dt': s5_log_dt[l], 's5_b_re': s5_b_re[l], 's5_b_im': s5_b_im[l],
            's5_c_re': s5_c_re[l], 's5_c_im': s5_c_im[l], 's5_d': s5_d[l], 's5_w_glu': s5_w_glu[l],
            's5_b_glu': s5_b_glu[l], 'w_out': w_out[l], 'g_cross': g_cross[l], 'w_cq': w_cq[l],
            'w_co': w_co[l], 'g_ffn2': g_ffn2[l], 'w_ffn2_gu': w_ffn2_gu[l], 'w_ffn2_down': w_ffn2_down[l],
        }
        mk, mv = memory_kv(mem_prompt, g_mem[l], w_ckv[l])
        hp, sg, sr, si = trunk_layer(
            hp,
            jnp.zeros((bp, GLA_HEADS, GLA_DK, GLA_DV), f32),
            jnp.zeros((bp, S5_GROUPS, S5_N), f32),
            jnp.zeros((bp, S5_GROUPS, S5_N), f32),
            mk, mv, w)
        gla_p.append(sg); re_p.append(sr); im_p.append(si); mk_p.append(mk); mv_p.append(mv)
        hs, sg, sr, si = trunk_layer(hs, state_gla[l], state_s5_re[l], state_s5_im[l],
                                     cache_mem_k[l], cache_mem_v[l], w)
        gla_s.append(sg); re_s.append(sr); im_s.append(si)
    y_prompt = rms_norm(hp, g_final)
    y_sample = rms_norm(hs, g_final)
    return (y_prompt, y_sample,
            jnp.stack(gla_p), jnp.stack(re_p), jnp.stack(im_p), jnp.stack(mk_p), jnp.stack(mv_p),
            jnp.stack(gla_s), jnp.stack(re_s), jnp.stack(im_s))
```

```cpp
#include <hip/hip_runtime.h>
#include <hip/hip_cooperative_groups.h>
#include <cstdio>
#include <cstdint>
namespace cg = cooperative_groups;

constexpr int D = 1024, MP = 16384, MS = 1024, M = MP + MS, FF = 2816, NGU = 2 * FF, NIN = 2064, NINP = 2304;
constexpr int MEMR = 2048;
constexpr float EPS = 1e-6f;
constexpr int PC_Q = 0, PC_K = 256, PC_V = 512, PC_R = 1024, PC_U = 1536, PC_ZG = 2048;
constexpr size_t O_Y = 0, O_GLAP = 17825792, O_REP = 18087936, O_IMP = 18104320, O_MKP = 18120704, O_MVP = 20217856,
                 O_GLAS = 22315008, O_RES = 26509312, O_IMS = 26771456, O_TOTAL = 27033600;
constexpr size_t MiB = 1u << 20;
constexpr size_t WS_SSQ = 0;
constexpr size_t WS_WGU1 = 1 * MiB, WS_WD1 = 12 * MiB, WS_WIN = 18 * MiB, WS_WOUT = 23 * MiB, WS_WCQ = 25 * MiB, WS_WCKV = 27 * MiB,
                 WS_WCO = 31 * MiB, WS_WGU2 = 33 * MiB, WS_WD2 = 44 * MiB, WS_EGT = 50 * MiB, WS_GTT = 51 * MiB, WS_MEMB = 53 * MiB,
                 WS_KB = 57 * MiB, WS_VBT = 61 * MiB, WS_XB = 65 * MiB, WS_HB = 99 * MiB, WS_H = 133 * MiB, WS_ACT = 201 * MiB,
                 WS_MIX = 295 * MiB, WS_Q = 329 * MiB, WS_O = 363 * MiB, WS_GLAD = 397 * MiB, WS_GLADEC = 429 * MiB, WS_S5E = 430 * MiB,
                 WS_S5X = 464 * MiB, WS_END = 481 * MiB;
constexpr int SSQ_X = 0, SSQ_MEM = M, SSQ_H1 = M + 2048, SSQ_H2 = 2 * M + 2048, SSQ_H3 = 3 * M + 2048, SSQ_WORDS = 4 * M + 2048;
static_assert((size_t)SSQ_WORDS * 4 <= MiB, "ssq region");
static_assert(WS_ACT + (size_t)M * FF * 2 <= WS_MIX && WS_ACT + (size_t)M * NINP * 2 <= WS_MIX, "act / P region");

constexpr int NWAVES = 8, NTHREADS = 512;
constexpr int LDS_BYTES = 147456;

#define LAS __attribute__((address_space(3)))
typedef unsigned short bf16_t;
typedef short bf16x8 __attribute__((ext_vector_type(8)));
typedef short bf16x4 __attribute__((ext_vector_type(4)));
typedef float f32x4 __attribute__((ext_vector_type(4)));
typedef float f32x2 __attribute__((ext_vector_type(2)));
typedef unsigned u32x4 __attribute__((ext_vector_type(4)));
typedef unsigned u32x2 __attribute__((ext_vector_type(2)));
#define DI __device__ __forceinline__

DI unsigned f2bf(float f) { unsigned u = __builtin_bit_cast(unsigned, f); return (u + 0x7fffu + ((u >> 16) & 1u)) >> 16; }
DI unsigned pk2(float lo, float hi) { return f2bf(lo) | (f2bf(hi) << 16); }
DI float bf2f(unsigned b) { return __builtin_bit_cast(float, b << 16); }
DI float bflo(unsigned w) { return __builtin_bit_cast(float, w << 16); }
DI float bfhi(unsigned w) { return __builtin_bit_cast(float, w & 0xffff0000u); }
DI float wave_sum(float v) {
#pragma unroll
    for (int o = 1; o < 64; o <<= 1) v += __shfl_xor(v, o);
    return v;
}
DI float sigmoidf_fast(float x) { return __builtin_amdgcn_rcpf(1.f + __expf(-x)); }
DI float siluf(float x) { return x * sigmoidf_fast(x); }
DI float logsigmoidf(float x) { return fminf(x, 0.f) - log1pf(__expf(-fabsf(x))); }
DI float gelu_tanh(float y) { const float a = 0.7978845608028654f * (y + 0.044715f * y * y * y); const float e = __expf(2.f * a); const float th = 1.f - 2.f * __builtin_amdgcn_rcpf(e + 1.f); return 0.5f * y * (1.f + th); }

namespace pg8 {
#define PG8_LAS __attribute__((address_space(3)))
constexpr int BM = 256, BK = 64, HALF = 128, HTB = HALF * BK * 2  , STAGE_BYTES = 8 * HTB, NXCD = 8, WGM = 8;

__host__ __device__ __forceinline__ int lds_byte(int r, int c) { const int st = (r >> 4) * 2 + (c >> 5), rr = r & 15, cc = c & 31, ob = rr * 64 + cc * 2; return st * 1024 + (ob ^ (((ob >> 9) & 1) << 5)); }
__host__ __device__ __forceinline__ void stage_rc(int b, int& R, int& C) { const int st = b / 1024, sb = b % 1024, swz = sb ^ (((sb >> 9) & 1) << 5); R = (st >> 1) * 16 + swz / 64; C = (st & 1) * 32 + (swz % 64) / 2; }
__host__ __device__ __forceinline__ int perm32(int rho) { const int n = rho >> 4, i = rho & 15; return 8 * (i >> 2) + 4 * n + (i & 3); }

struct Unit { int pm, pn; };
struct Gemm { const bf16_t* A; const bf16_t* Bt; int M, N, K; };

struct StaticOrder {
    int nM, nN, nwg, G, c;
    __host__ __device__ void init(int M_, int N_, int G_, int c_) { nM = M_ / BM; nN = N_ / BM; nwg = nM * nN; G = G_; c = c_; }
    __host__ __device__ bool next(int i, Unit& u) const {
        const long L = (long)i * G + c; if (L >= nwg) return false;
        int wgid = (int)L; { const int q = nwg / NXCD, r = nwg % NXCD, xcd = wgid % NXCD, off = wgid / NXCD; wgid = (xcd < r ? xcd * (q + 1) : r * (q + 1) + (xcd - r) * q) + off; }
        const int nig = WGM * nN, gid = wgid / nig, fm = gid * WGM, gsz = (nM - fm) < WGM ? (nM - fm) : WGM;
        u.pm = fm + ((wgid % nig) % gsz); u.pn = (wgid % nig) / gsz; return true;
    }
    __device__ __forceinline__ void a_ready(const Unit&) const {}
    __device__ __forceinline__ void done(const Unit&) const {}
};

__device__ __forceinline__ unsigned cvt_pk_bf16(float lo, float hi) { unsigned r; asm volatile("v_cvt_pk_bf16_f32 %0, %1, %2" : "=v"(r) : "v"(lo), "v"(hi)); return r; }


struct EpiSwiGLU {
    static constexpr bool PERM = true, AFTER_DRAIN = false;
    bf16_t* O; int ldc; const float* ssq;
    __device__ __forceinline__ void operator()(const f32x4 (&acc)[2][2][4][2], const Unit& u, int wr, int wc, int fr, int fq) const {
        const int row0 = u.pm * BM + wr * 64 + fr, col0 = u.pn * HALF + wc * 32 + 8 * fq;
#pragma unroll
        for (int ai = 0; ai < 2; ++ai)
#pragma unroll
            for (int m = 0; m < 4; ++m) {
                const int row = row0 + ai * HALF + m * 16;
                const float rs = rsqrtf(ssq[row] * (1.f / D) + EPS);
                const f32x4 g0 = acc[ai][0][m][0] * rs, g1 = acc[ai][0][m][1] * rs, u0 = acc[ai][1][m][0] * rs, u1 = acc[ai][1][m][1] * rs;
                u32x4 w;
                w.x = cvt_pk_bf16(siluf(g0[0]) * u0[0], siluf(g0[1]) * u0[1]); w.y = cvt_pk_bf16(siluf(g0[2]) * u0[2], siluf(g0[3]) * u0[3]);
                w.z = cvt_pk_bf16(siluf(g1[0]) * u1[0], siluf(g1[1]) * u1[1]); w.w = cvt_pk_bf16(siluf(g1[2]) * u1[2], siluf(g1[3]) * u1[3]);
                *(u32x4*)(O + (size_t)row * ldc + col0) = w;
            }
    }
};
struct EpiResid {
    static constexpr bool PERM = false, AFTER_DRAIN = false;
    const float* base0; const float* base1; float* out; bf16_t* hb; float* ssq; float alpha;
    __device__ __forceinline__ void operator()(const f32x4 (&acc)[2][2][4][2], const Unit& u, int wr, int wc, int fr, int fq) const {
        const int row0 = u.pm * BM + wr * 64 + fr, col0 = u.pn * BM + wc * 32 + 4 * fq;
#pragma unroll
        for (int ai = 0; ai < 2; ++ai)
#pragma unroll
            for (int m = 0; m < 4; ++m) {
                const int row = row0 + ai * HALF + m * 16;
                const float* bp = (row < MP) ? base0 + (size_t)row * D : base1 + (size_t)(row - MP) * D;
                float s = 0.f;
#pragma unroll
                for (int bj = 0; bj < 2; ++bj)
#pragma unroll
                    for (int n = 0; n < 2; ++n) {
                        const int c = col0 + bj * HALF + n * 16;
                        const f32x4 v = *(const f32x4*)(bp + c) + acc[ai][bj][m][n] * alpha;
                        *(f32x4*)(out + (size_t)row * D + c) = v;
                        s += (v[0] * v[0] + v[1] * v[1]) + (v[2] * v[2] + v[3] * v[3]);
                        if (hb) { u32x2 w; w.x = cvt_pk_bf16(v[0], v[1]); w.y = cvt_pk_bf16(v[2], v[3]); *(u32x2*)(hb + (size_t)row * D + c) = w; }
                    }
                if (ssq) { s += __shfl_xor(s, 16); s += __shfl_xor(s, 32); if (fq == 0) atomicAdd(ssq + row, s); }
            }
    }
};
struct EpiScaleBf16 {
    static constexpr bool PERM = true, AFTER_DRAIN = false;
    bf16_t* O; int ldc; const float* ssq; float scale;
    __device__ __forceinline__ void operator()(const f32x4 (&acc)[2][2][4][2], const Unit& u, int wr, int wc, int fr, int fq) const {
        const int row0 = u.pm * BM + wr * 64 + fr, col0 = u.pn * BM + wc * 32 + 8 * fq;
#pragma unroll
        for (int ai = 0; ai < 2; ++ai)
#pragma unroll
            for (int m = 0; m < 4; ++m) {
                const int row = row0 + ai * HALF + m * 16;
                const float rs = rsqrtf(ssq[row] * (1.f / D) + EPS) * scale;
#pragma unroll
                for (int bj = 0; bj < 2; ++bj) {
                    const f32x4 v0 = acc[ai][bj][m][0] * rs, v1 = acc[ai][bj][m][1] * rs;
                    u32x4 w; w.x = cvt_pk_bf16(v0[0], v0[1]); w.y = cvt_pk_bf16(v0[2], v0[3]); w.z = cvt_pk_bf16(v1[0], v1[1]); w.w = cvt_pk_bf16(v1[2], v1[3]);
                    *(u32x4*)(O + (size_t)row * ldc + col0 + bj * HALF) = w;
                }
            }
    }
};
struct EpiMemKV {
    static constexpr bool PERM = false, AFTER_DRAIN = false;
    float* outK; float* outV; bf16_t* kb; bf16_t* vbT; const float* ssq;
    __device__ __forceinline__ void operator()(const f32x4 (&acc)[2][2][4][2], const Unit& u, int wr, int wc, int fr, int fq) const {
        const int row0 = u.pm * BM + wr * 64 + fr; const bool isV = u.pn >= 4; const int col0 = (u.pn & 3) * BM + wc * 32 + 4 * fq;
        float* outp = isV ? outV : outK;
#pragma unroll
        for (int ai = 0; ai < 2; ++ai)
#pragma unroll
            for (int m = 0; m < 4; ++m) {
                const int row = row0 + ai * HALF + m * 16;
                const float rs = rsqrtf(ssq[row] * (1.f / D) + EPS);
                const int b = row >> 8, key = row & 255;
#pragma unroll
                for (int bj = 0; bj < 2; ++bj)
#pragma unroll
                    for (int n = 0; n < 2; ++n) {
                        const int c = col0 + bj * HALF + n * 16;
                        const f32x4 v = acc[ai][bj][m][n] * rs;
                        *(f32x4*)(outp + (size_t)row * D + c) = v;
                        if (!isV) { u32x2 w; w.x = cvt_pk_bf16(v[0], v[1]); w.y = cvt_pk_bf16(v[2], v[3]); *(u32x2*)(kb + (size_t)row * D + c) = w; }
                        else {
#pragma unroll
                            for (int i = 0; i < 4; ++i) vbT[((size_t)b * D + c + i) * 256 + key] = (bf16_t)f2bf(v[i]);
                        }
                    }
            }
    }
};

template <class Epi, class Sched, bool ALIGN_EPI = false, bool SP2 = false>
__device__ __forceinline__ void gemm_phase(PG8_LAS unsigned char* lds, const Gemm g, const Sched& S, const Epi& E) {
    const int tid = threadIdx.x, wid = __builtin_amdgcn_readfirstlane(tid >> 6), lane = tid & 63, wr = wid >> 2, wc = wid & 3, fr = lane & 15, fq = lane >> 4;
    const int K = g.K, nt = K / BK;
    unsigned voffA[2], voffB[2];
#pragma unroll
    for (int i = 0; i < 2; ++i) { int R, C; stage_rc(tid * 16 + i * 8192, R, C); const int Rb = Epi::PERM ? ((R & ~31) + perm32(R & 31)) : R;
        voffA[i] = (unsigned)(R * K + C) * 2u; voffB[i] = (unsigned)(Rb * K + C) * 2u; }
    const size_t kstep = (size_t)(BK * 2);
    const size_t hstep = (size_t)HALF * K * 2;
    const size_t tstep = 2 * hstep;
    const unsigned ldsw = (unsigned)wid * 1024u;
    const int aoff = lds_byte(wr * 64 + fr, fq * 8), boff = lds_byte(wc * 32 + fr, fq * 8);
#define PG8_SA(b, h) (((b) * 2 + (h)) * HTB)
#define PG8_SB(b, h) ((4 + (b) * 2 + (h)) * HTB)
#define PG8_STAGE(bufoff, gbase, voff) do { _Pragma("unroll") for (int _i = 0; _i < 2; ++_i) \
        __builtin_amdgcn_global_load_lds((const unsigned*)((const char*)(gbase) + (voff)[_i]), (PG8_LAS unsigned*)(lds + (bufoff) + ldsw + _i * 8192), 16, 0, 0); } while (0)
#define PG8_LDA(dst, b, h) do { _Pragma("unroll") for (int m = 0; m < 4; ++m) _Pragma("unroll") for (int k = 0; k < 2; ++k) dst[m][k] = *(const PG8_LAS bf16x8*)(lds + PG8_SA(b, h) + aoff + m * 2048 + k * 1024); } while (0)
#define PG8_LDB(dst, b, h) do { _Pragma("unroll") for (int n = 0; n < 2; ++n) _Pragma("unroll") for (int k = 0; k < 2; ++k) dst[n][k] = *(const PG8_LAS bf16x8*)(lds + PG8_SB(b, h) + boff + n * 2048 + k * 1024); } while (0)
#define PG8_MMA(ai, bj, At, Bt) do { __builtin_amdgcn_s_setprio(1); _Pragma("unroll") for (int m = 0; m < 4; ++m) _Pragma("unroll") for (int n = 0; n < 2; ++n) _Pragma("unroll") for (int k = 0; k < 2; ++k) \
        acc[ai][bj][m][n] = __builtin_amdgcn_mfma_f32_16x16x32_bf16(Bt[n][k], At[m][k], acc[ai][bj][m][n], 0, 0, 0); __builtin_amdgcn_s_setprio(0); } while (0)
#define PG8_WAIT_V(n) asm volatile("s_waitcnt vmcnt(" #n ")" ::: "memory")
#define PG8_WAIT_L(n) asm volatile("s_waitcnt lgkmcnt(" #n ")" ::: "memory")
#define PG8_BAR __builtin_amdgcn_s_barrier()
#define PG8_SCHED __builtin_amdgcn_sched_barrier(0)
    Unit cur, nxt; int ui = 0;
    if (!S.next(0, cur)) return;
    f32x4 acc[2][2][4][2];
#pragma unroll
    for (int a = 0; a < 2; ++a)
#pragma unroll
        for (int b = 0; b < 2; ++b)
#pragma unroll
            for (int m = 0; m < 4; ++m)
#pragma unroll
                for (int n = 0; n < 2; ++n) acc[a][b][m][n] = (f32x4){0.f, 0.f, 0.f, 0.f};
    bf16x8 At[4][2], B0[2][2], B1[2][2];
    const char* cA = (const char*)g.A + (size_t)cur.pm * tstep; const char* cB = (const char*)g.Bt + (size_t)cur.pn * tstep;
    S.a_ready(cur);
    if constexpr (SP2) {
        PG8_STAGE(PG8_SB(0, 0), cB, voffB); PG8_STAGE(PG8_SB(0, 1), cB + hstep, voffB); PG8_STAGE(PG8_SA(0, 0), cA, voffA); PG8_STAGE(PG8_SA(0, 1), cA + hstep, voffA);
        if (wr == 1) PG8_BAR;
        PG8_WAIT_V(2); PG8_BAR;
        PG8_STAGE(PG8_SB(1, 0), cB + kstep, voffB); PG8_STAGE(PG8_SA(1, 0), cA + kstep, voffA); PG8_STAGE(PG8_SB(1, 1), cB + hstep + kstep, voffB);
        PG8_WAIT_V(6); PG8_BAR;
    } else {
        PG8_STAGE(PG8_SB(0, 0), cB, voffB); PG8_STAGE(PG8_SA(0, 0), cA, voffA); PG8_STAGE(PG8_SB(0, 1), cB + hstep, voffB); PG8_STAGE(PG8_SA(0, 1), cA + hstep, voffA);
        if (wr == 1) PG8_BAR;
        PG8_WAIT_V(4); PG8_BAR;
        PG8_STAGE(PG8_SB(1, 0), cB + kstep, voffB); PG8_STAGE(PG8_SA(1, 0), cA + kstep, voffA); PG8_STAGE(PG8_SB(1, 1), cB + hstep + kstep, voffB);
        PG8_WAIT_V(6); PG8_BAR;
    }
    for (;;) {
        const bool has_next = S.next(ui + 1, nxt);
        const char* nA = has_next ? (const char*)g.A + (size_t)nxt.pm * tstep : cA; const char* nB = has_next ? (const char*)g.Bt + (size_t)nxt.pn * tstep : cB;
        for (int t = 0; t < nt; t += 2) {
            const bool last = (t == nt - 2);
            const char* a1 = cA + (size_t)(t + 1) * kstep;
            const char* a2 = last ? nA : cA + (size_t)(t + 2) * kstep; const char* b2 = last ? nB : cB + (size_t)(t + 2) * kstep;
            const char* a3 = a2 + kstep; const char* b3 = b2 + kstep;
            if (last && has_next) S.a_ready(nxt);
            if constexpr (SP2) {
            PG8_LDB(B0, 0, 0); PG8_LDB(B1, 0, 1); PG8_SCHED; PG8_LDA(At, 0, 0); PG8_STAGE(PG8_SA(1, 1), a1 + hstep, voffA);
            PG8_WAIT_V(8); PG8_WAIT_L(0); PG8_BAR; PG8_MMA(0, 0, At, B0); PG8_MMA(0, 1, At, B1); PG8_BAR; PG8_SCHED;
            PG8_LDA(At, 0, 1); PG8_STAGE(PG8_SB(0, 0), b2, voffB); PG8_STAGE(PG8_SB(0, 1), b2 + hstep, voffB); PG8_STAGE(PG8_SA(0, 0), a2, voffA);
            PG8_WAIT_V(8); PG8_WAIT_L(0); PG8_BAR; PG8_MMA(1, 0, At, B0); PG8_MMA(1, 1, At, B1); PG8_BAR; PG8_SCHED;
            PG8_LDB(B0, 1, 0); PG8_LDB(B1, 1, 1); PG8_SCHED; PG8_LDA(At, 1, 0); PG8_STAGE(PG8_SA(0, 1), a2 + hstep, voffA);
            PG8_WAIT_V(8); PG8_WAIT_L(0); PG8_BAR; PG8_MMA(0, 0, At, B0); PG8_MMA(0, 1, At, B1); PG8_BAR; PG8_SCHED;
            PG8_LDA(At, 1, 1); PG8_STAGE(PG8_SB(1, 0), b3, voffB); PG8_STAGE(PG8_SB(1, 1), b3 + hstep, voffB); PG8_STAGE(PG8_SA(1, 0), a3, voffA);
            PG8_WAIT_V(8); PG8_WAIT_L(0); PG8_BAR; PG8_MMA(1, 0, At, B0); PG8_MMA(1, 1, At, B1); PG8_BAR; PG8_SCHED;
            } else {
            PG8_LDB(B0, 0, 0); PG8_SCHED; PG8_LDA(At, 0, 0); PG8_STAGE(PG8_SA(1, 1), a1 + hstep, voffA);
            PG8_WAIT_L(8); PG8_BAR; PG8_WAIT_L(0); PG8_MMA(0, 0, At, B0); PG8_BAR; PG8_SCHED;
            PG8_LDB(B1, 0, 1); PG8_STAGE(PG8_SB(0, 0), b2, voffB);
            PG8_BAR; PG8_WAIT_L(0); PG8_MMA(0, 1, At, B1); PG8_BAR;
            PG8_LDA(At, 0, 1); PG8_STAGE(PG8_SA(0, 0), a2, voffA);
            PG8_BAR; PG8_WAIT_L(0); PG8_MMA(1, 0, At, B0); PG8_BAR; PG8_SCHED;
            PG8_STAGE(PG8_SB(0, 1), b2 + hstep, voffB);
            PG8_WAIT_V(6); PG8_BAR; PG8_MMA(1, 1, At, B1); PG8_BAR;
            PG8_LDB(B0, 1, 0); PG8_SCHED; PG8_LDA(At, 1, 0); PG8_STAGE(PG8_SA(0, 1), a2 + hstep, voffA);
            PG8_WAIT_L(8); PG8_BAR; PG8_WAIT_L(0); PG8_MMA(0, 0, At, B0); PG8_BAR; PG8_SCHED;
            PG8_LDB(B1, 1, 1); PG8_STAGE(PG8_SB(1, 0), b3, voffB);
            PG8_BAR; PG8_WAIT_L(0); PG8_MMA(0, 1, At, B1); PG8_BAR;
            PG8_LDA(At, 1, 1); PG8_STAGE(PG8_SA(1, 0), a3, voffA);
            PG8_BAR; PG8_WAIT_L(0); PG8_MMA(1, 0, At, B0); PG8_BAR; PG8_SCHED;
            PG8_STAGE(PG8_SB(1, 1), b3 + hstep, voffB);
            PG8_WAIT_V(6); PG8_BAR; PG8_MMA(1, 1, At, B1); PG8_BAR;
            }
        }
        if constexpr (ALIGN_EPI) { if (wr == 0) PG8_BAR; }
        if constexpr (!Epi::AFTER_DRAIN) { E(acc, cur, wr, wc, fr, fq); S.done(cur); }
        if (!has_next) break;
#pragma unroll
        for (int a = 0; a < 2; ++a)
#pragma unroll
            for (int b = 0; b < 2; ++b)
#pragma unroll
                for (int m = 0; m < 4; ++m)
#pragma unroll
                    for (int n = 0; n < 2; ++n) acc[a][b][m][n] = (f32x4){0.f, 0.f, 0.f, 0.f};
        cur = nxt; cA = nA; cB = nB; ++ui;
        if constexpr (ALIGN_EPI) { if (wr == 1) PG8_BAR; }
    }
    PG8_WAIT_V(0);
    if constexpr (!ALIGN_EPI) { if (wr == 0) PG8_BAR; }
    PG8_BAR;
#undef PG8_SA
#undef PG8_SB
#undef PG8_STAGE
#undef PG8_LDA
#undef PG8_LDB
#undef PG8_MMA
#undef PG8_WAIT_V
#undef PG8_WAIT_L
#undef PG8_BAR
#undef PG8_SCHED
}
}

struct Args { const float* in[36]; float* out; unsigned char* ws; int ph_lo, ph_hi; };
#define LDS_WAIT() asm volatile("s_waitcnt lgkmcnt(0)" ::: "memory")

DI int rowmap(int mode, int n) {
    if (mode == 1) { const int j = n < FF ? n : n - FF; return 256 * (j >> 7) + (n < FF ? 0 : 128) + (j & 127); }
    if (mode == 2) { if (n < 1024) return n; if (n < 1040) return n + 1024; return n - 16; }
    return n;
}
DI void p0_transpose_item(const float* W, const float* gain, int K, int N, bf16_t* WT, int mode, float* scr, int item, int lane) {
    const int nblk = (N + 31) / 32, kb = item / nblk, nb = item % nblk, k0 = 64 * kb, n0 = 32 * nb;
    const int nn = n0 + (lane & 31); const bool ok = nn < N;
#pragma unroll 8
    for (int i = 0; i < 32; ++i) { const int kk = 2 * i + (lane >> 5); float v = ok ? W[(size_t)(k0 + kk) * N + nn] : 0.f; if (gain) v *= gain[k0 + kk]; scr[kk * 33 + (lane & 31)] = v; }
    LDS_WAIT(); asm volatile("" ::: "memory");
    const int c = lane & 7;
#pragma unroll
    for (int j = 0; j < 4; ++j) { const int n = (lane >> 3) + 8 * j; const float* s = scr + (8 * c) * 33 + n;
        u32x4 o; o.x = pk2(s[0 * 33], s[1 * 33]); o.y = pk2(s[2 * 33], s[3 * 33]); o.z = pk2(s[4 * 33], s[5 * 33]); o.w = pk2(s[6 * 33], s[7 * 33]);
        if (n0 + n < N) *(u32x4*)(WT + (size_t)rowmap(mode, n0 + n) * K + k0 + 8 * c) = o; }
    LDS_WAIT(); asm volatile("" ::: "memory");
}
DI void row_to_bf16_ssq(const float* xrow, bf16_t* orow, float* ssq_slot, int lane) {
    const f32x4* xr = (const f32x4*)xrow + lane;
    f32x4 v[4]; float s = 0.f;
#pragma unroll
    for (int j = 0; j < 4; ++j) { v[j] = xr[64 * j]; s += (v[j].x * v[j].x + v[j].y * v[j].y) + (v[j].z * v[j].z + v[j].w * v[j].w); }
    s = wave_sum(s);
    unsigned long long* o8 = (unsigned long long*)orow + lane;
#pragma unroll
    for (int j = 0; j < 4; ++j) o8[64 * j] = (unsigned long long)pk2(v[j].x, v[j].y) | ((unsigned long long)pk2(v[j].z, v[j].w) << 32);
    if (lane == 0) *ssq_slot = s;
}
struct S5P { float dt, lr, li; };
DI S5P s5_par(const float* lre, const float* lim, const float* logdt, int g, int n) { S5P p; p.dt = expf(logdt[g]); p.lr = lre[g * 64 + n]; p.li = lim[g * 64 + n]; return p; }
DI f32x2 s5_pow(const S5P& p, int j) {
    const float mag = expf((float)j * (p.dt * p.lr)); float sn, cs; sincosf((float)j * (p.dt * p.li), &sn, &cs); return (f32x2){mag * cs, mag * sn};
}
DI f32x2 s5_coef(const S5P& p) {
    const f32x2 ab = s5_pow(p, 1); const float den = p.lr * p.lr + p.li * p.li;
    return (f32x2){((ab.x - 1.f) * p.lr + ab.y * p.li) / den, (ab.y * p.lr - (ab.x - 1.f) * p.li) / den};
}
DI f32x2 cmul(f32x2 a, f32x2 b) { return (f32x2){a.x * b.x - a.y * b.y, a.x * b.y + a.y * b.x}; }

template <int NT>
DI void gla_gate_cumsum(const float* zg, float* bb, float* seg, const float* wg, const float* bg, int h, int tid) {
    for (int i = tid; i < NT * 64; i += NTHREADS) { const int t = i >> 6, d = i & 63; float s = bg[h * 64 + d];
#pragma unroll
        for (int r = 0; r < 16; ++r) s += zg[t * 16 + r] * wg[r * 256 + h * 64 + d];
        bb[t * 65 + d] = logsigmoidf(s) * (1.f / 16.f); }
    __syncthreads();
    if constexpr (NT == 64) {
        const int d = tid & 63, sg = tid >> 6; float run = 0.f;
#pragma unroll
        for (int i = 0; i < 8; ++i) { run += bb[(sg * 8 + i) * 65 + d]; bb[(sg * 8 + i) * 65 + d] = run; }
        seg[sg * 64 + d] = run;
        __syncthreads();
        float pre = 0.f;
        for (int j = 0; j < sg; ++j) pre += seg[j * 64 + d];
#pragma unroll
        for (int i = 0; i < 8; ++i) bb[(sg * 8 + i) * 65 + d] += pre;
    } else {
        if (tid < 64) { float run = 0.f;
#pragma unroll
            for (int t = 0; t < NT; ++t) { run += bb[t * 65 + tid]; bb[t * 65 + tid] = run; } }
    }
    __syncthreads();
}

__global__ void __launch_bounds__(NTHREADS, 2) hymba_fwd(Args args) {
    extern __shared__ __attribute__((aligned(16))) unsigned char lds[];
    cg::grid_group grid = cg::this_grid();
    const int tid0 = threadIdx.x, wave = __builtin_amdgcn_readfirstlane(tid0 >> 6);
    const int G = gridDim.x, bx = blockIdx.x;
    const int gw = bx * NWAVES + wave, NGW = G * NWAVES;
    const int NGT = G * NTHREADS;
#define PHASE_LOCALS int tid_l_ = tid0; asm volatile("" : "+v"(tid_l_)); const int tid = tid_l_, lane = tid & 63, gt = bx * NTHREADS + tid; (void)lane; (void)gt
    unsigned char* ws = args.ws;
    float* out = args.out;
    float* fl = (float*)lds;
    LAS unsigned char* ldsl = (LAS unsigned char*)lds;

    const float* x_prompt = args.in[0]; const float* x_sample = args.in[1]; const float* state_gla = args.in[2];
    const float* st_re = args.in[3]; const float* st_im = args.in[4]; const float* cache_k = args.in[5]; const float* cache_v = args.in[6];
    const float* mem_prompt = args.in[7];
    const float* w_gate = args.in[13]; const float* b_gate = args.in[14]; const float* g_gla_out = args.in[15];
    const float* s5_lre = args.in[16]; const float* s5_lim = args.in[17]; const float* s5_logdt = args.in[18];
    const float* s5_bre = args.in[19]; const float* s5_bim = args.in[20]; const float* s5_cre = args.in[21]; const float* s5_cim = args.in[22];
    const float* s5_d = args.in[23]; const float* s5_wglu = args.in[24]; const float* s5_bglu = args.in[25];
    const float* g_final = args.in[35];

    float* ssq = (float*)(ws + WS_SSQ);
    bf16_t* Wgu1 = (bf16_t*)(ws + WS_WGU1); bf16_t* Wd1 = (bf16_t*)(ws + WS_WD1); bf16_t* Win = (bf16_t*)(ws + WS_WIN); bf16_t* Wout = (bf16_t*)(ws + WS_WOUT);
    bf16_t* Wcq = (bf16_t*)(ws + WS_WCQ); bf16_t* Wckv = (bf16_t*)(ws + WS_WCKV); bf16_t* Wco = (bf16_t*)(ws + WS_WCO); bf16_t* Wgu2 = (bf16_t*)(ws + WS_WGU2); bf16_t* Wd2 = (bf16_t*)(ws + WS_WD2);
    bf16_t* EgT = (bf16_t*)(ws + WS_EGT); bf16_t* GTt = (bf16_t*)(ws + WS_GTT);
    bf16_t* memb = (bf16_t*)(ws + WS_MEMB); bf16_t* kb = (bf16_t*)(ws + WS_KB); bf16_t* vbT = (bf16_t*)(ws + WS_VBT);
    bf16_t* xb = (bf16_t*)(ws + WS_XB); bf16_t* hb = (bf16_t*)(ws + WS_HB); float* hres = (float*)(ws + WS_H);
    bf16_t* act = (bf16_t*)(ws + WS_ACT); bf16_t* Pb = (bf16_t*)(ws + WS_ACT);
    bf16_t* mix = (bf16_t*)(ws + WS_MIX); bf16_t* qb = (bf16_t*)(ws + WS_Q); bf16_t* ob = (bf16_t*)(ws + WS_O);
    float* glaD = (float*)(ws + WS_GLAD); float* glaDec = (float*)(ws + WS_GLADEC);
    float* s5e = (float*)(ws + WS_S5E); bf16_t* s5x = (bf16_t*)(ws + WS_S5X);

    const int lo = args.ph_lo, hi = args.ph_hi;
#ifndef PHASE_MASK
#define PHASE_MASK 0xffffffffu
#endif
#define IN(k) (((PHASE_MASK >> (k)) & 1u) && lo <= (k) && (k) < hi)
#define SEAM(k) do { if (IN(k) && IN((k) + 1)) grid.sync(); } while (0)

    if (IN(0)) {
        PHASE_LOCALS;
        float* scr = fl + wave * (64 * 33);
        constexpr int I_GU = 16 * 176, I_D = 44 * 32, I_IN = 16 * 65, I_SQ = 16 * 32, I_CKV = 16 * 64;
        constexpr int NITEMS = 2 * I_GU + 2 * I_D + I_IN + 3 * I_SQ + I_CKV;
        for (int it = gw; it < NITEMS; it += NGW) {
            int r = it;
            if (r < I_GU) { p0_transpose_item(args.in[9], args.in[8], D, NGU, Wgu1, 1, scr, r, lane); continue; } r -= I_GU;
            if (r < I_GU) { p0_transpose_item(args.in[33], args.in[32], D, NGU, Wgu2, 1, scr, r, lane); continue; } r -= I_GU;
            if (r < I_D) { p0_transpose_item(args.in[10], nullptr, FF, D, Wd1, 0, scr, r, lane); continue; } r -= I_D;
            if (r < I_D) { p0_transpose_item(args.in[34], nullptr, FF, D, Wd2, 0, scr, r, lane); continue; } r -= I_D;
            if (r < I_IN) { p0_transpose_item(args.in[12], args.in[11], D, NIN, Win, 2, scr, r, lane); continue; } r -= I_IN;
            if (r < I_SQ) { p0_transpose_item(args.in[26], nullptr, D, D, Wout, 0, scr, r, lane); continue; } r -= I_SQ;
            if (r < I_SQ) { p0_transpose_item(args.in[29], args.in[27], D, D, Wcq, 0, scr, r, lane); continue; } r -= I_SQ;
            if (r < I_SQ) { p0_transpose_item(args.in[31], nullptr, D, D, Wco, 0, scr, r, lane); continue; } r -= I_SQ;
            p0_transpose_item(args.in[30], args.in[28], D, 2 * D, Wckv, 0, scr, r, lane);
        }
        for (int i = gt; i < (NINP - NIN) * D / 8; i += NGT) ((u32x4*)(Win + (size_t)NIN * D))[i] = (u32x4){0u, 0u, 0u, 0u};
        for (int i = gt; i < 3 * M; i += NGT) ssq[SSQ_H1 + i] = 0.f;
        for (int m = gw; m < M; m += NGW) { const float* xr = m < MP ? x_prompt + (size_t)m * D : x_sample + (size_t)(m - MP) * D; row_to_bf16_ssq(xr, xb + (size_t)m * D, ssq + SSQ_X + m, lane); }
        for (int m = gw; m < MEMR; m += NGW) row_to_bf16_ssq(mem_prompt + (size_t)m * D, memb + (size_t)m * D, ssq + SSQ_MEM + m, lane);
        for (int it = gt; it < 32 * 64 * 8; it += NGT) {
            const int g = it >> 9, n = (it >> 3) & 63, s = it & 7;
            const S5P p = s5_par(s5_lre, s5_lim, s5_logdt, g, n);
            const f32x2 mm = cmul(s5_pow(p, 7 - s), s5_coef(p));
            unsigned wre[8], wim[8];
#pragma unroll
            for (int pp = 0; pp < 8; ++pp) {
                const f32x2 b0 = (f32x2){s5_bre[(g * 64 + n) * 16 + 2 * pp], s5_bim[(g * 64 + n) * 16 + 2 * pp]}, b1 = (f32x2){s5_bre[(g * 64 + n) * 16 + 2 * pp + 1], s5_bim[(g * 64 + n) * 16 + 2 * pp + 1]};
                const f32x2 v0 = cmul(mm, b0), v1 = cmul(mm, b1);
                wre[pp] = pk2(v0.x, v1.x); wim[pp] = pk2(v0.y, v1.y);
            }
            u32x4* dre = (u32x4*)(EgT + ((size_t)(g * 128 + n) * 128 + s * 16)); u32x4* dim = (u32x4*)(EgT + ((size_t)(g * 128 + 64 + n) * 128 + s * 16));
            dre[0] = (u32x4){wre[0], wre[1], wre[2], wre[3]}; dre[1] = (u32x4){wre[4], wre[5], wre[6], wre[7]};
            dim[0] = (u32x4){wim[0], wim[1], wim[2], wim[3]}; dim[1] = (u32x4){wim[4], wim[5], wim[6], wim[7]};
        }
        for (int it = gt; it < 32 * 8 * 64; it += NGT) {
            const int g = it >> 9, t = (it >> 6) & 7, n = it & 63;
            const S5P p = s5_par(s5_lre, s5_lim, s5_logdt, g, n);
            const f32x2 pw = s5_pow(p, t + 1);
#pragma unroll
            for (int pp = 0; pp < 16; ++pp) {
                const f32x2 c = (f32x2){s5_cre[(g * 16 + pp) * 64 + n], s5_cim[(g * 16 + pp) * 64 + n]};
                const f32x2 v = cmul(c, pw);
                bf16_t* dst = GTt + (size_t)(g * 128 + t * 16 + pp) * 256;
                dst[n] = (bf16_t)f2bf(v.x); dst[64 + n] = (bf16_t)f2bf(-v.y);
            }
        }
        for (int it = gt; it < 32 * 8 * 8 * 16; it += NGT) {
            const int g = it >> 10, t = (it >> 7) & 7, s = (it >> 4) & 7, pp = it & 15;
            float a[16];
#pragma unroll
            for (int q = 0; q < 16; ++q) a[q] = 0.f;
            if (s <= t) {
                for (int n = 0; n < 64; ++n) {
                    const S5P p = s5_par(s5_lre, s5_lim, s5_logdt, g, n);
                    const f32x2 c = (f32x2){s5_cre[(g * 16 + pp) * 64 + n], s5_cim[(g * 16 + pp) * 64 + n]};
                    const f32x2 cc = cmul(cmul(c, s5_pow(p, t - s)), s5_coef(p));
                    const f32x4* br = (const f32x4*)(s5_bre + (g * 64 + n) * 16); const f32x4* bi = (const f32x4*)(s5_bim + (g * 64 + n) * 16);
#pragma unroll
                    for (int q4 = 0; q4 < 4; ++q4) { const f32x4 r4 = br[q4], i4 = bi[q4];
#pragma unroll
                        for (int e = 0; e < 4; ++e) a[q4 * 4 + e] += cc.x * r4[e] - cc.y * i4[e]; }
                }
            }
            u32x4* dst = (u32x4*)(GTt + (size_t)(g * 128 + t * 16 + pp) * 256 + 128 + s * 16);
            dst[0] = (u32x4){pk2(a[0], a[1]), pk2(a[2], a[3]), pk2(a[4], a[5]), pk2(a[6], a[7])};
            dst[1] = (u32x4){pk2(a[8], a[9]), pk2(a[10], a[11]), pk2(a[12], a[13]), pk2(a[14], a[15])};
        }
    }
    SEAM(0);

    if (IN(1)) {
        pg8::Gemm g{xb, Wgu1, M, NGU, D}; pg8::StaticOrder S; S.init(M, NGU, G, bx);
        pg8::EpiSwiGLU E{act, FF, ssq + SSQ_X};
        pg8::gemm_phase<pg8::EpiSwiGLU, pg8::StaticOrder, true, true>(ldsl, g, S, E);
    }
    SEAM(1);
    if (IN(2)) {
        pg8::Gemm g{act, Wd1, M, D, FF}; pg8::StaticOrder S; S.init(M, D, G, bx);
        pg8::EpiResid E{x_prompt, x_sample, hres, hb, ssq + SSQ_H1, 0.5f};
        pg8::gemm_phase<pg8::EpiResid, pg8::StaticOrder, true, true>(ldsl, g, S, E);
    }
    SEAM(2);
    if (IN(3)) {
        { pg8::Gemm g{hb, Win, M, NINP, D}; pg8::StaticOrder S; S.init(M, NINP, G, bx);
          pg8::EpiScaleBf16 E{Pb, NINP, ssq + SSQ_H1, 1.f};
          pg8::gemm_phase<pg8::EpiScaleBf16, pg8::StaticOrder, true, true>(ldsl, g, S, E); }
        { pg8::Gemm g{memb, Wckv, MEMR, 2 * D, D}; pg8::StaticOrder S; S.init(MEMR, 2 * D, G, (bx + 64) % G);
          pg8::EpiMemKV E{out + O_MKP, out + O_MVP, kb, vbT, ssq + SSQ_MEM};
          pg8::gemm_phase<pg8::EpiMemKV, pg8::StaticOrder, true, true>(ldsl, g, S, E); }
    }
    SEAM(3);

    if (IN(4)) {
        PHASE_LOCALS;
        {
            float* zg = fl; float* kk = zg + 64 * 16; float* vv = kk + 64 * 65; float* bb = vv + 64 * 128; float* seg = bb + 64 * 65;
            for (int unit = bx; unit < 1024; unit += G) {
                const int bh = unit >> 5, c = unit & 31, b = bh >> 2, h = bh & 3;
                const size_t r0 = (size_t)b * 2048 + c * 64;
                if (tid < 128) { const int t = tid >> 1, hf = tid & 1; const u32x4 w = *(const u32x4*)(Pb + (r0 + t) * NINP + PC_ZG + hf * 8);
                    float* z = zg + t * 16 + hf * 8; z[0] = bflo(w.x); z[1] = bfhi(w.x); z[2] = bflo(w.y); z[3] = bfhi(w.y); z[4] = bflo(w.z); z[5] = bfhi(w.z); z[6] = bflo(w.w); z[7] = bfhi(w.w); }
                { const int t = tid >> 3, c8 = tid & 7; const u32x4 w = *(const u32x4*)(Pb + (r0 + t) * NINP + PC_K + h * 64 + c8 * 8);
                    float* z = kk + t * 65 + c8 * 8; z[0] = bflo(w.x); z[1] = bfhi(w.x); z[2] = bflo(w.y); z[3] = bfhi(w.y); z[4] = bflo(w.z); z[5] = bfhi(w.z); z[6] = bflo(w.w); z[7] = bfhi(w.w); }
#pragma unroll
                for (int i = 0; i < 2; ++i) { const int ch = tid + i * 512, t = ch >> 4, c8 = ch & 15; const u32x4 w = *(const u32x4*)(Pb + (r0 + t) * NINP + PC_V + h * 128 + c8 * 8);
                    float* z = vv + t * 128 + c8 * 8; z[0] = bflo(w.x); z[1] = bfhi(w.x); z[2] = bflo(w.y); z[3] = bfhi(w.y); z[4] = bflo(w.z); z[5] = bfhi(w.z); z[6] = bflo(w.w); z[7] = bfhi(w.w); }
                __syncthreads();
                gla_gate_cumsum<64>(zg, bb, seg, w_gate, b_gate, h, tid);
                for (int i = tid; i < 64 * 64; i += NTHREADS) { const int t = i >> 6, d = i & 63; kk[t * 65 + d] *= __expf(bb[63 * 65 + d] - bb[t * 65 + d]); }
                __syncthreads();
                { const int d = tid >> 3, e0 = (tid & 7) * 16; f32x4 a0 = {0, 0, 0, 0}, a1 = a0, a2 = a0, a3 = a0;
                    for (int t = 0; t < 64; ++t) { const float kd = kk[t * 65 + d]; const f32x4* vp = (const f32x4*)(vv + t * 128 + e0); a0 += vp[0] * kd; a1 += vp[1] * kd; a2 += vp[2] * kd; a3 += vp[3] * kd; }
                    f32x4* dp = (f32x4*)(glaD + (size_t)unit * 8192 + d * 128 + e0); dp[0] = a0; dp[1] = a1; dp[2] = a2; dp[3] = a3; }
                if (tid < 64) glaDec[unit * 64 + tid] = __expf(bb[63 * 65 + tid]);
                __syncthreads();
            }
        }
        {
            float* zg = fl; float* qq = zg + 8 * 16; float* kk = qq + 8 * 65; float* kt = kk + 8 * 65; float* vv = kt + 8 * 65; float* bb = vv + 8 * 128; float* sc = bb + 8 * 65; float* S0 = sc + 64;
            for (int unit = bx; unit < 512; unit += G) {
                const int b = unit >> 2, h = unit & 3; const size_t r0 = (size_t)MP + b * 8;
                if (tid < 128) { const int t = tid >> 4, r = tid & 15; zg[t * 16 + r] = bf2f(Pb[(r0 + t) * NINP + PC_ZG + r]); }
                { const int t = tid >> 6, d = tid & 63; qq[t * 65 + d] = bf2f(Pb[(r0 + t) * NINP + PC_Q + h * 64 + d]); kk[t * 65 + d] = bf2f(Pb[(r0 + t) * NINP + PC_K + h * 64 + d]); }
#pragma unroll
                for (int i = 0; i < 2; ++i) { const int idx = tid + i * 512, t = idx >> 7, e = idx & 127; vv[t * 128 + e] = bf2f(Pb[(r0 + t) * NINP + PC_V + h * 128 + e]); }
                { const f32x4* sp = (const f32x4*)(state_gla + (size_t)unit * 8192); f32x4* dp = (f32x4*)S0;
#pragma unroll
                    for (int i = 0; i < 4; ++i) dp[tid + i * 512] = sp[tid + i * 512]; }
                __syncthreads();
                gla_gate_cumsum<8>(zg, bb, nullptr, w_gate, b_gate, h, tid);
                { const int t = tid >> 6, d = tid & 63; const float bt = bb[t * 65 + d], b7 = bb[7 * 65 + d]; const float kv = kk[t * 65 + d];
                    qq[t * 65 + d] *= __expf(bt) * 0.125f; kk[t * 65 + d] = kv * __expf(-bt); kt[t * 65 + d] = kv * __expf(b7 - bt); }
                __syncthreads();
                if (tid < 64) { const int t = tid >> 3, s = tid & 7; float a = 0.f; if (s <= t) { for (int d = 0; d < 64; ++d) a += qq[t * 65 + d] * kk[s * 65 + d]; } sc[t * 8 + s] = a; }
                __syncthreads();
                {
                    const int t = wave, e0 = lane * 2; float o0 = 0.f, o1 = 0.f;
                    for (int d = 0; d < 64; ++d) { const float qd = qq[t * 65 + d]; o0 += qd * S0[d * 128 + e0]; o1 += qd * S0[d * 128 + e0 + 1]; }
                    for (int s = 0; s <= t; ++s) { const float w = sc[t * 8 + s]; o0 += w * vv[s * 128 + e0]; o1 += w * vv[s * 128 + e0 + 1]; }
                    const float ss = wave_sum(o0 * o0 + o1 * o1); const float rs = rsqrtf(ss * (1.f / 128.f) + EPS);
                    const unsigned rw = *(const unsigned*)(Pb + (r0 + t) * NINP + PC_R + h * 128 + e0);
                    const float y0 = o0 * rs * g_gla_out[e0] * siluf(bflo(rw)), y1 = o1 * rs * g_gla_out[e0 + 1] * siluf(bfhi(rw));
                    *(unsigned*)(mix + (r0 + t) * D + h * 128 + e0) = pk2(y0, y1);
                }
                {
                    const int d = tid >> 3, e0 = (tid & 7) * 16; const float dec = __expf(bb[7 * 65 + d]);
                    f32x4 a[4];
#pragma unroll
                    for (int i = 0; i < 4; ++i) a[i] = ((const f32x4*)(S0 + d * 128 + e0))[i] * dec;
#pragma unroll
                    for (int s = 0; s < 8; ++s) { const float kd = kt[s * 65 + d]; const f32x4* vp = (const f32x4*)(vv + s * 128 + e0);
#pragma unroll
                        for (int i = 0; i < 4; ++i) a[i] += vp[i] * kd; }
                    f32x4* dp = (f32x4*)(out + O_GLAS + (size_t)unit * 8192 + d * 128 + e0);
#pragma unroll
                    for (int i = 0; i < 4; ++i) dp[i] = a[i];
                }
                __syncthreads();
            }
        }
        for (int it = gw; it < 136 * 32; it += NGW) {
            const int rb = it >> 5, g = it & 31, fr = lane & 15, fq = lane >> 4; const int R0 = rb * 16;
            f32x4 acc[8];
#pragma unroll
            for (int nb = 0; nb < 8; ++nb) acc[nb] = (f32x4){0.f, 0.f, 0.f, 0.f};
#pragma unroll
            for (int ks = 0; ks < 4; ++ks) {
                const bf16x8 a = *(const bf16x8*)(Pb + ((size_t)(R0 + fr) * 8 + ks * 2 + (fq >> 1)) * NINP + PC_U + g * 16 + (fq & 1) * 8);
#pragma unroll
                for (int nb = 0; nb < 8; ++nb) { const bf16x8 bfr = *(const bf16x8*)(EgT + (size_t)(g * 128 + nb * 16 + fr) * 128 + ks * 32 + fq * 8);
                    acc[nb] = __builtin_amdgcn_mfma_f32_16x16x32_bf16(a, bfr, acc[nb], 0, 0, 0); }
            }
#pragma unroll
            for (int nb = 0; nb < 8; ++nb)
#pragma unroll
                for (int r = 0; r < 4; ++r) s5e[((size_t)(R0 + fq * 4 + r) * 32 + g) * 128 + nb * 16 + fr] = acc[nb][r];
        }
    }
    SEAM(4);

    if (IN(5)) {
        PHASE_LOCALS;
        for (int idx = gt; idx < 32 * 8192; idx += NGT) {
            const int bh = idx >> 13, de = idx & 8191, d = de >> 7; float S = 0.f;
#pragma unroll 8
            for (int c = 0; c < 32; ++c) { const int unit = bh * 32 + c; float* p = glaD + (size_t)unit * 8192 + de; const float Dv = *p; const float dec = glaDec[unit * 64 + d]; *p = S; S = dec * S + Dv; }
            out[O_GLAP + idx] = S;
        }
        if (wave == 0) {
            for (int it = bx; it < 256; it += G) {
                const int b = it >> 5, g = it & 31, n = lane;
                const S5P p = s5_par(s5_lre, s5_lim, s5_logdt, g, n); const f32x2 a8 = s5_pow(p, 8);
                float xr = 0.f, xi = 0.f;
#pragma unroll 16
                for (int c = 0; c < 256; ++c) {
                    const size_t R = (size_t)b * 256 + c; const size_t o = (R * 32 + g) * 128;
                    s5x[o + n] = (bf16_t)f2bf(xr); s5x[o + 64 + n] = (bf16_t)f2bf(xi);
                    const float er = s5e[o + n], ei = s5e[o + 64 + n];
                    const float nr = a8.x * xr - a8.y * xi + er, ni = a8.x * xi + a8.y * xr + ei; xr = nr; xi = ni;
                }
                out[O_REP + (b * 32 + g) * 64 + n] = xr; out[O_IMP + (b * 32 + g) * 64 + n] = xi;
            }
        }
        for (int idx = gt; idx < 128 * 32 * 64; idx += NGT) {
            const int b = idx >> 11, g = (idx >> 6) & 31, n = idx & 63;
            const S5P p = s5_par(s5_lre, s5_lim, s5_logdt, g, n); const f32x2 a8 = s5_pow(p, 8);
            const float xr = st_re[idx], xi = st_im[idx];
            const size_t R = 2048 + b; const size_t o = (R * 32 + g) * 128;
            s5x[o + n] = (bf16_t)f2bf(xr); s5x[o + 64 + n] = (bf16_t)f2bf(xi);
            out[O_RES + idx] = a8.x * xr - a8.y * xi + s5e[o + n]; out[O_IMS + idx] = a8.x * xi + a8.y * xr + s5e[o + 64 + n];
        }
    }
    SEAM(5);

    if (IN(6)) {
        PHASE_LOCALS;
        {
            float* zg = fl; float* qq = zg + 64 * 16; float* kk = qq + 64 * 65; float* vv = kk + 64 * 65; float* bb = vv + 64 * 128; float* sc = bb + 64 * 65; float* Sp = sc + 64 * 65; float* seg = Sp + 64 * 128;
            for (int unit = bx; unit < 1024; unit += G) {
                const int bh = unit >> 5, c = unit & 31, b = bh >> 2, h = bh & 3;
                const size_t r0 = (size_t)b * 2048 + c * 64;
                if (tid < 128) { const int t = tid >> 1, hf = tid & 1; const u32x4 w = *(const u32x4*)(Pb + (r0 + t) * NINP + PC_ZG + hf * 8);
                    float* z = zg + t * 16 + hf * 8; z[0] = bflo(w.x); z[1] = bfhi(w.x); z[2] = bflo(w.y); z[3] = bfhi(w.y); z[4] = bflo(w.z); z[5] = bfhi(w.z); z[6] = bflo(w.w); z[7] = bfhi(w.w); }
                { const int t = tid >> 3, c8 = tid & 7;
                    const u32x4 w = *(const u32x4*)(Pb + (r0 + t) * NINP + PC_K + h * 64 + c8 * 8);
                    float* z = kk + t * 65 + c8 * 8; z[0] = bflo(w.x); z[1] = bfhi(w.x); z[2] = bflo(w.y); z[3] = bfhi(w.y); z[4] = bflo(w.z); z[5] = bfhi(w.z); z[6] = bflo(w.w); z[7] = bfhi(w.w);
                    const u32x4 wq = *(const u32x4*)(Pb + (r0 + t) * NINP + PC_Q + h * 64 + c8 * 8);
                    float* y = qq + t * 65 + c8 * 8; y[0] = bflo(wq.x); y[1] = bfhi(wq.x); y[2] = bflo(wq.y); y[3] = bfhi(wq.y); y[4] = bflo(wq.z); y[5] = bfhi(wq.z); y[6] = bflo(wq.w); y[7] = bfhi(wq.w); }
#pragma unroll
                for (int i = 0; i < 2; ++i) { const int ch = tid + i * 512, t = ch >> 4, c8 = ch & 15; const u32x4 w = *(const u32x4*)(Pb + (r0 + t) * NINP + PC_V + h * 128 + c8 * 8);
                    float* z = vv + t * 128 + c8 * 8; z[0] = bflo(w.x); z[1] = bfhi(w.x); z[2] = bflo(w.y); z[3] = bfhi(w.y); z[4] = bflo(w.z); z[5] = bfhi(w.z); z[6] = bflo(w.w); z[7] = bfhi(w.w); }
                { const f32x4* sp = (const f32x4*)(glaD + (size_t)unit * 8192); f32x4* dp = (f32x4*)Sp;
#pragma unroll
                    for (int i = 0; i < 4; ++i) dp[tid + i * 512] = sp[tid + i * 512]; }
                __syncthreads();
                gla_gate_cumsum<64>(zg, bb, seg, w_gate, b_gate, h, tid);
                for (int i = tid; i < 64 * 64; i += NTHREADS) { const int t = i >> 6, d = i & 63; const float bt = bb[t * 65 + d]; qq[t * 65 + d] *= __expf(bt) * 0.125f; kk[t * 65 + d] *= __expf(-bt); }
                __syncthreads();
                { const int t = tid >> 3, s0 = (tid & 7) * 8;
#pragma unroll
                    for (int j = 0; j < 8; ++j) { const int s = s0 + j; float a = 0.f; if (s <= t) { for (int d = 0; d < 64; ++d) a += qq[t * 65 + d] * kk[s * 65 + d]; } sc[t * 65 + s] = a; } }
                __syncthreads();
                { const int t = tid >> 3, e0 = (tid & 7) * 16; f32x4 a[4];
#pragma unroll
                    for (int i = 0; i < 4; ++i) a[i] = (f32x4){0.f, 0.f, 0.f, 0.f};
                    for (int d = 0; d < 64; ++d) { const float qd = qq[t * 65 + d]; const f32x4* sp = (const f32x4*)(Sp + d * 128 + e0);
#pragma unroll
                        for (int i = 0; i < 4; ++i) a[i] += sp[i] * qd; }
                    for (int s = 0; s <= t; ++s) { const float w = sc[t * 65 + s]; const f32x4* vp = (const f32x4*)(vv + s * 128 + e0);
#pragma unroll
                        for (int i = 0; i < 4; ++i) a[i] += vp[i] * w; }
                    float ss = 0.f;
#pragma unroll
                    for (int i = 0; i < 4; ++i) ss += (a[i][0] * a[i][0] + a[i][1] * a[i][1]) + (a[i][2] * a[i][2] + a[i][3] * a[i][3]);
                    ss += __shfl_xor(ss, 1); ss += __shfl_xor(ss, 2); ss += __shfl_xor(ss, 4);
                    const float rs = rsqrtf(ss * (1.f / 128.f) + EPS);
                    const u32x4* rp = (const u32x4*)(Pb + (r0 + t) * NINP + PC_R + h * 128 + e0); const f32x4* gp = (const f32x4*)(g_gla_out + e0);
                    u32x4* mp = (u32x4*)(mix + (r0 + t) * D + h * 128 + e0);
#pragma unroll
                    for (int hf = 0; hf < 2; ++hf) { const u32x4 rw = rp[hf]; const f32x4 g0 = gp[hf * 2], g1 = gp[hf * 2 + 1]; const f32x4 x0 = a[hf * 2] * rs * g0, x1 = a[hf * 2 + 1] * rs * g1;
                        u32x4 w; w.x = pk2(x0[0] * siluf(bflo(rw.x)), x0[1] * siluf(bfhi(rw.x))); w.y = pk2(x0[2] * siluf(bflo(rw.y)), x0[3] * siluf(bfhi(rw.y)));
                        w.z = pk2(x1[0] * siluf(bflo(rw.z)), x1[1] * siluf(bfhi(rw.z))); w.w = pk2(x1[2] * siluf(bflo(rw.w)), x1[3] * siluf(bfhi(rw.w))); mp[hf] = w; }
                }
                __syncthreads();
            }
        }
        for (int it = gw; it < 136 * 32; it += NGW) {
            const int rb = it >> 5, g = it & 31, fr = lane & 15, fq = lane >> 4; const int R0 = rb * 16;
            f32x4 acc[8];
#pragma unroll
            for (int nb = 0; nb < 8; ++nb) acc[nb] = (f32x4){0.f, 0.f, 0.f, 0.f};
#pragma unroll 1
            for (int ks = 0; ks < 8; ++ks) {
                bf16x8 a;
                if (ks < 4) a = *(const bf16x8*)(s5x + ((size_t)(R0 + fr) * 32 + g) * 128 + ks * 32 + fq * 8);
                else a = *(const bf16x8*)(Pb + ((size_t)(R0 + fr) * 8 + (ks - 4) * 2 + (fq >> 1)) * NINP + PC_U + g * 16 + (fq & 1) * 8);
#pragma unroll
                for (int nb = 0; nb < 8; ++nb) { const bf16x8 bfr = *(const bf16x8*)(GTt + (size_t)(g * 128 + nb * 16 + fr) * 256 + ks * 32 + fq * 8);
                    acc[nb] = __builtin_amdgcn_mfma_f32_16x16x32_bf16(bfr, a, acc[nb], 0, 0, 0); }
            }
            bf16x4 wA;
#pragma unroll
            for (int i = 0; i < 4; ++i) wA[i] = (short)f2bf(s5_wglu[(g * 16 + fq * 4 + i) * 16 + fr]);
            const f32x4 dsk = *(const f32x4*)(s5_d + g * 16 + fq * 4), bgl = *(const f32x4*)(s5_bglu + g * 16 + fq * 4);
#pragma unroll
            for (int nb = 0; nb < 8; ++nb) {
                const size_t row = (size_t)(R0 + fr) * 8 + nb;
                const u32x2 uw = *(const u32x2*)(Pb + row * NINP + PC_U + g * 16 + fq * 4);
                f32x4 z;
                z[0] = gelu_tanh(acc[nb][0] + dsk[0] * bflo(uw.x)); z[1] = gelu_tanh(acc[nb][1] + dsk[1] * bfhi(uw.x));
                z[2] = gelu_tanh(acc[nb][2] + dsk[2] * bflo(uw.y)); z[3] = gelu_tanh(acc[nb][3] + dsk[3] * bfhi(uw.y));
                const u32x2 zp = (u32x2){pk2(z[0], z[1]), pk2(z[2], z[3])};
                const f32x4 pre = __builtin_amdgcn_mfma_f32_16x16x16bf16_1k(wA, __builtin_bit_cast(bf16x4, zp), bgl, 0, 0, 0);
                u32x2 o; o.x = pk2(z[0] * sigmoidf_fast(pre[0]), z[1] * sigmoidf_fast(pre[1])); o.y = pk2(z[2] * sigmoidf_fast(pre[2]), z[3] * sigmoidf_fast(pre[3]));
                *(u32x2*)(mix + row * D + 512 + g * 16 + fq * 4) = o;
            }
        }
    }
    SEAM(6);

    if (IN(7)) {
        pg8::Gemm g{mix, Wout, M, D, D}; pg8::StaticOrder S; S.init(M, D, G, bx);
        pg8::EpiResid E{hres, hres + (size_t)MP * D, hres, hb, ssq + SSQ_H2, 1.f};
        pg8::gemm_phase<pg8::EpiResid, pg8::StaticOrder, true, true>(ldsl, g, S, E);
    }
    SEAM(7);
    if (IN(8)) {
        pg8::Gemm g{hb, Wcq, M, D, D}; pg8::StaticOrder S; S.init(M, D, G, bx);
        pg8::EpiScaleBf16 E{qb, D, ssq + SSQ_H2, 0.0625f};
        pg8::gemm_phase<pg8::EpiScaleBf16, pg8::StaticOrder, true, true>(ldsl, g, S, E);
    }
    SEAM(8);

    if (IN(9)) {
        PHASE_LOCALS;
        constexpr int QS = 264;
        bf16_t* Qs = (bf16_t*)lds; bf16_t* Ps = Qs + 64 * QS; float* redmax = (float*)(Ps + 64 * QS); float* redsum = redmax + 64 * 8;
        const int fr = lane & 15, fq = lane >> 4, w = wave;
        for (int unit = bx; unit < 1024 + 512; unit += G) {
            const bool smp = unit >= 1024;
            int b, h; size_t r0; int nrows;
            if (!smp) { const int qt = unit & 31; h = (unit >> 5) & 3; b = unit >> 7; r0 = (size_t)b * 2048 + qt * 64; nrows = 64; }
            else { const int u2 = unit - 1024; h = u2 & 3; b = u2 >> 2; r0 = (size_t)MP + b * 8; nrows = 8; }
            const int MB = smp ? 1 : 4;
            for (int ch = tid; ch < MB * 16 * 32; ch += NTHREADS) { const int row = ch >> 5, c8 = ch & 31; u32x4 v = (u32x4){0u, 0u, 0u, 0u};
                if (row < nrows) v = *(const u32x4*)(qb + (r0 + row) * D + h * 256 + c8 * 8);
                *(u32x4*)(Qs + row * QS + c8 * 8) = v; }
            __syncthreads();
            f32x4 sa[4][2];
#pragma unroll
            for (int mb = 0; mb < 4; ++mb) { sa[mb][0] = (f32x4){0.f, 0.f, 0.f, 0.f}; sa[mb][1] = sa[mb][0]; }
            if (!smp) {
                const bf16_t* kbase = kb + ((size_t)b * 256 + w * 32 + fr) * D + h * 256 + fq * 8;
#pragma unroll
                for (int ks = 0; ks < 8; ++ks) {
                    const bf16x8 b0 = *(const bf16x8*)(kbase + ks * 32), b1 = *(const bf16x8*)(kbase + (size_t)16 * D + ks * 32);
#pragma unroll
                    for (int mb = 0; mb < 4; ++mb) { const bf16x8 a = *(const bf16x8*)(Qs + (mb * 16 + fr) * QS + ks * 32 + fq * 8);
                        sa[mb][0] = __builtin_amdgcn_mfma_f32_16x16x32_bf16(a, b0, sa[mb][0], 0, 0, 0); sa[mb][1] = __builtin_amdgcn_mfma_f32_16x16x32_bf16(a, b1, sa[mb][1], 0, 0, 0); }
                }
            } else {
                const float* kbase = cache_k + ((size_t)b * 256 + w * 32 + fr) * D + h * 256 + fq * 8;
#pragma unroll
                for (int ks = 0; ks < 8; ++ks) {
                    u32x4 p0, p1;
                    { const f32x4 x0 = *(const f32x4*)(kbase + ks * 32), x1 = *(const f32x4*)(kbase + ks * 32 + 4); p0 = (u32x4){pk2(x0[0], x0[1]), pk2(x0[2], x0[3]), pk2(x1[0], x1[1]), pk2(x1[2], x1[3])}; }
                    { const f32x4 x0 = *(const f32x4*)(kbase + (size_t)16 * D + ks * 32), x1 = *(const f32x4*)(kbase + (size_t)16 * D + ks * 32 + 4); p1 = (u32x4){pk2(x0[0], x0[1]), pk2(x0[2], x0[3]), pk2(x1[0], x1[1]), pk2(x1[2], x1[3])}; }
                    const bf16x8 a = *(const bf16x8*)(Qs + fr * QS + ks * 32 + fq * 8);
                    sa[0][0] = __builtin_amdgcn_mfma_f32_16x16x32_bf16(a, __builtin_bit_cast(bf16x8, p0), sa[0][0], 0, 0, 0);
                    sa[0][1] = __builtin_amdgcn_mfma_f32_16x16x32_bf16(a, __builtin_bit_cast(bf16x8, p1), sa[0][1], 0, 0, 0);
                }
            }
#pragma unroll
            for (int mb = 0; mb < 4; ++mb) if (mb < MB) {
#pragma unroll
                for (int r = 0; r < 4; ++r) { float mx = fmaxf(sa[mb][0][r], sa[mb][1][r]);
                    mx = fmaxf(mx, __shfl_xor(mx, 1)); mx = fmaxf(mx, __shfl_xor(mx, 2)); mx = fmaxf(mx, __shfl_xor(mx, 4)); mx = fmaxf(mx, __shfl_xor(mx, 8));
                    if (fr == 0) redmax[(mb * 16 + fq * 4 + r) * 8 + w] = mx; }
            }
            __syncthreads();
#pragma unroll
            for (int mb = 0; mb < 4; ++mb) if (mb < MB) {
#pragma unroll
                for (int r = 0; r < 4; ++r) { const int q = mb * 16 + fq * 4 + r; const f32x4 m0 = *(const f32x4*)(redmax + q * 8), m1 = *(const f32x4*)(redmax + q * 8 + 4);
                    const float mx = fmaxf(fmaxf(fmaxf(m0[0], m0[1]), fmaxf(m0[2], m0[3])), fmaxf(fmaxf(m1[0], m1[1]), fmaxf(m1[2], m1[3])));
                    const float p0 = __expf(sa[mb][0][r] - mx), p1 = __expf(sa[mb][1][r] - mx);
                    Ps[q * QS + w * 32 + fr] = (bf16_t)f2bf(p0); Ps[q * QS + w * 32 + 16 + fr] = (bf16_t)f2bf(p1);
                    float sm = p0 + p1; sm += __shfl_xor(sm, 1); sm += __shfl_xor(sm, 2); sm += __shfl_xor(sm, 4); sm += __shfl_xor(sm, 8);
                    if (fr == 0) redsum[q * 8 + w] = sm; }
            }
            __syncthreads();
            f32x4 oa[4][2];
#pragma unroll
            for (int mb = 0; mb < 4; ++mb) { oa[mb][0] = (f32x4){0.f, 0.f, 0.f, 0.f}; oa[mb][1] = oa[mb][0]; }
            if (!smp) {
                const bf16_t* vbase = vbT + ((size_t)b * D + h * 256 + w * 32 + fr) * 256 + fq * 8;
#pragma unroll
                for (int ks = 0; ks < 8; ++ks) {
                    const bf16x8 b0 = *(const bf16x8*)(vbase + ks * 32), b1 = *(const bf16x8*)(vbase + 16 * 256 + ks * 32);
#pragma unroll
                    for (int mb = 0; mb < 4; ++mb) { const bf16x8 a = *(const bf16x8*)(Ps + (mb * 16 + fr) * QS + ks * 32 + fq * 8);
                        oa[mb][0] = __builtin_amdgcn_mfma_f32_16x16x32_bf16(a, b0, oa[mb][0], 0, 0, 0); oa[mb][1] = __builtin_amdgcn_mfma_f32_16x16x32_bf16(a, b1, oa[mb][1], 0, 0, 0); }
                }
            } else {
                const float* vbase = cache_v + ((size_t)b * 256 + fq * 8) * D + h * 256 + w * 32 + fr;
#pragma unroll
                for (int ks = 0; ks < 8; ++ks) {
                    float x0[8], x1[8];
#pragma unroll
                    for (int j = 0; j < 8; ++j) { x0[j] = vbase[(size_t)(ks * 32 + j) * D]; x1[j] = vbase[(size_t)(ks * 32 + j) * D + 16]; }
                    const u32x4 p0 = (u32x4){pk2(x0[0], x0[1]), pk2(x0[2], x0[3]), pk2(x0[4], x0[5]), pk2(x0[6], x0[7])};
                    const u32x4 p1 = (u32x4){pk2(x1[0], x1[1]), pk2(x1[2], x1[3]), pk2(x1[4], x1[5]), pk2(x1[6], x1[7])};
                    const bf16x8 a = *(const bf16x8*)(Ps + fr * QS + ks * 32 + fq * 8);
                    oa[0][0] = __builtin_amdgcn_mfma_f32_16x16x32_bf16(a, __builtin_bit_cast(bf16x8, p0), oa[0][0], 0, 0, 0);
                    oa[0][1] = __builtin_amdgcn_mfma_f32_16x16x32_bf16(a, __builtin_bit_cast(bf16x8, p1), oa[0][1], 0, 0, 0);
                }
            }
#pragma unroll
            for (int mb = 0; mb < 4; ++mb) if (mb < MB) {
#pragma unroll
                for (int r = 0; r < 4; ++r) { const int q = mb * 16 + fq * 4 + r; if (q < nrows) {
                    const f32x4 s0 = *(const f32x4*)(redsum + q * 8), s1 = *(const f32x4*)(redsum + q * 8 + 4);
                    const float inv = 1.f / (((s0[0] + s0[1]) + (s0[2] + s0[3])) + ((s1[0] + s1[1]) + (s1[2] + s1[3])));
                    bf16_t* op = ob + (r0 + q) * D + h * 256 + w * 32 + fr;
                    op[0] = (bf16_t)f2bf(oa[mb][0][r] * inv); op[16] = (bf16_t)f2bf(oa[mb][1][r] * inv); } }
            }
            __syncthreads();
        }
    }
    SEAM(9);

    if (IN(10)) {
        pg8::Gemm g{ob, Wco, M, D, D}; pg8::StaticOrder S; S.init(M, D, G, bx);
        pg8::EpiResid E{hres, hres + (size_t)MP * D, hres, hb, ssq + SSQ_H3, 1.f};
        pg8::gemm_phase<pg8::EpiResid, pg8::StaticOrder, true, true>(ldsl, g, S, E);
    }
    SEAM(10);
    if (IN(11)) {
        pg8::Gemm g{hb, Wgu2, M, NGU, D}; pg8::StaticOrder S; S.init(M, NGU, G, bx);
        pg8::EpiSwiGLU E{act, FF, ssq + SSQ_H3};
        pg8::gemm_phase<pg8::EpiSwiGLU, pg8::StaticOrder, true, true>(ldsl, g, S, E);
    }
    SEAM(11);
    if (IN(12)) {
        pg8::Gemm g{act, Wd2, M, D, FF}; pg8::StaticOrder S; S.init(M, D, G, bx);
        pg8::EpiResid E{hres, hres + (size_t)MP * D, out + O_Y, nullptr, nullptr, 0.5f};
        pg8::gemm_phase<pg8::EpiResid, pg8::StaticOrder, true, true>(ldsl, g, S, E);
    }
    SEAM(12);
    if (IN(13)) {
        PHASE_LOCALS;
        for (int m = gw; m < M; m += NGW) {
            f32x4* yr = (f32x4*)(out + O_Y + (size_t)m * D) + lane; f32x4 v[4]; float s = 0.f;
#pragma unroll
            for (int j = 0; j < 4; ++j) { v[j] = yr[64 * j]; s += (v[j].x * v[j].x + v[j].y * v[j].y) + (v[j].z * v[j].z + v[j].w * v[j].w); }
            const float rs = rsqrtf(wave_sum(s) * (1.f / D) + EPS);
#pragma unroll
            for (int j = 0; j < 4; ++j) { const f32x4 gq = ((const f32x4*)g_final)[lane + 64 * j]; yr[64 * j] = v[j] * rs * gq; }
        }
    }
#undef IN
#undef SEAM
}

extern "C" void kernel_launch(void* const* d_in, const int* in_sizes, int n_in, void* d_out, int out_size, void* d_ws, size_t ws_size, hipStream_t stream) {
    static int grid = 0;
    if (grid == 0) {
        if (n_in != 36 || (size_t)out_size != O_TOTAL || ws_size < WS_END) { fprintf(stderr, "kernel_launch: unexpected shapes (n_in %d, out %d, ws %zu)\n", n_in, out_size, ws_size); grid = -1; return; }
        int dev = 0, cus = 0, per_cu = 0;
        hipGetDevice(&dev); hipDeviceGetAttribute(&cus, hipDeviceAttributeMultiprocessorCount, dev);
        hipFuncSetAttribute((const void*)hymba_fwd, hipFuncAttributeMaxDynamicSharedMemorySize, LDS_BYTES);
        hipOccupancyMaxActiveBlocksPerMultiprocessor(&per_cu, (const void*)hymba_fwd, NTHREADS, LDS_BYTES);
        if (per_cu < 1) { fprintf(stderr, "kernel_launch: occupancy query says %d blocks per CU\n", per_cu); per_cu = 1; }
        grid = cus;
        (void)hipGetLastError();
    }
    if (grid < 0) return;
    Args a{};
    for (int i = 0; i < 36; ++i) a.in[i] = (const float*)d_in[i];
    a.out = (float*)d_out; a.ws = (unsigned char*)d_ws; a.ph_lo = 0; a.ph_hi = 14;
    void* params[] = {&a};
    hipError_t e = hipLaunchCooperativeKernel((const void*)hymba_fwd, dim3(grid), dim3(NTHREADS), params, LDS_BYTES, stream);
    if (e != hipSuccess) fprintf(stderr, "kernel_launch: cooperative launch failed: %s (grid %d)\n", hipGetErrorString(e), grid);
}
```

```cpp
#include <hip/hip_runtime.h>
#include <hip/hip_cooperative_groups.h>
#include <cstdio>
#include <cstdint>
namespace cg = cooperative_groups;

constexpr int D = 1024, MP = 16384, MS = 1024, M = MP + MS, FF = 2816, NGU = 2 * FF, NIN = 2064, NINP = 2304;
constexpr int MEMR = 2048;
constexpr float EPS = 1e-6f;
constexpr int PC_Q = 0, PC_K = 256, PC_V = 512, PC_R = 1024, PC_U = 1536, PC_ZG = 2048;
constexpr size_t O_Y = 0, O_GLAP = 17825792, O_REP = 18087936, O_IMP = 18104320, O_MKP = 18120704, O_MVP = 20217856,
                 O_GLAS = 22315008, O_RES = 26509312, O_IMS = 26771456, O_TOTAL = 27033600;
constexpr size_t MiB = 1u << 20;
constexpr int XCD_BAR_WORDS_C = 3456;
constexpr size_t WS_SSQ = 0;
constexpr size_t WS_WGU1 = 1 * MiB, WS_WD1 = 12 * MiB, WS_WIN = 18 * MiB, WS_WOUT = 23 * MiB, WS_WCQ = 25 * MiB, WS_WCKV = 27 * MiB,
                 WS_WCO = 31 * MiB, WS_WGU2 = 33 * MiB, WS_WD2 = 44 * MiB, WS_EGT = 50 * MiB, WS_GTT = 51 * MiB, WS_MEMB = 53 * MiB,
                 WS_KB = 57 * MiB, WS_VBT = 61 * MiB, WS_XB = 65 * MiB, WS_HB = 99 * MiB, WS_H = 133 * MiB, WS_ACT = 201 * MiB,
                 WS_MIX = 295 * MiB, WS_Q = 329 * MiB, WS_O = 363 * MiB, WS_GLAD = 397 * MiB, WS_GLADEC = 429 * MiB, WS_S5E = 430 * MiB,
                 WS_S5X = 464 * MiB, WS_END = 481 * MiB;
constexpr int SSQ_X = 0, SSQ_MEM = M, SSQ_H1 = M + 2048, SSQ_H2 = 2 * M + 2048, SSQ_H3 = 3 * M + 2048, SSQ_WORDS = 4 * M + 2048;
static_assert((size_t)SSQ_WORDS * 4 <= MiB, "ssq region");
static_assert(WS_ACT + (size_t)M * FF * 2 <= WS_MIX && WS_ACT + (size_t)M * NINP * 2 <= WS_MIX, "act / P region");

constexpr size_t WS_BAR = 512 * 1024, BAR_BYTES = 16384;
static_assert((size_t)SSQ_WORDS * 4 <= WS_BAR && XCD_BAR_WORDS_C * 4 <= BAR_BYTES, "ctl map");
constexpr int NWAVES = 8, NTHREADS = 512;
constexpr int LDS_BYTES = 147456;
constexpr int LDS_BARST = LDS_BYTES - 64;

#define LAS __attribute__((address_space(3)))
typedef unsigned short bf16_t;
typedef short bf16x8 __attribute__((ext_vector_type(8)));
typedef short bf16x4 __attribute__((ext_vector_type(4)));
typedef float f32x4 __attribute__((ext_vector_type(4)));
typedef float f32x2 __attribute__((ext_vector_type(2)));
typedef unsigned u32x4 __attribute__((ext_vector_type(4)));
typedef unsigned u32x2 __attribute__((ext_vector_type(2)));
#define DI __device__ __forceinline__

DI unsigned f2bf(float f) { unsigned u = __builtin_bit_cast(unsigned, f); return (u + 0x7fffu + ((u >> 16) & 1u)) >> 16; }
DI unsigned pk2(float lo, float hi) { return f2bf(lo) | (f2bf(hi) << 16); }
DI float bf2f(unsigned b) { return __builtin_bit_cast(float, b << 16); }
DI float bflo(unsigned w) { return __builtin_bit_cast(float, w << 16); }
DI float bfhi(unsigned w) { return __builtin_bit_cast(float, w & 0xffff0000u); }
DI float wave_sum(float v) {
#pragma unroll
    for (int o = 1; o < 64; o <<= 1) v += __shfl_xor(v, o);
    return v;
}
DI float sigmoidf_fast(float x) { return __builtin_amdgcn_rcpf(1.f + __expf(-x)); }
DI float siluf(float x) { return x * sigmoidf_fast(x); }
DI float logsigmoidf(float x) { return fminf(x, 0.f) - log1pf(__expf(-fabsf(x))); }
DI float gelu_tanh(float y) { const float a = 0.7978845608028654f * (y + 0.044715f * y * y * y); const float e = __expf(2.f * a); const float th = 1.f - 2.f * __builtin_amdgcn_rcpf(e + 1.f); return 0.5f * y * (1.f + th); }

namespace pg8 {
#define PG8_LAS __attribute__((address_space(3)))
constexpr int BM = 256, BK = 64, HALF = 128, HTB = HALF * BK * 2  , STAGE_BYTES = 8 * HTB, NXCD = 8, WGM = 8;

__host__ __device__ __forceinline__ int lds_byte(int r, int c) { const int st = (r >> 4) * 2 + (c >> 5), rr = r & 15, cc = c & 31, ob = rr * 64 + cc * 2; return st * 1024 + (ob ^ (((ob >> 9) & 1) << 5)); }
__host__ __device__ __forceinline__ void stage_rc(int b, int& R, int& C) { const int st = b / 1024, sb = b % 1024, swz = sb ^ (((sb >> 9) & 1) << 5); R = (st >> 1) * 16 + swz / 64; C = (st & 1) * 32 + (swz % 64) / 2; }
__host__ __device__ __forceinline__ int perm32(int rho) { const int n = rho >> 4, i = rho & 15; return 8 * (i >> 2) + 4 * n + (i & 3); }

struct Unit { int pm, pn; };
struct Gemm { const bf16_t* A; const bf16_t* Bt; int M, N, K; };

struct StaticOrder {
    int nM, nN, nwg, G, c;
    __host__ __device__ void init(int M_, int N_, int G_, int c_) { nM = M_ / BM; nN = N_ / BM; nwg = nM * nN; G = G_; c = c_; }
    __host__ __device__ bool next(int i, Unit& u) const {
        const long L = (long)i * G + c; if (L >= nwg) return false;
        int wgid = (int)L; { const int q = nwg / NXCD, r = nwg % NXCD, xcd = wgid % NXCD, off = wgid / NXCD; wgid = (xcd < r ? xcd * (q + 1) : r * (q + 1) + (xcd - r) * q) + off; }
        const int nig = WGM * nN, gid = wgid / nig, fm = gid * WGM, gsz = (nM - fm) < WGM ? (nM - fm) : WGM;
        u.pm = fm + ((wgid % nig) % gsz); u.pn = (wgid % nig) / gsz; return true;
    }
    __device__ __forceinline__ void a_ready(const Unit&) const {}
    __device__ __forceinline__ void done(const Unit&) const {}
};

__device__ __forceinline__ unsigned cvt_pk_bf16(float lo, float hi) { unsigned r; asm volatile("v_cvt_pk_bf16_f32 %0, %1, %2" : "=v"(r) : "v"(lo), "v"(hi)); return r; }


struct EpiSwiGLU {
    static constexpr bool PERM = true, AFTER_DRAIN = false;
    bf16_t* O; int ldc; const float* ssq;
    __device__ __forceinline__ void operator()(const f32x4 (&acc)[2][2][4][2], const Unit& u, int wr, int wc, int fr, int fq) const {
        const int row0 = u.pm * BM + wr * 64 + fr, col0 = u.pn * HALF + wc * 32 + 8 * fq;
#pragma unroll
        for (int ai = 0; ai < 2; ++ai)
#pragma unroll
            for (int m = 0; m < 4; ++m) {
                const int row = row0 + ai * HALF + m * 16;
                const float rs = rsqrtf(ssq[row] * (1.f / D) + EPS);
                const f32x4 g0 = acc[ai][0][m][0] * rs, g1 = acc[ai][0][m][1] * rs, u0 = acc[ai][1][m][0] * rs, u1 = acc[ai][1][m][1] * rs;
                u32x4 w;
                w.x = cvt_pk_bf16(siluf(g0[0]) * u0[0], siluf(g0[1]) * u0[1]); w.y = cvt_pk_bf16(siluf(g0[2]) * u0[2], siluf(g0[3]) * u0[3]);
                w.z = cvt_pk_bf16(siluf(g1[0]) * u1[0], siluf(g1[1]) * u1[1]); w.w = cvt_pk_bf16(siluf(g1[2]) * u1[2], siluf(g1[3]) * u1[3]);
                *(u32x4*)(O + (size_t)row * ldc + col0) = w;
            }
    }
};
struct EpiResid {
    static constexpr bool PERM = false, AFTER_DRAIN = false;
    const float* base0; const float* base1; float* out; bf16_t* hb; float* ssq; float alpha;
    __device__ __forceinline__ void operator()(const f32x4 (&acc)[2][2][4][2], const Unit& u, int wr, int wc, int fr, int fq) const {
        const int row0 = u.pm * BM + wr * 64 + fr, col0 = u.pn * BM + wc * 32 + 4 * fq;
#pragma unroll
        for (int ai = 0; ai < 2; ++ai)
#pragma unroll
            for (int m = 0; m < 4; ++m) {
                const int row = row0 + ai * HALF + m * 16;
                const float* bp = (row < MP) ? base0 + (size_t)row * D : base1 + (size_t)(row - MP) * D;
                float s = 0.f;
#pragma unroll
                for (int bj = 0; bj < 2; ++bj)
#pragma unroll
                    for (int n = 0; n < 2; ++n) {
                        const int c = col0 + bj * HALF + n * 16;
                        const f32x4 v = *(const f32x4*)(bp + c) + acc[ai][bj][m][n] * alpha;
                        *(f32x4*)(out + (size_t)row * D + c) = v;
                        s += (v[0] * v[0] + v[1] * v[1]) + (v[2] * v[2] + v[3] * v[3]);
                        if (hb) { u32x2 w; w.x = cvt_pk_bf16(v[0], v[1]); w.y = cvt_pk_bf16(v[2], v[3]); *(u32x2*)(hb + (size_t)row * D + c) = w; }
                    }
                if (ssq) { s += __shfl_xor(s, 16); s += __shfl_xor(s, 32); if (fq == 0) atomicAdd(ssq + row, s); }
            }
    }
};
struct EpiScaleBf16 {
    static constexpr bool PERM = true, AFTER_DRAIN = false;
    bf16_t* O; int ldc; const float* ssq; float scale;
    __device__ __forceinline__ void operator()(const f32x4 (&acc)[2][2][4][2], const Unit& u, int wr, int wc, int fr, int fq) const {
        const int row0 = u.pm * BM + wr * 64 + fr, col0 = u.pn * BM + wc * 32 + 8 * fq;
#pragma unroll
        for (int ai = 0; ai < 2; ++ai)
#pragma unroll
            for (int m = 0; m < 4; ++m) {
                const int row = row0 + ai * HALF + m * 16;
                const float rs = rsqrtf(ssq[row] * (1.f / D) + EPS) * scale;
#pragma unroll
                for (int bj = 0; bj < 2; ++bj) {
                    const f32x4 v0 = acc[ai][bj][m][0] * rs, v1 = acc[ai][bj][m][1] * rs;
                    u32x4 w; w.x = cvt_pk_bf16(v0[0], v0[1]); w.y = cvt_pk_bf16(v0[2], v0[3]); w.z = cvt_pk_bf16(v1[0], v1[1]); w.w = cvt_pk_bf16(v1[2], v1[3]);
                    *(u32x4*)(O + (size_t)row * ldc + col0 + bj * HALF) = w;
                }
            }
    }
};
struct EpiMemKV {
    static constexpr bool PERM = false, AFTER_DRAIN = false;
    float* outK; float* outV; bf16_t* kb; bf16_t* vbT; const float* ssq;
    __device__ __forceinline__ void operator()(const f32x4 (&acc)[2][2][4][2], const Unit& u, int wr, int wc, int fr, int fq) const {
        const int row0 = u.pm * BM + wr * 64 + fr; const bool isV = u.pn >= 4; const int col0 = (u.pn & 3) * BM + wc * 32 + 4 * fq;
        float* outp = isV ? outV : outK;
#pragma unroll
        for (int ai = 0; ai < 2; ++ai)
#pragma unroll
            for (int m = 0; m < 4; ++m) {
                const int row = row0 + ai * HALF + m * 16;
                const float rs = rsqrtf(ssq[row] * (1.f / D) + EPS);
                const int b = row >> 8, key = row & 255;
#pragma unroll
                for (int bj = 0; bj < 2; ++bj)
#pragma unroll
                    for (int n = 0; n < 2; ++n) {
                        const int c = col0 + bj * HALF + n * 16;
                        const f32x4 v = acc[ai][bj][m][n] * rs;
                        *(f32x4*)(outp + (size_t)row * D + c) = v;
                        if (!isV) { u32x2 w; w.x = cvt_pk_bf16(v[0], v[1]); w.y = cvt_pk_bf16(v[2], v[3]); *(u32x2*)(kb + (size_t)row * D + c) = w; }
                        else {
#pragma unroll
                            for (int i = 0; i < 4; ++i) vbT[((size_t)b * D + c + i) * 256 + key] = (bf16_t)f2bf(v[i]);
                        }
                    }
            }
    }
};

template <class Epi, class Sched, bool ALIGN_EPI = false, bool SP2 = false>
__device__ __forceinline__ void gemm_phase(PG8_LAS unsigned char* lds, const Gemm g, const Sched& S, const Epi& E) {
    const int tid = threadIdx.x, wid = __builtin_amdgcn_readfirstlane(tid >> 6), lane = tid & 63, wr = wid >> 2, wc = wid & 3, fr = lane & 15, fq = lane >> 4;
    const int K = g.K, nt = K / BK;
    unsigned voffA[2], voffB[2];
#pragma unroll
    for (int i = 0; i < 2; ++i) { int R, C; stage_rc(tid * 16 + i * 8192, R, C); const int Rb = Epi::PERM ? ((R & ~31) + perm32(R & 31)) : R;
        voffA[i] = (unsigned)(R * K + C) * 2u; voffB[i] = (unsigned)(Rb * K + C) * 2u; }
    const size_t kstep = (size_t)(BK * 2);
    const size_t hstep = (size_t)HALF * K * 2;
    const size_t tstep = 2 * hstep;
    const unsigned ldsw = (unsigned)wid * 1024u;
    const int aoff = lds_byte(wr * 64 + fr, fq * 8), boff = lds_byte(wc * 32 + fr, fq * 8);
#define PG8_SA(b, h) (((b) * 2 + (h)) * HTB)
#define PG8_SB(b, h) ((4 + (b) * 2 + (h)) * HTB)
#define PG8_STAGE(bufoff, gbase, voff) do { _Pragma("unroll") for (int _i = 0; _i < 2; ++_i) \
        __builtin_amdgcn_global_load_lds((const unsigned*)((const char*)(gbase) + (voff)[_i]), (PG8_LAS unsigned*)(lds + (bufoff) + ldsw + _i * 8192), 16, 0, 0); } while (0)
#define PG8_LDA(dst, b, h) do { _Pragma("unroll") for (int m = 0; m < 4; ++m) _Pragma("unroll") for (int k = 0; k < 2; ++k) dst[m][k] = *(const PG8_LAS bf16x8*)(lds + PG8_SA(b, h) + aoff + m * 2048 + k * 1024); } while (0)
#define PG8_LDB(dst, b, h) do { _Pragma("unroll") for (int n = 0; n < 2; ++n) _Pragma("unroll") for (int k = 0; k < 2; ++k) dst[n][k] = *(const PG8_LAS bf16x8*)(lds + PG8_SB(b, h) + boff + n * 2048 + k * 1024); } while (0)
#define PG8_MMA(ai, bj, At, Bt) do { __builtin_amdgcn_s_setprio(1); _Pragma("unroll") for (int m = 0; m < 4; ++m) _Pragma("unroll") for (int n = 0; n < 2; ++n) _Pragma("unroll") for (int k = 0; k < 2; ++k) \
        acc[ai][bj][m][n] = __builtin_amdgcn_mfma_f32_16x16x32_bf16(Bt[n][k], At[m][k], acc[ai][bj][m][n], 0, 0, 0); __builtin_amdgcn_s_setprio(0); } while (0)
#define PG8_WAIT_V(n) asm volatile("s_waitcnt vmcnt(" #n ")" ::: "memory")
#define PG8_WAIT_L(n) asm volatile("s_waitcnt lgkmcnt(" #n ")" ::: "memory")
#define PG8_BAR __builtin_amdgcn_s_barrier()
#define PG8_SCHED __builtin_amdgcn_sched_barrier(0)
    Unit cur, nxt; int ui = 0;
    if (!S.next(0, cur)) return;
    f32x4 acc[2][2][4][2];
#pragma unroll
    for (int a = 0; a < 2; ++a)
#pragma unroll
        for (int b = 0; b < 2; ++b)
#pragma unroll
            for (int m = 0; m < 4; ++m)
#pragma unroll
                for (int n = 0; n < 2; ++n) acc[a][b][m][n] = (f32x4){0.f, 0.f, 0.f, 0.f};
    bf16x8 At[4][2], B0[2][2], B1[2][2];
    const char* cA = (const char*)g.A + (size_t)cur.pm * tstep; const char* cB = (const char*)g.Bt + (size_t)cur.pn * tstep;
    S.a_ready(cur);
    if constexpr (SP2) {
        PG8_STAGE(PG8_SB(0, 0), cB, voffB); PG8_STAGE(PG8_SB(0, 1), cB + hstep, voffB); PG8_STAGE(PG8_SA(0, 0), cA, voffA); PG8_STAGE(PG8_SA(0, 1), cA + hstep, voffA);
        if (wr == 1) PG8_BAR;
        PG8_WAIT_V(2); PG8_BAR;
        PG8_STAGE(PG8_SB(1, 0), cB + kstep, voffB); PG8_STAGE(PG8_SA(1, 0), cA + kstep, voffA); PG8_STAGE(PG8_SB(1, 1), cB + hstep + kstep, voffB);
        PG8_WAIT_V(6); PG8_BAR;
    } else {
        PG8_STAGE(PG8_SB(0, 0), cB, voffB); PG8_STAGE(PG8_SA(0, 0), cA, voffA); PG8_STAGE(PG8_SB(0, 1), cB + hstep, voffB); PG8_STAGE(PG8_SA(0, 1), cA + hstep, voffA);
        if (wr == 1) PG8_BAR;
        PG8_WAIT_V(4); PG8_BAR;
        PG8_STAGE(PG8_SB(1, 0), cB + kstep, voffB); PG8_STAGE(PG8_SA(1, 0), cA + kstep, voffA); PG8_STAGE(PG8_SB(1, 1), cB + hstep + kstep, voffB);
        PG8_WAIT_V(6); PG8_BAR;
    }
    for (;;) {
        const bool has_next = S.next(ui + 1, nxt);
        const char* nA = has_next ? (const char*)g.A + (size_t)nxt.pm * tstep : cA; const char* nB = has_next ? (const char*)g.Bt + (size_t)nxt.pn * tstep : cB;
        for (int t = 0; t < nt; t += 2) {
            const bool last = (t == nt - 2);
            const char* a1 = cA + (size_t)(t + 1) * kstep;
            const char* a2 = last ? nA : cA + (size_t)(t + 2) * kstep; const char* b2 = last ? nB : cB + (size_t)(t + 2) * kstep;
            const char* a3 = a2 + kstep; const char* b3 = b2 + kstep;
            if (last && has_next) S.a_ready(nxt);
            if constexpr (SP2) {
            PG8_LDB(B0, 0, 0); PG8_LDB(B1, 0, 1); PG8_SCHED; PG8_LDA(At, 0, 0); PG8_STAGE(PG8_SA(1, 1), a1 + hstep, voffA);
            PG8_WAIT_V(8); PG8_WAIT_L(0); PG8_BAR; PG8_MMA(0, 0, At, B0); PG8_MMA(0, 1, At, B1); PG8_BAR; PG8_SCHED;
            PG8_LDA(At, 0, 1); PG8_STAGE(PG8_SB(0, 0), b2, voffB); PG8_STAGE(PG8_SB(0, 1), b2 + hstep, voffB); PG8_STAGE(PG8_SA(0, 0), a2, voffA);
            PG8_WAIT_V(8); PG8_WAIT_L(0); PG8_BAR; PG8_MMA(1, 0, At, B0); PG8_MMA(1, 1, At, B1); PG8_BAR; PG8_SCHED;
            PG8_LDB(B0, 1, 0); PG8_LDB(B1, 1, 1); PG8_SCHED; PG8_LDA(At, 1, 0); PG8_STAGE(PG8_SA(0, 1), a2 + hstep, voffA);
            PG8_WAIT_V(8); PG8_WAIT_L(0); PG8_BAR; PG8_MMA(0, 0, At, B0); PG8_MMA(0, 1, At, B1); PG8_BAR; PG8_SCHED;
            PG8_LDA(At, 1, 1); PG8_STAGE(PG8_SB(1, 0), b3, voffB); PG8_STAGE(PG8_SB(1, 1), b3 + hstep, voffB); PG8_STAGE(PG8_SA(1, 0), a3, voffA);
            PG8_WAIT_V(8); PG8_WAIT_L(0); PG8_BAR; PG8_MMA(1, 0, At, B0); PG8_MMA(1, 1, At, B1); PG8_BAR; PG8_SCHED;
            } else {
            PG8_LDB(B0, 0, 0); PG8_SCHED; PG8_LDA(At, 0, 0); PG8_STAGE(PG8_SA(1, 1), a1 + hstep, voffA);
            PG8_WAIT_L(8); PG8_BAR; PG8_WAIT_L(0); PG8_MMA(0, 0, At, B0); PG8_BAR; PG8_SCHED;
            PG8_LDB(B1, 0, 1); PG8_STAGE(PG8_SB(0, 0), b2, voffB);
            PG8_BAR; PG8_WAIT_L(0); PG8_MMA(0, 1, At, B1); PG8_BAR;
            PG8_LDA(At, 0, 1); PG8_STAGE(PG8_SA(0, 0), a2, voffA);
            PG8_BAR; PG8_WAIT_L(0); PG8_MMA(1, 0, At, B0); PG8_BAR; PG8_SCHED;
            PG8_STAGE(PG8_SB(0, 1), b2 + hstep, voffB);
            PG8_WAIT_V(6); PG8_BAR; PG8_MMA(1, 1, At, B1); PG8_BAR;
            PG8_LDB(B0, 1, 0); PG8_SCHED; PG8_LDA(At, 1, 0); PG8_STAGE(PG8_SA(0, 1), a2 + hstep, voffA);
            PG8_WAIT_L(8); PG8_BAR; PG8_WAIT_L(0); PG8_MMA(0, 0, At, B0); PG8_BAR; PG8_SCHED;
            PG8_LDB(B1, 1, 1); PG8_STAGE(PG8_SB(1, 0), b3, voffB);
            PG8_BAR; PG8_WAIT_L(0); PG8_MMA(0, 1, At, B1); PG8_BAR;
            PG8_LDA(At, 1, 1); PG8_STAGE(PG8_SA(1, 0), a3, voffA);
            PG8_BAR; PG8_WAIT_L(0); PG8_MMA(1, 0, At, B0); PG8_BAR; PG8_SCHED;
            PG8_STAGE(PG8_SB(1, 1), b3 + hstep, voffB);
            PG8_WAIT_V(6); PG8_BAR; PG8_MMA(1, 1, At, B1); PG8_BAR;
            }
        }
        if constexpr (ALIGN_EPI) { if (wr == 0) PG8_BAR; }
        if constexpr (!Epi::AFTER_DRAIN) { E(acc, cur, wr, wc, fr, fq); S.done(cur); }
        if (!has_next) break;
#pragma unroll
        for (int a = 0; a < 2; ++a)
#pragma unroll
            for (int b = 0; b < 2; ++b)
#pragma unroll
                for (int m = 0; m < 4; ++m)
#pragma unroll
                    for (int n = 0; n < 2; ++n) acc[a][b][m][n] = (f32x4){0.f, 0.f, 0.f, 0.f};
        cur = nxt; cA = nA; cB = nB; ++ui;
        if constexpr (ALIGN_EPI) { if (wr == 1) PG8_BAR; }
    }
    PG8_WAIT_V(0);
    if constexpr (!ALIGN_EPI) { if (wr == 0) PG8_BAR; }
    PG8_BAR;
#undef PG8_SA
#undef PG8_SB
#undef PG8_STAGE
#undef PG8_LDA
#undef PG8_LDB
#undef PG8_MMA
#undef PG8_WAIT_V
#undef PG8_WAIT_L
#undef PG8_BAR
#undef PG8_SCHED
}
}


#define XB_TMO      128
#define XB_XCNT(j)  (256  + 64 * (j))
#define XB_XSUB(j)  (1280 + 64 * (j))
#define XB_XGEN(j)  (2304 + 64 * (j))
#define XB_TOP      3328
#define XB_TOPGEN   3392
#define XCD_BAR_WORDS 3456
#define XB_SPIN_CAP (1u << 18)
__device__ __forceinline__ unsigned xb_ld(unsigned* p)              { return __hip_atomic_load(p, __ATOMIC_RELAXED, __HIP_MEMORY_SCOPE_AGENT); }
__device__ __forceinline__ unsigned xb_add(unsigned* p, unsigned v) { return __hip_atomic_fetch_add(p, v, __ATOMIC_RELAXED, __HIP_MEMORY_SCOPE_AGENT); }
__device__ __forceinline__ unsigned xb_xcc_id() { return (unsigned)__builtin_amdgcn_s_getreg((3 << 11) | 20) & 0xFu; }
#define XB_SPIN(cond, bar) do { unsigned _sp = 0; while (cond) { __builtin_amdgcn_s_sleep(1); \
    if ((++_sp & 255u) == 0u) { if (xb_ld(&(bar)[XB_TMO])) break; if (_sp > XB_SPIN_CAP) { atomicAdd(&(bar)[XB_TMO], 1u); break; } } } } while (0)
struct XcdBarrier { unsigned* bar; unsigned x; volatile LAS unsigned* st; };
__device__ __forceinline__ XcdBarrier xcd_barrier_post(unsigned* bar, volatile LAS unsigned* st) {
    XcdBarrier b; b.bar = bar; b.x = xb_xcc_id(); b.st = st;
    if (threadIdx.x == 0) (void)xb_add(&bar[XB_XCNT(b.x)], 1u);
    return b;
}
__device__ __forceinline__ void xcd_barrier_complete(unsigned* bar, unsigned x, unsigned& nloc, unsigned& nx) {
    const unsigned G = gridDim.x * gridDim.y * gridDim.z;
    unsigned sum, cnt, mine, sp = 0u;
    for (;;) {
        sum = 0u; cnt = 0u; mine = 0u;
#pragma unroll
        for (unsigned j = 0; j < 16; ++j) { const unsigned c = xb_ld(&bar[XB_XCNT(j)]); sum += c; cnt += (c > 0u) ? 1u : 0u; mine = (j == x) ? c : mine; }
        if (sum == G) break;
        __builtin_amdgcn_s_sleep(1);
        if ((++sp & 255u) == 0u) { if (xb_ld(&bar[XB_TMO])) break; if (sp > XB_SPIN_CAP) { atomicAdd(&bar[XB_TMO], 1u); break; } }
    }
    nloc = mine > 0u ? mine : 1u; nx = cnt > 0u ? cnt : 1u;
}
__device__ __forceinline__ void xcd_barrier(const XcdBarrier& b) {
    asm volatile("s_waitcnt vmcnt(0)" ::: "memory");
    __syncthreads();
    if (threadIdx.x == 0) {
        unsigned* bar = b.bar;
        __builtin_amdgcn_s_waitcnt(0);
        unsigned nloc = b.st[0], nx = b.st[1];
        if (nloc == 0u) { xcd_barrier_complete(bar, b.x, nloc, nx); b.st[0] = nloc; b.st[1] = nx; }
        const unsigned old = xb_add(&bar[XB_XSUB(b.x)], 1u);
        const unsigned gen = old / nloc;
        if (old + 1u == (gen + 1u) * nloc) {
            __builtin_amdgcn_fence(__ATOMIC_RELEASE, "agent");
            asm volatile("s_waitcnt vmcnt(0)" ::: "memory");
            const unsigned og = xb_add(&bar[XB_TOP], 1u);
            const unsigned tg = og / nx;
            if (og + 1u == (tg + 1u) * nx) xb_add(&bar[XB_TOPGEN], 1u);
            else XB_SPIN(xb_ld(&bar[XB_TOPGEN]) == tg, bar);
            __builtin_amdgcn_fence(__ATOMIC_ACQUIRE, "agent");
            xb_add(&bar[XB_XGEN(b.x)], 1u);
            asm volatile("s_waitcnt vmcnt(0)" ::: "memory");
        } else {
            XB_SPIN(xb_ld(&bar[XB_XGEN(b.x)]) == gen, bar);
            __builtin_amdgcn_fence(__ATOMIC_ACQUIRE, "agent");
            asm volatile("s_waitcnt vmcnt(0)" ::: "memory");
        }
    }
    __syncthreads();
}

struct Args { const float* in[36]; float* out; unsigned char* ws; int ph_lo, ph_hi; };
#define LDS_WAIT() asm volatile("s_waitcnt lgkmcnt(0)" ::: "memory")

DI int rowmap(int mode, int n) {
    if (mode == 1) { const int j = n < FF ? n : n - FF; return 256 * (j >> 7) + (n < FF ? 0 : 128) + (j & 127); }
    if (mode == 2) { if (n < 1024) return n; if (n < 1040) return n + 1024; return n - 16; }
    return n;
}
DI void p0_transpose_item(const float* W, const float* gain, int K, int N, bf16_t* WT, int mode, float* scr, int item, int lane) {
    const int nblk = (N + 31) / 32, kb = item / nblk, nb = item % nblk, k0 = 64 * kb, n0 = 32 * nb;
    const int nn = n0 + (lane & 31); const bool ok = nn < N;
#pragma unroll 8
    for (int i = 0; i < 32; ++i) { const int kk = 2 * i + (lane >> 5); float v = ok ? W[(size_t)(k0 + kk) * N + nn] : 0.f; if (gain) v *= gain[k0 + kk]; scr[kk * 33 + (lane & 31)] = v; }
    LDS_WAIT(); asm volatile("" ::: "memory");
    const int c = lane & 7;
#pragma unroll
    for (int j = 0; j < 4; ++j) { const int n = (lane >> 3) + 8 * j; const float* s = scr + (8 * c) * 33 + n;
        u32x4 o; o.x = pk2(s[0 * 33], s[1 * 33]); o.y = pk2(s[2 * 33], s[3 * 33]); o.z = pk2(s[4 * 33], s[5 * 33]); o.w = pk2(s[6 * 33], s[7 * 33]);
        if (n0 + n < N) *(u32x4*)(WT + (size_t)rowmap(mode, n0 + n) * K + k0 + 8 * c) = o; }
    LDS_WAIT(); asm volatile("" ::: "memory");
}
DI void row_to_bf16_ssq(const float* xrow, bf16_t* orow, float* ssq_slot, int lane) {
    const f32x4* xr = (const f32x4*)xrow + lane;
    f32x4 v[4]; float s = 0.f;
#pragma unroll
    for (int j = 0; j < 4; ++j) { v[j] = xr[64 * j]; s += (v[j].x * v[j].x + v[j].y * v[j].y) + (v[j].z * v[j].z + v[j].w * v[j].w); }
    s = wave_sum(s);
    unsigned long long* o8 = (unsigned long long*)orow + lane;
#pragma unroll
    for (int j = 0; j < 4; ++j) o8[64 * j] = (unsigned long long)pk2(v[j].x, v[j].y) | ((unsigned long long)pk2(v[j].z, v[j].w) << 32);
    if (lane == 0) *ssq_slot = s;
}
struct S5P { float dt, lr, li; };
DI S5P s5_par(const float* lre, const float* lim, const float* logdt, int g, int n) { S5P p; p.dt = expf(logdt[g]); p.lr = lre[g * 64 + n]; p.li = lim[g * 64 + n]; return p; }
DI f32x2 s5_pow(const S5P& p, int j) {
    const float mag = expf((float)j * (p.dt * p.lr)); float sn, cs; sincosf((float)j * (p.dt * p.li), &sn, &cs); return (f32x2){mag * cs, mag * sn};
}
DI f32x2 s5_coef(const S5P& p) {
    const f32x2 ab = s5_pow(p, 1); const float den = p.lr * p.lr + p.li * p.li;
    return (f32x2){((ab.x - 1.f) * p.lr + ab.y * p.li) / den, (ab.y * p.lr - (ab.x - 1.f) * p.li) / den};
}
DI f32x2 cmul(f32x2 a, f32x2 b) { return (f32x2){a.x * b.x - a.y * b.y, a.x * b.y + a.y * b.x}; }

template <int NT>
DI void gla_gate_cumsum(const float* zg, float* bb, float* seg, const float* wg, const float* bg, int h, int tid) {
    for (int i = tid; i < NT * 64; i += NTHREADS) { const int t = i >> 6, d = i & 63; float s = bg[h * 64 + d];
#pragma unroll
        for (int r = 0; r < 16; ++r) s += zg[t * 16 + r] * wg[r * 256 + h * 64 + d];
        bb[t * 65 + d] = logsigmoidf(s) * (1.f / 16.f); }
    __syncthreads();
    if constexpr (NT == 64) {
        const int d = tid & 63, sg = tid >> 6; float run = 0.f;
#pragma unroll
        for (int i = 0; i < 8; ++i) { run += bb[(sg * 8 + i) * 65 + d]; bb[(sg * 8 + i) * 65 + d] = run; }
        seg[sg * 64 + d] = run;
        __syncthreads();
        float pre = 0.f;
        for (int j = 0; j < sg; ++j) pre += seg[j * 64 + d];
#pragma unroll
        for (int i = 0; i < 8; ++i) bb[(sg * 8 + i) * 65 + d] += pre;
    } else {
        if (tid < 64) { float run = 0.f;
#pragma unroll
            for (int t = 0; t < NT; ++t) { run += bb[t * 65 + tid]; bb[t * 65 + tid] = run; } }
    }
    __syncthreads();
}

__global__ void __launch_bounds__(NTHREADS, 2) hymba_fwd(Args args) {
    extern __shared__ __attribute__((aligned(16))) unsigned char lds[];
    cg::grid_group grid = cg::this_grid();
    const int tid0 = threadIdx.x, wave = __builtin_amdgcn_readfirstlane(tid0 >> 6);
    const int G = gridDim.x, bx = blockIdx.x;
    const int gw = bx * NWAVES + wave, NGW = G * NWAVES;
    const int NGT = G * NTHREADS;
#define PHASE_LOCALS int tid_l_ = tid0; asm volatile("" : "+v"(tid_l_)); const int tid = tid_l_, lane = tid & 63, gt = bx * NTHREADS + tid; (void)lane; (void)gt
    unsigned char* ws = args.ws;
    float* out = args.out;
    float* fl = (float*)lds;
    LAS unsigned char* ldsl = (LAS unsigned char*)lds;

    const float* x_prompt = args.in[0]; const float* x_sample = args.in[1]; const float* state_gla = args.in[2];
    const float* st_re = args.in[3]; const float* st_im = args.in[4]; const float* cache_k = args.in[5]; const float* cache_v = args.in[6];
    const float* mem_prompt = args.in[7];
    const float* w_gate = args.in[13]; const float* b_gate = args.in[14]; const float* g_gla_out = args.in[15];
    const float* s5_lre = args.in[16]; const float* s5_lim = args.in[17]; const float* s5_logdt = args.in[18];
    const float* s5_bre = args.in[19]; const float* s5_bim = args.in[20]; const float* s5_cre = args.in[21]; const float* s5_cim = args.in[22];
    const float* s5_d = args.in[23]; const float* s5_wglu = args.in[24]; const float* s5_bglu = args.in[25];
    const float* g_final = args.in[35];

    float* ssq = (float*)(ws + WS_SSQ);
    bf16_t* Wgu1 = (bf16_t*)(ws + WS_WGU1); bf16_t* Wd1 = (bf16_t*)(ws + WS_WD1); bf16_t* Win = (bf16_t*)(ws + WS_WIN); bf16_t* Wout = (bf16_t*)(ws + WS_WOUT);
    bf16_t* Wcq = (bf16_t*)(ws + WS_WCQ); bf16_t* Wckv = (bf16_t*)(ws + WS_WCKV); bf16_t* Wco = (bf16_t*)(ws + WS_WCO); bf16_t* Wgu2 = (bf16_t*)(ws + WS_WGU2); bf16_t* Wd2 = (bf16_t*)(ws + WS_WD2);
    bf16_t* EgT = (bf16_t*)(ws + WS_EGT); bf16_t* GTt = (bf16_t*)(ws + WS_GTT);
    bf16_t* memb = (bf16_t*)(ws + WS_MEMB); bf16_t* kb = (bf16_t*)(ws + WS_KB); bf16_t* vbT = (bf16_t*)(ws + WS_VBT);
    bf16_t* xb = (bf16_t*)(ws + WS_XB); bf16_t* hb = (bf16_t*)(ws + WS_HB); float* hres = (float*)(ws + WS_H);
    bf16_t* act = (bf16_t*)(ws + WS_ACT); bf16_t* Pb = (bf16_t*)(ws + WS_ACT);
    bf16_t* mix = (bf16_t*)(ws + WS_MIX); bf16_t* qb = (bf16_t*)(ws + WS_Q); bf16_t* ob = (bf16_t*)(ws + WS_O);
    float* glaD = (float*)(ws + WS_GLAD); float* glaDec = (float*)(ws + WS_GLADEC);
    float* s5e = (float*)(ws + WS_S5E); bf16_t* s5x = (bf16_t*)(ws + WS_S5X);

    const int lo = args.ph_lo, hi = args.ph_hi;
    if (tid0 < 16) ((LAS unsigned*)(ldsl + LDS_BARST))[tid0] = 0u;
    __syncthreads();
    const XcdBarrier xbar = xcd_barrier_post((unsigned*)(ws + WS_BAR), (volatile LAS unsigned*)(ldsl + LDS_BARST));
    if (lo < 0) grid.sync();
#ifndef PHASE_MASK
#define PHASE_MASK 0xffffffffu
#endif
#define IN(k) (((PHASE_MASK >> (k)) & 1u) && lo <= (k) && (k) < hi)
#ifndef REPEAT_MASK
#define REPEAT_MASK 0u
#endif
#define PHASE(k) if (IN(k)) for (int rep_ = 0; rep_ < 1 + (int)((REPEAT_MASK >> (k)) & 1u); ++rep_)
#define REP_SYNC() do { if (rep_) xcd_barrier(xbar); } while (0)
#define SEAM(k) do { if (IN(k) && IN((k) + 1)) xcd_barrier(xbar); } while (0)

    PHASE(0) {
        REP_SYNC();
        PHASE_LOCALS;
        float* scr = fl + wave * (64 * 33);
        constexpr int I_GU = 16 * 176, I_D = 44 * 32, I_IN = 16 * 65, I_SQ = 16 * 32, I_CKV = 16 * 64;
        constexpr int NITEMS = 2 * I_GU + 2 * I_D + I_IN + 3 * I_SQ + I_CKV;
        for (int it = gw; it < NITEMS; it += NGW) {
            int r = it;
            if (r < I_GU) { p0_transpose_item(args.in[9], args.in[8], D, NGU, Wgu1, 1, scr, r, lane); continue; } r -= I_GU;
            if (r < I_GU) { p0_transpose_item(args.in[33], args.in[32], D, NGU, Wgu2, 1, scr, r, lane); continue; } r -= I_GU;
            if (r < I_D) { p0_transpose_item(args.in[10], nullptr, FF, D, Wd1, 0, scr, r, lane); continue; } r -= I_D;
            if (r < I_D) { p0_transpose_item(args.in[34], nullptr, FF, D, Wd2, 0, scr, r, lane); continue; } r -= I_D;
            if (r < I_IN) { p0_transpose_item(args.in[12], args.in[11], D, NIN, Win, 2, scr, r, lane); continue; } r -= I_IN;
            if (r < I_SQ) { p0_transpose_item(args.in[26], nullptr, D, D, Wout, 0, scr, r, lane); continue; } r -= I_SQ;
            if (r < I_SQ) { p0_transpose_item(args.in[29], args.in[27], D, D, Wcq, 0, scr, r, lane); continue; } r -= I_SQ;
            if (r < I_SQ) { p0_transpose_item(args.in[31], nullptr, D, D, Wco, 0, scr, r, lane); continue; } r -= I_SQ;
            p0_transpose_item(args.in[30], args.in[28], D, 2 * D, Wckv, 0, scr, r, lane);
        }
        for (int i = gt; i < (NINP - NIN) * D / 8; i += NGT) ((u32x4*)(Win + (size_t)NIN * D))[i] = (u32x4){0u, 0u, 0u, 0u};
        for (int i = gt; i < 3 * M; i += NGT) ssq[SSQ_H1 + i] = 0.f;
        for (int m = gw; m < M; m += NGW) { const float* xr = m < MP ? x_prompt + (size_t)m * D : x_sample + (size_t)(m - MP) * D; row_to_bf16_ssq(xr, xb + (size_t)m * D, ssq + SSQ_X + m, lane); }
        for (int m = gw; m < MEMR; m += NGW) row_to_bf16_ssq(mem_prompt + (size_t)m * D, memb + (size_t)m * D, ssq + SSQ_MEM + m, lane);
        for (int it = gt; it < 32 * 64 * 8; it += NGT) {
            const int g = it >> 9, n = (it >> 3) & 63, s = it & 7;
            const S5P p = s5_par(s5_lre, s5_lim, s5_logdt, g, n);
            const f32x2 mm = cmul(s5_pow(p, 7 - s), s5_coef(p));
            unsigned wre[8], wim[8];
#pragma unroll
            for (int pp = 0; pp < 8; ++pp) {
                const f32x2 b0 = (f32x2){s5_bre[(g * 64 + n) * 16 + 2 * pp], s5_bim[(g * 64 + n) * 16 + 2 * pp]}, b1 = (f32x2){s5_bre[(g * 64 + n) * 16 + 2 * pp + 1], s5_bim[(g * 64 + n) * 16 + 2 * pp + 1]};
                const f32x2 v0 = cmul(mm, b0), v1 = cmul(mm, b1);
                wre[pp] = pk2(v0.x, v1.x); wim[pp] = pk2(v0.y, v1.y);
            }
            u32x4* dre = (u32x4*)(EgT + ((size_t)(g * 128 + n) * 128 + s * 16)); u32x4* dim = (u32x4*)(EgT + ((size_t)(g * 128 + 64 + n) * 128 + s * 16));
            dre[0] = (u32x4){wre[0], wre[1], wre[2], wre[3]}; dre[1] = (u32x4){wre[4], wre[5], wre[6], wre[7]};
            dim[0] = (u32x4){wim[0], wim[1], wim[2], wim[3]}; dim[1] = (u32x4){wim[4], wim[5], wim[6], wim[7]};
        }
        for (int it = gt; it < 32 * 8 * 64; it += NGT) {
            const int g = it >> 9, t = (it >> 6) & 7, n = it & 63;
            const S5P p = s5_par(s5_lre, s5_lim, s5_logdt, g, n);
            const f32x2 pw = s5_pow(p, t + 1);
#pragma unroll
            for (int pp = 0; pp < 16; ++pp) {
                const f32x2 c = (f32x2){s5_cre[(g * 16 + pp) * 64 + n], s5_cim[(g * 16 + pp) * 64 + n]};
                const f32x2 v = cmul(c, pw);
                bf16_t* dst = GTt + (size_t)(g * 128 + t * 16 + pp) * 256;
                dst[n] = (bf16_t)f2bf(v.x); dst[64 + n] = (bf16_t)f2bf(-v.y);
            }
        }
        for (int it = gt; it < 32 * 8 * 8 * 16; it += NGT) {
            const int g = it >> 10, t = (it >> 7) & 7, s = (it >> 4) & 7, pp = it & 15;
            float a[16];
#pragma unroll
            for (int q = 0; q < 16; ++q) a[q] = 0.f;
            if (s <= t) {
                for (int n = 0; n < 64; ++n) {
                    const S5P p = s5_par(s5_lre, s5_lim, s5_logdt, g, n);
                    const f32x2 c = (f32x2){s5_cre[(g * 16 + pp) * 64 + n], s5_cim[(g * 16 + pp) * 64 + n]};
                    const f32x2 cc = cmul(cmul(c, s5_pow(p, t - s)), s5_coef(p));
                    const f32x4* br = (const f32x4*)(s5_bre + (g * 64 + n) * 16); const f32x4* bi = (const f32x4*)(s5_bim + (g * 64 + n) * 16);
#pragma unroll
                    for (int q4 = 0; q4 < 4; ++q4) { const f32x4 r4 = br[q4], i4 = bi[q4];
#pragma unroll
                        for (int e = 0; e < 4; ++e) a[q4 * 4 + e] += cc.x * r4[e] - cc.y * i4[e]; }
                }
            }
            u32x4* dst = (u32x4*)(GTt + (size_t)(g * 128 + t * 16 + pp) * 256 + 128 + s * 16);
            dst[0] = (u32x4){pk2(a[0], a[1]), pk2(a[2], a[3]), pk2(a[4], a[5]), pk2(a[6], a[7])};
            dst[1] = (u32x4){pk2(a[8], a[9]), pk2(a[10], a[11]), pk2(a[12], a[13]), pk2(a[14], a[15])};
        }
    }
    SEAM(0);

    PHASE(1) {
        REP_SYNC();
        pg8::Gemm g{xb, Wgu1, M, NGU, D}; pg8::StaticOrder S; S.init(M, NGU, G, bx);
        pg8::EpiSwiGLU E{act, FF, ssq + SSQ_X};
        pg8::gemm_phase<pg8::EpiSwiGLU, pg8::StaticOrder, true, true>(ldsl, g, S, E);
    }
    SEAM(1);
    PHASE(2) {
        REP_SYNC();
        pg8::Gemm g{act, Wd1, M, D, FF}; pg8::StaticOrder S; S.init(M, D, G, bx);
        pg8::EpiResid E{x_prompt, x_sample, hres, hb, ssq + SSQ_H1, 0.5f};
        pg8::gemm_phase<pg8::EpiResid, pg8::StaticOrder, true, true>(ldsl, g, S, E);
    }
    SEAM(2);
    PHASE(3) {
        REP_SYNC();
        { pg8::Gemm g{hb, Win, M, NINP, D}; pg8::StaticOrder S; S.init(M, NINP, G, bx);
          pg8::EpiScaleBf16 E{Pb, NINP, ssq + SSQ_H1, 1.f};
          pg8::gemm_phase<pg8::EpiScaleBf16, pg8::StaticOrder, true, true>(ldsl, g, S, E); }
        { pg8::Gemm g{memb, Wckv, MEMR, 2 * D, D}; pg8::StaticOrder S; S.init(MEMR, 2 * D, G, (bx + 64) % G);
          pg8::EpiMemKV E{out + O_MKP, out + O_MVP, kb, vbT, ssq + SSQ_MEM};
          pg8::gemm_phase<pg8::EpiMemKV, pg8::StaticOrder, true, true>(ldsl, g, S, E); }
    }
    SEAM(3);

    PHASE(4) {
        REP_SYNC();
        PHASE_LOCALS;
        {
            float* zg = fl; float* kk = zg + 64 * 16; float* vv = kk + 64 * 65; float* bb = vv + 64 * 128; float* seg = bb + 64 * 65;
            for (int unit = bx; unit < 1024; unit += G) {
                const int bh = unit >> 5, c = unit & 31, b = bh >> 2, h = bh & 3;
                const size_t r0 = (size_t)b * 2048 + c * 64;
                if (tid < 128) { const int t = tid >> 1, hf = tid & 1; const u32x4 w = *(const u32x4*)(Pb + (r0 + t) * NINP + PC_ZG + hf * 8);
                    float* z = zg + t * 16 + hf * 8; z[0] = bflo(w.x); z[1] = bfhi(w.x); z[2] = bflo(w.y); z[3] = bfhi(w.y); z[4] = bflo(w.z); z[5] = bfhi(w.z); z[6] = bflo(w.w); z[7] = bfhi(w.w); }
                { const int t = tid >> 3, c8 = tid & 7; const u32x4 w = *(const u32x4*)(Pb + (r0 + t) * NINP + PC_K + h * 64 + c8 * 8);
                    float* z = kk + t * 65 + c8 * 8; z[0] = bflo(w.x); z[1] = bfhi(w.x); z[2] = bflo(w.y); z[3] = bfhi(w.y); z[4] = bflo(w.z); z[5] = bfhi(w.z); z[6] = bflo(w.w); z[7] = bfhi(w.w); }
#pragma unroll
                for (int i = 0; i < 2; ++i) { const int ch = tid + i * 512, t = ch >> 4, c8 = ch & 15; const u32x4 w = *(const u32x4*)(Pb + (r0 + t) * NINP + PC_V + h * 128 + c8 * 8);
                    float* z = vv + t * 128 + c8 * 8; z[0] = bflo(w.x); z[1] = bfhi(w.x); z[2] = bflo(w.y); z[3] = bfhi(w.y); z[4] = bflo(w.z); z[5] = bfhi(w.z); z[6] = bflo(w.w); z[7] = bfhi(w.w); }
                __syncthreads();
                gla_gate_cumsum<64>(zg, bb, seg, w_gate, b_gate, h, tid);
                for (int i = tid; i < 64 * 64; i += NTHREADS) { const int t = i >> 6, d = i & 63; kk[t * 65 + d] *= __expf(bb[63 * 65 + d] - bb[t * 65 + d]); }
                __syncthreads();
                { const int d = tid >> 3, e0 = (tid & 7) * 16; f32x4 a0 = {0, 0, 0, 0}, a1 = a0, a2 = a0, a3 = a0;
                    for (int t = 0; t < 64; ++t) { const float kd = kk[t * 65 + d]; const f32x4* vp = (const f32x4*)(vv + t * 128 + e0); a0 += vp[0] * kd; a1 += vp[1] * kd; a2 += vp[2] * kd; a3 += vp[3] * kd; }
                    f32x4* dp = (f32x4*)(glaD + (size_t)unit * 8192 + d * 128 + e0); dp[0] = a0; dp[1] = a1; dp[2] = a2; dp[3] = a3; }
                if (tid < 64) glaDec[unit * 64 + tid] = __expf(bb[63 * 65 + tid]);
                __syncthreads();
            }
        }
        {
            float* zg = fl; float* qq = zg + 8 * 16; float* kk = qq + 8 * 65; float* kt = kk + 8 * 65; float* vv = kt + 8 * 65; float* bb = vv + 8 * 128; float* sc = bb + 8 * 65; float* S0 = sc + 64;
            for (int unit = bx; unit < 512; unit += G) {
                const int b = unit >> 2, h = unit & 3; const size_t r0 = (size_t)MP + b * 8;
                if (tid < 128) { const int t = tid >> 4, r = tid & 15; zg[t * 16 + r] = bf2f(Pb[(r0 + t) * NINP + PC_ZG + r]); }
                { const int t = tid >> 6, d = tid & 63; qq[t * 65 + d] = bf2f(Pb[(r0 + t) * NINP + PC_Q + h * 64 + d]); kk[t * 65 + d] = bf2f(Pb[(r0 + t) * NINP + PC_K + h * 64 + d]); }
#pragma unroll
                for (int i = 0; i < 2; ++i) { const int idx = tid + i * 512, t = idx >> 7, e = idx & 127; vv[t * 128 + e] = bf2f(Pb[(r0 + t) * NINP + PC_V + h * 128 + e]); }
                { const f32x4* sp = (const f32x4*)(state_gla + (size_t)unit * 8192); f32x4* dp = (f32x4*)S0;
#pragma unroll
                    for (int i = 0; i < 4; ++i) dp[tid + i * 512] = sp[tid + i * 512]; }
                __syncthreads();
                gla_gate_cumsum<8>(zg, bb, nullptr, w_gate, b_gate, h, tid);
                { const int t = tid >> 6, d = tid & 63; const float bt = bb[t * 65 + d], b7 = bb[7 * 65 + d]; const float kv = kk[t * 65 + d];
                    qq[t * 65 + d] *= __expf(bt) * 0.125f; kk[t * 65 + d] = kv * __expf(-bt); kt[t * 65 + d] = kv * __expf(b7 - bt); }
                __syncthreads();
                if (tid < 64) { const int t = tid >> 3, s = tid & 7; float a = 0.f; if (s <= t) { for (int d = 0; d < 64; ++d) a += qq[t * 65 + d] * kk[s * 65 + d]; } sc[t * 8 + s] = a; }
                __syncthreads();
                {
                    const int t = wave, e0 = lane * 2; float o0 = 0.f, o1 = 0.f;
                    for (int d = 0; d < 64; ++d) { const float qd = qq[t * 65 + d]; o0 += qd * S0[d * 128 + e0]; o1 += qd * S0[d * 128 + e0 + 1]; }
                    for (int s = 0; s <= t; ++s) { const float w = sc[t * 8 + s]; o0 += w * vv[s * 128 + e0]; o1 += w * vv[s * 128 + e0 + 1]; }
                    const float ss = wave_sum(o0 * o0 + o1 * o1); const float rs = rsqrtf(ss * (1.f / 128.f) + EPS);
                    const unsigned rw = *(const unsigned*)(Pb + (r0 + t) * NINP + PC_R + h * 128 + e0);
                    const float y0 = o0 * rs * g_gla_out[e0] * siluf(bflo(rw)), y1 = o1 * rs * g_gla_out[e0 + 1] * siluf(bfhi(rw));
                    *(unsigned*)(mix + (r0 + t) * D + h * 128 + e0) = pk2(y0, y1);
                }
                {
                    const int d = tid >> 3, e0 = (tid & 7) * 16; const float dec = __expf(bb[7 * 65 + d]);
                    f32x4 a[4];
#pragma unroll
                    for (int i = 0; i < 4; ++i) a[i] = ((const f32x4*)(S0 + d * 128 + e0))[i] * dec;
#pragma unroll
                    for (int s = 0; s < 8; ++s) { const float kd = kt[s * 65 + d]; const f32x4* vp = (const f32x4*)(vv + s * 128 + e0);
#pragma unroll
                        for (int i = 0; i < 4; ++i) a[i] += vp[i] * kd; }
                    f32x4* dp = (f32x4*)(out + O_GLAS + (size_t)unit * 8192 + d * 128 + e0);
#pragma unroll
                    for (int i = 0; i < 4; ++i) dp[i] = a[i];
                }
                __syncthreads();
            }
        }
        for (int it = gw; it < 136 * 32; it += NGW) {
            const int rb = it >> 5, g = it & 31, fr = lane & 15, fq = lane >> 4; const int R0 = rb * 16;
            f32x4 acc[8];
#pragma unroll
            for (int nb = 0; nb < 8; ++nb) acc[nb] = (f32x4){0.f, 0.f, 0.f, 0.f};
#pragma unroll
            for (int ks = 0; ks < 4; ++ks) {
                const bf16x8 a = *(const bf16x8*)(Pb + ((size_t)(R0 + fr) * 8 + ks * 2 + (fq >> 1)) * NINP + PC_U + g * 16 + (fq & 1) * 8);
#pragma unroll
                for (int nb = 0; nb < 8; ++nb) { const bf16x8 bfr = *(const bf16x8*)(EgT + (size_t)(g * 128 + nb * 16 + fr) * 128 + ks * 32 + fq * 8);
                    acc[nb] = __builtin_amdgcn_mfma_f32_16x16x32_bf16(a, bfr, acc[nb], 0, 0, 0); }
            }
#pragma unroll
            for (int nb = 0; nb < 8; ++nb)
#pragma unroll
                for (int r = 0; r < 4; ++r) s5e[((size_t)(R0 + fq * 4 + r) * 32 + g) * 128 + nb * 16 + fr] = acc[nb][r];
        }
    }
    SEAM(4);

    PHASE(5) {
        REP_SYNC();
        PHASE_LOCALS;
        for (int idx = gt; idx < 32 * 8192; idx += NGT) {
            const int bh = idx >> 13, de = idx & 8191, d = de >> 7;
            float Dv[32], dc[32];
#pragma unroll
            for (int c = 0; c < 32; ++c) { const int unit = bh * 32 + c; Dv[c] = glaD[(size_t)unit * 8192 + de]; dc[c] = glaDec[unit * 64 + d]; }
            float S = 0.f;
#pragma unroll
            for (int c = 0; c < 32; ++c) { glaD[(size_t)(bh * 32 + c) * 8192 + de] = S; S = dc[c] * S + Dv[c]; }
            out[O_GLAP + idx] = S;
        }
        for (int it = bx; it < 256; it += G) {
            const int b = it >> 5, g = it & 31, n = tid & 63, sgm = wave;
            const S5P p = s5_par(s5_lre, s5_lim, s5_logdt, g, n); const f32x2 a8 = s5_pow(p, 8);
            f32x2 a256 = a8;
#pragma unroll
            for (int i = 0; i < 5; ++i) a256 = cmul(a256, a256);
            float er[32], ei[32];
            const size_t o0 = (((size_t)b * 256 + sgm * 32) * 32 + g) * 128;
#pragma unroll
            for (int i = 0; i < 32; ++i) { er[i] = s5e[o0 + (size_t)i * 4096 + n]; ei[i] = s5e[o0 + (size_t)i * 4096 + 64 + n]; }
            float yr = 0.f, yi = 0.f;
#pragma unroll
            for (int i = 0; i < 32; ++i) { const float pr = yr, pi = yi; yr = a8.x * pr - a8.y * pi + er[i]; yi = a8.x * pi + a8.y * pr + ei[i]; er[i] = pr; ei[i] = pi; }
            fl[sgm * 64 + n] = yr; fl[512 + sgm * 64 + n] = yi;
            __syncthreads();
            float xr = 0.f, xi = 0.f;
            for (int j = 0; j < sgm; ++j) { const float tr = fl[j * 64 + n], ti = fl[512 + j * 64 + n]; const float nr = a256.x * xr - a256.y * xi + tr, ni = a256.x * xi + a256.y * xr + ti; xr = nr; xi = ni; }
            f32x2 pw = (f32x2){1.f, 0.f};
#pragma unroll
            for (int i = 0; i < 32; ++i) {
                s5x[o0 + (size_t)i * 4096 + n] = (bf16_t)f2bf(er[i] + pw.x * xr - pw.y * xi); s5x[o0 + (size_t)i * 4096 + 64 + n] = (bf16_t)f2bf(ei[i] + pw.x * xi + pw.y * xr);
                pw = cmul(pw, a8);
            }
            if (sgm == 7) { out[O_REP + (b * 32 + g) * 64 + n] = yr + a256.x * xr - a256.y * xi; out[O_IMP + (b * 32 + g) * 64 + n] = yi + a256.x * xi + a256.y * xr; }
            __syncthreads();
        }
        for (int idx = gt; idx < 128 * 32 * 64; idx += NGT) {
            const int b = idx >> 11, g = (idx >> 6) & 31, n = idx & 63;
            const S5P p = s5_par(s5_lre, s5_lim, s5_logdt, g, n); const f32x2 a8 = s5_pow(p, 8);
            const float xr = st_re[idx], xi = st_im[idx];
            const size_t R = 2048 + b; const size_t o = (R * 32 + g) * 128;
            s5x[o + n] = (bf16_t)f2bf(xr); s5x[o + 64 + n] = (bf16_t)f2bf(xi);
            out[O_RES + idx] = a8.x * xr - a8.y * xi + s5e[o + n]; out[O_IMS + idx] = a8.x * xi + a8.y * xr + s5e[o + 64 + n];
        }
    }
    SEAM(5);

    PHASE(6) {
        REP_SYNC();
        PHASE_LOCALS;
        {
            float* zg = fl; float* qq = zg + 64 * 16; float* kk = qq + 64 * 65; float* vv = kk + 64 * 65; float* bb = vv + 64 * 128; float* sc = bb + 64 * 65; float* Sp = sc + 64 * 65; float* seg = Sp + 64 * 128;
            for (int unit = bx; unit < 1024; unit += G) {
                const int bh = unit >> 5, c = unit & 31, b = bh >> 2, h = bh & 3;
                const size_t r0 = (size_t)b * 2048 + c * 64;
                if (tid < 128) { const int t = tid >> 1, hf = tid & 1; const u32x4 w = *(const u32x4*)(Pb + (r0 + t) * NINP + PC_ZG + hf * 8);
                    float* z = zg + t * 16 + hf * 8; z[0] = bflo(w.x); z[1] = bfhi(w.x); z[2] = bflo(w.y); z[3] = bfhi(w.y); z[4] = bflo(w.z); z[5] = bfhi(w.z); z[6] = bflo(w.w); z[7] = bfhi(w.w); }
                { const int t = tid >> 3, c8 = tid & 7;
                    const u32x4 w = *(const u32x4*)(Pb + (r0 + t) * NINP + PC_K + h * 64 + c8 * 8);
                    float* z = kk + t * 65 + c8 * 8; z[0] = bflo(w.x); z[1] = bfhi(w.x); z[2] = bflo(w.y); z[3] = bfhi(w.y); z[4] = bflo(w.z); z[5] = bfhi(w.z); z[6] = bflo(w.w); z[7] = bfhi(w.w);
                    const u32x4 wq = *(const u32x4*)(Pb + (r0 + t) * NINP + PC_Q + h * 64 + c8 * 8);
                    float* y = qq + t * 65 + c8 * 8; y[0] = bflo(wq.x); y[1] = bfhi(wq.x); y[2] = bflo(wq.y); y[3] = bfhi(wq.y); y[4] = bflo(wq.z); y[5] = bfhi(wq.z); y[6] = bflo(wq.w); y[7] = bfhi(wq.w); }
#pragma unroll
                for (int i = 0; i < 2; ++i) { const int ch = tid + i * 512, t = ch >> 4, c8 = ch & 15; const u32x4 w = *(const u32x4*)(Pb + (r0 + t) * NINP + PC_V + h * 128 + c8 * 8);
                    float* z = vv + t * 128 + c8 * 8; z[0] = bflo(w.x); z[1] = bfhi(w.x); z[2] = bflo(w.y); z[3] = bfhi(w.y); z[4] = bflo(w.z); z[5] = bfhi(w.z); z[6] = bflo(w.w); z[7] = bfhi(w.w); }
                { const f32x4* sp = (const f32x4*)(glaD + (size_t)unit * 8192); f32x4* dp = (f32x4*)Sp;
#pragma unroll
                    for (int i = 0; i < 4; ++i) dp[tid + i * 512] = sp[tid + i * 512]; }
                __syncthreads();
                gla_gate_cumsum<64>(zg, bb, seg, w_gate, b_gate, h, tid);
                for (int i = tid; i < 64 * 64; i += NTHREADS) { const int t = i >> 6, d = i & 63; const float bt = bb[t * 65 + d]; qq[t * 65 + d] *= __expf(bt) * 0.125f; kk[t * 65 + d] *= __expf(-bt); }
                __syncthreads();
                { const int t = tid >> 3, s0 = (tid & 7) * 8;
#pragma unroll
                    for (int j = 0; j < 8; ++j) { const int s = s0 + j; float a = 0.f; if (s <= t) { for (int d = 0; d < 64; ++d) a += qq[t * 65 + d] * kk[s * 65 + d]; } sc[t * 65 + s] = a; } }
                __syncthreads();
                { const int t = tid >> 3, e0 = (tid & 7) * 16; f32x4 a[4];
#pragma unroll
                    for (int i = 0; i < 4; ++i) a[i] = (f32x4){0.f, 0.f, 0.f, 0.f};
                    for (int d = 0; d < 64; ++d) { const float qd = qq[t * 65 + d]; const f32x4* sp = (const f32x4*)(Sp + d * 128 + e0);
#pragma unroll
                        for (int i = 0; i < 4; ++i) a[i] += sp[i] * qd; }
                    for (int s = 0; s <= t; ++s) { const float w = sc[t * 65 + s]; const f32x4* vp = (const f32x4*)(vv + s * 128 + e0);
#pragma unroll
                        for (int i = 0; i < 4; ++i) a[i] += vp[i] * w; }
                    float ss = 0.f;
#pragma unroll
                    for (int i = 0; i < 4; ++i) ss += (a[i][0] * a[i][0] + a[i][1] * a[i][1]) + (a[i][2] * a[i][2] + a[i][3] * a[i][3]);
                    ss += __shfl_xor(ss, 1); ss += __shfl_xor(ss, 2); ss += __shfl_xor(ss, 4);
                    const float rs = rsqrtf(ss * (1.f / 128.f) + EPS);
                    const u32x4* rp = (const u32x4*)(Pb + (r0 + t) * NINP + PC_R + h * 128 + e0); const f32x4* gp = (const f32x4*)(g_gla_out + e0);
                    u32x4* mp = (u32x4*)(mix + (r0 + t) * D + h * 128 + e0);
#pragma unroll
                    for (int hf = 0; hf < 2; ++hf) { const u32x4 rw = rp[hf]; const f32x4 g0 = gp[hf * 2], g1 = gp[hf * 2 + 1]; const f32x4 x0 = a[hf * 2] * rs * g0, x1 = a[hf * 2 + 1] * rs * g1;
                        u32x4 w; w.x = pk2(x0[0] * siluf(bflo(rw.x)), x0[1] * siluf(bfhi(rw.x))); w.y = pk2(x0[2] * siluf(bflo(rw.y)), x0[3] * siluf(bfhi(rw.y)));
                        w.z = pk2(x1[0] * siluf(bflo(rw.z)), x1[1] * siluf(bfhi(rw.z))); w.w = pk2(x1[2] * siluf(bflo(rw.w)), x1[3] * siluf(bfhi(rw.w))); mp[hf] = w; }
                }
                __syncthreads();
            }
        }
        for (int it = gw; it < 136 * 32; it += NGW) {
            const int rb = it >> 5, g = it & 31, fr = lane & 15, fq = lane >> 4; const int R0 = rb * 16;
            f32x4 acc[8];
#pragma unroll
            for (int nb = 0; nb < 8; ++nb) acc[nb] = (f32x4){0.f, 0.f, 0.f, 0.f};
#pragma unroll 1
            for (int ks = 0; ks < 8; ++ks) {
                bf16x8 a;
                if (ks < 4) a = *(const bf16x8*)(s5x + ((size_t)(R0 + fr) * 32 + g) * 128 + ks * 32 + fq * 8);
                else a = *(const bf16x8*)(Pb + ((size_t)(R0 + fr) * 8 + (ks - 4) * 2 + (fq >> 1)) * NINP + PC_U + g * 16 + (fq & 1) * 8);
#pragma unroll
                for (int nb = 0; nb < 8; ++nb) { const bf16x8 bfr = *(const bf16x8*)(GTt + (size_t)(g * 128 + nb * 16 + fr) * 256 + ks * 32 + fq * 8);
                    acc[nb] = __builtin_amdgcn_mfma_f32_16x16x32_bf16(bfr, a, acc[nb], 0, 0, 0); }
            }
            bf16x4 wA;
#pragma unroll
            for (int i = 0; i < 4; ++i) wA[i] = (short)f2bf(s5_wglu[(g * 16 + fq * 4 + i) * 16 + fr]);
            const f32x4 dsk = *(const f32x4*)(s5_d + g * 16 + fq * 4), bgl = *(const f32x4*)(s5_bglu + g * 16 + fq * 4);
#pragma unroll
            for (int nb = 0; nb < 8; ++nb) {
                const size_t row = (size_t)(R0 + fr) * 8 + nb;
                const u32x2 uw = *(const u32x2*)(Pb + row * NINP + PC_U + g * 16 + fq * 4);
                f32x4 z;
                z[0] = gelu_tanh(acc[nb][0] + dsk[0] * bflo(uw.x)); z[1] = gelu_tanh(acc[nb][1] + dsk[1] * bfhi(uw.x));
                z[2] = gelu_tanh(acc[nb][2] + dsk[2] * bflo(uw.y)); z[3] = gelu_tanh(acc[nb][3] + dsk[3] * bfhi(uw.y));
                const u32x2 zp = (u32x2){pk2(z[0], z[1]), pk2(z[2], z[3])};
                const f32x4 pre = __builtin_amdgcn_mfma_f32_16x16x16bf16_1k(wA, __builtin_bit_cast(bf16x4, zp), bgl, 0, 0, 0);
                u32x2 o; o.x = pk2(z[0] * sigmoidf_fast(pre[0]), z[1] * sigmoidf_fast(pre[1])); o.y = pk2(z[2] * sigmoidf_fast(pre[2]), z[3] * sigmoidf_fast(pre[3]));
                *(u32x2*)(mix + row * D + 512 + g * 16 + fq * 4) = o;
            }
        }
    }
    SEAM(6);

    PHASE(7) {
        REP_SYNC();
        pg8::Gemm g{mix, Wout, M, D, D}; pg8::StaticOrder S; S.init(M, D, G, bx);
        pg8::EpiResid E{hres, hres + (size_t)MP * D, hres, hb, ssq + SSQ_H2, 1.f};
        pg8::gemm_phase<pg8::EpiResid, pg8::StaticOrder, true, true>(ldsl, g, S, E);
    }
    SEAM(7);
    PHASE(8) {
        REP_SYNC();
        pg8::Gemm g{hb, Wcq, M, D, D}; pg8::StaticOrder S; S.init(M, D, G, bx);
        pg8::EpiScaleBf16 E{qb, D, ssq + SSQ_H2, 0.0625f};
        pg8::gemm_phase<pg8::EpiScaleBf16, pg8::StaticOrder, true, true>(ldsl, g, S, E);
    }
    SEAM(8);

    PHASE(9) {
        REP_SYNC();
        PHASE_LOCALS;
        constexpr int QS = 264;
        bf16_t* Qs = (bf16_t*)lds; bf16_t* Ps = Qs + 64 * QS; float* redmax = (float*)(Ps + 64 * QS); float* redsum = redmax + 64 * 8;
        const int fr = lane & 15, fq = lane >> 4, w = wave;
        for (int unit = bx; unit < 1024 + 512; unit += G) {
            const bool smp = unit >= 1024;
            int b, h; size_t r0; int nrows;
            if (!smp) { const int qt = unit & 31; h = (unit >> 5) & 3; b = unit >> 7; r0 = (size_t)b * 2048 + qt * 64; nrows = 64; }
            else { const int u2 = unit - 1024; h = u2 & 3; b = u2 >> 2; r0 = (size_t)MP + b * 8; nrows = 8; }
            const int MB = smp ? 1 : 4;
            for (int ch = tid; ch < MB * 16 * 32; ch += NTHREADS) { const int row = ch >> 5, c8 = ch & 31; u32x4 v = (u32x4){0u, 0u, 0u, 0u};
                if (row < nrows) v = *(const u32x4*)(qb + (r0 + row) * D + h * 256 + c8 * 8);
                *(u32x4*)(Qs + row * QS + c8 * 8) = v; }
            __syncthreads();
            f32x4 sa[4][2];
#pragma unroll
            for (int mb = 0; mb < 4; ++mb) { sa[mb][0] = (f32x4){0.f, 0.f, 0.f, 0.f}; sa[mb][1] = sa[mb][0]; }
            if (!smp) {
                const bf16_t* kbase = kb + ((size_t)b * 256 + w * 32 + fr) * D + h * 256 + fq * 8;
#pragma unroll
                for (int ks = 0; ks < 8; ++ks) {
                    const bf16x8 b0 = *(const bf16x8*)(kbase + ks * 32), b1 = *(const bf16x8*)(kbase + (size_t)16 * D + ks * 32);
#pragma unroll
                    for (int mb = 0; mb < 4; ++mb) { const bf16x8 a = *(const bf16x8*)(Qs + (mb * 16 + fr) * QS + ks * 32 + fq * 8);
                        sa[mb][0] = __builtin_amdgcn_mfma_f32_16x16x32_bf16(a, b0, sa[mb][0], 0, 0, 0); sa[mb][1] = __builtin_amdgcn_mfma_f32_16x16x32_bf16(a, b1, sa[mb][1], 0, 0, 0); }
                }
            } else {
                const float* kbase = cache_k + ((size_t)b * 256 + w * 32 + fr) * D + h * 256 + fq * 8;
#pragma unroll
                for (int ks = 0; ks < 8; ++ks) {
                    u32x4 p0, p1;
                    { const f32x4 x0 = *(const f32x4*)(kbase + ks * 32), x1 = *(const f32x4*)(kbase + ks * 32 + 4); p0 = (u32x4){pk2(x0[0], x0[1]), pk2(x0[2], x0[3]), pk2(x1[0], x1[1]), pk2(x1[2], x1[3])}; }
                    { const f32x4 x0 = *(const f32x4*)(kbase + (size_t)16 * D + ks * 32), x1 = *(const f32x4*)(kbase + (size_t)16 * D + ks * 32 + 4); p1 = (u32x4){pk2(x0[0], x0[1]), pk2(x0[2], x0[3]), pk2(x1[0], x1[1]), pk2(x1[2], x1[3])}; }
                    const bf16x8 a = *(const bf16x8*)(Qs + fr * QS + ks * 32 + fq * 8);
                    sa[0][0] = __builtin_amdgcn_mfma_f32_16x16x32_bf16(a, __builtin_bit_cast(bf16x8, p0), sa[0][0], 0, 0, 0);
                    sa[0][1] = __builtin_amdgcn_mfma_f32_16x16x32_bf16(a, __builtin_bit_cast(bf16x8, p1), sa[0][1], 0, 0, 0);
                }
            }
#pragma unroll
            for (int mb = 0; mb < 4; ++mb) if (mb < MB) {
#pragma unroll
                for (int r = 0; r < 4; ++r) { float mx = fmaxf(sa[mb][0][r], sa[mb][1][r]);
                    mx = fmaxf(mx, __shfl_xor(mx, 1)); mx = fmaxf(mx, __shfl_xor(mx, 2)); mx = fmaxf(mx, __shfl_xor(mx, 4)); mx = fmaxf(mx, __shfl_xor(mx, 8));
                    if (fr == 0) redmax[(mb * 16 + fq * 4 + r) * 8 + w] = mx; }
            }
            __syncthreads();
#pragma unroll
            for (int mb = 0; mb < 4; ++mb) if (mb < MB) {
#pragma unroll
                for (int r = 0; r < 4; ++r) { const int q = mb * 16 + fq * 4 + r; const f32x4 m0 = *(const f32x4*)(redmax + q * 8), m1 = *(const f32x4*)(redmax + q * 8 + 4);
                    const float mx = fmaxf(fmaxf(fmaxf(m0[0], m0[1]), fmaxf(m0[2], m0[3])), fmaxf(fmaxf(m1[0], m1[1]), fmaxf(m1[2], m1[3])));
                    const float p0 = __expf(sa[mb][0][r] - mx), p1 = __expf(sa[mb][1][r] - mx);
                    Ps[q * QS + w * 32 + fr] = (bf16_t)f2bf(p0); Ps[q * QS + w * 32 + 16 + fr] = (bf16_t)f2bf(p1);
                    float sm = p0 + p1; sm += __shfl_xor(sm, 1); sm += __shfl_xor(sm, 2); sm += __shfl_xor(sm, 4); sm += __shfl_xor(sm, 8);
                    if (fr == 0) redsum[q * 8 + w] = sm; }
            }
            __syncthreads();
            f32x4 oa[4][2];
#pragma unroll
            for (int mb = 0; mb < 4; ++mb) { oa[mb][0] = (f32x4){0.f, 0.f, 0.f, 0.f}; oa[mb][1] = oa[mb][0]; }
            if (!smp) {
                const bf16_t* vbase = vbT + ((size_t)b * D + h * 256 + w * 32 + fr) * 256 + fq * 8;
#pragma unroll
                for (int ks = 0; ks < 8; ++ks) {
                    const bf16x8 b0 = *(const bf16x8*)(vbase + ks * 32), b1 = *(const bf16x8*)(vbase + 16 * 256 + ks * 32);
#pragma unroll
                    for (int mb = 0; mb < 4; ++mb) { const bf16x8 a = *(const bf16x8*)(Ps + (mb * 16 + fr) * QS + ks * 32 + fq * 8);
                        oa[mb][0] = __builtin_amdgcn_mfma_f32_16x16x32_bf16(a, b0, oa[mb][0], 0, 0, 0); oa[mb][1] = __builtin_amdgcn_mfma_f32_16x16x32_bf16(a, b1, oa[mb][1], 0, 0, 0); }
                }
            } else {
                const float* vbase = cache_v + ((size_t)b * 256 + fq * 8) * D + h * 256 + w * 32 + fr;
#pragma unroll
                for (int ks = 0; ks < 8; ++ks) {
                    float x0[8], x1[8];
#pragma unroll
                    for (int j = 0; j < 8; ++j) { x0[j] = vbase[(size_t)(ks * 32 + j) * D]; x1[j] = vbase[(size_t)(ks * 32 + j) * D + 16]; }
                    const u32x4 p0 = (u32x4){pk2(x0[0], x0[1]), pk2(x0[2], x0[3]), pk2(x0[4], x0[5]), pk2(x0[6], x0[7])};
                    const u32x4 p1 = (u32x4){pk2(x1[0], x1[1]), pk2(x1[2], x1[3]), pk2(x1[4], x1[5]), pk2(x1[6], x1[7])};
                    const bf16x8 a = *(const bf16x8*)(Ps + fr * QS + ks * 32 + fq * 8);
                    oa[0][0] = __builtin_amdgcn_mfma_f32_16x16x32_bf16(a, __builtin_bit_cast(bf16x8, p0), oa[0][0], 0, 0, 0);
                    oa[0][1] = __builtin_amdgcn_mfma_f32_16x16x32_bf16(a, __builtin_bit_cast(bf16x8, p1), oa[0][1], 0, 0, 0);
                }
            }
#pragma unroll
            for (int mb = 0; mb < 4; ++mb) if (mb < MB) {
#pragma unroll
                for (int r = 0; r < 4; ++r) { const int q = mb * 16 + fq * 4 + r; if (q < nrows) {
                    const f32x4 s0 = *(const f32x4*)(redsum + q * 8), s1 = *(const f32x4*)(redsum + q * 8 + 4);
                    const float inv = 1.f / (((s0[0] + s0[1]) + (s0[2] + s0[3])) + ((s1[0] + s1[1]) + (s1[2] + s1[3])));
                    bf16_t* op = ob + (r0 + q) * D + h * 256 + w * 32 + fr;
                    op[0] = (bf16_t)f2bf(oa[mb][0][r] * inv); op[16] = (bf16_t)f2bf(oa[mb][1][r] * inv); } }
            }
            __syncthreads();
        }
    }
    SEAM(9);

    PHASE(10) {
        REP_SYNC();
        pg8::Gemm g{ob, Wco, M, D, D}; pg8::StaticOrder S; S.init(M, D, G, bx);
        pg8::EpiResid E{hres, hres + (size_t)MP * D, hres, hb, ssq + SSQ_H3, 1.f};
        pg8::gemm_phase<pg8::EpiResid, pg8::StaticOrder, true, true>(ldsl, g, S, E);
    }
    SEAM(10);
    PHASE(11) {
        REP_SYNC();
        pg8::Gemm g{hb, Wgu2, M, NGU, D}; pg8::StaticOrder S; S.init(M, NGU, G, bx);
        pg8::EpiSwiGLU E{act, FF, ssq + SSQ_H3};
        pg8::gemm_phase<pg8::EpiSwiGLU, pg8::StaticOrder, true, true>(ldsl, g, S, E);
    }
    SEAM(11);
    PHASE(12) {
        REP_SYNC();
        pg8::Gemm g{act, Wd2, M, D, FF}; pg8::StaticOrder S; S.init(M, D, G, bx);
        pg8::EpiResid E{hres, hres + (size_t)MP * D, out + O_Y, nullptr, nullptr, 0.5f};
        pg8::gemm_phase<pg8::EpiResid, pg8::StaticOrder, true, true>(ldsl, g, S, E);
    }
    SEAM(12);
    PHASE(13) {
        REP_SYNC();
        PHASE_LOCALS;
        for (int m = gw; m < M; m += NGW) {
            f32x4* yr = (f32x4*)(out + O_Y + (size_t)m * D) + lane; f32x4 v[4]; float s = 0.f;
#pragma unroll
            for (int j = 0; j < 4; ++j) { v[j] = yr[64 * j]; s += (v[j].x * v[j].x + v[j].y * v[j].y) + (v[j].z * v[j].z + v[j].w * v[j].w); }
            const float rs = rsqrtf(wave_sum(s) * (1.f / D) + EPS);
#pragma unroll
            for (int j = 0; j < 4; ++j) { const f32x4 gq = ((const f32x4*)g_final)[lane + 64 * j]; yr[64 * j] = v[j] * rs * gq; }
        }
    }
#undef IN
#undef SEAM
}

extern "C" void kernel_launch(void* const* d_in, const int* in_sizes, int n_in, void* d_out, int out_size, void* d_ws, size_t ws_size, hipStream_t stream) {
    static int grid = 0;
    if (grid == 0) {
        if (n_in != 36 || (size_t)out_size != O_TOTAL || ws_size < WS_END) { fprintf(stderr, "kernel_launch: unexpected shapes (n_in %d, out %d, ws %zu)\n", n_in, out_size, ws_size); grid = -1; return; }
        int dev = 0, cus = 0, per_cu = 0;
        hipGetDevice(&dev); hipDeviceGetAttribute(&cus, hipDeviceAttributeMultiprocessorCount, dev);
        hipFuncSetAttribute((const void*)hymba_fwd, hipFuncAttributeMaxDynamicSharedMemorySize, LDS_BYTES);
        hipOccupancyMaxActiveBlocksPerMultiprocessor(&per_cu, (const void*)hymba_fwd, NTHREADS, LDS_BYTES);
        if (per_cu < 1) { fprintf(stderr, "kernel_launch: occupancy query says %d blocks per CU\n", per_cu); per_cu = 1; }
        grid = cus;
        (void)hipGetLastError();
    }
    if (grid < 0) return;
    if (hipMemsetAsync((char*)d_ws + WS_BAR, 0, BAR_BYTES, stream) != hipSuccess) { fprintf(stderr, "kernel_launch: memset failed\n"); return; }
    Args a{};
    for (int i = 0; i < 36; ++i) a.in[i] = (const float*)d_in[i];
    a.out = (float*)d_out; a.ws = (unsigned char*)d_ws; a.ph_lo = 0; a.ph_hi = 14;
    void* params[] = {&a};
    hipError_t e = hipLaunchCooperativeKernel((const void*)hymba_fwd, dim3(grid), dim3(NTHREADS), params, LDS_BYTES, stream);
    if (e != hipSuccess) fprintf(stderr, "kernel_launch: cooperative launch failed: %s (grid %d)\n", hipGetErrorString(e), grid);
}
```

```cpp
#include <hip/hip_runtime.h>
#include <hip/hip_cooperative_groups.h>
#include <cstdio>
#include <cstdint>
namespace cg = cooperative_groups;

constexpr int D = 1024, MP = 16384, MS = 1024, M = MP + MS, FF = 2816, NGU = 2 * FF, NIN = 2064, NINP = 2304;
constexpr int MEMR = 2048;
constexpr float EPS = 1e-6f;
constexpr int PC_Q = 0, PC_K = 256, PC_V = 512, PC_R = 1024, PC_U = 1536, PC_ZG = 2048;
constexpr size_t O_Y = 0, O_GLAP = 17825792, O_REP = 18087936, O_IMP = 18104320, O_MKP = 18120704, O_MVP = 20217856,
                 O_GLAS = 22315008, O_RES = 26509312, O_IMS = 26771456, O_TOTAL = 27033600;
constexpr size_t MiB = 1u << 20;
constexpr int XCD_BAR_WORDS_C = 3456;
constexpr size_t WS_SSQ = 0;
constexpr size_t WS_WGU1 = 1 * MiB, WS_WD1 = 12 * MiB, WS_WIN = 18 * MiB, WS_WOUT = 23 * MiB, WS_WCQ = 25 * MiB, WS_WCKV = 27 * MiB,
                 WS_WCO = 31 * MiB, WS_WGU2 = 33 * MiB, WS_WD2 = 44 * MiB, WS_EGT = 50 * MiB, WS_GTT = 51 * MiB, WS_MEMB = 53 * MiB,
                 WS_KB = 57 * MiB, WS_VBT = 61 * MiB, WS_XB = 65 * MiB, WS_HB = 99 * MiB, WS_H = 133 * MiB, WS_ACT = 201 * MiB,
                 WS_MIX = 295 * MiB, WS_Q = 329 * MiB, WS_O = 363 * MiB, WS_GLAD = 397 * MiB, WS_GLADEC = 429 * MiB, WS_S5E = 430 * MiB,
                 WS_S5X = 464 * MiB, WS_END = 481 * MiB;
constexpr int SSQ_X = 0, SSQ_MEM = M, SSQ_H1 = M + 2048, SSQ_H2 = 2 * M + 2048, SSQ_H3 = 3 * M + 2048, SSQ_WORDS = 4 * M + 2048;
static_assert((size_t)SSQ_WORDS * 4 <= MiB, "ssq region");
static_assert(WS_ACT + (size_t)M * FF * 2 <= WS_MIX && WS_ACT + (size_t)M * NINP * 2 <= WS_MIX, "act / P region");

constexpr size_t WS_BAR = 512 * 1024, BAR_BYTES = 16384;
static_assert((size_t)SSQ_WORDS * 4 <= WS_BAR && XCD_BAR_WORDS_C * 4 <= BAR_BYTES, "ctl map");
constexpr int NWAVES = 8, NTHREADS = 512;
constexpr int LDS_BYTES = 147456;
constexpr int LDS_BARST = LDS_BYTES - 64;

#define LAS __attribute__((address_space(3)))
typedef unsigned short bf16_t;
typedef short bf16x8 __attribute__((ext_vector_type(8)));
typedef short bf16x4 __attribute__((ext_vector_type(4)));
typedef float f32x4 __attribute__((ext_vector_type(4)));
typedef float f32x2 __attribute__((ext_vector_type(2)));
typedef unsigned u32x4 __attribute__((ext_vector_type(4)));
typedef unsigned u32x2 __attribute__((ext_vector_type(2)));
#define DI __device__ __forceinline__

DI unsigned f2bf(float f) { unsigned u = __builtin_bit_cast(unsigned, f); return (u + 0x7fffu + ((u >> 16) & 1u)) >> 16; }
DI unsigned pk2(float lo, float hi) { return f2bf(lo) | (f2bf(hi) << 16); }
DI float bf2f(unsigned b) { return __builtin_bit_cast(float, b << 16); }
DI float bflo(unsigned w) { return __builtin_bit_cast(float, w << 16); }
DI float bfhi(unsigned w) { return __builtin_bit_cast(float, w & 0xffff0000u); }
DI float wave_sum(float v) {
#pragma unroll
    for (int o = 1; o < 64; o <<= 1) v += __shfl_xor(v, o);
    return v;
}
DI float sigmoidf_fast(float x) { return __builtin_amdgcn_rcpf(1.f + __expf(-x)); }
DI float siluf(float x) { return x * sigmoidf_fast(x); }
DI float logsigmoidf(float x) { return fminf(x, 0.f) - log1pf(__expf(-fabsf(x))); }
DI float gelu_tanh(float y) { const float a = 0.7978845608028654f * (y + 0.044715f * y * y * y); const float e = __expf(2.f * a); const float th = 1.f - 2.f * __builtin_amdgcn_rcpf(e + 1.f); return 0.5f * y * (1.f + th); }

namespace pg8 {
#define PG8_LAS __attribute__((address_space(3)))
constexpr int BM = 256, BK = 64, HALF = 128, HTB = HALF * BK * 2  , STAGE_BYTES = 8 * HTB, NXCD = 8, WGM = 8;

__host__ __device__ __forceinline__ int lds_byte(int r, int c) { const int st = (r >> 4) * 2 + (c >> 5), rr = r & 15, cc = c & 31, ob = rr * 64 + cc * 2; return st * 1024 + (ob ^ (((ob >> 9) & 1) << 5)); }
__host__ __device__ __forceinline__ void stage_rc(int b, int& R, int& C) { const int st = b / 1024, sb = b % 1024, swz = sb ^ (((sb >> 9) & 1) << 5); R = (st >> 1) * 16 + swz / 64; C = (st & 1) * 32 + (swz % 64) / 2; }
__host__ __device__ __forceinline__ int perm32(int rho) { const int n = rho >> 4, i = rho & 15; return 8 * (i >> 2) + 4 * n + (i & 3); }

struct Unit { int pm, pn; };
struct Gemm { const bf16_t* A; const bf16_t* Bt; int M, N, K; };

struct StaticOrder {
    int nM, nN, nwg, G, c;
    __host__ __device__ void init(int M_, int N_, int G_, int c_) { nM = M_ / BM; nN = N_ / BM; nwg = nM * nN; G = G_; c = c_; }
    __host__ __device__ bool next(int i, Unit& u) const {
        const long L = (long)i * G + c; if (L >= nwg) return false;
        int wgid = (int)L; { const int q = nwg / NXCD, r = nwg % NXCD, xcd = wgid % NXCD, off = wgid / NXCD; wgid = (xcd < r ? xcd * (q + 1) : r * (q + 1) + (xcd - r) * q) + off; }
        const int nig = WGM * nN, gid = wgid / nig, fm = gid * WGM, gsz = (nM - fm) < WGM ? (nM - fm) : WGM;
        u.pm = fm + ((wgid % nig) % gsz); u.pn = (wgid % nig) / gsz; return true;
    }
    __device__ __forceinline__ void a_ready(const Unit&) const {}
    __device__ __forceinline__ void done(const Unit&) const {}
};

__device__ __forceinline__ unsigned cvt_pk_bf16(float lo, float hi) { unsigned r; asm volatile("v_cvt_pk_bf16_f32 %0, %1, %2" : "=v"(r) : "v"(lo), "v"(hi)); return r; }


struct EpiSwiGLU {
    static constexpr bool PERM = true, AFTER_DRAIN = false;
    bf16_t* O; int ldc; const float* ssq;
    __device__ __forceinline__ void operator()(const f32x4 (&acc)[2][2][4][2], const Unit& u, int wr, int wc, int fr, int fq) const {
        const int row0 = u.pm * BM + wr * 64 + fr, col0 = u.pn * HALF + wc * 32 + 8 * fq;
#pragma unroll
        for (int ai = 0; ai < 2; ++ai)
#pragma unroll
            for (int m = 0; m < 4; ++m) {
                const int row = row0 + ai * HALF + m * 16;
                const float rs = rsqrtf(ssq[row] * (1.f / D) + EPS);
                const f32x4 g0 = acc[ai][0][m][0] * rs, g1 = acc[ai][0][m][1] * rs, u0 = acc[ai][1][m][0] * rs, u1 = acc[ai][1][m][1] * rs;
                u32x4 w;
                w.x = cvt_pk_bf16(siluf(g0[0]) * u0[0], siluf(g0[1]) * u0[1]); w.y = cvt_pk_bf16(siluf(g0[2]) * u0[2], siluf(g0[3]) * u0[3]);
                w.z = cvt_pk_bf16(siluf(g1[0]) * u1[0], siluf(g1[1]) * u1[1]); w.w = cvt_pk_bf16(siluf(g1[2]) * u1[2], siluf(g1[3]) * u1[3]);
                *(u32x4*)(O + (size_t)row * ldc + col0) = w;
            }
    }
};
struct EpiResid {
    static constexpr bool PERM = false, AFTER_DRAIN = false;
    const float* base0; const float* base1; float* out; bf16_t* hb; float* ssq; float alpha;
    __device__ __forceinline__ void operator()(const f32x4 (&acc)[2][2][4][2], const Unit& u, int wr, int wc, int fr, int fq) const {
        const int row0 = u.pm * BM + wr * 64 + fr, col0 = u.pn * BM + wc * 32 + 4 * fq;
#pragma unroll
        for (int ai = 0; ai < 2; ++ai)
#pragma unroll
            for (int m = 0; m < 4; ++m) {
                const int row = row0 + ai * HALF + m * 16;
                const float* bp = (row < MP) ? base0 + (size_t)row * D : base1 + (size_t)(row - MP) * D;
                float s = 0.f;
#pragma unroll
                for (int bj = 0; bj < 2; ++bj)
#pragma unroll
                    for (int n = 0; n < 2; ++n) {
                        const int c = col0 + bj * HALF + n * 16;
                        const f32x4 v = *(const f32x4*)(bp + c) + acc[ai][bj][m][n] * alpha;
                        *(f32x4*)(out + (size_t)row * D + c) = v;
                        s += (v[0] * v[0] + v[1] * v[1]) + (v[2] * v[2] + v[3] * v[3]);
                        if (hb) { u32x2 w; w.x = cvt_pk_bf16(v[0], v[1]); w.y = cvt_pk_bf16(v[2], v[3]); *(u32x2*)(hb + (size_t)row * D + c) = w; }
                    }
                if (ssq) { s += __shfl_xor(s, 16); s += __shfl_xor(s, 32); if (fq == 0) atomicAdd(ssq + row, s); }
            }
    }
};
struct EpiScaleBf16 {
    static constexpr bool PERM = true, AFTER_DRAIN = false;
    bf16_t* O; int ldc; const float* ssq; float scale;
    __device__ __forceinline__ void operator()(const f32x4 (&acc)[2][2][4][2], const Unit& u, int wr, int wc, int fr, int fq) const {
        const int row0 = u.pm * BM + wr * 64 + fr, col0 = u.pn * BM + wc * 32 + 8 * fq;
#pragma unroll
        for (int ai = 0; ai < 2; ++ai)
#pragma unroll
            for (int m = 0; m < 4; ++m) {
                const int row = row0 + ai * HALF + m * 16;
                const float rs = rsqrtf(ssq[row] * (1.f / D) + EPS) * scale;
#pragma unroll
                for (int bj = 0; bj < 2; ++bj) {
                    const f32x4 v0 = acc[ai][bj][m][0] * rs, v1 = acc[ai][bj][m][1] * rs;
                    u32x4 w; w.x = cvt_pk_bf16(v0[0], v0[1]); w.y = cvt_pk_bf16(v0[2], v0[3]); w.z = cvt_pk_bf16(v1[0], v1[1]); w.w = cvt_pk_bf16(v1[2], v1[3]);
                    *(u32x4*)(O + (size_t)row * ldc + col0 + bj * HALF) = w;
                }
            }
    }
};
struct EpiMemKV {
    static constexpr bool PERM = false, AFTER_DRAIN = false;
    float* outK; float* outV; bf16_t* kb; bf16_t* vbT; const float* ssq;
    __device__ __forceinline__ void operator()(const f32x4 (&acc)[2][2][4][2], const Unit& u, int wr, int wc, int fr, int fq) const {
        const int row0 = u.pm * BM + wr * 64 + fr; const bool isV = u.pn >= 4; const int col0 = (u.pn & 3) * BM + wc * 32 + 4 * fq;
        float* outp = isV ? outV : outK;
#pragma unroll
        for (int ai = 0; ai < 2; ++ai)
#pragma unroll
            for (int m = 0; m < 4; ++m) {
                const int row = row0 + ai * HALF + m * 16;
                const float rs = rsqrtf(ssq[row] * (1.f / D) + EPS);
                const int b = row >> 8, key = row & 255;
#pragma unroll
                for (int bj = 0; bj < 2; ++bj)
#pragma unroll
                    for (int n = 0; n < 2; ++n) {
                        const int c = col0 + bj * HALF + n * 16;
                        const f32x4 v = acc[ai][bj][m][n] * rs;
                        *(f32x4*)(outp + (size_t)row * D + c) = v;
                        if (!isV) { u32x2 w; w.x = cvt_pk_bf16(v[0], v[1]); w.y = cvt_pk_bf16(v[2], v[3]); *(u32x2*)(kb + (size_t)row * D + c) = w; }
                        else {
#pragma unroll
                            for (int i = 0; i < 4; ++i) vbT[((size_t)b * D + c + i) * 256 + key] = (bf16_t)f2bf(v[i]);
                        }
                    }
            }
    }
};

template <class Epi, class Sched, bool ALIGN_EPI = false, bool SP2 = false>
__device__ __forceinline__ void gemm_phase(PG8_LAS unsigned char* lds, const Gemm g, const Sched& S, const Epi& E) {
    const int tid = threadIdx.x, wid = __builtin_amdgcn_readfirstlane(tid >> 6), lane = tid & 63, wr = wid >> 2, wc = wid & 3, fr = lane & 15, fq = lane >> 4;
    const int K = g.K, nt = K / BK;
    unsigned voffA[2], voffB[2];
#pragma unroll
    for (int i = 0; i < 2; ++i) { int R, C; stage_rc(tid * 16 + i * 8192, R, C); const int Rb = Epi::PERM ? ((R & ~31) + perm32(R & 31)) : R;
        voffA[i] = (unsigned)(R * K + C) * 2u; voffB[i] = (unsigned)(Rb * K + C) * 2u; }
    const size_t kstep = (size_t)(BK * 2);
    const size_t hstep = (size_t)HALF * K * 2;
    const size_t tstep = 2 * hstep;
    const unsigned ldsw = (unsigned)wid * 1024u;
    const int aoff = lds_byte(wr * 64 + fr, fq * 8), boff = lds_byte(wc * 32 + fr, fq * 8);
#define PG8_SA(b, h) (((b) * 2 + (h)) * HTB)
#define PG8_SB(b, h) ((4 + (b) * 2 + (h)) * HTB)
#define PG8_STAGE(bufoff, gbase, voff) do { _Pragma("unroll") for (int _i = 0; _i < 2; ++_i) \
        __builtin_amdgcn_global_load_lds((const unsigned*)((const char*)(gbase) + (voff)[_i]), (PG8_LAS unsigned*)(lds + (bufoff) + ldsw + _i * 8192), 16, 0, 0); } while (0)
#define PG8_LDA(dst, b, h) do { _Pragma("unroll") for (int m = 0; m < 4; ++m) _Pragma("unroll") for (int k = 0; k < 2; ++k) dst[m][k] = *(const PG8_LAS bf16x8*)(lds + PG8_SA(b, h) + aoff + m * 2048 + k * 1024); } while (0)
#define PG8_LDB(dst, b, h) do { _Pragma("unroll") for (int n = 0; n < 2; ++n) _Pragma("unroll") for (int k = 0; k < 2; ++k) dst[n][k] = *(const PG8_LAS bf16x8*)(lds + PG8_SB(b, h) + boff + n * 2048 + k * 1024); } while (0)
#define PG8_MMA(ai, bj, At, Bt) do { __builtin_amdgcn_s_setprio(1); _Pragma("unroll") for (int m = 0; m < 4; ++m) _Pragma("unroll") for (int n = 0; n < 2; ++n) _Pragma("unroll") for (int k = 0; k < 2; ++k) \
        acc[ai][bj][m][n] = __builtin_amdgcn_mfma_f32_16x16x32_bf16(Bt[n][k], At[m][k], acc[ai][bj][m][n], 0, 0, 0); __builtin_amdgcn_s_setprio(0); } while (0)
#define PG8_WAIT_V(n) asm volatile("s_waitcnt vmcnt(" #n ")" ::: "memory")
#define PG8_WAIT_L(n) asm volatile("s_waitcnt lgkmcnt(" #n ")" ::: "memory")
#define PG8_BAR __builtin_amdgcn_s_barrier()
#define PG8_SCHED __builtin_amdgcn_sched_barrier(0)
    Unit cur, nxt; int ui = 0;
    if (!S.next(0, cur)) return;
    f32x4 acc[2][2][4][2];
#pragma unroll
    for (int a = 0; a < 2; ++a)
#pragma unroll
        for (int b = 0; b < 2; ++b)
#pragma unroll
            for (int m = 0; m < 4; ++m)
#pragma unroll
                for (int n = 0; n < 2; ++n) acc[a][b][m][n] = (f32x4){0.f, 0.f, 0.f, 0.f};
    bf16x8 At[4][2], B0[2][2], B1[2][2];
    const char* cA = (const char*)g.A + (size_t)cur.pm * tstep; const char* cB = (const char*)g.Bt + (size_t)cur.pn * tstep;
    S.a_ready(cur);
    if constexpr (SP2) {
        PG8_STAGE(PG8_SB(0, 0), cB, voffB); PG8_STAGE(PG8_SB(0, 1), cB + hstep, voffB); PG8_STAGE(PG8_SA(0, 0), cA, voffA); PG8_STAGE(PG8_SA(0, 1), cA + hstep, voffA);
        if (wr == 1) PG8_BAR;
        PG8_WAIT_V(2); PG8_BAR;
        PG8_STAGE(PG8_SB(1, 0), cB + kstep, voffB); PG8_STAGE(PG8_SA(1, 0), cA + kstep, voffA); PG8_STAGE(PG8_SB(1, 1), cB + hstep + kstep, voffB);
        PG8_WAIT_V(6); PG8_BAR;
    } else {
        PG8_STAGE(PG8_SB(0, 0), cB, voffB); PG8_STAGE(PG8_SA(0, 0), cA, voffA); PG8_STAGE(PG8_SB(0, 1), cB + hstep, voffB); PG8_STAGE(PG8_SA(0, 1), cA + hstep, voffA);
        if (wr == 1) PG8_BAR;
        PG8_WAIT_V(4); PG8_BAR;
        PG8_STAGE(PG8_SB(1, 0), cB + kstep, voffB); PG8_STAGE(PG8_SA(1, 0), cA + kstep, voffA); PG8_STAGE(PG8_SB(1, 1), cB + hstep + kstep, voffB);
        PG8_WAIT_V(6); PG8_BAR;
    }
    for (;;) {
        const bool has_next = S.next(ui + 1, nxt);
        const char* nA = has_next ? (const char*)g.A + (size_t)nxt.pm * tstep : cA; const char* nB = has_next ? (const char*)g.Bt + (size_t)nxt.pn * tstep : cB;
        for (int t = 0; t < nt; t += 2) {
            const bool last = (t == nt - 2);
            const char* a1 = cA + (size_t)(t + 1) * kstep;
            const char* a2 = last ? nA : cA + (size_t)(t + 2) * kstep; const char* b2 = last ? nB : cB + (size_t)(t + 2) * kstep;
            const char* a3 = a2 + kstep; const char* b3 = b2 + kstep;
            if (last && has_next) S.a_ready(nxt);
            if constexpr (SP2) {
            PG8_LDB(B0, 0, 0); PG8_LDB(B1, 0, 1); PG8_SCHED; PG8_LDA(At, 0, 0); PG8_STAGE(PG8_SA(1, 1), a1 + hstep, voffA);
            PG8_WAIT_V(8); PG8_WAIT_L(0); PG8_BAR; PG8_MMA(0, 0, At, B0); PG8_MMA(0, 1, At, B1); PG8_BAR; PG8_SCHED;
            PG8_LDA(At, 0, 1); PG8_STAGE(PG8_SB(0, 0), b2, voffB); PG8_STAGE(PG8_SB(0, 1), b2 + hstep, voffB); PG8_STAGE(PG8_SA(0, 0), a2, voffA);
            PG8_WAIT_V(8); PG8_WAIT_L(0); PG8_BAR; PG8_MMA(1, 0, At, B0); PG8_MMA(1, 1, At, B1); PG8_BAR; PG8_SCHED;
            PG8_LDB(B0, 1, 0); PG8_LDB(B1, 1, 1); PG8_SCHED; PG8_LDA(At, 1, 0); PG8_STAGE(PG8_SA(0, 1), a2 + hstep, voffA);
            PG8_WAIT_V(8); PG8_WAIT_L(0); PG8_BAR; PG8_MMA(0, 0, At, B0); PG8_MMA(0, 1, At, B1); PG8_BAR; PG8_SCHED;
            PG8_LDA(At, 1, 1); PG8_STAGE(PG8_SB(1, 0), b3, voffB); PG8_STAGE(PG8_SB(1, 1), b3 + hstep, voffB); PG8_STAGE(PG8_SA(1, 0), a3, voffA);
            PG8_WAIT_V(8); PG8_WAIT_L(0); PG8_BAR; PG8_MMA(1, 0, At, B0); PG8_MMA(1, 1, At, B1); PG8_BAR; PG8_SCHED;
            } else {
            PG8_LDB(B0, 0, 0); PG8_SCHED; PG8_LDA(At, 0, 0); PG8_STAGE(PG8_SA(1, 1), a1 + hstep, voffA);
            PG8_WAIT_L(8); PG8_BAR; PG8_WAIT_L(0); PG8_MMA(0, 0, At, B0); PG8_BAR; PG8_SCHED;
            PG8_LDB(B1, 0, 1); PG8_STAGE(PG8_SB(0, 0), b2, voffB);
            PG8_BAR; PG8_WAIT_L(0); PG8_MMA(0, 1, At, B1); PG8_BAR;
            PG8_LDA(At, 0, 1); PG8_STAGE(PG8_SA(0, 0), a2, voffA);
            PG8_BAR; PG8_WAIT_L(0); PG8_MMA(1, 0, At, B0); PG8_BAR; PG8_SCHED;
            PG8_STAGE(PG8_SB(0, 1), b2 + hstep, voffB);
            PG8_WAIT_V(6); PG8_BAR; PG8_MMA(1, 1, At, B1); PG8_BAR;
            PG8_LDB(B0, 1, 0); PG8_SCHED; PG8_LDA(At, 1, 0); PG8_STAGE(PG8_SA(0, 1), a2 + hstep, voffA);
            PG8_WAIT_L(8); PG8_BAR; PG8_WAIT_L(0); PG8_MMA(0, 0, At, B0); PG8_BAR; PG8_SCHED;
            PG8_LDB(B1, 1, 1); PG8_STAGE(PG8_SB(1, 0), b3, voffB);
            PG8_BAR; PG8_WAIT_L(0); PG8_MMA(0, 1, At, B1); PG8_BAR;
            PG8_LDA(At, 1, 1); PG8_STAGE(PG8_SA(1, 0), a3, voffA);
            PG8_BAR; PG8_WAIT_L(0); PG8_MMA(1, 0, At, B0); PG8_BAR; PG8_SCHED;
            PG8_STAGE(PG8_SB(1, 1), b3 + hstep, voffB);
            PG8_WAIT_V(6); PG8_BAR; PG8_MMA(1, 1, At, B1); PG8_BAR;
            }
        }
        if constexpr (ALIGN_EPI) { if (wr == 0) PG8_BAR; }
        if constexpr (!Epi::AFTER_DRAIN) { E(acc, cur, wr, wc, fr, fq); S.done(cur); }
        if (!has_next) break;
#pragma unroll
        for (int a = 0; a < 2; ++a)
#pragma unroll
            for (int b = 0; b < 2; ++b)
#pragma unroll
                for (int m = 0; m < 4; ++m)
#pragma unroll
                    for (int n = 0; n < 2; ++n) acc[a][b][m][n] = (f32x4){0.f, 0.f, 0.f, 0.f};
        cur = nxt; cA = nA; cB = nB; ++ui;
        if constexpr (ALIGN_EPI) { if (wr == 1) PG8_BAR; }
    }
    PG8_WAIT_V(0);
    if constexpr (!ALIGN_EPI) { if (wr == 0) PG8_BAR; }
    PG8_BAR;
#undef PG8_SA
#undef PG8_SB
#undef PG8_STAGE
#undef PG8_LDA
#undef PG8_LDB
#undef PG8_MMA
#undef PG8_WAIT_V
#undef PG8_WAIT_L
#undef PG8_BAR
#undef PG8_SCHED
}
}


#define XB_TMO      128
#define XB_XCNT(j)  (256  + 64 * (j))
#define XB_XSUB(j)  (1280 + 64 * (j))
#define XB_XGEN(j)  (2304 + 64 * (j))
#define XB_TOP      3328
#define XB_TOPGEN   3392
#define XCD_BAR_WORDS 3456
#define XB_SPIN_CAP (1u << 18)
__device__ __forceinline__ unsigned xb_ld(unsigned* p)              { return __hip_atomic_load(p, __ATOMIC_RELAXED, __HIP_MEMORY_SCOPE_AGENT); }
__device__ __forceinline__ unsigned xb_add(unsigned* p, unsigned v) { return __hip_atomic_fetch_add(p, v, __ATOMIC_RELAXED, __HIP_MEMORY_SCOPE_AGENT); }
__device__ __forceinline__ unsigned xb_xcc_id() { return (unsigned)__builtin_amdgcn_s_getreg((3 << 11) | 20) & 0xFu; }
#define XB_SPIN(cond, bar) do { unsigned _sp = 0; while (cond) { __builtin_amdgcn_s_sleep(1); \
    if ((++_sp & 255u) == 0u) { if (xb_ld(&(bar)[XB_TMO])) break; if (_sp > XB_SPIN_CAP) { atomicAdd(&(bar)[XB_TMO], 1u); break; } } } } while (0)
struct XcdBarrier { unsigned* bar; unsigned x; volatile LAS unsigned* st; };
__device__ __forceinline__ XcdBarrier xcd_barrier_post(unsigned* bar, volatile LAS unsigned* st) {
    XcdBarrier b; b.bar = bar; b.x = xb_xcc_id(); b.st = st;
    if (threadIdx.x == 0) (void)xb_add(&bar[XB_XCNT(b.x)], 1u);
    return b;
}
__device__ __forceinline__ void xcd_barrier_complete(unsigned* bar, unsigned x, unsigned& nloc, unsigned& nx) {
    const unsigned G = gridDim.x * gridDim.y * gridDim.z;
    unsigned sum, cnt, mine, sp = 0u;
    for (;;) {
        sum = 0u; cnt = 0u; mine = 0u;
#pragma unroll
        for (unsigned j = 0; j < 16; ++j) { const unsigned c = xb_ld(&bar[XB_XCNT(j)]); sum += c; cnt += (c > 0u) ? 1u : 0u; mine = (j == x) ? c : mine; }
        if (sum == G) break;
        __builtin_amdgcn_s_sleep(1);
        if ((++sp & 255u) == 0u) { if (xb_ld(&bar[XB_TMO])) break; if (sp > XB_SPIN_CAP) { atomicAdd(&bar[XB_TMO], 1u); break; } }
    }
    nloc = mine > 0u ? mine : 1u; nx = cnt > 0u ? cnt : 1u;
}
__device__ __forceinline__ void xcd_barrier(const XcdBarrier& b) {
    asm volatile("s_waitcnt vmcnt(0)" ::: "memory");
    __syncthreads();
    if (threadIdx.x == 0) {
        unsigned* bar = b.bar;
        __builtin_amdgcn_s_waitcnt(0);
        unsigned nloc = b.st[0], nx = b.st[1];
        if (nloc == 0u) { xcd_barrier_complete(bar, b.x, nloc, nx); b.st[0] = nloc; b.st[1] = nx; }
        const unsigned old = xb_add(&bar[XB_XSUB(b.x)], 1u);
        const unsigned gen = old / nloc;
        if (old + 1u == (gen + 1u) * nloc) {
            __builtin_amdgcn_fence(__ATOMIC_RELEASE, "agent");
            asm volatile("s_waitcnt vmcnt(0)" ::: "memory");
            const unsigned og = xb_add(&bar[XB_TOP], 1u);
            const unsigned tg = og / nx;
            if (og + 1u == (tg + 1u) * nx) xb_add(&bar[XB_TOPGEN], 1u);
            else XB_SPIN(xb_ld(&bar[XB_TOPGEN]) == tg, bar);
            __builtin_amdgcn_fence(__ATOMIC_ACQUIRE, "agent");
            xb_add(&bar[XB_XGEN(b.x)], 1u);
            asm volatile("s_waitcnt vmcnt(0)" ::: "memory");
        } else {
            XB_SPIN(xb_ld(&bar[XB_XGEN(b.x)]) == gen, bar);
            __builtin_amdgcn_fence(__ATOMIC_ACQUIRE, "agent");
            asm volatile("s_waitcnt vmcnt(0)" ::: "memory");
        }
    }
    __syncthreads();
}

struct Args { const float* in[36]; float* out; unsigned char* ws; int ph_lo, ph_hi; };
#define LDS_WAIT() asm volatile("s_waitcnt lgkmcnt(0)" ::: "memory")

DI int rowmap(int mode, int n) {
    if (mode == 1) { const int j = n < FF ? n : n - FF; return 256 * (j >> 7) + (n < FF ? 0 : 128) + (j & 127); }
    if (mode == 2) { if (n < 1024) return n; if (n < 1040) return n + 1024; return n - 16; }
    return n;
}
DI void p0_transpose_item(const float* W, const float* gain, int K, int N, bf16_t* WT, int mode, float* scr, int item, int lane) {
    const int nblk = (N + 31) / 32, kb = item / nblk, nb = item % nblk, k0 = 64 * kb, n0 = 32 * nb;
    const int nn = n0 + (lane & 31); const bool ok = nn < N;
#pragma unroll 8
    for (int i = 0; i < 32; ++i) { const int kk = 2 * i + (lane >> 5); float v = ok ? W[(size_t)(k0 + kk) * N + nn] : 0.f; if (gain) v *= gain[k0 + kk]; scr[kk * 33 + (lane & 31)] = v; }
    LDS_WAIT(); asm volatile("" ::: "memory");
    const int c = lane & 7;
#pragma unroll
    for (int j = 0; j < 4; ++j) { const int n = (lane >> 3) + 8 * j; const float* s = scr + (8 * c) * 33 + n;
        u32x4 o; o.x = pk2(s[0 * 33], s[1 * 33]); o.y = pk2(s[2 * 33], s[3 * 33]); o.z = pk2(s[4 * 33], s[5 * 33]); o.w = pk2(s[6 * 33], s[7 * 33]);
        if (n0 + n < N) *(u32x4*)(WT + (size_t)rowmap(mode, n0 + n) * K + k0 + 8 * c) = o; }
    LDS_WAIT(); asm volatile("" ::: "memory");
}
DI void row_to_bf16_ssq(const float* xrow, bf16_t* orow, float* ssq_slot, int lane) {
    const f32x4* xr = (const f32x4*)xrow + lane;
    f32x4 v[4]; float s = 0.f;
#pragma unroll
    for (int j = 0; j < 4; ++j) { v[j] = xr[64 * j]; s += (v[j].x * v[j].x + v[j].y * v[j].y) + (v[j].z * v[j].z + v[j].w * v[j].w); }
    s = wave_sum(s);
    unsigned long long* o8 = (unsigned long long*)orow + lane;
#pragma unroll
    for (int j = 0; j < 4; ++j) o8[64 * j] = (unsigned long long)pk2(v[j].x, v[j].y) | ((unsigned long long)pk2(v[j].z, v[j].w) << 32);
    if (lane == 0) *ssq_slot = s;
}
struct S5P { float dt, lr, li; };
DI S5P s5_par(const float* lre, const float* lim, const float* logdt, int g, int n) { S5P p; p.dt = expf(logdt[g]); p.lr = lre[g * 64 + n]; p.li = lim[g * 64 + n]; return p; }
DI f32x2 s5_pow(const S5P& p, int j) {
    const float mag = expf((float)j * (p.dt * p.lr)); float sn, cs; sincosf((float)j * (p.dt * p.li), &sn, &cs); return (f32x2){mag * cs, mag * sn};
}
DI f32x2 s5_coef(const S5P& p) {
    const f32x2 ab = s5_pow(p, 1); const float den = p.lr * p.lr + p.li * p.li;
    return (f32x2){((ab.x - 1.f) * p.lr + ab.y * p.li) / den, (ab.y * p.lr - (ab.x - 1.f) * p.li) / den};
}
DI f32x2 cmul(f32x2 a, f32x2 b) { return (f32x2){a.x * b.x - a.y * b.y, a.x * b.y + a.y * b.x}; }

template <int NT>
DI void gla_gate_cumsum(const float* zg, float* bb, float* seg, const float* wg, const float* bg, int h, int tid) {
    for (int i = tid; i < NT * 64; i += NTHREADS) { const int t = i >> 6, d = i & 63; float s = bg[h * 64 + d];
#pragma unroll
        for (int r = 0; r < 16; ++r) s += zg[t * 16 + r] * wg[r * 256 + h * 64 + d];
        bb[t * 65 + d] = logsigmoidf(s) * (1.f / 16.f); }
    __syncthreads();
    if constexpr (NT == 64) {
        const int d = tid & 63, sg = tid >> 6; float run = 0.f;
#pragma unroll
        for (int i = 0; i < 8; ++i) { run += bb[(sg * 8 + i) * 65 + d]; bb[(sg * 8 + i) * 65 + d] = run; }
        seg[sg * 64 + d] = run;
        __syncthreads();
        float pre = 0.f;
        for (int j = 0; j < sg; ++j) pre += seg[j * 64 + d];
#pragma unroll
        for (int i = 0; i < 8; ++i) bb[(sg * 8 + i) * 65 + d] += pre;
    } else {
        if (tid < 64) { float run = 0.f;
#pragma unroll
            for (int t = 0; t < NT; ++t) { run += bb[t * 65 + tid]; bb[t * 65 + tid] = run; } }
    }
    __syncthreads();
}


struct SEpiResid {
    const float* base; float* out; bf16_t* hb; float* ssq; float alpha;
    DI void operator()(int row, int col, const f32x4& a0, const f32x4& a1, int tid) const {
        const f32x4 v0 = *(const f32x4*)(base + (size_t)row * D + col) + a0 * alpha, v1 = *(const f32x4*)(base + (size_t)row * D + col + 4) + a1 * alpha;
        *(f32x4*)(out + (size_t)row * D + col) = v0; *(f32x4*)(out + (size_t)row * D + col + 4) = v1;
        if (hb) { u32x4 w; w.x = pk2(v0[0], v0[1]); w.y = pk2(v0[2], v0[3]); w.z = pk2(v1[0], v1[1]); w.w = pk2(v1[2], v1[3]); *(u32x4*)(hb + (size_t)row * D + col) = w; }
        if (ssq) { float sq = (v0[0] * v0[0] + v0[1] * v0[1]) + (v0[2] * v0[2] + v0[3] * v0[3]) + (v1[0] * v1[0] + v1[1] * v1[1]) + (v1[2] * v1[2] + v1[3] * v1[3]);
            sq += __shfl_xor(sq, 1); sq += __shfl_xor(sq, 2); sq += __shfl_xor(sq, 4); if ((tid & 7) == 0) atomicAdd(ssq + row, sq); }
    }
};
struct SEpiScaleBf16 {
    bf16_t* O; const float* ssq; float scale;
    DI void operator()(int row, int col, const f32x4& a0, const f32x4& a1, int) const {
        const float rs = rsqrtf(ssq[row] * (1.f / D) + EPS) * scale; const f32x4 v0 = a0 * rs, v1 = a1 * rs;
        u32x4 w; w.x = pk2(v0[0], v0[1]); w.y = pk2(v0[2], v0[3]); w.z = pk2(v1[0], v1[1]); w.w = pk2(v1[2], v1[3]); *(u32x4*)(O + (size_t)row * D + col) = w;
    }
};
template <class F>
DI void small_gemm(const bf16_t* A, const bf16_t* Bt, int K, float* red, int G, int bx, int wave, int tid, const F& epi) {
    const int lane = tid & 63, fr = lane & 15, fq = lane >> 4, kw = K >> 3, nsteps = kw >> 5;
    for (int tile = bx; tile < 256; tile += G) {
        const int row0 = (tile >> 4) * 64, col0 = (tile & 15) * 64;
        f32x4 acc[4][4];
#pragma unroll
        for (int i = 0; i < 4; ++i)
#pragma unroll
            for (int j = 0; j < 4; ++j) acc[i][j] = (f32x4){0.f, 0.f, 0.f, 0.f};
        const bf16_t* ap = A + (size_t)(row0 + fr) * K + wave * kw + fq * 8;
        const bf16_t* bp = Bt + (size_t)(col0 + fr) * K + wave * kw + fq * 8;
#pragma unroll 2
        for (int st = 0; st < nsteps; ++st) {
            bf16x8 a[4], b[4];
#pragma unroll
            for (int i = 0; i < 4; ++i) { a[i] = *(const bf16x8*)(ap + (size_t)i * 16 * K + st * 32); b[i] = *(const bf16x8*)(bp + (size_t)i * 16 * K + st * 32); }
#pragma unroll
            for (int i = 0; i < 4; ++i)
#pragma unroll
                for (int j = 0; j < 4; ++j) acc[i][j] = __builtin_amdgcn_mfma_f32_16x16x32_bf16(a[i], b[j], acc[i][j], 0, 0, 0);
        }
        float* my = red + wave * (64 * 68);
#pragma unroll
        for (int i = 0; i < 4; ++i)
#pragma unroll
            for (int j = 0; j < 4; ++j)
#pragma unroll
                for (int r = 0; r < 4; ++r) my[(i * 16 + fq * 4 + r) * 68 + j * 16 + fr] = acc[i][j][r];
        __syncthreads();
        { const int row = tid >> 3, c8 = (tid & 7) * 8; f32x4 s0 = (f32x4){0.f, 0.f, 0.f, 0.f}, s1 = s0;
#pragma unroll
            for (int w = 0; w < 8; ++w) { const f32x4* p = (const f32x4*)(red + w * (64 * 68) + row * 68 + c8); s0 += p[0]; s1 += p[1]; }
            epi(MP + row0 + row, col0 + c8, s0, s1, tid); }
        __syncthreads();
    }
}

__global__ void __launch_bounds__(NTHREADS, 2) hymba_fwd(Args args) {
    extern __shared__ __attribute__((aligned(16))) unsigned char lds[];
    cg::grid_group grid = cg::this_grid();
    const int tid0 = threadIdx.x, wave = __builtin_amdgcn_readfirstlane(tid0 >> 6);
    const int G = gridDim.x, bx = blockIdx.x;
    const int gw = bx * NWAVES + wave, NGW = G * NWAVES;
    const int NGT = G * NTHREADS;
#define PHASE_LOCALS int tid_l_ = tid0; asm volatile("" : "+v"(tid_l_)); const int tid = tid_l_, lane = tid & 63, gt = bx * NTHREADS + tid; (void)lane; (void)gt
    unsigned char* ws = args.ws;
    float* out = args.out;
    float* fl = (float*)lds;
    LAS unsigned char* ldsl = (LAS unsigned char*)lds;

    const float* x_prompt = args.in[0]; const float* x_sample = args.in[1]; const float* state_gla = args.in[2];
    const float* st_re = args.in[3]; const float* st_im = args.in[4]; const float* cache_k = args.in[5]; const float* cache_v = args.in[6];
    const float* mem_prompt = args.in[7];
    const float* w_gate = args.in[13]; const float* b_gate = args.in[14]; const float* g_gla_out = args.in[15];
    const float* s5_lre = args.in[16]; const float* s5_lim = args.in[17]; const float* s5_logdt = args.in[18];
    const float* s5_bre = args.in[19]; const float* s5_bim = args.in[20]; const float* s5_cre = args.in[21]; const float* s5_cim = args.in[22];
    const float* s5_d = args.in[23]; const float* s5_wglu = args.in[24]; const float* s5_bglu = args.in[25];
    const float* g_final = args.in[35];

    float* ssq = (float*)(ws + WS_SSQ);
    bf16_t* Wgu1 = (bf16_t*)(ws + WS_WGU1); bf16_t* Wd1 = (bf16_t*)(ws + WS_WD1); bf16_t* Win = (bf16_t*)(ws + WS_WIN); bf16_t* Wout = (bf16_t*)(ws + WS_WOUT);
    bf16_t* Wcq = (bf16_t*)(ws + WS_WCQ); bf16_t* Wckv = (bf16_t*)(ws + WS_WCKV); bf16_t* Wco = (bf16_t*)(ws + WS_WCO); bf16_t* Wgu2 = (bf16_t*)(ws + WS_WGU2); bf16_t* Wd2 = (bf16_t*)(ws + WS_WD2);
    bf16_t* EgT = (bf16_t*)(ws + WS_EGT); bf16_t* GTt = (bf16_t*)(ws + WS_GTT);
    bf16_t* memb = (bf16_t*)(ws + WS_MEMB); bf16_t* kb = (bf16_t*)(ws + WS_KB); bf16_t* vbT = (bf16_t*)(ws + WS_VBT);
    bf16_t* xb = (bf16_t*)(ws + WS_XB); bf16_t* hb = (bf16_t*)(ws + WS_HB); float* hres = (float*)(ws + WS_H);
    bf16_t* act = (bf16_t*)(ws + WS_ACT); bf16_t* Pb = (bf16_t*)(ws + WS_ACT);
    bf16_t* mix = (bf16_t*)(ws + WS_MIX); bf16_t* qb = (bf16_t*)(ws + WS_Q); bf16_t* ob = (bf16_t*)(ws + WS_O);
    float* glaD = (float*)(ws + WS_GLAD); float* glaDec = (float*)(ws + WS_GLADEC);
    float* s5e = (float*)(ws + WS_S5E); bf16_t* s5x = (bf16_t*)(ws + WS_S5X);

    const int lo = args.ph_lo, hi = args.ph_hi;
    if (tid0 < 16) ((LAS unsigned*)(ldsl + LDS_BARST))[tid0] = 0u;
    __syncthreads();
    const XcdBarrier xbar = xcd_barrier_post((unsigned*)(ws + WS_BAR), (volatile LAS unsigned*)(ldsl + LDS_BARST));
    if (lo < 0) grid.sync();
#ifndef PHASE_MASK
#define PHASE_MASK 0xffffffffu
#endif
#define IN(k) (((PHASE_MASK >> (k)) & 1u) && lo <= (k) && (k) < hi)
#ifndef REPEAT_MASK
#define REPEAT_MASK 0u
#endif
#define PHASE(k) if (IN(k)) for (int rep_ = 0; rep_ < 1 + (int)((REPEAT_MASK >> (k)) & 1u); ++rep_)
#define REP_SYNC() do { if (rep_) xcd_barrier(xbar); } while (0)
#define SEAM(k) do { if (IN(k) && IN((k) + 1)) xcd_barrier(xbar); } while (0)

    PHASE(0) {
        REP_SYNC();
        PHASE_LOCALS;
        float* scr = fl + wave * (64 * 33);
        constexpr int I_GU = 16 * 176, I_D = 44 * 32, I_IN = 16 * 65, I_SQ = 16 * 32, I_CKV = 16 * 64;
        constexpr int NITEMS = 2 * I_GU + 2 * I_D + I_IN + 3 * I_SQ + I_CKV;
        for (int it = gw; it < NITEMS; it += NGW) {
            int r = it;
            if (r < I_GU) { p0_transpose_item(args.in[9], args.in[8], D, NGU, Wgu1, 1, scr, r, lane); continue; } r -= I_GU;
            if (r < I_GU) { p0_transpose_item(args.in[33], args.in[32], D, NGU, Wgu2, 1, scr, r, lane); continue; } r -= I_GU;
            if (r < I_D) { p0_transpose_item(args.in[10], nullptr, FF, D, Wd1, 0, scr, r, lane); continue; } r -= I_D;
            if (r < I_D) { p0_transpose_item(args.in[34], nullptr, FF, D, Wd2, 0, scr, r, lane); continue; } r -= I_D;
            if (r < I_IN) { p0_transpose_item(args.in[12], args.in[11], D, NIN, Win, 2, scr, r, lane); continue; } r -= I_IN;
            if (r < I_SQ) { p0_transpose_item(args.in[26], nullptr, D, D, Wout, 0, scr, r, lane); continue; } r -= I_SQ;
            if (r < I_SQ) { p0_transpose_item(args.in[29], args.in[27], D, D, Wcq, 0, scr, r, lane); continue; } r -= I_SQ;
            if (r < I_SQ) { p0_transpose_item(args.in[31], nullptr, D, D, Wco, 0, scr, r, lane); continue; } r -= I_SQ;
            p0_transpose_item(args.in[30], args.in[28], D, 2 * D, Wckv, 0, scr, r, lane);
        }
        for (int i = gt; i < (NINP - NIN) * D / 8; i += NGT) ((u32x4*)(Win + (size_t)NIN * D))[i] = (u32x4){0u, 0u, 0u, 0u};
        for (int i = gt; i < 3 * M; i += NGT) ssq[SSQ_H1 + i] = 0.f;
        for (int m = gw; m < M; m += NGW) { const float* xr = m < MP ? x_prompt + (size_t)m * D : x_sample + (size_t)(m - MP) * D; row_to_bf16_ssq(xr, xb + (size_t)m * D, ssq + SSQ_X + m, lane); }
        for (int m = gw; m < MEMR; m += NGW) row_to_bf16_ssq(mem_prompt + (size_t)m * D, memb + (size_t)m * D, ssq + SSQ_MEM + m, lane);
        for (int it = gt; it < 32 * 64 * 8; it += NGT) {
            const int g = it >> 9, n = (it >> 3) & 63, s = it & 7;
            const S5P p = s5_par(s5_lre, s5_lim, s5_logdt, g, n);
            const f32x2 mm = cmul(s5_pow(p, 7 - s), s5_coef(p));
            unsigned wre[8], wim[8];
#pragma unroll
            for (int pp = 0; pp < 8; ++pp) {
                const f32x2 b0 = (f32x2){s5_bre[(g * 64 + n) * 16 + 2 * pp], s5_bim[(g * 64 + n) * 16 + 2 * pp]}, b1 = (f32x2){s5_bre[(g * 64 + n) * 16 + 2 * pp + 1], s5_bim[(g * 64 + n) * 16 + 2 * pp + 1]};
                const f32x2 v0 = cmul(mm, b0), v1 = cmul(mm, b1);
                wre[pp] = pk2(v0.x, v1.x); wim[pp] = pk2(v0.y, v1.y);
            }
            u32x4* dre = (u32x4*)(EgT + ((size_t)(g * 128 + n) * 128 + s * 16)); u32x4* dim = (u32x4*)(EgT + ((size_t)(g * 128 + 64 + n) * 128 + s * 16));
            dre[0] = (u32x4){wre[0], wre[1], wre[2], wre[3]}; dre[1] = (u32x4){wre[4], wre[5], wre[6], wre[7]};
            dim[0] = (u32x4){wim[0], wim[1], wim[2], wim[3]}; dim[1] = (u32x4){wim[4], wim[5], wim[6], wim[7]};
        }
        for (int it = gt; it < 32 * 8 * 64; it += NGT) {
            const int g = it >> 9, t = (it >> 6) & 7, n = it & 63;
            const S5P p = s5_par(s5_lre, s5_lim, s5_logdt, g, n);
            const f32x2 pw = s5_pow(p, t + 1);
#pragma unroll
            for (int pp = 0; pp < 16; ++pp) {
                const f32x2 c = (f32x2){s5_cre[(g * 16 + pp) * 64 + n], s5_cim[(g * 16 + pp) * 64 + n]};
                const f32x2 v = cmul(c, pw);
                bf16_t* dst = GTt + (size_t)(g * 128 + t * 16 + pp) * 256;
                dst[n] = (bf16_t)f2bf(v.x); dst[64 + n] = (bf16_t)f2bf(-v.y);
            }
        }
        for (int it = gt; it < 32 * 8 * 8 * 16; it += NGT) {
            const int g = it >> 10, t = (it >> 7) & 7, s = (it >> 4) & 7, pp = it & 15;
            float a[16];
#pragma unroll
            for (int q = 0; q < 16; ++q) a[q] = 0.f;
            if (s <= t) {
                for (int n = 0; n < 64; ++n) {
                    const S5P p = s5_par(s5_lre, s5_lim, s5_logdt, g, n);
                    const f32x2 c = (f32x2){s5_cre[(g * 16 + pp) * 64 + n], s5_cim[(g * 16 + pp) * 64 + n]};
                    const f32x2 cc = cmul(cmul(c, s5_pow(p, t - s)), s5_coef(p));
                    const f32x4* br = (const f32x4*)(s5_bre + (g * 64 + n) * 16); const f32x4* bi = (const f32x4*)(s5_bim + (g * 64 + n) * 16);
#pragma unroll
                    for (int q4 = 0; q4 < 4; ++q4) { const f32x4 r4 = br[q4], i4 = bi[q4];
#pragma unroll
                        for (int e = 0; e < 4; ++e) a[q4 * 4 + e] += cc.x * r4[e] - cc.y * i4[e]; }
                }
            }
            u32x4* dst = (u32x4*)(GTt + (size_t)(g * 128 + t * 16 + pp) * 256 + 128 + s * 16);
            dst[0] = (u32x4){pk2(a[0], a[1]), pk2(a[2], a[3]), pk2(a[4], a[5]), pk2(a[6], a[7])};
            dst[1] = (u32x4){pk2(a[8], a[9]), pk2(a[10], a[11]), pk2(a[12], a[13]), pk2(a[14], a[15])};
        }
    }
    SEAM(0);

    PHASE(1) {
        REP_SYNC();
        pg8::Gemm g{xb, Wgu1, M, NGU, D}; pg8::StaticOrder S; S.init(M, NGU, G, bx);
        pg8::EpiSwiGLU E{act, FF, ssq + SSQ_X};
        pg8::gemm_phase<pg8::EpiSwiGLU, pg8::StaticOrder, true, true>(ldsl, g, S, E);
    }
    SEAM(1);
    PHASE(2) {
        REP_SYNC();
        pg8::Gemm g{act, Wd1, MP, D, FF}; pg8::StaticOrder S; S.init(MP, D, G, bx);
        pg8::EpiResid E{x_prompt, x_sample, hres, hb, ssq + SSQ_H1, 0.5f};
        pg8::gemm_phase<pg8::EpiResid, pg8::StaticOrder, true, true>(ldsl, g, S, E);
        SEpiResid SE{x_sample - (size_t)MP * D, hres, hb, ssq + SSQ_H1, 0.5f};
        small_gemm(act + (size_t)MP * FF, Wd1, FF, fl, G, bx, wave, tid0, SE);
    }
    SEAM(2);
    PHASE(3) {
        REP_SYNC();
        { pg8::Gemm g{hb, Win, M, NINP, D}; pg8::StaticOrder S; S.init(M, NINP, G, bx);
          pg8::EpiScaleBf16 E{Pb, NINP, ssq + SSQ_H1, 1.f};
          pg8::gemm_phase<pg8::EpiScaleBf16, pg8::StaticOrder, true, true>(ldsl, g, S, E); }
        { pg8::Gemm g{memb, Wckv, MEMR, 2 * D, D}; pg8::StaticOrder S; S.init(MEMR, 2 * D, G, (bx + 64) % G);
          pg8::EpiMemKV E{out + O_MKP, out + O_MVP, kb, vbT, ssq + SSQ_MEM};
          pg8::gemm_phase<pg8::EpiMemKV, pg8::StaticOrder, true, true>(ldsl, g, S, E); }
    }
    SEAM(3);

    PHASE(4) {
        REP_SYNC();
        PHASE_LOCALS;
        {
            float* zg = fl; float* kk = zg + 64 * 16; float* vv = kk + 64 * 65; float* bb = vv + 64 * 128; float* seg = bb + 64 * 65;
            for (int unit = bx; unit < 1024; unit += G) {
                const int bh = unit >> 5, c = unit & 31, b = bh >> 2, h = bh & 3;
                const size_t r0 = (size_t)b * 2048 + c * 64;
                if (tid < 128) { const int t = tid >> 1, hf = tid & 1; const u32x4 w = *(const u32x4*)(Pb + (r0 + t) * NINP + PC_ZG + hf * 8);
                    float* z = zg + t * 16 + hf * 8; z[0] = bflo(w.x); z[1] = bfhi(w.x); z[2] = bflo(w.y); z[3] = bfhi(w.y); z[4] = bflo(w.z); z[5] = bfhi(w.z); z[6] = bflo(w.w); z[7] = bfhi(w.w); }
                { const int t = tid >> 3, c8 = tid & 7; const u32x4 w = *(const u32x4*)(Pb + (r0 + t) * NINP + PC_K + h * 64 + c8 * 8);
                    float* z = kk + t * 65 + c8 * 8; z[0] = bflo(w.x); z[1] = bfhi(w.x); z[2] = bflo(w.y); z[3] = bfhi(w.y); z[4] = bflo(w.z); z[5] = bfhi(w.z); z[6] = bflo(w.w); z[7] = bfhi(w.w); }
#pragma unroll
                for (int i = 0; i < 2; ++i) { const int ch = tid + i * 512, t = ch >> 4, c8 = ch & 15; const u32x4 w = *(const u32x4*)(Pb + (r0 + t) * NINP + PC_V + h * 128 + c8 * 8);
                    float* z = vv + t * 128 + c8 * 8; z[0] = bflo(w.x); z[1] = bfhi(w.x); z[2] = bflo(w.y); z[3] = bfhi(w.y); z[4] = bflo(w.z); z[5] = bfhi(w.z); z[6] = bflo(w.w); z[7] = bfhi(w.w); }
                __syncthreads();
                gla_gate_cumsum<64>(zg, bb, seg, w_gate, b_gate, h, tid);
                for (int i = tid; i < 64 * 64; i += NTHREADS) { const int t = i >> 6, d = i & 63; kk[t * 65 + d] *= __expf(bb[63 * 65 + d] - bb[t * 65 + d]); }
                __syncthreads();
                { const int d = tid >> 3, e0 = (tid & 7) * 16; f32x4 a0 = {0, 0, 0, 0}, a1 = a0, a2 = a0, a3 = a0;
                    for (int t = 0; t < 64; ++t) { const float kd = kk[t * 65 + d]; const f32x4* vp = (const f32x4*)(vv + t * 128 + e0); a0 += vp[0] * kd; a1 += vp[1] * kd; a2 += vp[2] * kd; a3 += vp[3] * kd; }
                    f32x4* dp = (f32x4*)(glaD + (size_t)unit * 8192 + d * 128 + e0); dp[0] = a0; dp[1] = a1; dp[2] = a2; dp[3] = a3; }
                if (tid < 64) glaDec[unit * 64 + tid] = __expf(bb[63 * 65 + tid]);
                __syncthreads();
            }
        }
        {
            float* zg = fl; float* qq = zg + 8 * 16; float* kk = qq + 8 * 65; float* kt = kk + 8 * 65; float* vv = kt + 8 * 65; float* bb = vv + 8 * 128; float* sc = bb + 8 * 65; float* S0 = sc + 64;
            for (int unit = bx; unit < 512; unit += G) {
                const int b = unit >> 2, h = unit & 3; const size_t r0 = (size_t)MP + b * 8;
                if (tid < 128) { const int t = tid >> 4, r = tid & 15; zg[t * 16 + r] = bf2f(Pb[(r0 + t) * NINP + PC_ZG + r]); }
                { const int t = tid >> 6, d = tid & 63; qq[t * 65 + d] = bf2f(Pb[(r0 + t) * NINP + PC_Q + h * 64 + d]); kk[t * 65 + d] = bf2f(Pb[(r0 + t) * NINP + PC_K + h * 64 + d]); }
#pragma unroll
                for (int i = 0; i < 2; ++i) { const int idx = tid + i * 512, t = idx >> 7, e = idx & 127; vv[t * 128 + e] = bf2f(Pb[(r0 + t) * NINP + PC_V + h * 128 + e]); }
                { const f32x4* sp = (const f32x4*)(state_gla + (size_t)unit * 8192); f32x4* dp = (f32x4*)S0;
#pragma unroll
                    for (int i = 0; i < 4; ++i) dp[tid + i * 512] = sp[tid + i * 512]; }
                __syncthreads();
                gla_gate_cumsum<8>(zg, bb, nullptr, w_gate, b_gate, h, tid);
                { const int t = tid >> 6, d = tid & 63; const float bt = bb[t * 65 + d], b7 = bb[7 * 65 + d]; const float kv = kk[t * 65 + d];
                    qq[t * 65 + d] *= __expf(bt) * 0.125f; kk[t * 65 + d] = kv * __expf(-bt); kt[t * 65 + d] = kv * __expf(b7 - bt); }
                __syncthreads();
                if (tid < 64) { const int t = tid >> 3, s = tid & 7; float a = 0.f; if (s <= t) { for (int d = 0; d < 64; ++d) a += qq[t * 65 + d] * kk[s * 65 + d]; } sc[t * 8 + s] = a; }
                __syncthreads();
                {
                    const int t = wave, e0 = lane * 2; float o0 = 0.f, o1 = 0.f;
                    for (int d = 0; d < 64; ++d) { const float qd = qq[t * 65 + d]; o0 += qd * S0[d * 128 + e0]; o1 += qd * S0[d * 128 + e0 + 1]; }
                    for (int s = 0; s <= t; ++s) { const float w = sc[t * 8 + s]; o0 += w * vv[s * 128 + e0]; o1 += w * vv[s * 128 + e0 + 1]; }
                    const float ss = wave_sum(o0 * o0 + o1 * o1); const float rs = rsqrtf(ss * (1.f / 128.f) + EPS);
                    const unsigned rw = *(const unsigned*)(Pb + (r0 + t) * NINP + PC_R + h * 128 + e0);
                    const float y0 = o0 * rs * g_gla_out[e0] * siluf(bflo(rw)), y1 = o1 * rs * g_gla_out[e0 + 1] * siluf(bfhi(rw));
                    *(unsigned*)(mix + (r0 + t) * D + h * 128 + e0) = pk2(y0, y1);
                }
                {
                    const int d = tid >> 3, e0 = (tid & 7) * 16; const float dec = __expf(bb[7 * 65 + d]);
                    f32x4 a[4];
#pragma unroll
                    for (int i = 0; i < 4; ++i) a[i] = ((const f32x4*)(S0 + d * 128 + e0))[i] * dec;
#pragma unroll
                    for (int s = 0; s < 8; ++s) { const float kd = kt[s * 65 + d]; const f32x4* vp = (const f32x4*)(vv + s * 128 + e0);
#pragma unroll
                        for (int i = 0; i < 4; ++i) a[i] += vp[i] * kd; }
                    f32x4* dp = (f32x4*)(out + O_GLAS + (size_t)unit * 8192 + d * 128 + e0);
#pragma unroll
                    for (int i = 0; i < 4; ++i) dp[i] = a[i];
                }
                __syncthreads();
            }
        }
        for (int it = gw; it < 136 * 32; it += NGW) {
            const int rb = it >> 5, g = it & 31, fr = lane & 15, fq = lane >> 4; const int R0 = rb * 16;
            f32x4 acc[8];
#pragma unroll
            for (int nb = 0; nb < 8; ++nb) acc[nb] = (f32x4){0.f, 0.f, 0.f, 0.f};
#pragma unroll
            for (int ks = 0; ks < 4; ++ks) {
                const bf16x8 a = *(const bf16x8*)(Pb + ((size_t)(R0 + fr) * 8 + ks * 2 + (fq >> 1)) * NINP + PC_U + g * 16 + (fq & 1) * 8);
#pragma unroll
                for (int nb = 0; nb < 8; ++nb) { const bf16x8 bfr = *(const bf16x8*)(EgT + (size_t)(g * 128 + nb * 16 + fr) * 128 + ks * 32 + fq * 8);
                    acc[nb] = __builtin_amdgcn_mfma_f32_16x16x32_bf16(a, bfr, acc[nb], 0, 0, 0); }
            }
#pragma unroll
            for (int nb = 0; nb < 8; ++nb)
#pragma unroll
                for (int r = 0; r < 4; ++r) s5e[((size_t)(R0 + fq * 4 + r) * 32 + g) * 128 + nb * 16 + fr] = acc[nb][r];
        }
    }
    SEAM(4);

    PHASE(5) {
        REP_SYNC();
        PHASE_LOCALS;
        for (int idx = gt; idx < 32 * 8192; idx += NGT) {
            const int bh = idx >> 13, de = idx & 8191, d = de >> 7;
            float Dv[32], dc[32];
#pragma unroll
            for (int c = 0; c < 32; ++c) { const int unit = bh * 32 + c; Dv[c] = glaD[(size_t)unit * 8192 + de]; dc[c] = glaDec[unit * 64 + d]; }
            float S = 0.f;
#pragma unroll
            for (int c = 0; c < 32; ++c) { glaD[(size_t)(bh * 32 + c) * 8192 + de] = S; S = dc[c] * S + Dv[c]; }
            out[O_GLAP + idx] = S;
        }
        for (int it = bx; it < 256; it += G) {
            const int b = it >> 5, g = it & 31, n = tid & 63, sgm = wave;
            const S5P p = s5_par(s5_lre, s5_lim, s5_logdt, g, n); const f32x2 a8 = s5_pow(p, 8);
            f32x2 a256 = a8;
#pragma unroll
            for (int i = 0; i < 5; ++i) a256 = cmul(a256, a256);
            float er[32], ei[32];
            const size_t o0 = (((size_t)b * 256 + sgm * 32) * 32 + g) * 128;
#pragma unroll
            for (int i = 0; i < 32; ++i) { er[i] = s5e[o0 + (size_t)i * 4096 + n]; ei[i] = s5e[o0 + (size_t)i * 4096 + 64 + n]; }
            float yr = 0.f, yi = 0.f;
#pragma unroll
            for (int i = 0; i < 32; ++i) { const float pr = yr, pi = yi; yr = a8.x * pr - a8.y * pi + er[i]; yi = a8.x * pi + a8.y * pr + ei[i]; er[i] = pr; ei[i] = pi; }
            fl[sgm * 64 + n] = yr; fl[512 + sgm * 64 + n] = yi;
            __syncthreads();
            float xr = 0.f, xi = 0.f;
            for (int j = 0; j < sgm; ++j) { const float tr = fl[j * 64 + n], ti = fl[512 + j * 64 + n]; const float nr = a256.x * xr - a256.y * xi + tr, ni = a256.x * xi + a256.y * xr + ti; xr = nr; xi = ni; }
            f32x2 pw = (f32x2){1.f, 0.f};
#pragma unroll
            for (int i = 0; i < 32; ++i) {
                s5x[o0 + (size_t)i * 4096 + n] = (bf16_t)f2bf(er[i] + pw.x * xr - pw.y * xi); s5x[o0 + (size_t)i * 4096 + 64 + n] = (bf16_t)f2bf(ei[i] + pw.x * xi + pw.y * xr);
                pw = cmul(pw, a8);
            }
            if (sgm == 7) { out[O_REP + (b * 32 + g) * 64 + n] = yr + a256.x * xr - a256.y * xi; out[O_IMP + (b * 32 + g) * 64 + n] = yi + a256.x * xi + a256.y * xr; }
            __syncthreads();
        }
        for (int idx = gt; idx < 128 * 32 * 64; idx += NGT) {
            const int b = idx >> 11, g = (idx >> 6) & 31, n = idx & 63;
            const S5P p = s5_par(s5_lre, s5_lim, s5_logdt, g, n); const f32x2 a8 = s5_pow(p, 8);
            const float xr = st_re[idx], xi = st_im[idx];
            const size_t R = 2048 + b; const size_t o = (R * 32 + g) * 128;
            s5x[o + n] = (bf16_t)f2bf(xr); s5x[o + 64 + n] = (bf16_t)f2bf(xi);
            out[O_RES + idx] = a8.x * xr - a8.y * xi + s5e[o + n]; out[O_IMS + idx] = a8.x * xi + a8.y * xr + s5e[o + 64 + n];
        }
    }
    SEAM(5);

    PHASE(6) {
        REP_SYNC();
        PHASE_LOCALS;
        {
            float* zg = fl; float* qq = zg + 64 * 16; float* kk = qq + 64 * 65; float* vv = kk + 64 * 65; float* bb = vv + 64 * 128; float* sc = bb + 64 * 65; float* Sp = sc + 64 * 65; float* seg = Sp + 64 * 128;
            for (int unit = bx; unit < 1024; unit += G) {
                const int bh = unit >> 5, c = unit & 31, b = bh >> 2, h = bh & 3;
                const size_t r0 = (size_t)b * 2048 + c * 64;
                if (tid < 128) { const int t = tid >> 1, hf = tid & 1; const u32x4 w = *(const u32x4*)(Pb + (r0 + t) * NINP + PC_ZG + hf * 8);
                    float* z = zg + t * 16 + hf * 8; z[0] = bflo(w.x); z[1] = bfhi(w.x); z[2] = bflo(w.y); z[3] = bfhi(w.y); z[4] = bflo(w.z); z[5] = bfhi(w.z); z[6] = bflo(w.w); z[7] = bfhi(w.w); }
                { const int t = tid >> 3, c8 = tid & 7;
                    const u32x4 w = *(const u32x4*)(Pb + (r0 + t) * NINP + PC_K + h * 64 + c8 * 8);
                    float* z = kk + t * 65 + c8 * 8; z[0] = bflo(w.x); z[1] = bfhi(w.x); z[2] = bflo(w.y); z[3] = bfhi(w.y); z[4] = bflo(w.z); z[5] = bfhi(w.z); z[6] = bflo(w.w); z[7] = bfhi(w.w);
                    const u32x4 wq = *(const u32x4*)(Pb + (r0 + t) * NINP + PC_Q + h * 64 + c8 * 8);
                    float* y = qq + t * 65 + c8 * 8; y[0] = bflo(wq.x); y[1] = bfhi(wq.x); y[2] = bflo(wq.y); y[3] = bfhi(wq.y); y[4] = bflo(wq.z); y[5] = bfhi(wq.z); y[6] = bflo(wq.w); y[7] = bfhi(wq.w); }
#pragma unroll
                for (int i = 0; i < 2; ++i) { const int ch = tid + i * 512, t = ch >> 4, c8 = ch & 15; const u32x4 w = *(const u32x4*)(Pb + (r0 + t) * NINP + PC_V + h * 128 + c8 * 8);
                    float* z = vv + t * 128 + c8 * 8; z[0] = bflo(w.x); z[1] = bfhi(w.x); z[2] = bflo(w.y); z[3] = bfhi(w.y); z[4] = bflo(w.z); z[5] = bfhi(w.z); z[6] = bflo(w.w); z[7] = bfhi(w.w); }
                { const f32x4* sp = (const f32x4*)(glaD + (size_t)unit * 8192); f32x4* dp = (f32x4*)Sp;
#pragma unroll
                    for (int i = 0; i < 4; ++i) dp[tid + i * 512] = sp[tid + i * 512]; }
                __syncthreads();
                gla_gate_cumsum<64>(zg, bb, seg, w_gate, b_gate, h, tid);
                for (int i = tid; i < 64 * 64; i += NTHREADS) { const int t = i >> 6, d = i & 63; const float bt = bb[t * 65 + d]; qq[t * 65 + d] *= __expf(bt) * 0.125f; kk[t * 65 + d] *= __expf(-bt); }
                __syncthreads();
                { const int t = tid >> 3, s0 = (tid & 7) * 8;
#pragma unroll
                    for (int j = 0; j < 8; ++j) { const int s = s0 + j; float a = 0.f; if (s <= t) { for (int d = 0; d < 64; ++d) a += qq[t * 65 + d] * kk[s * 65 + d]; } sc[t * 65 + s] = a; } }
                __syncthreads();
                { const int t = tid >> 3, e0 = (tid & 7) * 16; f32x4 a[4];
#pragma unroll
                    for (int i = 0; i < 4; ++i) a[i] = (f32x4){0.f, 0.f, 0.f, 0.f};
                    for (int d = 0; d < 64; ++d) { const float qd = qq[t * 65 + d]; const f32x4* sp = (const f32x4*)(Sp + d * 128 + e0);
#pragma unroll
                        for (int i = 0; i < 4; ++i) a[i] += sp[i] * qd; }
                    for (int s = 0; s <= t; ++s) { const float w = sc[t * 65 + s]; const f32x4* vp = (const f32x4*)(vv + s * 128 + e0);
#pragma unroll
                        for (int i = 0; i < 4; ++i) a[i] += vp[i] * w; }
                    float ss = 0.f;
#pragma unroll
                    for (int i = 0; i < 4; ++i) ss += (a[i][0] * a[i][0] + a[i][1] * a[i][1]) + (a[i][2] * a[i][2] + a[i][3] * a[i][3]);
                    ss += __shfl_xor(ss, 1); ss += __shfl_xor(ss, 2); ss += __shfl_xor(ss, 4);
                    const float rs = rsqrtf(ss * (1.f / 128.f) + EPS);
                    const u32x4* rp = (const u32x4*)(Pb + (r0 + t) * NINP + PC_R + h * 128 + e0); const f32x4* gp = (const f32x4*)(g_gla_out + e0);
                    u32x4* mp = (u32x4*)(mix + (r0 + t) * D + h * 128 + e0);
#pragma unroll
                    for (int hf = 0; hf < 2; ++hf) { const u32x4 rw = rp[hf]; const f32x4 g0 = gp[hf * 2], g1 = gp[hf * 2 + 1]; const f32x4 x0 = a[hf * 2] * rs * g0, x1 = a[hf * 2 + 1] * rs * g1;
                        u32x4 w; w.x = pk2(x0[0] * siluf(bflo(rw.x)), x0[1] * siluf(bfhi(rw.x))); w.y = pk2(x0[2] * siluf(bflo(rw.y)), x0[3] * siluf(bfhi(rw.y)));
                        w.z = pk2(x1[0] * siluf(bflo(rw.z)), x1[1] * siluf(bfhi(rw.z))); w.w = pk2(x1[2] * siluf(bflo(rw.w)), x1[3] * siluf(bfhi(rw.w))); mp[hf] = w; }
                }
                __syncthreads();
            }
        }
        for (int it = gw; it < 136 * 32; it += NGW) {
            const int rb = it >> 5, g = it & 31, fr = lane & 15, fq = lane >> 4; const int R0 = rb * 16;
            f32x4 acc[8];
#pragma unroll
            for (int nb = 0; nb < 8; ++nb) acc[nb] = (f32x4){0.f, 0.f, 0.f, 0.f};
#pragma unroll 1
            for (int ks = 0; ks < 8; ++ks) {
                bf16x8 a;
                if (ks < 4) a = *(const bf16x8*)(s5x + ((size_t)(R0 + fr) * 32 + g) * 128 + ks * 32 + fq * 8);
                else a = *(const bf16x8*)(Pb + ((size_t)(R0 + fr) * 8 + (ks - 4) * 2 + (fq >> 1)) * NINP + PC_U + g * 16 + (fq & 1) * 8);
#pragma unroll
                for (int nb = 0; nb < 8; ++nb) { const bf16x8 bfr = *(const bf16x8*)(GTt + (size_t)(g * 128 + nb * 16 + fr) * 256 + ks * 32 + fq * 8);
                    acc[nb] = __builtin_amdgcn_mfma_f32_16x16x32_bf16(bfr, a, acc[nb], 0, 0, 0); }
            }
            bf16x4 wA;
#pragma unroll
            for (int i = 0; i < 4; ++i) wA[i] = (short)f2bf(s5_wglu[(g * 16 + fq * 4 + i) * 16 + fr]);
            const f32x4 dsk = *(const f32x4*)(s5_d + g * 16 + fq * 4), bgl = *(const f32x4*)(s5_bglu + g * 16 + fq * 4);
#pragma unroll
            for (int nb = 0; nb < 8; ++nb) {
                const size_t row = (size_t)(R0 + fr) * 8 + nb;
                const u32x2 uw = *(const u32x2*)(Pb + row * NINP + PC_U + g * 16 + fq * 4);
                f32x4 z;
                z[0] = gelu_tanh(acc[nb][0] + dsk[0] * bflo(uw.x)); z[1] = gelu_tanh(acc[nb][1] + dsk[1] * bfhi(uw.x));
                z[2] = gelu_tanh(acc[nb][2] + dsk[2] * bflo(uw.y)); z[3] = gelu_tanh(acc[nb][3] + dsk[3] * bfhi(uw.y));
                const u32x2 zp = (u32x2){pk2(z[0], z[1]), pk2(z[2], z[3])};
                const f32x4 pre = __builtin_amdgcn_mfma_f32_16x16x16bf16_1k(wA, __builtin_bit_cast(bf16x4, zp), bgl, 0, 0, 0);
                u32x2 o; o.x = pk2(z[0] * sigmoidf_fast(pre[0]), z[1] * sigmoidf_fast(pre[1])); o.y = pk2(z[2] * sigmoidf_fast(pre[2]), z[3] * sigmoidf_fast(pre[3]));
                *(u32x2*)(mix + row * D + 512 + g * 16 + fq * 4) = o;
            }
        }
    }
    SEAM(6);

    PHASE(7) {
        REP_SYNC();
        pg8::Gemm g{mix, Wout, MP, D, D}; pg8::StaticOrder S; S.init(MP, D, G, bx);
        pg8::EpiResid E{hres, hres + (size_t)MP * D, hres, hb, ssq + SSQ_H2, 1.f};
        pg8::gemm_phase<pg8::EpiResid, pg8::StaticOrder, true, true>(ldsl, g, S, E);
        SEpiResid SE{hres, hres, hb, ssq + SSQ_H2, 1.f};
        small_gemm(mix + (size_t)MP * D, Wout, D, fl, G, bx, wave, tid0, SE);
    }
    SEAM(7);
    PHASE(8) {
        REP_SYNC();
        pg8::Gemm g{hb, Wcq, MP, D, D}; pg8::StaticOrder S; S.init(MP, D, G, bx);
        pg8::EpiScaleBf16 E{qb, D, ssq + SSQ_H2, 0.0625f};
        pg8::gemm_phase<pg8::EpiScaleBf16, pg8::StaticOrder, true, true>(ldsl, g, S, E);
        SEpiScaleBf16 SE{qb, ssq + SSQ_H2, 0.0625f};
        small_gemm(hb + (size_t)MP * D, Wcq, D, fl, G, bx, wave, tid0, SE);
    }
    SEAM(8);

    PHASE(9) {
        REP_SYNC();
        PHASE_LOCALS;
        constexpr int QS = 264;
        bf16_t* Qs = (bf16_t*)lds; bf16_t* Ps = Qs + 64 * QS; float* redmax = (float*)(Ps + 64 * QS); float* redsum = redmax + 64 * 8;
        const int fr = lane & 15, fq = lane >> 4, w = wave;
        for (int unit = bx; unit < 1024 + 512; unit += G) {
            const bool smp = unit >= 1024;
            int b, h; size_t r0; int nrows;
            if (!smp) { const int qt = unit & 31; h = (unit >> 5) & 3; b = unit >> 7; r0 = (size_t)b * 2048 + qt * 64; nrows = 64; }
            else { const int u2 = unit - 1024; h = u2 & 3; b = u2 >> 2; r0 = (size_t)MP + b * 8; nrows = 8; }
            const int MB = smp ? 1 : 4;
            for (int ch = tid; ch < MB * 16 * 32; ch += NTHREADS) { const int row = ch >> 5, c8 = ch & 31; u32x4 v = (u32x4){0u, 0u, 0u, 0u};
                if (row < nrows) v = *(const u32x4*)(qb + (r0 + row) * D + h * 256 + c8 * 8);
                *(u32x4*)(Qs + row * QS + c8 * 8) = v; }
            __syncthreads();
            f32x4 sa[4][2];
#pragma unroll
            for (int mb = 0; mb < 4; ++mb) { sa[mb][0] = (f32x4){0.f, 0.f, 0.f, 0.f}; sa[mb][1] = sa[mb][0]; }
            if (!smp) {
                const bf16_t* kbase = kb + ((size_t)b * 256 + w * 32 + fr) * D + h * 256 + fq * 8;
#pragma unroll
                for (int ks = 0; ks < 8; ++ks) {
                    const bf16x8 b0 = *(const bf16x8*)(kbase + ks * 32), b1 = *(const bf16x8*)(kbase + (size_t)16 * D + ks * 32);
#pragma unroll
                    for (int mb = 0; mb < 4; ++mb) { const bf16x8 a = *(const bf16x8*)(Qs + (mb * 16 + fr) * QS + ks * 32 + fq * 8);
                        sa[mb][0] = __builtin_amdgcn_mfma_f32_16x16x32_bf16(a, b0, sa[mb][0], 0, 0, 0); sa[mb][1] = __builtin_amdgcn_mfma_f32_16x16x32_bf16(a, b1, sa[mb][1], 0, 0, 0); }
                }
            } else {
                const float* kbase = cache_k + ((size_t)b * 256 + w * 32 + fr) * D + h * 256 + fq * 8;
#pragma unroll
                for (int ks = 0; ks < 8; ++ks) {
                    u32x4 p0, p1;
                    { const f32x4 x0 = *(const f32x4*)(kbase + ks * 32), x1 = *(const f32x4*)(kbase + ks * 32 + 4); p0 = (u32x4){pk2(x0[0], x0[1]), pk2(x0[2], x0[3]), pk2(x1[0], x1[1]), pk2(x1[2], x1[3])}; }
                    { const f32x4 x0 = *(const f32x4*)(kbase + (size_t)16 * D + ks * 32), x1 = *(const f32x4*)(kbase + (size_t)16 * D + ks * 32 + 4); p1 = (u32x4){pk2(x0[0], x0[1]), pk2(x0[2], x0[3]), pk2(x1[0], x1[1]), pk2(x1[2], x1[3])}; }
                    const bf16x8 a = *(const bf16x8*)(Qs + fr * QS + ks * 32 + fq * 8);
                    sa[0][0] = __builtin_amdgcn_mfma_f32_16x16x32_bf16(a, __builtin_bit_cast(bf16x8, p0), sa[0][0], 0, 0, 0);
                    sa[0][1] = __builtin_amdgcn_mfma_f32_16x16x32_bf16(a, __builtin_bit_cast(bf16x8, p1), sa[0][1], 0, 0, 0);
                }
            }
#pragma unroll
            for (int mb = 0; mb < 4; ++mb) if (mb < MB) {
#pragma unroll
                for (int r = 0; r < 4; ++r) { float mx = fmaxf(sa[mb][0][r], sa[mb][1][r]);
                    mx = fmaxf(mx, __shfl_xor(mx, 1)); mx = fmaxf(mx, __shfl_xor(mx, 2)); mx = fmaxf(mx, __shfl_xor(mx, 4)); mx = fmaxf(mx, __shfl_xor(mx, 8));
                    if (fr == 0) redmax[(mb * 16 + fq * 4 + r) * 8 + w] = mx; }
            }
            __syncthreads();
#pragma unroll
            for (int mb = 0; mb < 4; ++mb) if (mb < MB) {
#pragma unroll
                for (int r = 0; r < 4; ++r) { const int q = mb * 16 + fq * 4 + r; const f32x4 m0 = *(const f32x4*)(redmax + q * 8), m1 = *(const f32x4*)(redmax + q * 8 + 4);
                    const float mx = fmaxf(fmaxf(fmaxf(m0[0], m0[1]), fmaxf(m0[2], m0[3])), fmaxf(fmaxf(m1[0], m1[1]), fmaxf(m1[2], m1[3])));
                    const float p0 = __expf(sa[mb][0][r] - mx), p1 = __expf(sa[mb][1][r] - mx);
                    Ps[q * QS + w * 32 + fr] = (bf16_t)f2bf(p0); Ps[q * QS + w * 32 + 16 + fr] = (bf16_t)f2bf(p1);
                    float sm = p0 + p1; sm += __shfl_xor(sm, 1); sm += __shfl_xor(sm, 2); sm += __shfl_xor(sm, 4); sm += __shfl_xor(sm, 8);
                    if (fr == 0) redsum[q * 8 + w] = sm; }
            }
            __syncthreads();
            f32x4 oa[4][2];
#pragma unroll
            for (int mb = 0; mb < 4; ++mb) { oa[mb][0] = (f32x4){0.f, 0.f, 0.f, 0.f}; oa[mb][1] = oa[mb][0]; }
            if (!smp) {
                const bf16_t* vbase = vbT + ((size_t)b * D + h * 256 + w * 32 + fr) * 256 + fq * 8;
#pragma unroll
                for (int ks = 0; ks < 8; ++ks) {
                    const bf16x8 b0 = *(const bf16x8*)(vbase + ks * 32), b1 = *(const bf16x8*)(vbase + 16 * 256 + ks * 32);
#pragma unroll
                    for (int mb = 0; mb < 4; ++mb) { const bf16x8 a = *(const bf16x8*)(Ps + (mb * 16 + fr) * QS + ks * 32 + fq * 8);
                        oa[mb][0] = __builtin_amdgcn_mfma_f32_16x16x32_bf16(a, b0, oa[mb][0], 0, 0, 0); oa[mb][1] = __builtin_amdgcn_mfma_f32_16x16x32_bf16(a, b1, oa[mb][1], 0, 0, 0); }
                }
            } else {
                const float* vbase = cache_v + ((size_t)b * 256 + fq * 8) * D + h * 256 + w * 32 + fr;
#pragma unroll
                for (int ks = 0; ks < 8; ++ks) {
                    float x0[8], x1[8];
#pragma unroll
                    for (int j = 0; j < 8; ++j) { x0[j] = vbase[(size_t)(ks * 32 + j) * D]; x1[j] = vbase[(size_t)(ks * 32 + j) * D + 16]; }
                    const u32x4 p0 = (u32x4){pk2(x0[0], x0[1]), pk2(x0[2], x0[3]), pk2(x0[4], x0[5]), pk2(x0[6], x0[7])};
                    const u32x4 p1 = (u32x4){pk2(x1[0], x1[1]), pk2(x1[2], x1[3]), pk2(x1[4], x1[5]), pk2(x1[6], x1[7])};
                    const bf16x8 a = *(const bf16x8*)(Ps + fr * QS + ks * 32 + fq * 8);
                    oa[0][0] = __builtin_amdgcn_mfma_f32_16x16x32_bf16(a, __builtin_bit_cast(bf16x8, p0), oa[0][0], 0, 0, 0);
                    oa[0][1] = __builtin_amdgcn_mfma_f32_16x16x32_bf16(a, __builtin_bit_cast(bf16x8, p1), oa[0][1], 0, 0, 0);
                }
            }
#pragma unroll
            for (int mb = 0; mb < 4; ++mb) if (mb < MB) {
#pragma unroll
                for (int r = 0; r < 4; ++r) { const int q = mb * 16 + fq * 4 + r; if (q < nrows) {
                    const f32x4 s0 = *(const f32x4*)(redsum + q * 8), s1 = *(const f32x4*)(redsum + q * 8 + 4);
                    const float inv = 1.f / (((s0[0] + s0[1]) + (s0[2] + s0[3])) + ((s1[0] + s1[1]) + (s1[2] + s1[3])));
                    bf16_t* op = ob + (r0 + q) * D + h * 256 + w * 32 + fr;
                    op[0] = (bf16_t)f2bf(oa[mb][0][r] * inv); op[16] = (bf16_t)f2bf(oa[mb][1][r] * inv); } }
            }
            __syncthreads();
        }
    }
    SEAM(9);

    PHASE(10) {
        REP_SYNC();
        pg8::Gemm g{ob, Wco, MP, D, D}; pg8::StaticOrder S; S.init(MP, D, G, bx);
        pg8::EpiResid E{hres, hres + (size_t)MP * D, hres, hb, ssq + SSQ_H3, 1.f};
        pg8::gemm_phase<pg8::EpiResid, pg8::StaticOrder, true, true>(ldsl, g, S, E);
        SEpiResid SE{hres, hres, hb, ssq + SSQ_H3, 1.f};
        small_gemm(ob + (size_t)MP * D, Wco, D, fl, G, bx, wave, tid0, SE);
    }
    SEAM(10);
    PHASE(11) {
        REP_SYNC();
        pg8::Gemm g{hb, Wgu2, M, NGU, D}; pg8::StaticOrder S; S.init(M, NGU, G, bx);
        pg8::EpiSwiGLU E{act, FF, ssq + SSQ_H3};
        pg8::gemm_phase<pg8::EpiSwiGLU, pg8::StaticOrder, true, true>(ldsl, g, S, E);
    }
    SEAM(11);
    PHASE(12) {
        REP_SYNC();
        pg8::Gemm g{act, Wd2, MP, D, FF}; pg8::StaticOrder S; S.init(MP, D, G, bx);
        pg8::EpiResid E{hres, hres + (size_t)MP * D, out + O_Y, nullptr, nullptr, 0.5f};
        pg8::gemm_phase<pg8::EpiResid, pg8::StaticOrder, true, true>(ldsl, g, S, E);
        SEpiResid SE{hres, out + O_Y, nullptr, nullptr, 0.5f};
        small_gemm(act + (size_t)MP * FF, Wd2, FF, fl, G, bx, wave, tid0, SE);
    }
    SEAM(12);
    PHASE(13) {
        REP_SYNC();
        PHASE_LOCALS;
        for (int m = gw; m < M; m += NGW) {
            f32x4* yr = (f32x4*)(out + O_Y + (size_t)m * D) + lane; f32x4 v[4]; float s = 0.f;
#pragma unroll
            for (int j = 0; j < 4; ++j) { v[j] = yr[64 * j]; s += (v[j].x * v[j].x + v[j].y * v[j].y) + (v[j].z * v[j].z + v[j].w * v[j].w); }
            const float rs = rsqrtf(wave_sum(s) * (1.f / D) + EPS);
#pragma unroll
            for (int j = 0; j < 4; ++j) { const f32x4 gq = ((const f32x4*)g_final)[lane + 64 * j]; yr[64 * j] = v[j] * rs * gq; }
        }
    }
#undef IN
#undef SEAM
}

extern "C" void kernel_launch(void* const* d_in, const int* in_sizes, int n_in, void* d_out, int out_size, void* d_ws, size_t ws_size, hipStream_t stream) {
    static int grid = 0;
    if (grid == 0) {
        if (n_in != 36 || (size_t)out_size != O_TOTAL || ws_size < WS_END) { fprintf(stderr, "kernel_launch: unexpected shapes (n_in %d, out %d, ws %zu)\n", n_in, out_size, ws_size); grid = -1; return; }
        int dev = 0, cus = 0, per_cu = 0;
        hipGetDevice(&dev); hipDeviceGetAttribute(&cus, hipDeviceAttributeMultiprocessorCount, dev);
        hipFuncSetAttribute((const void*)hymba_fwd, hipFuncAttributeMaxDynamicSharedMemorySize, LDS_BYTES);
        hipOccupancyMaxActiveBlocksPerMultiprocessor(&per_cu, (const void*)hymba_fwd, NTHREADS, LDS_BYTES);
        if (per_cu < 1) { fprintf(stderr, "kernel_launch: occupancy query says %d blocks per CU\n", per_cu); per_cu = 1; }
        grid = cus;
        (void)hipGetLastError();
    }
    if (grid < 0) return;
    if (hipMemsetAsync((char*)d_ws + WS_BAR, 0, BAR_BYTES, stream) != hipSuccess) { fprintf(stderr, "kernel_launch: memset failed\n"); return; }
    Args a{};
    for (int i = 0; i < 36; ++i) a.in[i] = (const float*)d_in[i];
    a.out = (float*)d_out; a.ws = (unsigned char*)d_ws; a.ph_lo = 0; a.ph_hi = 14;
    void* params[] = {&a};
    hipError_t e = hipLaunchCooperativeKernel((const void*)hymba_fwd, dim3(grid), dim3(NTHREADS), params, LDS_BYTES, stream);
    if (e != hipSuccess) fprintf(stderr, "kernel_launch: cooperative launch failed: %s (grid %d)\n", hipGetErrorString(e), grid);
}
```

```cpp
#include <hip/hip_runtime.h>
#include <hip/hip_cooperative_groups.h>
#include <cstdio>
#include <cstdint>
namespace cg = cooperative_groups;

constexpr int D = 1024, MP = 16384, MS = 1024, M = MP + MS, FF = 2816, NGU = 2 * FF, NIN = 2064, NINP = 2304;
constexpr int MEMR = 2048;
constexpr float EPS = 1e-6f;
constexpr int PC_Q = 0, PC_K = 256, PC_V = 512, PC_R = 1024, PC_U = 1536, PC_ZG = 2048;
constexpr size_t O_Y = 0, O_GLAP = 17825792, O_REP = 18087936, O_IMP = 18104320, O_MKP = 18120704, O_MVP = 20217856,
                 O_GLAS = 22315008, O_RES = 26509312, O_IMS = 26771456, O_TOTAL = 27033600;
constexpr size_t MiB = 1u << 20;
constexpr int XCD_BAR_WORDS_C = 3456;
constexpr size_t WS_SSQ = 0;
constexpr size_t WS_WGU1 = 1 * MiB, WS_WD1 = 12 * MiB, WS_WIN = 18 * MiB, WS_WOUT = 23 * MiB, WS_WCQ = 25 * MiB, WS_WCKV = 27 * MiB,
                 WS_WCO = 31 * MiB, WS_WGU2 = 33 * MiB, WS_WD2 = 44 * MiB, WS_EGT = 50 * MiB, WS_GTT = 51 * MiB, WS_MEMB = 53 * MiB,
                 WS_KB = 57 * MiB, WS_VBT = 61 * MiB, WS_XB = 65 * MiB, WS_HB = 99 * MiB, WS_H = 133 * MiB, WS_ACT = 201 * MiB,
                 WS_MIX = 295 * MiB, WS_Q = 329 * MiB, WS_O = 363 * MiB, WS_GLAD = 397 * MiB, WS_GLADEC = 429 * MiB, WS_S5E = 430 * MiB,
                 WS_S5X = 464 * MiB, WS_END = 481 * MiB;
constexpr int SSQ_X = 0, SSQ_MEM = M, SSQ_H1 = M + 2048, SSQ_H2 = 2 * M + 2048, SSQ_H3 = 3 * M + 2048, SSQ_WORDS = 4 * M + 2048;
static_assert((size_t)SSQ_WORDS * 4 <= MiB, "ssq region");
static_assert(WS_ACT + (size_t)M * FF * 2 <= WS_MIX && WS_ACT + (size_t)M * NINP * 2 <= WS_MIX, "act / P region");

constexpr size_t WS_BAR = 512 * 1024, BAR_BYTES = 16384;
static_assert((size_t)SSQ_WORDS * 4 <= WS_BAR && XCD_BAR_WORDS_C * 4 <= BAR_BYTES, "ctl map");
constexpr int NWAVES = 8, NTHREADS = 512;
constexpr int LDS_BYTES = 147456;
constexpr int LDS_BARST = LDS_BYTES - 64;

#define LAS __attribute__((address_space(3)))
typedef unsigned short bf16_t;
typedef short bf16x8 __attribute__((ext_vector_type(8)));
typedef short bf16x4 __attribute__((ext_vector_type(4)));
typedef float f32x4 __attribute__((ext_vector_type(4)));
typedef float f32x2 __attribute__((ext_vector_type(2)));
typedef unsigned u32x4 __attribute__((ext_vector_type(4)));
typedef unsigned u32x2 __attribute__((ext_vector_type(2)));
#define DI __device__ __forceinline__

DI unsigned f2bf(float f) { unsigned u = __builtin_bit_cast(unsigned, f); return (u + 0x7fffu + ((u >> 16) & 1u)) >> 16; }
DI unsigned pk2(float lo, float hi) { return f2bf(lo) | (f2bf(hi) << 16); }
DI float bf2f(unsigned b) { return __builtin_bit_cast(float, b << 16); }
DI float bflo(unsigned w) { return __builtin_bit_cast(float, w << 16); }
DI float bfhi(unsigned w) { return __builtin_bit_cast(float, w & 0xffff0000u); }
DI float wave_sum(float v) {
#pragma unroll
    for (int o = 1; o < 64; o <<= 1) v += __shfl_xor(v, o);
    return v;
}
DI float sigmoidf_fast(float x) { return __builtin_amdgcn_rcpf(1.f + __expf(-x)); }
DI float siluf(float x) { return x * sigmoidf_fast(x); }
DI float logsigmoidf(float x) { return fminf(x, 0.f) - log1pf(__expf(-fabsf(x))); }
DI float gelu_tanh(float y) { const float a = 0.7978845608028654f * (y + 0.044715f * y * y * y); const float e = __expf(2.f * a); const float th = 1.f - 2.f * __builtin_amdgcn_rcpf(e + 1.f); return 0.5f * y * (1.f + th); }

namespace pg8 {
#define PG8_LAS __attribute__((address_space(3)))
constexpr int BM = 256, BK = 64, HALF = 128, HTB = HALF * BK * 2  , STAGE_BYTES = 8 * HTB, NXCD = 8, WGM = 8;

__host__ __device__ __forceinline__ int lds_byte(int r, int c) { const int st = (r >> 4) * 2 + (c >> 5), rr = r & 15, cc = c & 31, ob = rr * 64 + cc * 2; return st * 1024 + (ob ^ (((ob >> 9) & 1) << 5)); }
__host__ __device__ __forceinline__ void stage_rc(int b, int& R, int& C) { const int st = b / 1024, sb = b % 1024, swz = sb ^ (((sb >> 9) & 1) << 5); R = (st >> 1) * 16 + swz / 64; C = (st & 1) * 32 + (swz % 64) / 2; }
__host__ __device__ __forceinline__ int perm32(int rho) { const int n = rho >> 4, i = rho & 15; return 8 * (i >> 2) + 4 * n + (i & 3); }

struct Unit { int pm, pn; };
struct Gemm { const bf16_t* A; const bf16_t* Bt; int M, N, K; };

struct StaticOrder {
    int nM, nN, nwg, G, c;
    __host__ __device__ void init(int M_, int N_, int G_, int c_) { nM = M_ / BM; nN = N_ / BM; nwg = nM * nN; G = G_; c = c_; }
    __host__ __device__ bool next(int i, Unit& u) const {
        const long L = (long)i * G + c; if (L >= nwg) return false;
        int wgid = (int)L; { const int q = nwg / NXCD, r = nwg % NXCD, xcd = wgid % NXCD, off = wgid / NXCD; wgid = (xcd < r ? xcd * (q + 1) : r * (q + 1) + (xcd - r) * q) + off; }
        const int nig = WGM * nN, gid = wgid / nig, fm = gid * WGM, gsz = (nM - fm) < WGM ? (nM - fm) : WGM;
        u.pm = fm + ((wgid % nig) % gsz); u.pn = (wgid % nig) / gsz; return true;
    }
    __device__ __forceinline__ void a_ready(const Unit&) const {}
    __device__ __forceinline__ void done(const Unit&) const {}
};

__device__ __forceinline__ unsigned cvt_pk_bf16(float lo, float hi) { unsigned r; asm volatile("v_cvt_pk_bf16_f32 %0, %1, %2" : "=v"(r) : "v"(lo), "v"(hi)); return r; }


struct EpiSwiGLU {
    static constexpr bool PERM = true, AFTER_DRAIN = false;
    bf16_t* O; int ldc; const float* ssq;
    __device__ __forceinline__ void operator()(const f32x4 (&acc)[2][2][4][2], const Unit& u, int wr, int wc, int fr, int fq) const {
        const int row0 = u.pm * BM + wr * 64 + fr, col0 = u.pn * HALF + wc * 32 + 8 * fq;
#pragma unroll
        for (int ai = 0; ai < 2; ++ai)
#pragma unroll
            for (int m = 0; m < 4; ++m) {
                const int row = row0 + ai * HALF + m * 16;
                const float rs = rsqrtf(ssq[row] * (1.f / D) + EPS);
                const f32x4 g0 = acc[ai][0][m][0] * rs, g1 = acc[ai][0][m][1] * rs, u0 = acc[ai][1][m][0] * rs, u1 = acc[ai][1][m][1] * rs;
                u32x4 w;
                w.x = cvt_pk_bf16(siluf(g0[0]) * u0[0], siluf(g0[1]) * u0[1]); w.y = cvt_pk_bf16(siluf(g0[2]) * u0[2], siluf(g0[3]) * u0[3]);
                w.z = cvt_pk_bf16(siluf(g1[0]) * u1[0], siluf(g1[1]) * u1[1]); w.w = cvt_pk_bf16(siluf(g1[2]) * u1[2], siluf(g1[3]) * u1[3]);
                *(u32x4*)(O + (size_t)row * ldc + col0) = w;
            }
    }
};
struct EpiResid {
    static constexpr bool PERM = false, AFTER_DRAIN = false;
    const float* base0; const float* base1; float* out; bf16_t* hb; float* ssq; float alpha;
    __device__ __forceinline__ void operator()(const f32x4 (&acc)[2][2][4][2], const Unit& u, int wr, int wc, int fr, int fq) const {
        const int row0 = u.pm * BM + wr * 64 + fr, col0 = u.pn * BM + wc * 32 + 4 * fq;
#pragma unroll
        for (int ai = 0; ai < 2; ++ai)
#pragma unroll
            for (int m = 0; m < 4; ++m) {
                const int row = row0 + ai * HALF + m * 16;
                const float* bp = (row < MP) ? base0 + (size_t)row * D : base1 + (size_t)(row - MP) * D;
                float s = 0.f;
#pragma unroll
                for (int bj = 0; bj < 2; ++bj)
#pragma unroll
                    for (int n = 0; n < 2; ++n) {
                        const int c = col0 + bj * HALF + n * 16;
                        const f32x4 v = *(const f32x4*)(bp + c) + acc[ai][bj][m][n] * alpha;
                        *(f32x4*)(out + (size_t)row * D + c) = v;
                        s += (v[0] * v[0] + v[1] * v[1]) + (v[2] * v[2] + v[3] * v[3]);
                        if (hb) { u32x2 w; w.x = cvt_pk_bf16(v[0], v[1]); w.y = cvt_pk_bf16(v[2], v[3]); *(u32x2*)(hb + (size_t)row * D + c) = w; }
                    }
                if (ssq) { s += __shfl_xor(s, 16); s += __shfl_xor(s, 32); if (fq == 0) atomicAdd(ssq + row, s); }
            }
    }
};
struct EpiScaleBf16 {
    static constexpr bool PERM = true, AFTER_DRAIN = false;
    bf16_t* O; int ldc; const float* ssq; float scale;
    __device__ __forceinline__ void operator()(const f32x4 (&acc)[2][2][4][2], const Unit& u, int wr, int wc, int fr, int fq) const {
        const int row0 = u.pm * BM + wr * 64 + fr, col0 = u.pn * BM + wc * 32 + 8 * fq;
#pragma unroll
        for (int ai = 0; ai < 2; ++ai)
#pragma unroll
            for (int m = 0; m < 4; ++m) {
                const int row = row0 + ai * HALF + m * 16;
                const float rs = rsqrtf(ssq[row] * (1.f / D) + EPS) * scale;
#pragma unroll
                for (int bj = 0; bj < 2; ++bj) {
                    const f32x4 v0 = acc[ai][bj][m][0] * rs, v1 = acc[ai][bj][m][1] * rs;
                    u32x4 w; w.x = cvt_pk_bf16(v0[0], v0[1]); w.y = cvt_pk_bf16(v0[2], v0[3]); w.z = cvt_pk_bf16(v1[0], v1[1]); w.w = cvt_pk_bf16(v1[2], v1[3]);
                    *(u32x4*)(O + (size_t)row * ldc + col0 + bj * HALF) = w;
                }
            }
    }
};
struct EpiMemKV {
    static constexpr bool PERM = false, AFTER_DRAIN = false;
    float* outK; float* outV; bf16_t* kb; bf16_t* vbT; const float* ssq;
    __device__ __forceinline__ void operator()(const f32x4 (&acc)[2][2][4][2], const Unit& u, int wr, int wc, int fr, int fq) const {
        const int row0 = u.pm * BM + wr * 64 + fr; const bool isV = u.pn >= 4; const int col0 = (u.pn & 3) * BM + wc * 32 + 4 * fq;
        float* outp = isV ? outV : outK;
#pragma unroll
        for (int ai = 0; ai < 2; ++ai)
#pragma unroll
            for (int m = 0; m < 4; ++m) {
                const int row = row0 + ai * HALF + m * 16;
                const float rs = rsqrtf(ssq[row] * (1.f / D) + EPS);
                const int b = row >> 8, key = row & 255;
#pragma unroll
                for (int bj = 0; bj < 2; ++bj)
#pragma unroll
                    for (int n = 0; n < 2; ++n) {
                        const int c = col0 + bj * HALF + n * 16;
                        const f32x4 v = acc[ai][bj][m][n] * rs;
                        *(f32x4*)(outp + (size_t)row * D + c) = v;
                        if (!isV) { u32x2 w; w.x = cvt_pk_bf16(v[0], v[1]); w.y = cvt_pk_bf16(v[2], v[3]); *(u32x2*)(kb + (size_t)row * D + c) = w; }
                        else {
#pragma unroll
                            for (int i = 0; i < 4; ++i) vbT[((size_t)b * D + c + i) * 256 + key] = (bf16_t)f2bf(v[i]);
                        }
                    }
            }
    }
};

template <class Epi, class Sched, bool ALIGN_EPI = false, bool SP2 = false>
__device__ __forceinline__ void gemm_phase(PG8_LAS unsigned char* lds, const Gemm g, const Sched& S, const Epi& E) {
    const int tid = threadIdx.x, wid = __builtin_amdgcn_readfirstlane(tid >> 6), lane = tid & 63, wr = wid >> 2, wc = wid & 3, fr = lane & 15, fq = lane >> 4;
    const int K = g.K, nt = K / BK;
    unsigned voffA[2], voffB[2];
#pragma unroll
    for (int i = 0; i < 2; ++i) { int R, C; stage_rc(tid * 16 + i * 8192, R, C); const int Rb = Epi::PERM ? ((R & ~31) + perm32(R & 31)) : R;
        voffA[i] = (unsigned)(R * K + C) * 2u; voffB[i] = (unsigned)(Rb * K + C) * 2u; }
    const size_t kstep = (size_t)(BK * 2);
    const size_t hstep = (size_t)HALF * K * 2;
    const size_t tstep = 2 * hstep;
    const unsigned ldsw = (unsigned)wid * 1024u;
    const int aoff = lds_byte(wr * 64 + fr, fq * 8), boff = lds_byte(wc * 32 + fr, fq * 8);
#define PG8_SA(b, h) (((b) * 2 + (h)) * HTB)
#define PG8_SB(b, h) ((4 + (b) * 2 + (h)) * HTB)
#define PG8_STAGE(bufoff, gbase, voff) do { _Pragma("unroll") for (int _i = 0; _i < 2; ++_i) \
        __builtin_amdgcn_global_load_lds((const unsigned*)((const char*)(gbase) + (voff)[_i]), (PG8_LAS unsigned*)(lds + (bufoff) + ldsw + _i * 8192), 16, 0, 0); } while (0)
#define PG8_LDA(dst, b, h) do { _Pragma("unroll") for (int m = 0; m < 4; ++m) _Pragma("unroll") for (int k = 0; k < 2; ++k) dst[m][k] = *(const PG8_LAS bf16x8*)(lds + PG8_SA(b, h) + aoff + m * 2048 + k * 1024); } while (0)
#define PG8_LDB(dst, b, h) do { _Pragma("unroll") for (int n = 0; n < 2; ++n) _Pragma("unroll") for (int k = 0; k < 2; ++k) dst[n][k] = *(const PG8_LAS bf16x8*)(lds + PG8_SB(b, h) + boff + n * 2048 + k * 1024); } while (0)
#define PG8_MMA(ai, bj, At, Bt) do { __builtin_amdgcn_s_setprio(1); _Pragma("unroll") for (int m = 0; m < 4; ++m) _Pragma("unroll") for (int n = 0; n < 2; ++n) _Pragma("unroll") for (int k = 0; k < 2; ++k) \
        acc[ai][bj][m][n] = __builtin_amdgcn_mfma_f32_16x16x32_bf16(Bt[n][k], At[m][k], acc[ai][bj][m][n], 0, 0, 0); __builtin_amdgcn_s_setprio(0); } while (0)
#define PG8_WAIT_V(n) asm volatile("s_waitcnt vmcnt(" #n ")" ::: "memory")
#define PG8_WAIT_L(n) asm volatile("s_waitcnt lgkmcnt(" #n ")" ::: "memory")
#define PG8_BAR __builtin_amdgcn_s_barrier()
#define PG8_SCHED __builtin_amdgcn_sched_barrier(0)
    Unit cur, nxt; int ui = 0;
    if (!S.next(0, cur)) return;
    f32x4 acc[2][2][4][2];
#pragma unroll
    for (int a = 0; a < 2; ++a)
#pragma unroll
        for (int b = 0; b < 2; ++b)
#pragma unroll
            for (int m = 0; m < 4; ++m)
#pragma unroll
                for (int n = 0; n < 2; ++n) acc[a][b][m][n] = (f32x4){0.f, 0.f, 0.f, 0.f};
    bf16x8 At[4][2], B0[2][2], B1[2][2];
    const char* cA = (const char*)g.A + (size_t)cur.pm * tstep; const char* cB = (const char*)g.Bt + (size_t)cur.pn * tstep;
    S.a_ready(cur);
    if constexpr (SP2) {
        PG8_STAGE(PG8_SB(0, 0), cB, voffB); PG8_STAGE(PG8_SB(0, 1), cB + hstep, voffB); PG8_STAGE(PG8_SA(0, 0), cA, voffA); PG8_STAGE(PG8_SA(0, 1), cA + hstep, voffA);
        if (wr == 1) PG8_BAR;
        PG8_WAIT_V(2); PG8_BAR;
        PG8_STAGE(PG8_SB(1, 0), cB + kstep, voffB); PG8_STAGE(PG8_SA(1, 0), cA + kstep, voffA); PG8_STAGE(PG8_SB(1, 1), cB + hstep + kstep, voffB);
        PG8_WAIT_V(6); PG8_BAR;
    } else {
        PG8_STAGE(PG8_SB(0, 0), cB, voffB); PG8_STAGE(PG8_SA(0, 0), cA, voffA); PG8_STAGE(PG8_SB(0, 1), cB + hstep, voffB); PG8_STAGE(PG8_SA(0, 1), cA + hstep, voffA);
        if (wr == 1) PG8_BAR;
        PG8_WAIT_V(4); PG8_BAR;
        PG8_STAGE(PG8_SB(1, 0), cB + kstep, voffB); PG8_STAGE(PG8_SA(1, 0), cA + kstep, voffA); PG8_STAGE(PG8_SB(1, 1), cB + hstep + kstep, voffB);
        PG8_WAIT_V(6); PG8_BAR;
    }
    for (;;) {
        const bool has_next = S.next(ui + 1, nxt);
        const char* nA = has_next ? (const char*)g.A + (size_t)nxt.pm * tstep : cA; const char* nB = has_next ? (const char*)g.Bt + (size_t)nxt.pn * tstep : cB;
        for (int t = 0; t < nt; t += 2) {
            const bool last = (t == nt - 2);
            const char* a1 = cA + (size_t)(t + 1) * kstep;
            const char* a2 = last ? nA : cA + (size_t)(t + 2) * kstep; const char* b2 = last ? nB : cB + (size_t)(t + 2) * kstep;
            const char* a3 = a2 + kstep; const char* b3 = b2 + kstep;
            if (last && has_next) S.a_ready(nxt);
            if constexpr (SP2) {
            PG8_LDB(B0, 0, 0); PG8_LDB(B1, 0, 1); PG8_SCHED; PG8_LDA(At, 0, 0); PG8_STAGE(PG8_SA(1, 1), a1 + hstep, voffA);
            PG8_WAIT_V(8); PG8_WAIT_L(0); PG8_BAR; PG8_MMA(0, 0, At, B0); PG8_MMA(0, 1, At, B1); PG8_BAR; PG8_SCHED;
            PG8_LDA(At, 0, 1); PG8_STAGE(PG8_SB(0, 0), b2, voffB); PG8_STAGE(PG8_SB(0, 1), b2 + hstep, voffB); PG8_STAGE(PG8_SA(0, 0), a2, voffA);
            PG8_WAIT_V(8); PG8_WAIT_L(0); PG8_BAR; PG8_MMA(1, 0, At, B0); PG8_MMA(1, 1, At, B1); PG8_BAR; PG8_SCHED;
            PG8_LDB(B0, 1, 0); PG8_LDB(B1, 1, 1); PG8_SCHED; PG8_LDA(At, 1, 0); PG8_STAGE(PG8_SA(0, 1), a2 + hstep, voffA);
            PG8_WAIT_V(8); PG8_WAIT_L(0); PG8_BAR; PG8_MMA(0, 0, At, B0); PG8_MMA(0, 1, At, B1); PG8_BAR; PG8_SCHED;
            PG8_LDA(At, 1, 1); PG8_STAGE(PG8_SB(1, 0), b3, voffB); PG8_STAGE(PG8_SB(1, 1), b3 + hstep, voffB); PG8_STAGE(PG8_SA(1, 0), a3, voffA);
            PG8_WAIT_V(8); PG8_WAIT_L(0); PG8_BAR; PG8_MMA(1, 0, At, B0); PG8_MMA(1, 1, At, B1); PG8_BAR; PG8_SCHED;
            } else {
            PG8_LDB(B0, 0, 0); PG8_SCHED; PG8_LDA(At, 0, 0); PG8_STAGE(PG8_SA(1, 1), a1 + hstep, voffA);
            PG8_WAIT_L(8); PG8_BAR; PG8_WAIT_L(0); PG8_MMA(0, 0, At, B0); PG8_BAR; PG8_SCHED;
            PG8_LDB(B1, 0, 1); PG8_STAGE(PG8_SB(0, 0), b2, voffB);
            PG8_BAR; PG8_WAIT_L(0); PG8_MMA(0, 1, At, B1); PG8_BAR;
            PG8_LDA(At, 0, 1); PG8_STAGE(PG8_SA(0, 0), a2, voffA);
            PG8_BAR; PG8_WAIT_L(0); PG8_MMA(1, 0, At, B0); PG8_BAR; PG8_SCHED;
            PG8_STAGE(PG8_SB(0, 1), b2 + hstep, voffB);
            PG8_WAIT_V(6); PG8_BAR; PG8_MMA(1, 1, At, B1); PG8_BAR;
            PG8_LDB(B0, 1, 0); PG8_SCHED; PG8_LDA(At, 1, 0); PG8_STAGE(PG8_SA(0, 1), a2 + hstep, voffA);
            PG8_WAIT_L(8); PG8_BAR; PG8_WAIT_L(0); PG8_MMA(0, 0, At, B0); PG8_BAR; PG8_SCHED;
            PG8_LDB(B1, 1, 1); PG8_STAGE(PG8_SB(1, 0), b3, voffB);
            PG8_BAR; PG8_WAIT_L(0); PG8_MMA(0, 1, At, B1); PG8_BAR;
            PG8_LDA(At, 1, 1); PG8_STAGE(PG8_SA(1, 0), a3, voffA);
            PG8_BAR; PG8_WAIT_L(0); PG8_MMA(1, 0, At, B0); PG8_BAR; PG8_SCHED;
            PG8_STAGE(PG8_SB(1, 1), b3 + hstep, voffB);
            PG8_WAIT_V(6); PG8_BAR; PG8_MMA(1, 1, At, B1); PG8_BAR;
            }
        }
        if constexpr (ALIGN_EPI) { if (wr == 0) PG8_BAR; }
        if constexpr (!Epi::AFTER_DRAIN) { E(acc, cur, wr, wc, fr, fq); S.done(cur); }
        if (!has_next) break;
#pragma unroll
        for (int a = 0; a < 2; ++a)
#pragma unroll
            for (int b = 0; b < 2; ++b)
#pragma unroll
                for (int m = 0; m < 4; ++m)
#pragma unroll
                    for (int n = 0; n < 2; ++n) acc[a][b][m][n] = (f32x4){0.f, 0.f, 0.f, 0.f};
        cur = nxt; cA = nA; cB = nB; ++ui;
        if constexpr (ALIGN_EPI) { if (wr == 1) PG8_BAR; }
    }
    PG8_WAIT_V(0);
    if constexpr (!ALIGN_EPI) { if (wr == 0) PG8_BAR; }
    PG8_BAR;
#undef PG8_SA
#undef PG8_SB
#undef PG8_STAGE
#undef PG8_LDA
#undef PG8_LDB
#undef PG8_MMA
#undef PG8_WAIT_V
#undef PG8_WAIT_L
#undef PG8_BAR
#undef PG8_SCHED
}
}


#define XB_TMO      128
#define XB_XCNT(j)  (256  + 64 * (j))
#define XB_XSUB(j)  (1280 + 64 * (j))
#define XB_XGEN(j)  (2304 + 64 * (j))
#define XB_TOP      3328
#define XB_TOPGEN   3392
#define XCD_BAR_WORDS 3456
#define XB_SPIN_CAP (1u << 18)
__device__ __forceinline__ unsigned xb_ld(unsigned* p)              { return __hip_atomic_load(p, __ATOMIC_RELAXED, __HIP_MEMORY_SCOPE_AGENT); }
__device__ __forceinline__ unsigned xb_add(unsigned* p, unsigned v) { return __hip_atomic_fetch_add(p, v, __ATOMIC_RELAXED, __HIP_MEMORY_SCOPE_AGENT); }
__device__ __forceinline__ unsigned xb_xcc_id() { return (unsigned)__builtin_amdgcn_s_getreg((3 << 11) | 20) & 0xFu; }
#define XB_SPIN(cond, bar) do { unsigned _sp = 0; while (cond) { __builtin_amdgcn_s_sleep(1); \
    if ((++_sp & 255u) == 0u) { if (xb_ld(&(bar)[XB_TMO])) break; if (_sp > XB_SPIN_CAP) { atomicAdd(&(bar)[XB_TMO], 1u); break; } } } } while (0)
struct XcdBarrier { unsigned* bar; unsigned x; volatile LAS unsigned* st; };
__device__ __forceinline__ XcdBarrier xcd_barrier_post(unsigned* bar, volatile LAS unsigned* st) {
    XcdBarrier b; b.bar = bar; b.x = xb_xcc_id(); b.st = st;
    if (threadIdx.x == 0) (void)xb_add(&bar[XB_XCNT(b.x)], 1u);
    return b;
}
__device__ __forceinline__ void xcd_barrier_complete(unsigned* bar, unsigned x, unsigned& nloc, unsigned& nx) {
    const unsigned G = gridDim.x * gridDim.y * gridDim.z;
    unsigned sum, cnt, mine, sp = 0u;
    for (;;) {
        sum = 0u; cnt = 0u; mine = 0u;
#pragma unroll
        for (unsigned j = 0; j < 16; ++j) { const unsigned c = xb_ld(&bar[XB_XCNT(j)]); sum += c; cnt += (c > 0u) ? 1u : 0u; mine = (j == x) ? c : mine; }
        if (sum == G) break;
        __builtin_amdgcn_s_sleep(1);
        if ((++sp & 255u) == 0u) { if (xb_ld(&bar[XB_TMO])) break; if (sp > XB_SPIN_CAP) { atomicAdd(&bar[XB_TMO], 1u); break; } }
    }
    nloc = mine > 0u ? mine : 1u; nx = cnt > 0u ? cnt : 1u;
}
__device__ __forceinline__ void xcd_barrier(const XcdBarrier& b) {
    asm volatile("s_waitcnt vmcnt(0)" ::: "memory");
    __syncthreads();
    if (threadIdx.x == 0) {
        unsigned* bar = b.bar;
        __builtin_amdgcn_s_waitcnt(0);
        unsigned nloc = b.st[0], nx = b.st[1];
        if (nloc == 0u) { xcd_barrier_complete(bar, b.x, nloc, nx); b.st[0] = nloc; b.st[1] = nx; }
        const unsigned old = xb_add(&bar[XB_XSUB(b.x)], 1u);
        const unsigned gen = old / nloc;
        if (old + 1u == (gen + 1u) * nloc) {
            __builtin_amdgcn_fence(__ATOMIC_RELEASE, "agent");
            asm volatile("s_waitcnt vmcnt(0)" ::: "memory");
            const unsigned og = xb_add(&bar[XB_TOP], 1u);
            const unsigned tg = og / nx;
            if (og + 1u == (tg + 1u) * nx) xb_add(&bar[XB_TOPGEN], 1u);
            else XB_SPIN(xb_ld(&bar[XB_TOPGEN]) == tg, bar);
            __builtin_amdgcn_fence(__ATOMIC_ACQUIRE, "agent");
            xb_add(&bar[XB_XGEN(b.x)], 1u);
            asm volatile("s_waitcnt vmcnt(0)" ::: "memory");
        } else {
            XB_SPIN(xb_ld(&bar[XB_XGEN(b.x)]) == gen, bar);
            __builtin_amdgcn_fence(__ATOMIC_ACQUIRE, "agent");
            asm volatile("s_waitcnt vmcnt(0)" ::: "memory");
        }
    }
    __syncthreads();
}

struct Args { const float* in[36]; float* out; unsigned char* ws; int ph_lo, ph_hi; };
#define LDS_WAIT() asm volatile("s_waitcnt lgkmcnt(0)" ::: "memory")

DI int rowmap(int mode, int n) {
    if (mode == 1) { const int j = n < FF ? n : n - FF; return 256 * (j >> 7) + (n < FF ? 0 : 128) + (j & 127); }
    if (mode == 2) { if (n < 1024) return n; if (n < 1040) return n + 1024; return n - 16; }
    return n;
}
DI void p0_transpose_item(const float* W, const float* gain, int K, int N, bf16_t* WT, int mode, float* scr, int item, int lane) {
    const int nblk = (N + 31) / 32, kb = item / nblk, nb = item % nblk, k0 = 64 * kb, n0 = 32 * nb;
    const int nn = n0 + (lane & 31); const bool ok = nn < N;
#pragma unroll 8
    for (int i = 0; i < 32; ++i) { const int kk = 2 * i + (lane >> 5); float v = ok ? W[(size_t)(k0 + kk) * N + nn] : 0.f; if (gain) v *= gain[k0 + kk]; scr[kk * 33 + (lane & 31)] = v; }
    LDS_WAIT(); asm volatile("" ::: "memory");
    const int c = lane & 7;
#pragma unroll
    for (int j = 0; j < 4; ++j) { const int n = (lane >> 3) + 8 * j; const float* s = scr + (8 * c) * 33 + n;
        u32x4 o; o.x = pk2(s[0 * 33], s[1 * 33]); o.y = pk2(s[2 * 33], s[3 * 33]); o.z = pk2(s[4 * 33], s[5 * 33]); o.w = pk2(s[6 * 33], s[7 * 33]);
        if (n0 + n < N) *(u32x4*)(WT + (size_t)rowmap(mode, n0 + n) * K + k0 + 8 * c) = o; }
    LDS_WAIT(); asm volatile("" ::: "memory");
}
DI void row_to_bf16_ssq(const float* xrow, bf16_t* orow, float* ssq_slot, int lane) {
    const f32x4* xr = (const f32x4*)xrow + lane;
    f32x4 v[4]; float s = 0.f;
#pragma unroll
    for (int j = 0; j < 4; ++j) { v[j] = xr[64 * j]; s += (v[j].x * v[j].x + v[j].y * v[j].y) + (v[j].z * v[j].z + v[j].w * v[j].w); }
    s = wave_sum(s);
    unsigned long long* o8 = (unsigned long long*)orow + lane;
#pragma unroll
    for (int j = 0; j < 4; ++j) o8[64 * j] = (unsigned long long)pk2(v[j].x, v[j].y) | ((unsigned long long)pk2(v[j].z, v[j].w) << 32);
    if (lane == 0) *ssq_slot = s;
}
struct S5P { float dt, lr, li; };
DI S5P s5_par(const float* lre, const float* lim, const float* logdt, int g, int n) { S5P p; p.dt = expf(logdt[g]); p.lr = lre[g * 64 + n]; p.li = lim[g * 64 + n]; return p; }
DI f32x2 s5_pow(const S5P& p, int j) {
    const float mag = expf((float)j * (p.dt * p.lr)); float sn, cs; sincosf((float)j * (p.dt * p.li), &sn, &cs); return (f32x2){mag * cs, mag * sn};
}
DI f32x2 s5_coef(const S5P& p) {
    const f32x2 ab = s5_pow(p, 1); const float den = p.lr * p.lr + p.li * p.li;
    return (f32x2){((ab.x - 1.f) * p.lr + ab.y * p.li) / den, (ab.y * p.lr - (ab.x - 1.f) * p.li) / den};
}
DI f32x2 cmul(f32x2 a, f32x2 b) { return (f32x2){a.x * b.x - a.y * b.y, a.x * b.y + a.y * b.x}; }

template <int NT>
DI void gla_gate_cumsum(const float* zg, float* bb, float* seg, const float* wg, const float* bg, int h, int tid) {
    if constexpr (NT == 64) {
        const int d = tid & 63; float wr[16]; const float bias = bg[h * 64 + d];
#pragma unroll
        for (int r = 0; r < 16; ++r) wr[r] = wg[r * 256 + h * 64 + d];
#pragma unroll
        for (int k = 0; k < 8; ++k) { const int t = (tid >> 6) + 8 * k; const f32x4* zp = (const f32x4*)(zg + t * 16); float s = bias;
#pragma unroll
            for (int r4 = 0; r4 < 4; ++r4) { const f32x4 z = zp[r4]; s += z[0] * wr[r4 * 4] + z[1] * wr[r4 * 4 + 1] + z[2] * wr[r4 * 4 + 2] + z[3] * wr[r4 * 4 + 3]; }
            bb[t * 65 + d] = logsigmoidf(s) * (1.f / 16.f); }
    } else {
    for (int i = tid; i < NT * 64; i += NTHREADS) { const int t = i >> 6, d = i & 63; float s = bg[h * 64 + d];
#pragma unroll
        for (int r = 0; r < 16; ++r) s += zg[t * 16 + r] * wg[r * 256 + h * 64 + d];
        bb[t * 65 + d] = logsigmoidf(s) * (1.f / 16.f); }
    }
    __syncthreads();
    if constexpr (NT == 64) {
        const int d = tid & 63, sg = tid >> 6; float run = 0.f;
#pragma unroll
        for (int i = 0; i < 8; ++i) { run += bb[(sg * 8 + i) * 65 + d]; bb[(sg * 8 + i) * 65 + d] = run; }
        seg[sg * 64 + d] = run;
        __syncthreads();
        float pre = 0.f;
        for (int j = 0; j < sg; ++j) pre += seg[j * 64 + d];
#pragma unroll
        for (int i = 0; i < 8; ++i) bb[(sg * 8 + i) * 65 + d] += pre;
    } else {
        if (tid < 64) { float run = 0.f;
#pragma unroll
            for (int t = 0; t < NT; ++t) { run += bb[t * 65 + tid]; bb[t * 65 + tid] = run; } }
    }
    __syncthreads();
}


struct SEpiResid {
    const float* base; float* out; bf16_t* hb; float* ssq; float alpha;
    DI void operator()(int row, int col, const f32x4& a0, const f32x4& a1, int tid) const {
        const f32x4 v0 = *(const f32x4*)(base + (size_t)row * D + col) + a0 * alpha, v1 = *(const f32x4*)(base + (size_t)row * D + col + 4) + a1 * alpha;
        *(f32x4*)(out + (size_t)row * D + col) = v0; *(f32x4*)(out + (size_t)row * D + col + 4) = v1;
        if (hb) { u32x4 w; w.x = pk2(v0[0], v0[1]); w.y = pk2(v0[2], v0[3]); w.z = pk2(v1[0], v1[1]); w.w = pk2(v1[2], v1[3]); *(u32x4*)(hb + (size_t)row * D + col) = w; }
        if (ssq) { float sq = (v0[0] * v0[0] + v0[1] * v0[1]) + (v0[2] * v0[2] + v0[3] * v0[3]) + (v1[0] * v1[0] + v1[1] * v1[1]) + (v1[2] * v1[2] + v1[3] * v1[3]);
            sq += __shfl_xor(sq, 1); sq += __shfl_xor(sq, 2); sq += __shfl_xor(sq, 4); if ((tid & 7) == 0) atomicAdd(ssq + row, sq); }
    }
};
struct SEpiScaleBf16 {
    bf16_t* O; const float* ssq; float scale;
    DI void operator()(int row, int col, const f32x4& a0, const f32x4& a1, int) const {
        const float rs = rsqrtf(ssq[row] * (1.f / D) + EPS) * scale; const f32x4 v0 = a0 * rs, v1 = a1 * rs;
        u32x4 w; w.x = pk2(v0[0], v0[1]); w.y = pk2(v0[2], v0[3]); w.z = pk2(v1[0], v1[1]); w.w = pk2(v1[2], v1[3]); *(u32x4*)(O + (size_t)row * D + col) = w;
    }
};
template <class F>
DI void small_gemm(const bf16_t* A, const bf16_t* Bt, int K, float* red, int G, int bx, int wave, int tid, const F& epi) {
    const int lane = tid & 63, fr = lane & 15, fq = lane >> 4, kw = K >> 3, nsteps = kw >> 5;
    for (int tile = bx; tile < 256; tile += G) {
        const int row0 = (tile >> 4) * 64, col0 = (tile & 15) * 64;
        f32x4 acc[4][4];
#pragma unroll
        for (int i = 0; i < 4; ++i)
#pragma unroll
            for (int j = 0; j < 4; ++j) acc[i][j] = (f32x4){0.f, 0.f, 0.f, 0.f};
        const bf16_t* ap = A + (size_t)(row0 + fr) * K + wave * kw + fq * 8;
        const bf16_t* bp = Bt + (size_t)(col0 + fr) * K + wave * kw + fq * 8;
#pragma unroll 2
        for (int st = 0; st < nsteps; ++st) {
            bf16x8 a[4], b[4];
#pragma unroll
            for (int i = 0; i < 4; ++i) { a[i] = *(const bf16x8*)(ap + (size_t)i * 16 * K + st * 32); b[i] = *(const bf16x8*)(bp + (size_t)i * 16 * K + st * 32); }
#pragma unroll
            for (int i = 0; i < 4; ++i)
#pragma unroll
                for (int j = 0; j < 4; ++j) acc[i][j] = __builtin_amdgcn_mfma_f32_16x16x32_bf16(a[i], b[j], acc[i][j], 0, 0, 0);
        }
        float* my = red + wave * (64 * 68);
#pragma unroll
        for (int i = 0; i < 4; ++i)
#pragma unroll
            for (int j = 0; j < 4; ++j)
#pragma unroll
                for (int r = 0; r < 4; ++r) my[(i * 16 + fq * 4 + r) * 68 + j * 16 + fr] = acc[i][j][r];
        __syncthreads();
        { const int row = tid >> 3, c8 = (tid & 7) * 8; f32x4 s0 = (f32x4){0.f, 0.f, 0.f, 0.f}, s1 = s0;
#pragma unroll
            for (int w = 0; w < 8; ++w) { const f32x4* p = (const f32x4*)(red + w * (64 * 68) + row * 68 + c8); s0 += p[0]; s1 += p[1]; }
            epi(MP + row0 + row, col0 + c8, s0, s1, tid); }
        __syncthreads();
    }
}

__global__ void __launch_bounds__(NTHREADS, 2) hymba_fwd(Args args) {
    extern __shared__ __attribute__((aligned(16))) unsigned char lds[];
    cg::grid_group grid = cg::this_grid();
    const int tid0 = threadIdx.x, wave = __builtin_amdgcn_readfirstlane(tid0 >> 6);
    const int G = gridDim.x, bx = blockIdx.x;
    const int gw = bx * NWAVES + wave, NGW = G * NWAVES;
    const int NGT = G * NTHREADS;
#define PHASE_LOCALS int tid_l_ = tid0; asm volatile("" : "+v"(tid_l_)); const int tid = tid_l_, lane = tid & 63, gt = bx * NTHREADS + tid; (void)lane; (void)gt
    unsigned char* ws = args.ws;
    float* out = args.out;
    float* fl = (float*)lds;
    LAS unsigned char* ldsl = (LAS unsigned char*)lds;

    const float* x_prompt = args.in[0]; const float* x_sample = args.in[1]; const float* state_gla = args.in[2];
    const float* st_re = args.in[3]; const float* st_im = args.in[4]; const float* cache_k = args.in[5]; const float* cache_v = args.in[6];
    const float* mem_prompt = args.in[7];
    const float* w_gate = args.in[13]; const float* b_gate = args.in[14]; const float* g_gla_out = args.in[15];
    const float* s5_lre = args.in[16]; const float* s5_lim = args.in[17]; const float* s5_logdt = args.in[18];
    const float* s5_bre = args.in[19]; const float* s5_bim = args.in[20]; const float* s5_cre = args.in[21]; const float* s5_cim = args.in[22];
    const float* s5_d = args.in[23]; const float* s5_wglu = args.in[24]; const float* s5_bglu = args.in[25];
    const float* g_final = args.in[35];

    float* ssq = (float*)(ws + WS_SSQ);
    bf16_t* Wgu1 = (bf16_t*)(ws + WS_WGU1); bf16_t* Wd1 = (bf16_t*)(ws + WS_WD1); bf16_t* Win = (bf16_t*)(ws + WS_WIN); bf16_t* Wout = (bf16_t*)(ws + WS_WOUT);
    bf16_t* Wcq = (bf16_t*)(ws + WS_WCQ); bf16_t* Wckv = (bf16_t*)(ws + WS_WCKV); bf16_t* Wco = (bf16_t*)(ws + WS_WCO); bf16_t* Wgu2 = (bf16_t*)(ws + WS_WGU2); bf16_t* Wd2 = (bf16_t*)(ws + WS_WD2);
    bf16_t* EgT = (bf16_t*)(ws + WS_EGT); bf16_t* GTt = (bf16_t*)(ws + WS_GTT);
    bf16_t* memb = (bf16_t*)(ws + WS_MEMB); bf16_t* kb = (bf16_t*)(ws + WS_KB); bf16_t* vbT = (bf16_t*)(ws + WS_VBT);
    bf16_t* xb = (bf16_t*)(ws + WS_XB); bf16_t* hb = (bf16_t*)(ws + WS_HB); float* hres = (float*)(ws + WS_H);
    bf16_t* act = (bf16_t*)(ws + WS_ACT); bf16_t* Pb = (bf16_t*)(ws + WS_ACT);
    bf16_t* mix = (bf16_t*)(ws + WS_MIX); bf16_t* qb = (bf16_t*)(ws + WS_Q); bf16_t* ob = (bf16_t*)(ws + WS_O);
    float* glaD = (float*)(ws + WS_GLAD); float* glaDec = (float*)(ws + WS_GLADEC);
    float* s5e = (float*)(ws + WS_S5E); bf16_t* s5x = (bf16_t*)(ws + WS_S5X);

    const int lo = args.ph_lo, hi = args.ph_hi;
    if (tid0 < 16) ((LAS unsigned*)(ldsl + LDS_BARST))[tid0] = 0u;
    __syncthreads();
    const XcdBarrier xbar = xcd_barrier_post((unsigned*)(ws + WS_BAR), (volatile LAS unsigned*)(ldsl + LDS_BARST));
    if (lo < 0) grid.sync();
#ifndef PHASE_MASK
#define PHASE_MASK 0xffffffffu
#endif
#define IN(k) (((PHASE_MASK >> (k)) & 1u) && lo <= (k) && (k) < hi)
#ifndef REPEAT_MASK
#define REPEAT_MASK 0u
#endif
#define PHASE(k) if (IN(k)) for (int rep_ = 0; rep_ < 1 + (int)((REPEAT_MASK >> (k)) & 1u); ++rep_)
#define REP_SYNC() do { if (rep_) xcd_barrier(xbar); } while (0)
#define SEAM(k) do { if (IN(k) && IN((k) + 1)) xcd_barrier(xbar); } while (0)

    PHASE(0) {
        REP_SYNC();
        PHASE_LOCALS;
        float* scr = fl + wave * (64 * 33);
        constexpr int I_GU = 16 * 176, I_D = 44 * 32, I_IN = 16 * 65, I_SQ = 16 * 32, I_CKV = 16 * 64;
        constexpr int NITEMS = 2 * I_GU + 2 * I_D + I_IN + 3 * I_SQ + I_CKV;
        for (int it = gw; it < NITEMS; it += NGW) {
            int r = it;
            if (r < I_GU) { p0_transpose_item(args.in[9], args.in[8], D, NGU, Wgu1, 1, scr, r, lane); continue; } r -= I_GU;
            if (r < I_GU) { p0_transpose_item(args.in[33], args.in[32], D, NGU, Wgu2, 1, scr, r, lane); continue; } r -= I_GU;
            if (r < I_D) { p0_transpose_item(args.in[10], nullptr, FF, D, Wd1, 0, scr, r, lane); continue; } r -= I_D;
            if (r < I_D) { p0_transpose_item(args.in[34], nullptr, FF, D, Wd2, 0, scr, r, lane); continue; } r -= I_D;
            if (r < I_IN) { p0_transpose_item(args.in[12], args.in[11], D, NIN, Win, 2, scr, r, lane); continue; } r -= I_IN;
            if (r < I_SQ) { p0_transpose_item(args.in[26], nullptr, D, D, Wout, 0, scr, r, lane); continue; } r -= I_SQ;
            if (r < I_SQ) { p0_transpose_item(args.in[29], args.in[27], D, D, Wcq, 0, scr, r, lane); continue; } r -= I_SQ;
            if (r < I_SQ) { p0_transpose_item(args.in[31], nullptr, D, D, Wco, 0, scr, r, lane); continue; } r -= I_SQ;
            p0_transpose_item(args.in[30], args.in[28], D, 2 * D, Wckv, 0, scr, r, lane);
        }
        for (int i = gt; i < (NINP - NIN) * D / 8; i += NGT) ((u32x4*)(Win + (size_t)NIN * D))[i] = (u32x4){0u, 0u, 0u, 0u};
        for (int i = gt; i < 3 * M; i += NGT) ssq[SSQ_H1 + i] = 0.f;
        for (int m = gw; m < M; m += NGW) { const float* xr = m < MP ? x_prompt + (size_t)m * D : x_sample + (size_t)(m - MP) * D; row_to_bf16_ssq(xr, xb + (size_t)m * D, ssq + SSQ_X + m, lane); }
        for (int m = gw; m < MEMR; m += NGW) row_to_bf16_ssq(mem_prompt + (size_t)m * D, memb + (size_t)m * D, ssq + SSQ_MEM + m, lane);
        for (int it = gt; it < 32 * 64 * 8; it += NGT) {
            const int g = it >> 9, n = (it >> 3) & 63, s = it & 7;
            const S5P p = s5_par(s5_lre, s5_lim, s5_logdt, g, n);
            const f32x2 mm = cmul(s5_pow(p, 7 - s), s5_coef(p));
            unsigned wre[8], wim[8];
#pragma unroll
            for (int pp = 0; pp < 8; ++pp) {
                const f32x2 b0 = (f32x2){s5_bre[(g * 64 + n) * 16 + 2 * pp], s5_bim[(g * 64 + n) * 16 + 2 * pp]}, b1 = (f32x2){s5_bre[(g * 64 + n) * 16 + 2 * pp + 1], s5_bim[(g * 64 + n) * 16 + 2 * pp + 1]};
                const f32x2 v0 = cmul(mm, b0), v1 = cmul(mm, b1);
                wre[pp] = pk2(v0.x, v1.x); wim[pp] = pk2(v0.y, v1.y);
            }
            u32x4* dre = (u32x4*)(EgT + ((size_t)(g * 128 + n) * 128 + s * 16)); u32x4* dim = (u32x4*)(EgT + ((size_t)(g * 128 + 64 + n) * 128 + s * 16));
            dre[0] = (u32x4){wre[0], wre[1], wre[2], wre[3]}; dre[1] = (u32x4){wre[4], wre[5], wre[6], wre[7]};
            dim[0] = (u32x4){wim[0], wim[1], wim[2], wim[3]}; dim[1] = (u32x4){wim[4], wim[5], wim[6], wim[7]};
        }
        for (int it = gt; it < 32 * 8 * 64; it += NGT) {
            const int g = it >> 9, t = (it >> 6) & 7, n = it & 63;
            const S5P p = s5_par(s5_lre, s5_lim, s5_logdt, g, n);
            const f32x2 pw = s5_pow(p, t + 1);
#pragma unroll
            for (int pp = 0; pp < 16; ++pp) {
                const f32x2 c = (f32x2){s5_cre[(g * 16 + pp) * 64 + n], s5_cim[(g * 16 + pp) * 64 + n]};
                const f32x2 v = cmul(c, pw);
                bf16_t* dst = GTt + (size_t)(g * 128 + t * 16 + pp) * 256;
                dst[n] = (bf16_t)f2bf(v.x); dst[64 + n] = (bf16_t)f2bf(-v.y);
            }
        }
        for (int it = gt; it < 32 * 8 * 8 * 16; it += NGT) {
            const int g = it >> 10, t = (it >> 7) & 7, s = (it >> 4) & 7, pp = it & 15;
            float a[16];
#pragma unroll
            for (int q = 0; q < 16; ++q) a[q] = 0.f;
            if (s <= t) {
                for (int n = 0; n < 64; ++n) {
                    const S5P p = s5_par(s5_lre, s5_lim, s5_logdt, g, n);
                    const f32x2 c = (f32x2){s5_cre[(g * 16 + pp) * 64 + n], s5_cim[(g * 16 + pp) * 64 + n]};
                    const f32x2 cc = cmul(cmul(c, s5_pow(p, t - s)), s5_coef(p));
                    const f32x4* br = (const f32x4*)(s5_bre + (g * 64 + n) * 16); const f32x4* bi = (const f32x4*)(s5_bim + (g * 64 + n) * 16);
#pragma unroll
                    for (int q4 = 0; q4 < 4; ++q4) { const f32x4 r4 = br[q4], i4 = bi[q4];
#pragma unroll
                        for (int e = 0; e < 4; ++e) a[q4 * 4 + e] += cc.x * r4[e] - cc.y * i4[e]; }
                }
            }
            u32x4* dst = (u32x4*)(GTt + (size_t)(g * 128 + t * 16 + pp) * 256 + 128 + s * 16);
            dst[0] = (u32x4){pk2(a[0], a[1]), pk2(a[2], a[3]), pk2(a[4], a[5]), pk2(a[6], a[7])};
            dst[1] = (u32x4){pk2(a[8], a[9]), pk2(a[10], a[11]), pk2(a[12], a[13]), pk2(a[14], a[15])};
        }
    }
    SEAM(0);

    PHASE(1) {
        REP_SYNC();
        pg8::Gemm g{xb, Wgu1, M, NGU, D}; pg8::StaticOrder S; S.init(M, NGU, G, bx);
        pg8::EpiSwiGLU E{act, FF, ssq + SSQ_X};
        pg8::gemm_phase<pg8::EpiSwiGLU, pg8::StaticOrder, true, true>(ldsl, g, S, E);
    }
    SEAM(1);
    PHASE(2) {
        REP_SYNC();
        pg8::Gemm g{act, Wd1, MP, D, FF}; pg8::StaticOrder S; S.init(MP, D, G, bx);
        pg8::EpiResid E{x_prompt, x_sample, hres, hb, ssq + SSQ_H1, 0.5f};
        pg8::gemm_phase<pg8::EpiResid, pg8::StaticOrder, true, true>(ldsl, g, S, E);
        SEpiResid SE{x_sample - (size_t)MP * D, hres, hb, ssq + SSQ_H1, 0.5f};
        small_gemm(act + (size_t)MP * FF, Wd1, FF, fl, G, bx, wave, tid0, SE);
    }
    SEAM(2);
    PHASE(3) {
        REP_SYNC();
        { pg8::Gemm g{hb, Win, M, NINP, D}; pg8::StaticOrder S; S.init(M, NINP, G, bx);
          pg8::EpiScaleBf16 E{Pb, NINP, ssq + SSQ_H1, 1.f};
          pg8::gemm_phase<pg8::EpiScaleBf16, pg8::StaticOrder, true, true>(ldsl, g, S, E); }
        { pg8::Gemm g{memb, Wckv, MEMR, 2 * D, D}; pg8::StaticOrder S; S.init(MEMR, 2 * D, G, (bx + 64) % G);
          pg8::EpiMemKV E{out + O_MKP, out + O_MVP, kb, vbT, ssq + SSQ_MEM};
          pg8::gemm_phase<pg8::EpiMemKV, pg8::StaticOrder, true, true>(ldsl, g, S, E); }
    }
    SEAM(3);

    PHASE(4) {
        REP_SYNC();
        PHASE_LOCALS;
        {
            float* zg = fl; float* kk = zg + 64 * 16; float* vv = kk + 64 * 65; float* bb = vv + 64 * 129; float* seg = bb + 64 * 65;
            const int fr = lane & 15, fq = lane >> 4;
            for (int unit = bx; unit < 1024; unit += G) {
                const int bh = unit >> 5, c = unit & 31, b = bh >> 2, h = bh & 3;
                const size_t r0 = (size_t)b * 2048 + c * 64;
                if (tid < 128) { const int t = tid >> 1, hf = tid & 1; const u32x4 w = *(const u32x4*)(Pb + (r0 + t) * NINP + PC_ZG + hf * 8);
                    float* z = zg + t * 16 + hf * 8; z[0] = bflo(w.x); z[1] = bfhi(w.x); z[2] = bflo(w.y); z[3] = bfhi(w.y); z[4] = bflo(w.z); z[5] = bfhi(w.z); z[6] = bflo(w.w); z[7] = bfhi(w.w); }
                const u32x4 kw = *(const u32x4*)(Pb + (r0 + (tid >> 3)) * NINP + PC_K + h * 64 + (tid & 7) * 8);
#pragma unroll
                for (int i = 0; i < 2; ++i) { const int ch = tid + i * 512, t = ch >> 4, c8 = ch & 15; const u32x4 w = *(const u32x4*)(Pb + (r0 + t) * NINP + PC_V + h * 128 + c8 * 8);
                    float* z = vv + t * 129 + c8 * 8; z[0] = bflo(w.x); z[1] = bfhi(w.x); z[2] = bflo(w.y); z[3] = bfhi(w.y); z[4] = bflo(w.z); z[5] = bfhi(w.z); z[6] = bflo(w.w); z[7] = bfhi(w.w); }
                __syncthreads();
                gla_gate_cumsum<64>(zg, bb, seg, w_gate, b_gate, h, tid);
                { const int t = tid >> 3, d0 = (tid & 7) * 8; float* z = kk + t * 65 + d0; const float* bl = bb + 63 * 65 + d0; const float* bt = bb + t * 65 + d0;
                    z[0] = bflo(kw.x) * __expf(bl[0] - bt[0]); z[1] = bfhi(kw.x) * __expf(bl[1] - bt[1]); z[2] = bflo(kw.y) * __expf(bl[2] - bt[2]); z[3] = bfhi(kw.y) * __expf(bl[3] - bt[3]);
                    z[4] = bflo(kw.z) * __expf(bl[4] - bt[4]); z[5] = bfhi(kw.z) * __expf(bl[5] - bt[5]); z[6] = bflo(kw.w) * __expf(bl[6] - bt[6]); z[7] = bfhi(kw.w) * __expf(bl[7] - bt[7]); }
                __syncthreads();
                {
                    f32x4 acc[4];
#pragma unroll
                    for (int db = 0; db < 4; ++db) acc[db] = (f32x4){0.f, 0.f, 0.f, 0.f};
#pragma unroll
                    for (int ks = 0; ks < 2; ++ks) {
                        float av[8];
#pragma unroll
                        for (int j = 0; j < 8; ++j) av[j] = vv[(ks * 32 + fq * 8 + j) * 129 + wave * 16 + fr];
                        const u32x4 ap = (u32x4){pk2(av[0], av[1]), pk2(av[2], av[3]), pk2(av[4], av[5]), pk2(av[6], av[7])};
#pragma unroll
                        for (int db = 0; db < 4; ++db) {
                            float bv[8];
#pragma unroll
                            for (int j = 0; j < 8; ++j) bv[j] = kk[(ks * 32 + fq * 8 + j) * 65 + db * 16 + fr];
                            const u32x4 bp = (u32x4){pk2(bv[0], bv[1]), pk2(bv[2], bv[3]), pk2(bv[4], bv[5]), pk2(bv[6], bv[7])};
                            acc[db] = __builtin_amdgcn_mfma_f32_16x16x32_bf16(__builtin_bit_cast(bf16x8, ap), __builtin_bit_cast(bf16x8, bp), acc[db], 0, 0, 0);
                        }
                    }
                    float* dp = glaD + (size_t)unit * 8192;
#pragma unroll
                    for (int db = 0; db < 4; ++db)
#pragma unroll
                        for (int r = 0; r < 4; ++r) dp[(wave * 16 + fq * 4 + r) * 64 + db * 16 + fr] = acc[db][r];
                }
                if (tid < 64) glaDec[unit * 64 + tid] = __expf(bb[63 * 65 + tid]);
                __syncthreads();
            }
        }
        {
            float* zg = fl; float* qq = zg + 8 * 16; float* kk = qq + 8 * 65; float* kt = kk + 8 * 65; float* vv = kt + 8 * 65; float* bb = vv + 8 * 128; float* sc = bb + 8 * 65; float* S0 = sc + 64;
            for (int unit = bx; unit < 512; unit += G) {
                const int b = unit >> 2, h = unit & 3; const size_t r0 = (size_t)MP + b * 8;
                if (tid < 128) { const int t = tid >> 4, r = tid & 15; zg[t * 16 + r] = bf2f(Pb[(r0 + t) * NINP + PC_ZG + r]); }
                { const int t = tid >> 6, d = tid & 63; qq[t * 65 + d] = bf2f(Pb[(r0 + t) * NINP + PC_Q + h * 64 + d]); kk[t * 65 + d] = bf2f(Pb[(r0 + t) * NINP + PC_K + h * 64 + d]); }
#pragma unroll
                for (int i = 0; i < 2; ++i) { const int idx = tid + i * 512, t = idx >> 7, e = idx & 127; vv[t * 128 + e] = bf2f(Pb[(r0 + t) * NINP + PC_V + h * 128 + e]); }
                { const f32x4* sp = (const f32x4*)(state_gla + (size_t)unit * 8192); f32x4* dp = (f32x4*)S0;
#pragma unroll
                    for (int i = 0; i < 4; ++i) dp[tid + i * 512] = sp[tid + i * 512]; }
                __syncthreads();
                gla_gate_cumsum<8>(zg, bb, nullptr, w_gate, b_gate, h, tid);
                { const int t = tid >> 6, d = tid & 63; const float bt = bb[t * 65 + d], b7 = bb[7 * 65 + d]; const float kv = kk[t * 65 + d];
                    qq[t * 65 + d] *= __expf(bt) * 0.125f; kk[t * 65 + d] = kv * __expf(-bt); kt[t * 65 + d] = kv * __expf(b7 - bt); }
                __syncthreads();
                if (tid < 64) { const int t = tid >> 3, s = tid & 7; float a = 0.f; if (s <= t) { for (int d = 0; d < 64; ++d) a += qq[t * 65 + d] * kk[s * 65 + d]; } sc[t * 8 + s] = a; }
                __syncthreads();
                {
                    const int t = wave, e0 = lane * 2; float o0 = 0.f, o1 = 0.f;
                    for (int d = 0; d < 64; ++d) { const float qd = qq[t * 65 + d]; o0 += qd * S0[d * 128 + e0]; o1 += qd * S0[d * 128 + e0 + 1]; }
                    for (int s = 0; s <= t; ++s) { const float w = sc[t * 8 + s]; o0 += w * vv[s * 128 + e0]; o1 += w * vv[s * 128 + e0 + 1]; }
                    const float ss = wave_sum(o0 * o0 + o1 * o1); const float rs = rsqrtf(ss * (1.f / 128.f) + EPS);
                    const unsigned rw = *(const unsigned*)(Pb + (r0 + t) * NINP + PC_R + h * 128 + e0);
                    const float y0 = o0 * rs * g_gla_out[e0] * siluf(bflo(rw)), y1 = o1 * rs * g_gla_out[e0 + 1] * siluf(bfhi(rw));
                    *(unsigned*)(mix + (r0 + t) * D + h * 128 + e0) = pk2(y0, y1);
                }
                {
                    const int d = tid >> 3, e0 = (tid & 7) * 16; const float dec = __expf(bb[7 * 65 + d]);
                    f32x4 a[4];
#pragma unroll
                    for (int i = 0; i < 4; ++i) a[i] = ((const f32x4*)(S0 + d * 128 + e0))[i] * dec;
#pragma unroll
                    for (int s = 0; s < 8; ++s) { const float kd = kt[s * 65 + d]; const f32x4* vp = (const f32x4*)(vv + s * 128 + e0);
#pragma unroll
                        for (int i = 0; i < 4; ++i) a[i] += vp[i] * kd; }
                    f32x4* dp = (f32x4*)(out + O_GLAS + (size_t)unit * 8192 + d * 128 + e0);
#pragma unroll
                    for (int i = 0; i < 4; ++i) dp[i] = a[i];
                }
                __syncthreads();
            }
        }
        for (int it = gw; it < 136 * 32; it += NGW) {
            const int rb = it >> 5, g = it & 31, fr = lane & 15, fq = lane >> 4; const int R0 = rb * 16;
            f32x4 acc[8];
#pragma unroll
            for (int nb = 0; nb < 8; ++nb) acc[nb] = (f32x4){0.f, 0.f, 0.f, 0.f};
#pragma unroll
            for (int ks = 0; ks < 4; ++ks) {
                const bf16x8 a = *(const bf16x8*)(Pb + ((size_t)(R0 + fr) * 8 + ks * 2 + (fq >> 1)) * NINP + PC_U + g * 16 + (fq & 1) * 8);
#pragma unroll
                for (int nb = 0; nb < 8; ++nb) { const bf16x8 bfr = *(const bf16x8*)(EgT + (size_t)(g * 128 + nb * 16 + fr) * 128 + ks * 32 + fq * 8);
                    acc[nb] = __builtin_amdgcn_mfma_f32_16x16x32_bf16(a, bfr, acc[nb], 0, 0, 0); }
            }
#pragma unroll
            for (int nb = 0; nb < 8; ++nb)
#pragma unroll
                for (int r = 0; r < 4; ++r) s5e[((size_t)(R0 + fq * 4 + r) * 32 + g) * 128 + nb * 16 + fr] = acc[nb][r];
        }
    }
    SEAM(4);

    PHASE(5) {
        REP_SYNC();
        PHASE_LOCALS;
        for (int idx = gt; idx < 32 * 8192; idx += NGT) {
            const int bh = idx >> 13, de = idx & 8191, d = de & 63, e = de >> 6;
            float Dv[32], dc[32];
#pragma unroll
            for (int c = 0; c < 32; ++c) { const int unit = bh * 32 + c; Dv[c] = glaD[(size_t)unit * 8192 + de]; dc[c] = glaDec[unit * 64 + d]; }
            float S = 0.f;
#pragma unroll
            for (int c = 0; c < 32; ++c) { glaD[(size_t)(bh * 32 + c) * 8192 + de] = S; S = dc[c] * S + Dv[c]; }
            out[O_GLAP + (size_t)bh * 8192 + d * 128 + e] = S;
        }
        for (int it = bx; it < 256; it += G) {
            const int b = it >> 5, g = it & 31, n = tid & 63, sgm = wave;
            const S5P p = s5_par(s5_lre, s5_lim, s5_logdt, g, n); const f32x2 a8 = s5_pow(p, 8);
            f32x2 a256 = a8;
#pragma unroll
            for (int i = 0; i < 5; ++i) a256 = cmul(a256, a256);
            float er[32], ei[32];
            const size_t o0 = (((size_t)b * 256 + sgm * 32) * 32 + g) * 128;
#pragma unroll
            for (int i = 0; i < 32; ++i) { er[i] = s5e[o0 + (size_t)i * 4096 + n]; ei[i] = s5e[o0 + (size_t)i * 4096 + 64 + n]; }
            float yr = 0.f, yi = 0.f;
#pragma unroll
            for (int i = 0; i < 32; ++i) { const float pr = yr, pi = yi; yr = a8.x * pr - a8.y * pi + er[i]; yi = a8.x * pi + a8.y * pr + ei[i]; er[i] = pr; ei[i] = pi; }
            fl[sgm * 64 + n] = yr; fl[512 + sgm * 64 + n] = yi;
            __syncthreads();
            float xr = 0.f, xi = 0.f;
            for (int j = 0; j < sgm; ++j) { const float tr = fl[j * 64 + n], ti = fl[512 + j * 64 + n]; const float nr = a256.x * xr - a256.y * xi + tr, ni = a256.x * xi + a256.y * xr + ti; xr = nr; xi = ni; }
            f32x2 pw = (f32x2){1.f, 0.f};
#pragma unroll
            for (int i = 0; i < 32; ++i) {
                s5x[o0 + (size_t)i * 4096 + n] = (bf16_t)f2bf(er[i] + pw.x * xr - pw.y * xi); s5x[o0 + (size_t)i * 4096 + 64 + n] = (bf16_t)f2bf(ei[i] + pw.x * xi + pw.y * xr);
                pw = cmul(pw, a8);
            }
            if (sgm == 7) { out[O_REP + (b * 32 + g) * 64 + n] = yr + a256.x * xr - a256.y * xi; out[O_IMP + (b * 32 + g) * 64 + n] = yi + a256.x * xi + a256.y * xr; }
            __syncthreads();
        }
        for (int idx = gt; idx < 128 * 32 * 64; idx += NGT) {
            const int b = idx >> 11, g = (idx >> 6) & 31, n = idx & 63;
            const S5P p = s5_par(s5_lre, s5_lim, s5_logdt, g, n); const f32x2 a8 = s5_pow(p, 8);
            const float xr = st_re[idx], xi = st_im[idx];
            const size_t R = 2048 + b; const size_t o = (R * 32 + g) * 128;
            s5x[o + n] = (bf16_t)f2bf(xr); s5x[o + 64 + n] = (bf16_t)f2bf(xi);
            out[O_RES + idx] = a8.x * xr - a8.y * xi + s5e[o + n]; out[O_IMS + idx] = a8.x * xi + a8.y * xr + s5e[o + 64 + n];
        }
    }
    SEAM(5);

    PHASE(6) {
        REP_SYNC();
        PHASE_LOCALS;
        {
            float* zg = fl; float* bb = zg + 64 * 16; float* seg = bb + 64 * 65; float* vv = seg + 512; float* red = vv + 64 * 129;
            bf16_t* qq = (bf16_t*)(red + 512); bf16_t* kk = qq + 64 * 72; bf16_t* sc = kk + 64 * 72;
            const int fr = lane & 15, fq = lane >> 4;
            for (int unit = bx; unit < 1024; unit += G) {
                const int bh = unit >> 5, c = unit & 31, b = bh >> 2, h = bh & 3;
                const size_t r0 = (size_t)b * 2048 + c * 64;
                if (tid < 128) { const int t = tid >> 1, hf = tid & 1; const u32x4 w = *(const u32x4*)(Pb + (r0 + t) * NINP + PC_ZG + hf * 8);
                    float* z = zg + t * 16 + hf * 8; z[0] = bflo(w.x); z[1] = bfhi(w.x); z[2] = bflo(w.y); z[3] = bfhi(w.y); z[4] = bflo(w.z); z[5] = bfhi(w.z); z[6] = bflo(w.w); z[7] = bfhi(w.w); }
                const u32x4 kw = *(const u32x4*)(Pb + (r0 + (tid >> 3)) * NINP + PC_K + h * 64 + (tid & 7) * 8);
                const u32x4 qw = *(const u32x4*)(Pb + (r0 + (tid >> 3)) * NINP + PC_Q + h * 64 + (tid & 7) * 8);
#pragma unroll
                for (int i = 0; i < 2; ++i) { const int ch = tid + i * 512, t = ch >> 4, c8 = ch & 15; const u32x4 w = *(const u32x4*)(Pb + (r0 + t) * NINP + PC_V + h * 128 + c8 * 8);
                    float* z = vv + t * 129 + c8 * 8; z[0] = bflo(w.x); z[1] = bfhi(w.x); z[2] = bflo(w.y); z[3] = bfhi(w.y); z[4] = bflo(w.z); z[5] = bfhi(w.z); z[6] = bflo(w.w); z[7] = bfhi(w.w); }
                __syncthreads();
                gla_gate_cumsum<64>(zg, bb, seg, w_gate, b_gate, h, tid);
                {
                    const int t = tid >> 3, d0 = (tid & 7) * 8; const float* bt = bb + t * 65 + d0;
                    float eb[8];
#pragma unroll
                    for (int j = 0; j < 8; ++j) eb[j] = __expf(bt[j]);
                    u32x4 qo, ko;
                    qo.x = pk2(bflo(qw.x) * eb[0] * 0.125f, bfhi(qw.x) * eb[1] * 0.125f); qo.y = pk2(bflo(qw.y) * eb[2] * 0.125f, bfhi(qw.y) * eb[3] * 0.125f);
                    qo.z = pk2(bflo(qw.z) * eb[4] * 0.125f, bfhi(qw.z) * eb[5] * 0.125f); qo.w = pk2(bflo(qw.w) * eb[6] * 0.125f, bfhi(qw.w) * eb[7] * 0.125f);
#pragma unroll
                    for (int j = 0; j < 8; ++j) eb[j] = __builtin_amdgcn_rcpf(eb[j]);
                    ko.x = pk2(bflo(kw.x) * eb[0], bfhi(kw.x) * eb[1]); ko.y = pk2(bflo(kw.y) * eb[2], bfhi(kw.y) * eb[3]);
                    ko.z = pk2(bflo(kw.z) * eb[4], bfhi(kw.z) * eb[5]); ko.w = pk2(bflo(kw.w) * eb[6], bfhi(kw.w) * eb[7]);
                    *(u32x4*)(qq + t * 72 + d0) = qo; *(u32x4*)(kk + t * 72 + d0) = ko;
                }
                __syncthreads();
                {
                    const int tb = wave >> 1;
#pragma unroll
                    for (int i = 0; i < 2; ++i) {
                        const int sb = (wave & 1) * 2 + i;
                        f32x4 a = (f32x4){0.f, 0.f, 0.f, 0.f};
                        if (sb <= tb) {
#pragma unroll
                            for (int ks = 0; ks < 2; ++ks) { const bf16x8 af = *(const bf16x8*)(qq + (tb * 16 + fr) * 72 + ks * 32 + fq * 8), bf = *(const bf16x8*)(kk + (sb * 16 + fr) * 72 + ks * 32 + fq * 8);
                                a = __builtin_amdgcn_mfma_f32_16x16x32_bf16(af, bf, a, 0, 0, 0); }
                            if (sb == tb) {
#pragma unroll
                                for (int r = 0; r < 4; ++r) if (fr > fq * 4 + r) a[r] = 0.f;
                            }
                        }
#pragma unroll
                        for (int r = 0; r < 4; ++r) sc[(tb * 16 + fq * 4 + r) * 72 + sb * 16 + fr] = (bf16_t)f2bf(a[r]);
                    }
                }
                __syncthreads();
                {
                    bf16x8 bS[2], bV[2];
                    const float* sp = glaD + (size_t)unit * 8192 + (size_t)(wave * 16 + fr) * 64 + fq * 8;
#pragma unroll
                    for (int ks = 0; ks < 2; ++ks) {
                        const f32x4 x0 = *(const f32x4*)(sp + ks * 32), x1 = *(const f32x4*)(sp + ks * 32 + 4);
                        const u32x4 p = (u32x4){pk2(x0[0], x0[1]), pk2(x0[2], x0[3]), pk2(x1[0], x1[1]), pk2(x1[2], x1[3])}; bS[ks] = __builtin_bit_cast(bf16x8, p);
                        float av[8];
#pragma unroll
                        for (int j = 0; j < 8; ++j) av[j] = vv[(ks * 32 + fq * 8 + j) * 129 + wave * 16 + fr];
                        const u32x4 pv = (u32x4){pk2(av[0], av[1]), pk2(av[2], av[3]), pk2(av[4], av[5]), pk2(av[6], av[7])}; bV[ks] = __builtin_bit_cast(bf16x8, pv);
                    }
                    f32x4 oa[4];
#pragma unroll
                    for (int tb = 0; tb < 4; ++tb) {
                        oa[tb] = (f32x4){0.f, 0.f, 0.f, 0.f};
#pragma unroll
                        for (int ks = 0; ks < 2; ++ks) {
                            const bf16x8 aq = *(const bf16x8*)(qq + (tb * 16 + fr) * 72 + ks * 32 + fq * 8), as = *(const bf16x8*)(sc + (tb * 16 + fr) * 72 + ks * 32 + fq * 8);
                            oa[tb] = __builtin_amdgcn_mfma_f32_16x16x32_bf16(aq, bS[ks], oa[tb], 0, 0, 0);
                            oa[tb] = __builtin_amdgcn_mfma_f32_16x16x32_bf16(as, bV[ks], oa[tb], 0, 0, 0);
                        }
                    }
#pragma unroll
                    for (int tb = 0; tb < 4; ++tb)
#pragma unroll
                        for (int r = 0; r < 4; ++r) { float q2 = oa[tb][r] * oa[tb][r]; q2 += __shfl_xor(q2, 1); q2 += __shfl_xor(q2, 2); q2 += __shfl_xor(q2, 4); q2 += __shfl_xor(q2, 8);
                            if (fr == 0) red[(tb * 16 + fq * 4 + r) * 8 + wave] = q2; }
                    __syncthreads();
                    const float gcol = g_gla_out[wave * 16 + fr];
#pragma unroll
                    for (int tb = 0; tb < 4; ++tb)
#pragma unroll
                        for (int r = 0; r < 4; ++r) { const int t = tb * 16 + fq * 4 + r; const f32x4 s0 = *(const f32x4*)(red + t * 8), s1 = *(const f32x4*)(red + t * 8 + 4);
                            const float rs = rsqrtf((((s0[0] + s0[1]) + (s0[2] + s0[3])) + ((s1[0] + s1[1]) + (s1[2] + s1[3]))) * (1.f / 128.f) + EPS);
                            const float rv = bf2f(Pb[(r0 + t) * NINP + PC_R + h * 128 + wave * 16 + fr]);
                            mix[(r0 + t) * D + h * 128 + wave * 16 + fr] = (bf16_t)f2bf(oa[tb][r] * rs * gcol * siluf(rv)); }
                }
                __syncthreads();
            }
        }
        for (int it = gw; it < 136 * 32; it += NGW) {
            const int rb = it >> 5, g = it & 31, fr = lane & 15, fq = lane >> 4; const int R0 = rb * 16;
            f32x4 acc[8];
#pragma unroll
            for (int nb = 0; nb < 8; ++nb) acc[nb] = (f32x4){0.f, 0.f, 0.f, 0.f};
#pragma unroll 1
            for (int ks = 0; ks < 8; ++ks) {
                bf16x8 a;
                if (ks < 4) a = *(const bf16x8*)(s5x + ((size_t)(R0 + fr) * 32 + g) * 128 + ks * 32 + fq * 8);
                else a = *(const bf16x8*)(Pb + ((size_t)(R0 + fr) * 8 + (ks - 4) * 2 + (fq >> 1)) * NINP + PC_U + g * 16 + (fq & 1) * 8);
#pragma unroll
                for (int nb = 0; nb < 8; ++nb) { const bf16x8 bfr = *(const bf16x8*)(GTt + (size_t)(g * 128 + nb * 16 + fr) * 256 + ks * 32 + fq * 8);
                    acc[nb] = __builtin_amdgcn_mfma_f32_16x16x32_bf16(bfr, a, acc[nb], 0, 0, 0); }
            }
            bf16x4 wA;
#pragma unroll
            for (int i = 0; i < 4; ++i) wA[i] = (short)f2bf(s5_wglu[(g * 16 + fq * 4 + i) * 16 + fr]);
            const f32x4 dsk = *(const f32x4*)(s5_d + g * 16 + fq * 4), bgl = *(const f32x4*)(s5_bglu + g * 16 + fq * 4);
#pragma unroll
            for (int nb = 0; nb < 8; ++nb) {
                const size_t row = (size_t)(R0 + fr) * 8 + nb;
                const u32x2 uw = *(const u32x2*)(Pb + row * NINP + PC_U + g * 16 + fq * 4);
                f32x4 z;
                z[0] = gelu_tanh(acc[nb][0] + dsk[0] * bflo(uw.x)); z[1] = gelu_tanh(acc[nb][1] + dsk[1] * bfhi(uw.x));
                z[2] = gelu_tanh(acc[nb][2] + dsk[2] * bflo(uw.y)); z[3] = gelu_tanh(acc[nb][3] + dsk[3] * bfhi(uw.y));
                const u32x2 zp = (u32x2){pk2(z[0], z[1]), pk2(z[2], z[3])};
                const f32x4 pre = __builtin_amdgcn_mfma_f32_16x16x16bf16_1k(wA, __builtin_bit_cast(bf16x4, zp), bgl, 0, 0, 0);
                u32x2 o; o.x = pk2(z[0] * sigmoidf_fast(pre[0]), z[1] * sigmoidf_fast(pre[1])); o.y = pk2(z[2] * sigmoidf_fast(pre[2]), z[3] * sigmoidf_fast(pre[3]));
                *(u32x2*)(mix + row * D + 512 + g * 16 + fq * 4) = o;
            }
        }
    }
    SEAM(6);

    PHASE(7) {
        REP_SYNC();
        pg8::Gemm g{mix, Wout, MP, D, D}; pg8::StaticOrder S; S.init(MP, D, G, bx);
        pg8::EpiResid E{hres, hres + (size_t)MP * D, hres, hb, ssq + SSQ_H2, 1.f};
        pg8::gemm_phase<pg8::EpiResid, pg8::StaticOrder, true, true>(ldsl, g, S, E);
        SEpiResid SE{hres, hres, hb, ssq + SSQ_H2, 1.f};
        small_gemm(mix + (size_t)MP * D, Wout, D, fl, G, bx, wave, tid0, SE);
    }
    SEAM(7);
    PHASE(8) {
        REP_SYNC();
        pg8::Gemm g{hb, Wcq, MP, D, D}; pg8::StaticOrder S; S.init(MP, D, G, bx);
        pg8::EpiScaleBf16 E{qb, D, ssq + SSQ_H2, 0.0625f};
        pg8::gemm_phase<pg8::EpiScaleBf16, pg8::StaticOrder, true, true>(ldsl, g, S, E);
        SEpiScaleBf16 SE{qb, ssq + SSQ_H2, 0.0625f};
        small_gemm(hb + (size_t)MP * D, Wcq, D, fl, G, bx, wave, tid0, SE);
    }
    SEAM(8);

    PHASE(9) {
        REP_SYNC();
        PHASE_LOCALS;
        constexpr int QS = 264;
        bf16_t* Qs = (bf16_t*)lds; bf16_t* Ps = Qs + 64 * QS; float* redmax = (float*)(Ps + 64 * QS); float* redsum = redmax + 64 * 8;
        const int fr = lane & 15, fq = lane >> 4, w = wave;
        for (int unit = bx; unit < 1024 + 512; unit += G) {
            const bool smp = unit >= 1024;
            int b, h; size_t r0; int nrows;
            if (!smp) { const int qt = unit & 31; h = (unit >> 5) & 3; b = unit >> 7; r0 = (size_t)b * 2048 + qt * 64; nrows = 64; }
            else { const int u2 = unit - 1024; h = u2 & 3; b = u2 >> 2; r0 = (size_t)MP + b * 8; nrows = 8; }
            const int MB = smp ? 1 : 4;
            for (int ch = tid; ch < MB * 16 * 32; ch += NTHREADS) { const int row = ch >> 5, c8 = ch & 31; u32x4 v = (u32x4){0u, 0u, 0u, 0u};
                if (row < nrows) v = *(const u32x4*)(qb + (r0 + row) * D + h * 256 + c8 * 8);
                *(u32x4*)(Qs + row * QS + c8 * 8) = v; }
            __syncthreads();
            f32x4 sa[4][2];
#pragma unroll
            for (int mb = 0; mb < 4; ++mb) { sa[mb][0] = (f32x4){0.f, 0.f, 0.f, 0.f}; sa[mb][1] = sa[mb][0]; }
            if (!smp) {
                const bf16_t* kbase = kb + ((size_t)b * 256 + w * 32 + fr) * D + h * 256 + fq * 8;
#pragma unroll
                for (int ks = 0; ks < 8; ++ks) {
                    const bf16x8 b0 = *(const bf16x8*)(kbase + ks * 32), b1 = *(const bf16x8*)(kbase + (size_t)16 * D + ks * 32);
#pragma unroll
                    for (int mb = 0; mb < 4; ++mb) { const bf16x8 a = *(const bf16x8*)(Qs + (mb * 16 + fr) * QS + ks * 32 + fq * 8);
                        sa[mb][0] = __builtin_amdgcn_mfma_f32_16x16x32_bf16(a, b0, sa[mb][0], 0, 0, 0); sa[mb][1] = __builtin_amdgcn_mfma_f32_16x16x32_bf16(a, b1, sa[mb][1], 0, 0, 0); }
                }
            } else {
                const float* kbase = cache_k + ((size_t)b * 256 + w * 32 + fr) * D + h * 256 + fq * 8;
#pragma unroll
                for (int ks = 0; ks < 8; ++ks) {
                    u32x4 p0, p1;
                    { const f32x4 x0 = *(const f32x4*)(kbase + ks * 32), x1 = *(const f32x4*)(kbase + ks * 32 + 4); p0 = (u32x4){pk2(x0[0], x0[1]), pk2(x0[2], x0[3]), pk2(x1[0], x1[1]), pk2(x1[2], x1[3])}; }
                    { const f32x4 x0 = *(const f32x4*)(kbase + (size_t)16 * D + ks * 32), x1 = *(const f32x4*)(kbase + (size_t)16 * D + ks * 32 + 4); p1 = (u32x4){pk2(x0[0], x0[1]), pk2(x0[2], x0[3]), pk2(x1[0], x1[1]), pk2(x1[2], x1[3])}; }
                    const bf16x8 a = *(const bf16x8*)(Qs + fr * QS + ks * 32 + fq * 8);
                    sa[0][0] = __builtin_amdgcn_mfma_f32_16x16x32_bf16(a, __builtin_bit_cast(bf16x8, p0), sa[0][0], 0, 0, 0);
                    sa[0][1] = __builtin_amdgcn_mfma_f32_16x16x32_bf16(a, __builtin_bit_cast(bf16x8, p1), sa[0][1], 0, 0, 0);
                }
            }
#pragma unroll
            for (int mb = 0; mb < 4; ++mb) if (mb < MB) {
#pragma unroll
                for (int r = 0; r < 4; ++r) { float mx = fmaxf(sa[mb][0][r], sa[mb][1][r]);
                    mx = fmaxf(mx, __shfl_xor(mx, 1)); mx = fmaxf(mx, __shfl_xor(mx, 2)); mx = fmaxf(mx, __shfl_xor(mx, 4)); mx = fmaxf(mx, __shfl_xor(mx, 8));
                    if (fr == 0) redmax[(mb * 16 + fq * 4 + r) * 8 + w] = mx; }
            }
            __syncthreads();
#pragma unroll
            for (int mb = 0; mb < 4; ++mb) if (mb < MB) {
#pragma unroll
                for (int r = 0; r < 4; ++r) { const int q = mb * 16 + fq * 4 + r; const f32x4 m0 = *(const f32x4*)(redmax + q * 8), m1 = *(const f32x4*)(redmax + q * 8 + 4);
                    const float mx = fmaxf(fmaxf(fmaxf(m0[0], m0[1]), fmaxf(m0[2], m0[3])), fmaxf(fmaxf(m1[0], m1[1]), fmaxf(m1[2], m1[3])));
                    const float p0 = __expf(sa[mb][0][r] - mx), p1 = __expf(sa[mb][1][r] - mx);
                    Ps[q * QS + w * 32 + fr] = (bf16_t)f2bf(p0); Ps[q * QS + w * 32 + 16 + fr] = (bf16_t)f2bf(p1);
                    float sm = p0 + p1; sm += __shfl_xor(sm, 1); sm += __shfl_xor(sm, 2); sm += __shfl_xor(sm, 4); sm += __shfl_xor(sm, 8);
                    if (fr == 0) redsum[q * 8 + w] = sm; }
            }
            __syncthreads();
            f32x4 oa[4][2];
#pragma unroll
            for (int mb = 0; mb < 4; ++mb) { oa[mb][0] = (f32x4){0.f, 0.f, 0.f, 0.f}; oa[mb][1] = oa[mb][0]; }
            if (!smp) {
                const bf16_t* vbase = vbT + ((size_t)b * D + h * 256 + w * 32 + fr) * 256 + fq * 8;
#pragma unroll
                for (int ks = 0; ks < 8; ++ks) {
                    const bf16x8 b0 = *(const bf16x8*)(vbase + ks * 32), b1 = *(const bf16x8*)(vbase + 16 * 256 + ks * 32);
#pragma unroll
                    for (int mb = 0; mb < 4; ++mb) { const bf16x8 a = *(const bf16x8*)(Ps + (mb * 16 + fr) * QS + ks * 32 + fq * 8);
                        oa[mb][0] = __builtin_amdgcn_mfma_f32_16x16x32_bf16(a, b0, oa[mb][0], 0, 0, 0); oa[mb][1] = __builtin_amdgcn_mfma_f32_16x16x32_bf16(a, b1, oa[mb][1], 0, 0, 0); }
                }
            } else {
                const float* vbase = cache_v + ((size_t)b * 256 + fq * 8) * D + h * 256 + w * 32 + fr;
#pragma unroll
                for (int ks = 0; ks < 8; ++ks) {
                    float x0[8], x1[8];
#pragma unroll
                    for (int j = 0; j < 8; ++j) { x0[j] = vbase[(size_t)(ks * 32 + j) * D]; x1[j] = vbase[(size_t)(ks * 32 + j) * D + 16]; }
                    const u32x4 p0 = (u32x4){pk2(x0[0], x0[1]), pk2(x0[2], x0[3]), pk2(x0[4], x0[5]), pk2(x0[6], x0[7])};
                    const u32x4 p1 = (u32x4){pk2(x1[0], x1[1]), pk2(x1[2], x1[3]), pk2(x1[4], x1[5]), pk2(x1[6], x1[7])};
                    const bf16x8 a = *(const bf16x8*)(Ps + fr * QS + ks * 32 + fq * 8);
                    oa[0][0] = __builtin_amdgcn_mfma_f32_16x16x32_bf16(a, __builtin_bit_cast(bf16x8, p0), oa[0][0], 0, 0, 0);
                    oa[0][1] = __builtin_amdgcn_mfma_f32_16x16x32_bf16(a, __builtin_bit_cast(bf16x8, p1), oa[0][1], 0, 0, 0);
                }
            }
#pragma unroll
            for (int mb = 0; mb < 4; ++mb) if (mb < MB) {
#pragma unroll
                for (int r = 0; r < 4; ++r) { const int q = mb * 16 + fq * 4 + r; if (q < nrows) {
                    const f32x4 s0 = *(const f32x4*)(redsum + q * 8), s1 = *(const f32x4*)(redsum + q * 8 + 4);
                    const float inv = 1.f / (((s0[0] + s0[1]) + (s0[2] + s0[3])) + ((s1[0] + s1[1]) + (s1[2] + s1[3])));
                    bf16_t* op = ob + (r0 + q) * D + h * 256 + w * 32 + fr;
                    op[0] = (bf16_t)f2bf(oa[mb][0][r] * inv); op[16] = (bf16_t)f2bf(oa[mb][1][r] * inv); } }
            }
            __syncthreads();
        }
    }
    SEAM(9);

    PHASE(10) {
        REP_SYNC();
        pg8::Gemm g{ob, Wco, MP, D, D}; pg8::StaticOrder S; S.init(MP, D, G, bx);
        pg8::EpiResid E{hres, hres + (size_t)MP * D, hres, hb, ssq + SSQ_H3, 1.f};
        pg8::gemm_phase<pg8::EpiResid, pg8::StaticOrder, true, true>(ldsl, g, S, E);
        SEpiResid SE{hres, hres, hb, ssq + SSQ_H3, 1.f};
        small_gemm(ob + (size_t)MP * D, Wco, D, fl, G, bx, wave, tid0, SE);
    }
    SEAM(10);
    PHASE(11) {
        REP_SYNC();
        pg8::Gemm g{hb, Wgu2, M, NGU, D}; pg8::StaticOrder S; S.init(M, NGU, G, bx);
        pg8::EpiSwiGLU E{act, FF, ssq + SSQ_H3};
        pg8::gemm_phase<pg8::EpiSwiGLU, pg8::StaticOrder, true, true>(ldsl, g, S, E);
    }
    SEAM(11);
    PHASE(12) {
        REP_SYNC();
        pg8::Gemm g{act, Wd2, MP, D, FF}; pg8::StaticOrder S; S.init(MP, D, G, bx);
        pg8::EpiResid E{hres, hres + (size_t)MP * D, out + O_Y, nullptr, nullptr, 0.5f};
        pg8::gemm_phase<pg8::EpiResid, pg8::StaticOrder, true, true>(ldsl, g, S, E);
        SEpiResid SE{hres, out + O_Y, nullptr, nullptr, 0.5f};
        small_gemm(act + (size_t)MP * FF, Wd2, FF, fl, G, bx, wave, tid0, SE);
    }
    SEAM(12);
    PHASE(13) {
        REP_SYNC();
        PHASE_LOCALS;
        for (int m = gw; m < M; m += NGW) {
            f32x4* yr = (f32x4*)(out + O_Y + (size_t)m * D) + lane; f32x4 v[4]; float s = 0.f;
#pragma unroll
            for (int j = 0; j < 4; ++j) { v[j] = yr[64 * j]; s += (v[j].x * v[j].x + v[j].y * v[j].y) + (v[j].z * v[j].z + v[j].w * v[j].w); }
            const float rs = rsqrtf(wave_sum(s) * (1.f / D) + EPS);
#pragma unroll
            for (int j = 0; j < 4; ++j) { const f32x4 gq = ((const f32x4*)g_final)[lane + 64 * j]; yr[64 * j] = v[j] * rs * gq; }
        }
    }
#undef IN
#undef SEAM
}

extern "C" void kernel_launch(void* const* d_in, const int* in_sizes, int n_in, void* d_out, int out_size, void* d_ws, size_t ws_size, hipStream_t stream) {
    static int grid = 0;
    if (grid == 0) {
        if (n_in != 36 || (size_t)out_size != O_TOTAL || ws_size < WS_END) { fprintf(stderr, "kernel_launch: unexpected shapes (n_in %d, out %d, ws %zu)\n", n_in, out_size, ws_size); grid = -1; return; }
        int dev = 0, cus = 0, per_cu = 0;
        hipGetDevice(&dev); hipDeviceGetAttribute(&cus, hipDeviceAttributeMultiprocessorCount, dev);
        hipFuncSetAttribute((const void*)hymba_fwd, hipFuncAttributeMaxDynamicSharedMemorySize, LDS_BYTES);
        hipOccupancyMaxActiveBlocksPerMultiprocessor(&per_cu, (const void*)hymba_fwd, NTHREADS, LDS_BYTES);
        if (per_cu < 1) { fprintf(stderr, "kernel_launch: occupancy query says %d blocks per CU\n", per_cu); per_cu = 1; }
        grid = cus;
        (void)hipGetLastError();
    }
    if (grid < 0) return;
    if (hipMemsetAsync((char*)d_ws + WS_BAR, 0, BAR_BYTES, stream) != hipSuccess) { fprintf(stderr, "kernel_launch: memset failed\n"); return; }
    Args a{};
    for (int i = 0; i < 36; ++i) a.in[i] = (const float*)d_in[i];
    a.out = (float*)d_out; a.ws = (unsigned char*)d_ws; a.ph_lo = 0; a.ph_hi = 14;
    void* params[] = {&a};
    hipError_t e = hipLaunchCooperativeKernel((const void*)hymba_fwd, dim3(grid), dim3(NTHREADS), params, LDS_BYTES, stream);
    if (e != hipSuccess) fprintf(stderr, "kernel_launch: cooperative launch failed: %s (grid %d)\n", hipGetErrorString(e), grid);
}
```

```cpp
#include <hip/hip_runtime.h>
#include <hip/hip_cooperative_groups.h>
#include <cstdio>
#include <cstdint>
namespace cg = cooperative_groups;

constexpr int D = 1024, MP = 16384, MS = 1024, M = MP + MS, FF = 2816, NGU = 2 * FF, NIN = 2064, NINP = 2304;
constexpr int MEMR = 2048;
constexpr float EPS = 1e-6f;
constexpr int PC_Q = 0, PC_K = 256, PC_V = 512, PC_R = 1024, PC_U = 1536, PC_ZG = 2048;
constexpr size_t O_Y = 0, O_GLAP = 17825792, O_REP = 18087936, O_IMP = 18104320, O_MKP = 18120704, O_MVP = 20217856,
                 O_GLAS = 22315008, O_RES = 26509312, O_IMS = 26771456, O_TOTAL = 27033600;
constexpr size_t MiB = 1u << 20;
constexpr int XCD_BAR_WORDS_C = 3456;
constexpr size_t WS_SSQ = 0;
constexpr size_t WS_WGU1 = 1 * MiB, WS_WD1 = 12 * MiB, WS_WIN = 18 * MiB, WS_WOUT = 23 * MiB, WS_WCQ = 25 * MiB, WS_WCKV = 27 * MiB,
                 WS_WCO = 31 * MiB, WS_WGU2 = 33 * MiB, WS_WD2 = 44 * MiB, WS_EGT = 50 * MiB, WS_GTT = 51 * MiB, WS_MEMB = 53 * MiB,
                 WS_KB = 57 * MiB, WS_VBT = 61 * MiB, WS_XB = 65 * MiB, WS_HB = 99 * MiB, WS_H = 133 * MiB, WS_ACT = 201 * MiB,
                 WS_MIX = 295 * MiB, WS_Q = 329 * MiB, WS_O = 363 * MiB, WS_GLAD = 397 * MiB, WS_GLADEC = 429 * MiB, WS_S5E = 430 * MiB,
                 WS_S5X = 464 * MiB, WS_END = 481 * MiB;
constexpr int SSQ_X = 0, SSQ_MEM = M, SSQ_H1 = M + 2048, SSQ_H2 = 2 * M + 2048, SSQ_H3 = 3 * M + 2048, SSQ_WORDS = 4 * M + 2048;
static_assert((size_t)SSQ_WORDS * 4 <= MiB, "ssq region");
static_assert(WS_XB + (size_t)1024 * 8192 * 4 <= WS_HB, "glaS over xb");
static_assert(WS_ACT + (size_t)M * FF * 2 <= WS_MIX && WS_ACT + (size_t)M * NINP * 2 <= WS_MIX, "act / P region");

constexpr size_t WS_BAR = 512 * 1024, BAR_BYTES = 16384;
static_assert((size_t)SSQ_WORDS * 4 <= WS_BAR && XCD_BAR_WORDS_C * 4 <= BAR_BYTES, "ctl map");
constexpr int NWAVES = 8, NTHREADS = 512;
constexpr int LDS_BYTES = 147456;
constexpr int LDS_BARST = LDS_BYTES - 64;

#define LAS __attribute__((address_space(3)))
typedef unsigned short bf16_t;
typedef short bf16x8 __attribute__((ext_vector_type(8)));
typedef short bf16x4 __attribute__((ext_vector_type(4)));
typedef float f32x4 __attribute__((ext_vector_type(4)));
typedef float f32x2 __attribute__((ext_vector_type(2)));
typedef unsigned u32x4 __attribute__((ext_vector_type(4)));
typedef unsigned u32x2 __attribute__((ext_vector_type(2)));
#define DI __device__ __forceinline__

DI unsigned f2bf(float f) { unsigned u = __builtin_bit_cast(unsigned, f); return (u + 0x7fffu + ((u >> 16) & 1u)) >> 16; }
DI unsigned pk2(float lo, float hi) { return f2bf(lo) | (f2bf(hi) << 16); }
DI float bf2f(unsigned b) { return __builtin_bit_cast(float, b << 16); }
DI float bflo(unsigned w) { return __builtin_bit_cast(float, w << 16); }
DI float bfhi(unsigned w) { return __builtin_bit_cast(float, w & 0xffff0000u); }
DI float wave_sum(float v) {
#pragma unroll
    for (int o = 1; o < 64; o <<= 1) v += __shfl_xor(v, o);
    return v;
}
DI float sigmoidf_fast(float x) { return __builtin_amdgcn_rcpf(1.f + __expf(-x)); }
DI float siluf(float x) { return x * sigmoidf_fast(x); }
DI float logsigmoidf(float x) { return fminf(x, 0.f) - log1pf(__expf(-fabsf(x))); }
DI float gelu_tanh(float y) { const float a = 0.7978845608028654f * (y + 0.044715f * y * y * y); const float e = __expf(2.f * a); const float th = 1.f - 2.f * __builtin_amdgcn_rcpf(e + 1.f); return 0.5f * y * (1.f + th); }

namespace pg8 {
#define PG8_LAS __attribute__((address_space(3)))
constexpr int BM = 256, BK = 64, HALF = 128, HTB = HALF * BK * 2  , STAGE_BYTES = 8 * HTB, NXCD = 8, WGM = 8;

__host__ __device__ __forceinline__ int lds_byte(int r, int c) { const int st = (r >> 4) * 2 + (c >> 5), rr = r & 15, cc = c & 31, ob = rr * 64 + cc * 2; return st * 1024 + (ob ^ (((ob >> 9) & 1) << 5)); }
__host__ __device__ __forceinline__ void stage_rc(int b, int& R, int& C) { const int st = b / 1024, sb = b % 1024, swz = sb ^ (((sb >> 9) & 1) << 5); R = (st >> 1) * 16 + swz / 64; C = (st & 1) * 32 + (swz % 64) / 2; }
__host__ __device__ __forceinline__ int perm32(int rho) { const int n = rho >> 4, i = rho & 15; return 8 * (i >> 2) + 4 * n + (i & 3); }

struct Unit { int pm, pn; };
struct Gemm { const bf16_t* A; const bf16_t* Bt; int M, N, K; };

struct StaticOrder {
    int nM, nN, nwg, G, c, rep;
    __host__ __device__ void init(int M_, int N_, int G_, int c_, int rep_ = 1) { nM = M_ / BM; nN = N_ / BM; nwg = nM * nN; G = G_; c = c_; rep = rep_; }
    __host__ __device__ bool next(int i, Unit& u) const {
        const long L = (long)i * G + c; if (L >= (long)nwg * rep) return false;
        int wgid = (int)(L % nwg); { const int q = nwg / NXCD, r = nwg % NXCD, xcd = wgid % NXCD, off = wgid / NXCD; wgid = (xcd < r ? xcd * (q + 1) : r * (q + 1) + (xcd - r) * q) + off; }
        const int nig = WGM * nN, gid = wgid / nig, fm = gid * WGM, gsz = (nM - fm) < WGM ? (nM - fm) : WGM;
        u.pm = fm + ((wgid % nig) % gsz); u.pn = (wgid % nig) / gsz; return true;
    }
    __device__ __forceinline__ void a_ready(const Unit&) const {}
    __device__ __forceinline__ void done(const Unit&) const {}
};

__device__ __forceinline__ unsigned cvt_pk_bf16(float lo, float hi) { unsigned r; asm volatile("v_cvt_pk_bf16_f32 %0, %1, %2" : "=v"(r) : "v"(lo), "v"(hi)); return r; }


struct EpiSwiGLU {
    static constexpr bool PERM = true, AFTER_DRAIN = false;
    bf16_t* O; int ldc; const float* ssq;
    __device__ __forceinline__ void operator()(const f32x4 (&acc)[2][2][4][2], const Unit& u, int wr, int wc, int fr, int fq) const {
        const int row0 = u.pm * BM + wr * 64 + fr, col0 = u.pn * HALF + wc * 32 + 8 * fq;
#pragma unroll
        for (int ai = 0; ai < 2; ++ai)
#pragma unroll
            for (int m = 0; m < 4; ++m) {
                const int row = row0 + ai * HALF + m * 16;
                const float rs = rsqrtf(ssq[row] * (1.f / D) + EPS);
                const f32x4 g0 = acc[ai][0][m][0] * rs, g1 = acc[ai][0][m][1] * rs, u0 = acc[ai][1][m][0] * rs, u1 = acc[ai][1][m][1] * rs;
                u32x4 w;
                w.x = cvt_pk_bf16(siluf(g0[0]) * u0[0], siluf(g0[1]) * u0[1]); w.y = cvt_pk_bf16(siluf(g0[2]) * u0[2], siluf(g0[3]) * u0[3]);
                w.z = cvt_pk_bf16(siluf(g1[0]) * u1[0], siluf(g1[1]) * u1[1]); w.w = cvt_pk_bf16(siluf(g1[2]) * u1[2], siluf(g1[3]) * u1[3]);
                *(u32x4*)(O + (size_t)row * ldc + col0) = w;
            }
    }
};
template <bool OUT_F32> struct EpiResid {
    static constexpr bool PERM = true, AFTER_DRAIN = false;
    const bf16_t* base; bf16_t* hbo; float* outf; float* ssq; float alpha;
    __device__ __forceinline__ void operator()(const f32x4 (&acc)[2][2][4][2], const Unit& u, int wr, int wc, int fr, int fq) const {
        const int row0 = u.pm * BM + wr * 64 + fr, col0 = u.pn * BM + wc * 32 + 8 * fq;
#pragma unroll
        for (int ai = 0; ai < 2; ++ai)
#pragma unroll
            for (int m = 0; m < 4; ++m) {
                const int row = row0 + ai * HALF + m * 16;
                float s = 0.f;
#pragma unroll
                for (int bj = 0; bj < 2; ++bj) {
                    const int c = col0 + bj * HALF;
                    const u32x4 bw = *(const u32x4*)(base + (size_t)row * D + c);
                    f32x4 v0 = acc[ai][bj][m][0] * alpha, v1 = acc[ai][bj][m][1] * alpha;
                    v0[0] += bflo(bw.x); v0[1] += bfhi(bw.x); v0[2] += bflo(bw.y); v0[3] += bfhi(bw.y); v1[0] += bflo(bw.z); v1[1] += bfhi(bw.z); v1[2] += bflo(bw.w); v1[3] += bfhi(bw.w);
                    if constexpr (OUT_F32) { *(f32x4*)(outf + (size_t)row * D + c) = v0; *(f32x4*)(outf + (size_t)row * D + c + 4) = v1; }
                    else {
                        s += ((v0[0] * v0[0] + v0[1] * v0[1]) + (v0[2] * v0[2] + v0[3] * v0[3])) + ((v1[0] * v1[0] + v1[1] * v1[1]) + (v1[2] * v1[2] + v1[3] * v1[3]));
                        u32x4 w; w.x = cvt_pk_bf16(v0[0], v0[1]); w.y = cvt_pk_bf16(v0[2], v0[3]); w.z = cvt_pk_bf16(v1[0], v1[1]); w.w = cvt_pk_bf16(v1[2], v1[3]);
                        *(u32x4*)(hbo + (size_t)row * D + c) = w;
                    }
                }
                if constexpr (!OUT_F32) { s += __shfl_xor(s, 16); s += __shfl_xor(s, 32); if (fq == 0) atomicAdd(ssq + row, s); }
            }
    }
};
struct EpiScaleBf16 {
    static constexpr bool PERM = true, AFTER_DRAIN = false;
    bf16_t* O; int ldc; const float* ssq; float scale;
    __device__ __forceinline__ void operator()(const f32x4 (&acc)[2][2][4][2], const Unit& u, int wr, int wc, int fr, int fq) const {
        const int row0 = u.pm * BM + wr * 64 + fr, col0 = u.pn * BM + wc * 32 + 8 * fq;
#pragma unroll
        for (int ai = 0; ai < 2; ++ai)
#pragma unroll
            for (int m = 0; m < 4; ++m) {
                const int row = row0 + ai * HALF + m * 16;
                const float rs = rsqrtf(ssq[row] * (1.f / D) + EPS) * scale;
#pragma unroll
                for (int bj = 0; bj < 2; ++bj) {
                    const f32x4 v0 = acc[ai][bj][m][0] * rs, v1 = acc[ai][bj][m][1] * rs;
                    u32x4 w; w.x = cvt_pk_bf16(v0[0], v0[1]); w.y = cvt_pk_bf16(v0[2], v0[3]); w.z = cvt_pk_bf16(v1[0], v1[1]); w.w = cvt_pk_bf16(v1[2], v1[3]);
                    *(u32x4*)(O + (size_t)row * ldc + col0 + bj * HALF) = w;
                }
            }
    }
};
struct EpiMemKV {
    static constexpr bool PERM = false, AFTER_DRAIN = false;
    float* outK; float* outV; bf16_t* kb; bf16_t* vbT; const float* ssq;
    __device__ __forceinline__ void operator()(const f32x4 (&acc)[2][2][4][2], const Unit& u, int wr, int wc, int fr, int fq) const {
        const int row0 = u.pm * BM + wr * 64 + fr; const bool isV = u.pn >= 4; const int col0 = (u.pn & 3) * BM + wc * 32 + 4 * fq;
        float* outp = isV ? outV : outK;
#pragma unroll
        for (int ai = 0; ai < 2; ++ai)
#pragma unroll
            for (int m = 0; m < 4; ++m) {
                const int row = row0 + ai * HALF + m * 16;
                const float rs = rsqrtf(ssq[row] * (1.f / D) + EPS);
                const int b = row >> 8, key = row & 255;
#pragma unroll
                for (int bj = 0; bj < 2; ++bj)
#pragma unroll
                    for (int n = 0; n < 2; ++n) {
                        const int c = col0 + bj * HALF + n * 16;
                        const f32x4 v = acc[ai][bj][m][n] * rs;
                        *(f32x4*)(outp + (size_t)row * D + c) = v;
                        if (!isV) { u32x2 w; w.x = cvt_pk_bf16(v[0], v[1]); w.y = cvt_pk_bf16(v[2], v[3]); *(u32x2*)(kb + (size_t)row * D + c) = w; }
                        else {
#pragma unroll
                            for (int i = 0; i < 4; ++i) vbT[((size_t)b * D + c + i) * 256 + key] = (bf16_t)f2bf(v[i]);
                        }
                    }
            }
    }
};

template <class Epi, class Sched, bool ALIGN_EPI = false, bool SP2 = false>
__device__ __forceinline__ void gemm_phase(PG8_LAS unsigned char* lds, const Gemm g, const Sched& S, const Epi& E) {
    const int tid = threadIdx.x, wid = __builtin_amdgcn_readfirstlane(tid >> 6), lane = tid & 63, wr = wid >> 2, wc = wid & 3, fr = lane & 15, fq = lane >> 4;
    const int K = g.K, nt = K / BK;
    unsigned voffA[2], voffB[2];
#pragma unroll
    for (int i = 0; i < 2; ++i) { int R, C; stage_rc(tid * 16 + i * 8192, R, C); const int Rb = Epi::PERM ? ((R & ~31) + perm32(R & 31)) : R;
        voffA[i] = (unsigned)(R * K + C) * 2u; voffB[i] = (unsigned)(Rb * K + C) * 2u; }
    const size_t kstep = (size_t)(BK * 2);
    const size_t hstep = (size_t)HALF * K * 2;
    const size_t tstep = 2 * hstep;
    const unsigned ldsw = (unsigned)wid * 1024u;
    const int aoff = lds_byte(wr * 64 + fr, fq * 8), boff = lds_byte(wc * 32 + fr, fq * 8);
#define PG8_SA(b, h) (((b) * 2 + (h)) * HTB)
#define PG8_SB(b, h) ((4 + (b) * 2 + (h)) * HTB)
#define PG8_STAGE(bufoff, gbase, voff) do { _Pragma("unroll") for (int _i = 0; _i < 2; ++_i) \
        __builtin_amdgcn_global_load_lds((const unsigned*)((const char*)(gbase) + (voff)[_i]), (PG8_LAS unsigned*)(lds + (bufoff) + ldsw + _i * 8192), 16, 0, 0); } while (0)
#define PG8_LDA(dst, b, h) do { _Pragma("unroll") for (int m = 0; m < 4; ++m) _Pragma("unroll") for (int k = 0; k < 2; ++k) dst[m][k] = *(const PG8_LAS bf16x8*)(lds + PG8_SA(b, h) + aoff + m * 2048 + k * 1024); } while (0)
#define PG8_LDB(dst, b, h) do { _Pragma("unroll") for (int n = 0; n < 2; ++n) _Pragma("unroll") for (int k = 0; k < 2; ++k) dst[n][k] = *(const PG8_LAS bf16x8*)(lds + PG8_SB(b, h) + boff + n * 2048 + k * 1024); } while (0)
#define PG8_MMA(ai, bj, At, Bt) do { __builtin_amdgcn_s_setprio(1); _Pragma("unroll") for (int m = 0; m < 4; ++m) _Pragma("unroll") for (int n = 0; n < 2; ++n) _Pragma("unroll") for (int k = 0; k < 2; ++k) \
        acc[ai][bj][m][n] = __builtin_amdgcn_mfma_f32_16x16x32_bf16(Bt[n][k], At[m][k], acc[ai][bj][m][n], 0, 0, 0); __builtin_amdgcn_s_setprio(0); } while (0)
#define PG8_WAIT_V(n) asm volatile("s_waitcnt vmcnt(" #n ")" ::: "memory")
#define PG8_WAIT_L(n) asm volatile("s_waitcnt lgkmcnt(" #n ")" ::: "memory")
#define PG8_BAR __builtin_amdgcn_s_barrier()
#define PG8_SCHED __builtin_amdgcn_sched_barrier(0)
    Unit cur, nxt; int ui = 0;
    if (!S.next(0, cur)) return;
    f32x4 acc[2][2][4][2];
#pragma unroll
    for (int a = 0; a < 2; ++a)
#pragma unroll
        for (int b = 0; b < 2; ++b)
#pragma unroll
            for (int m = 0; m < 4; ++m)
#pragma unroll
                for (int n = 0; n < 2; ++n) acc[a][b][m][n] = (f32x4){0.f, 0.f, 0.f, 0.f};
    bf16x8 At[4][2], B0[2][2], B1[2][2];
    const char* cA = (const char*)g.A + (size_t)cur.pm * tstep; const char* cB = (const char*)g.Bt + (size_t)cur.pn * tstep;
    S.a_ready(cur);
    if constexpr (SP2) {
        PG8_STAGE(PG8_SB(0, 0), cB, voffB); PG8_STAGE(PG8_SB(0, 1), cB + hstep, voffB); PG8_STAGE(PG8_SA(0, 0), cA, voffA); PG8_STAGE(PG8_SA(0, 1), cA + hstep, voffA);
        if (wr == 1) PG8_BAR;
        PG8_WAIT_V(2); PG8_BAR;
        PG8_STAGE(PG8_SB(1, 0), cB + kstep, voffB); PG8_STAGE(PG8_SA(1, 0), cA + kstep, voffA); PG8_STAGE(PG8_SB(1, 1), cB + hstep + kstep, voffB);
        PG8_WAIT_V(6); PG8_BAR;
    } else {
        PG8_STAGE(PG8_SB(0, 0), cB, voffB); PG8_STAGE(PG8_SA(0, 0), cA, voffA); PG8_STAGE(PG8_SB(0, 1), cB + hstep, voffB); PG8_STAGE(PG8_SA(0, 1), cA + hstep, voffA);
        if (wr == 1) PG8_BAR;
        PG8_WAIT_V(4); PG8_BAR;
        PG8_STAGE(PG8_SB(1, 0), cB + kstep, voffB); PG8_STAGE(PG8_SA(1, 0), cA + kstep, voffA); PG8_STAGE(PG8_SB(1, 1), cB + hstep + kstep, voffB);
        PG8_WAIT_V(6); PG8_BAR;
    }
    for (;;) {
        const bool has_next = S.next(ui + 1, nxt);
        const char* nA = has_next ? (const char*)g.A + (size_t)nxt.pm * tstep : cA; const char* nB = has_next ? (const char*)g.Bt + (size_t)nxt.pn * tstep : cB;
        for (int t = 0; t < nt; t += 2) {
            const bool last = (t == nt - 2);
            const char* a1 = cA + (size_t)(t + 1) * kstep;
            const char* a2 = last ? nA : cA + (size_t)(t + 2) * kstep; const char* b2 = last ? nB : cB + (size_t)(t + 2) * kstep;
            const char* a3 = a2 + kstep; const char* b3 = b2 + kstep;
            if (last && has_next) S.a_ready(nxt);
            if constexpr (SP2) {
            PG8_LDB(B0, 0, 0); PG8_LDB(B1, 0, 1); PG8_SCHED; PG8_LDA(At, 0, 0); PG8_STAGE(PG8_SA(1, 1), a1 + hstep, voffA);
            PG8_WAIT_V(8); PG8_WAIT_L(0); PG8_BAR; PG8_MMA(0, 0, At, B0); PG8_MMA(0, 1, At, B1); PG8_BAR; PG8_SCHED;
            PG8_LDA(At, 0, 1); PG8_STAGE(PG8_SB(0, 0), b2, voffB); PG8_STAGE(PG8_SB(0, 1), b2 + hstep, voffB); PG8_STAGE(PG8_SA(0, 0), a2, voffA);
            PG8_WAIT_V(8); PG8_WAIT_L(0); PG8_BAR; PG8_MMA(1, 0, At, B0); PG8_MMA(1, 1, At, B1); PG8_BAR; PG8_SCHED;
            PG8_LDB(B0, 1, 0); PG8_LDB(B1, 1, 1); PG8_SCHED; PG8_LDA(At, 1, 0); PG8_STAGE(PG8_SA(0, 1), a2 + hstep, voffA);
            PG8_WAIT_V(8); PG8_WAIT_L(0); PG8_BAR; PG8_MMA(0, 0, At, B0); PG8_MMA(0, 1, At, B1); PG8_BAR; PG8_SCHED;
            PG8_LDA(At, 1, 1); PG8_STAGE(PG8_SB(1, 0), b3, voffB); PG8_STAGE(PG8_SB(1, 1), b3 + hstep, voffB); PG8_STAGE(PG8_SA(1, 0), a3, voffA);
            PG8_WAIT_V(8); PG8_WAIT_L(0); PG8_BAR; PG8_MMA(1, 0, At, B0); PG8_MMA(1, 1, At, B1); PG8_BAR; PG8_SCHED;
            } else {
            PG8_LDB(B0, 0, 0); PG8_SCHED; PG8_LDA(At, 0, 0); PG8_STAGE(PG8_SA(1, 1), a1 + hstep, voffA);
            PG8_WAIT_L(8); PG8_BAR; PG8_WAIT_L(0); PG8_MMA(0, 0, At, B0); PG8_BAR; PG8_SCHED;
            PG8_LDB(B1, 0, 1); PG8_STAGE(PG8_SB(0, 0), b2, voffB);
            PG8_BAR; PG8_WAIT_L(0); PG8_MMA(0, 1, At, B1); PG8_BAR;
            PG8_LDA(At, 0, 1); PG8_STAGE(PG8_SA(0, 0), a2, voffA);
            PG8_BAR; PG8_WAIT_L(0); PG8_MMA(1, 0, At, B0); PG8_BAR; PG8_SCHED;
            PG8_STAGE(PG8_SB(0, 1), b2 + hstep, voffB);
            PG8_WAIT_V(6); PG8_BAR; PG8_MMA(1, 1, At, B1); PG8_BAR;
            PG8_LDB(B0, 1, 0); PG8_SCHED; PG8_LDA(At, 1, 0); PG8_STAGE(PG8_SA(0, 1), a2 + hstep, voffA);
            PG8_WAIT_L(8); PG8_BAR; PG8_WAIT_L(0); PG8_MMA(0, 0, At, B0); PG8_BAR; PG8_SCHED;
            PG8_LDB(B1, 1, 1); PG8_STAGE(PG8_SB(1, 0), b3, voffB);
            PG8_BAR; PG8_WAIT_L(0); PG8_MMA(0, 1, At, B1); PG8_BAR;
            PG8_LDA(At, 1, 1); PG8_STAGE(PG8_SA(1, 0), a3, voffA);
            PG8_BAR; PG8_WAIT_L(0); PG8_MMA(1, 0, At, B0); PG8_BAR; PG8_SCHED;
            PG8_STAGE(PG8_SB(1, 1), b3 + hstep, voffB);
            PG8_WAIT_V(6); PG8_BAR; PG8_MMA(1, 1, At, B1); PG8_BAR;
            }
        }
        if constexpr (ALIGN_EPI) { if (wr == 0) PG8_BAR; }
        if constexpr (!Epi::AFTER_DRAIN) { E(acc, cur, wr, wc, fr, fq); S.done(cur); }
        if (!has_next) break;
#pragma unroll
        for (int a = 0; a < 2; ++a)
#pragma unroll
            for (int b = 0; b < 2; ++b)
#pragma unroll
                for (int m = 0; m < 4; ++m)
#pragma unroll
                    for (int n = 0; n < 2; ++n) acc[a][b][m][n] = (f32x4){0.f, 0.f, 0.f, 0.f};
        cur = nxt; cA = nA; cB = nB; ++ui;
        if constexpr (ALIGN_EPI) { if (wr == 1) PG8_BAR; }
    }
    PG8_WAIT_V(0);
    if constexpr (!ALIGN_EPI) { if (wr == 0) PG8_BAR; }
    PG8_BAR;
#undef PG8_SA
#undef PG8_SB
#undef PG8_STAGE
#undef PG8_LDA
#undef PG8_LDB
#undef PG8_MMA
#undef PG8_WAIT_V
#undef PG8_WAIT_L
#undef PG8_BAR
#undef PG8_SCHED
}
}


#define XB_TMO      128
#define XB_XCNT(j)  (256  + 64 * (j))
#define XB_XSUB(j)  (1280 + 64 * (j))
#define XB_XGEN(j)  (2304 + 64 * (j))
#define XB_TOP      3328
#define XB_TOPGEN   3392
#define XCD_BAR_WORDS 3456
#define XB_SPIN_CAP (1u << 18)
__device__ __forceinline__ unsigned xb_ld(unsigned* p)              { return __hip_atomic_load(p, __ATOMIC_RELAXED, __HIP_MEMORY_SCOPE_AGENT); }
__device__ __forceinline__ unsigned xb_add(unsigned* p, unsigned v) { return __hip_atomic_fetch_add(p, v, __ATOMIC_RELAXED, __HIP_MEMORY_SCOPE_AGENT); }
__device__ __forceinline__ unsigned xb_xcc_id() { return (unsigned)__builtin_amdgcn_s_getreg((3 << 11) | 20) & 0xFu; }
#define XB_SPIN(cond, bar) do { unsigned _sp = 0; while (cond) { __builtin_amdgcn_s_sleep(1); \
    if ((++_sp & 255u) == 0u) { if (xb_ld(&(bar)[XB_TMO])) break; if (_sp > XB_SPIN_CAP) { atomicAdd(&(bar)[XB_TMO], 1u); break; } } } } while (0)
struct XcdBarrier { unsigned* bar; unsigned x; volatile LAS unsigned* st; };
__device__ __forceinline__ XcdBarrier xcd_barrier_post(unsigned* bar, volatile LAS unsigned* st) {
    XcdBarrier b; b.bar = bar; b.x = xb_xcc_id(); b.st = st;
    if (threadIdx.x == 0) (void)xb_add(&bar[XB_XCNT(b.x)], 1u);
    return b;
}
__device__ __forceinline__ void xcd_barrier_complete(unsigned* bar, unsigned x, unsigned& nloc, unsigned& nx) {
    const unsigned G = gridDim.x * gridDim.y * gridDim.z;
    unsigned sum, cnt, mine, sp = 0u;
    for (;;) {
        sum = 0u; cnt = 0u; mine = 0u;
#pragma unroll
        for (unsigned j = 0; j < 16; ++j) { const unsigned c = xb_ld(&bar[XB_XCNT(j)]); sum += c; cnt += (c > 0u) ? 1u : 0u; mine = (j == x) ? c : mine; }
        if (sum == G) break;
        __builtin_amdgcn_s_sleep(1);
        if ((++sp & 255u) == 0u) { if (xb_ld(&bar[XB_TMO])) break; if (sp > XB_SPIN_CAP) { atomicAdd(&bar[XB_TMO], 1u); break; } }
    }
    nloc = mine > 0u ? mine : 1u; nx = cnt > 0u ? cnt : 1u;
}
__device__ __forceinline__ void xcd_barrier(const XcdBarrier& b) {
    asm volatile("s_waitcnt vmcnt(0)" ::: "memory");
    __syncthreads();
    if (threadIdx.x == 0) {
        unsigned* bar = b.bar;
        __builtin_amdgcn_s_waitcnt(0);
        unsigned nloc = b.st[0], nx = b.st[1];
        if (nloc == 0u) { xcd_barrier_complete(bar, b.x, nloc, nx); b.st[0] = nloc; b.st[1] = nx; }
        const unsigned old = xb_add(&bar[XB_XSUB(b.x)], 1u);
        const unsigned gen = old / nloc;
        if (old + 1u == (gen + 1u) * nloc) {
            __builtin_amdgcn_fence(__ATOMIC_RELEASE, "agent");
            asm volatile("s_waitcnt vmcnt(0)" ::: "memory");
            const unsigned og = xb_add(&bar[XB_TOP], 1u);
            const unsigned tg = og / nx;
            if (og + 1u == (tg + 1u) * nx) xb_add(&bar[XB_TOPGEN], 1u);
            else XB_SPIN(xb_ld(&bar[XB_TOPGEN]) == tg, bar);
            __builtin_amdgcn_fence(__ATOMIC_ACQUIRE, "agent");
            xb_add(&bar[XB_XGEN(b.x)], 1u);
            asm volatile("s_waitcnt vmcnt(0)" ::: "memory");
        } else {
            XB_SPIN(xb_ld(&bar[XB_XGEN(b.x)]) == gen, bar);
            __builtin_amdgcn_fence(__ATOMIC_ACQUIRE, "agent");
            asm volatile("s_waitcnt vmcnt(0)" ::: "memory");
        }
    }
    __syncthreads();
}

struct Args { const float* in[36]; float* out; unsigned char* ws; int ph_lo, ph_hi; };
#define LDS_WAIT() asm volatile("s_waitcnt lgkmcnt(0)" ::: "memory")

DI int rowmap(int mode, int n) {
    if (mode == 1) { const int j = n < FF ? n : n - FF; return 256 * (j >> 7) + (n < FF ? 0 : 128) + (j & 127); }
    if (mode == 2) { if (n < 1024) return n; if (n < 1040) return n + 1024; return n - 16; }
    return n;
}
DI void p0_transpose_item(const float* W, const float* gain, int K, int N, bf16_t* WT, int mode, float* scr, int item, int lane) {
    const int nblk = (N + 31) / 32, kb = item / nblk, nb = item % nblk, k0 = 64 * kb, n0 = 32 * nb;
    const int nn = n0 + (lane & 31); const bool ok = nn < N;
#pragma unroll 8
    for (int i = 0; i < 32; ++i) { const int kk = 2 * i + (lane >> 5); float v = ok ? W[(size_t)(k0 + kk) * N + nn] : 0.f; if (gain) v *= gain[k0 + kk]; scr[kk * 33 + (lane & 31)] = v; }
    LDS_WAIT(); asm volatile("" ::: "memory");
    const int c = lane & 7;
#pragma unroll
    for (int j = 0; j < 4; ++j) { const int n = (lane >> 3) + 8 * j; const float* s = scr + (8 * c) * 33 + n;
        u32x4 o; o.x = pk2(s[0 * 33], s[1 * 33]); o.y = pk2(s[2 * 33], s[3 * 33]); o.z = pk2(s[4 * 33], s[5 * 33]); o.w = pk2(s[6 * 33], s[7 * 33]);
        if (n0 + n < N) *(u32x4*)(WT + (size_t)rowmap(mode, n0 + n) * K + k0 + 8 * c) = o; }
    LDS_WAIT(); asm volatile("" ::: "memory");
}
DI void row_to_bf16_ssq(const float* xrow, bf16_t* orow, float* ssq_slot, int lane) {
    const f32x4* xr = (const f32x4*)xrow + lane;
    f32x4 v[4]; float s = 0.f;
#pragma unroll
    for (int j = 0; j < 4; ++j) { v[j] = xr[64 * j]; s += (v[j].x * v[j].x + v[j].y * v[j].y) + (v[j].z * v[j].z + v[j].w * v[j].w); }
    s = wave_sum(s);
    unsigned long long* o8 = (unsigned long long*)orow + lane;
#pragma unroll
    for (int j = 0; j < 4; ++j) o8[64 * j] = (unsigned long long)pk2(v[j].x, v[j].y) | ((unsigned long long)pk2(v[j].z, v[j].w) << 32);
    if (lane == 0) *ssq_slot = s;
}
struct S5P { float dt, lr, li; };
DI S5P s5_par(const float* lre, const float* lim, const float* logdt, int g, int n) { S5P p; p.dt = expf(logdt[g]); p.lr = lre[g * 64 + n]; p.li = lim[g * 64 + n]; return p; }
DI f32x2 s5_pow(const S5P& p, int j) {
    const float mag = expf((float)j * (p.dt * p.lr)); float sn, cs; sincosf((float)j * (p.dt * p.li), &sn, &cs); return (f32x2){mag * cs, mag * sn};
}
DI f32x2 s5_coef(const S5P& p) {
    const f32x2 ab = s5_pow(p, 1); const float den = p.lr * p.lr + p.li * p.li;
    return (f32x2){((ab.x - 1.f) * p.lr + ab.y * p.li) / den, (ab.y * p.lr - (ab.x - 1.f) * p.li) / den};
}
DI f32x2 cmul(f32x2 a, f32x2 b) { return (f32x2){a.x * b.x - a.y * b.y, a.x * b.y + a.y * b.x}; }

template <int NT>
DI void gla_gate_cumsum(const float* zg, float* bb, float* seg, const float* wg, const float* bg, int h, int tid) {
    if constexpr (NT == 64) {
        const int d = tid & 63; float wr[16]; const float bias = bg[h * 64 + d];
#pragma unroll
        for (int r = 0; r < 16; ++r) wr[r] = wg[r * 256 + h * 64 + d];
#pragma unroll
        for (int k = 0; k < 8; ++k) { const int t = (tid >> 6) + 8 * k; const f32x4* zp = (const f32x4*)(zg + t * 16); float s = bias;
#pragma unroll
            for (int r4 = 0; r4 < 4; ++r4) { const f32x4 z = zp[r4]; s += z[0] * wr[r4 * 4] + z[1] * wr[r4 * 4 + 1] + z[2] * wr[r4 * 4 + 2] + z[3] * wr[r4 * 4 + 3]; }
            bb[t * 65 + d] = logsigmoidf(s) * (1.f / 16.f); }
    } else {
    for (int i = tid; i < NT * 64; i += NTHREADS) { const int t = i >> 6, d = i & 63; float s = bg[h * 64 + d];
#pragma unroll
        for (int r = 0; r < 16; ++r) s += zg[t * 16 + r] * wg[r * 256 + h * 64 + d];
        bb[t * 65 + d] = logsigmoidf(s) * (1.f / 16.f); }
    }
    __syncthreads();
    if constexpr (NT == 64) {
        const int d = tid & 63, sg = tid >> 6; float run = 0.f;
#pragma unroll
        for (int i = 0; i < 8; ++i) { run += bb[(sg * 8 + i) * 65 + d]; bb[(sg * 8 + i) * 65 + d] = run; }
        seg[sg * 64 + d] = run;
        __syncthreads();
        float pre = 0.f;
        for (int j = 0; j < sg; ++j) pre += seg[j * 64 + d];
#pragma unroll
        for (int i = 0; i < 8; ++i) bb[(sg * 8 + i) * 65 + d] += pre;
    } else {
        if (tid < 64) { float run = 0.f;
#pragma unroll
            for (int t = 0; t < NT; ++t) { run += bb[t * 65 + tid]; bb[t * 65 + tid] = run; } }
    }
    __syncthreads();
}


template <bool OUT_F32> struct SEpiResid {
    const bf16_t* base; bf16_t* hbo; float* outf; float* ssq; float alpha;
    DI void operator()(int row, int col, const f32x4& a0, const f32x4& a1, int tid) const {
        const u32x4 bw = *(const u32x4*)(base + (size_t)row * D + col);
        f32x4 v0 = a0 * alpha, v1 = a1 * alpha;
        v0[0] += bflo(bw.x); v0[1] += bfhi(bw.x); v0[2] += bflo(bw.y); v0[3] += bfhi(bw.y); v1[0] += bflo(bw.z); v1[1] += bfhi(bw.z); v1[2] += bflo(bw.w); v1[3] += bfhi(bw.w);
        if constexpr (OUT_F32) { *(f32x4*)(outf + (size_t)row * D + col) = v0; *(f32x4*)(outf + (size_t)row * D + col + 4) = v1; }
        else {
            u32x4 w; w.x = pk2(v0[0], v0[1]); w.y = pk2(v0[2], v0[3]); w.z = pk2(v1[0], v1[1]); w.w = pk2(v1[2], v1[3]); *(u32x4*)(hbo + (size_t)row * D + col) = w;
            float sq = (v0[0] * v0[0] + v0[1] * v0[1]) + (v0[2] * v0[2] + v0[3] * v0[3]) + (v1[0] * v1[0] + v1[1] * v1[1]) + (v1[2] * v1[2] + v1[3] * v1[3]);
            sq += __shfl_xor(sq, 1); sq += __shfl_xor(sq, 2); sq += __shfl_xor(sq, 4); if ((tid & 7) == 0) atomicAdd(ssq + row, sq);
        }
    }
};
struct SEpiScaleBf16 {
    bf16_t* O; const float* ssq; float scale;
    DI void operator()(int row, int col, const f32x4& a0, const f32x4& a1, int) const {
        const float rs = rsqrtf(ssq[row] * (1.f / D) + EPS) * scale; const f32x4 v0 = a0 * rs, v1 = a1 * rs;
        u32x4 w; w.x = pk2(v0[0], v0[1]); w.y = pk2(v0[2], v0[3]); w.z = pk2(v1[0], v1[1]); w.w = pk2(v1[2], v1[3]); *(u32x4*)(O + (size_t)row * D + col) = w;
    }
};
template <class F>
DI void small_gemm(const bf16_t* A, const bf16_t* Bt, int K, float* red, int G, int bx, int wave, int tid, const F& epi) {
    const int lane = tid & 63, fr = lane & 15, fq = lane >> 4, kw = K >> 3, nsteps = kw >> 5;
    for (int tile = bx; tile < 256; tile += G) {
        const int row0 = (tile >> 4) * 64, col0 = (tile & 15) * 64;
        f32x4 acc[4][4];
#pragma unroll
        for (int i = 0; i < 4; ++i)
#pragma unroll
            for (int j = 0; j < 4; ++j) acc[i][j] = (f32x4){0.f, 0.f, 0.f, 0.f};
        const bf16_t* ap = A + (size_t)(row0 + fr) * K + wave * kw + fq * 8;
        const bf16_t* bp = Bt + (size_t)(col0 + fr) * K + wave * kw + fq * 8;
#pragma unroll 2
        for (int st = 0; st < nsteps; ++st) {
            bf16x8 a[4], b[4];
#pragma unroll
            for (int i = 0; i < 4; ++i) { a[i] = *(const bf16x8*)(ap + (size_t)i * 16 * K + st * 32); b[i] = *(const bf16x8*)(bp + (size_t)i * 16 * K + st * 32); }
#pragma unroll
            for (int i = 0; i < 4; ++i)
#pragma unroll
                for (int j = 0; j < 4; ++j) acc[i][j] = __builtin_amdgcn_mfma_f32_16x16x32_bf16(a[i], b[j], acc[i][j], 0, 0, 0);
        }
        float* my = red + wave * (64 * 68);
#pragma unroll
        for (int i = 0; i < 4; ++i)
#pragma unroll
            for (int j = 0; j < 4; ++j)
#pragma unroll
                for (int r = 0; r < 4; ++r) my[(i * 16 + fq * 4 + r) * 68 + j * 16 + fr] = acc[i][j][r];
        __syncthreads();
        { const int row = tid >> 3, c8 = (tid & 7) * 8; f32x4 s0 = (f32x4){0.f, 0.f, 0.f, 0.f}, s1 = s0;
#pragma unroll
            for (int w = 0; w < 8; ++w) { const f32x4* p = (const f32x4*)(red + w * (64 * 68) + row * 68 + c8); s0 += p[0]; s1 += p[1]; }
            epi(MP + row0 + row, col0 + c8, s0, s1, tid); }
        __syncthreads();
    }
}

__global__ void __launch_bounds__(NTHREADS, 2) hymba_fwd(Args args) {
    extern __shared__ __attribute__((aligned(16))) unsigned char lds[];
    cg::grid_group grid = cg::this_grid();
    const int tid0 = threadIdx.x, wave = __builtin_amdgcn_readfirstlane(tid0 >> 6);
    const int G = gridDim.x, bx = blockIdx.x;
    const int gw = bx * NWAVES + wave, NGW = G * NWAVES;
    const int NGT = G * NTHREADS;
#define PHASE_LOCALS int tid_l_ = tid0; asm volatile("" : "+v"(tid_l_)); const int tid = tid_l_, lane = tid & 63, gt = bx * NTHREADS + tid; (void)lane; (void)gt
    unsigned char* ws = args.ws;
    float* out = args.out;
    float* fl = (float*)lds;
    LAS unsigned char* ldsl = (LAS unsigned char*)lds;

    const float* x_prompt = args.in[0]; const float* x_sample = args.in[1]; const float* state_gla = args.in[2];
    const float* st_re = args.in[3]; const float* st_im = args.in[4]; const float* cache_k = args.in[5]; const float* cache_v = args.in[6];
    const float* mem_prompt = args.in[7];
    const float* w_gate = args.in[13]; const float* b_gate = args.in[14]; const float* g_gla_out = args.in[15];
    const float* s5_lre = args.in[16]; const float* s5_lim = args.in[17]; const float* s5_logdt = args.in[18];
    const float* s5_bre = args.in[19]; const float* s5_bim = args.in[20]; const float* s5_cre = args.in[21]; const float* s5_cim = args.in[22];
    const float* s5_d = args.in[23]; const float* s5_wglu = args.in[24]; const float* s5_bglu = args.in[25];
    const float* g_final = args.in[35];

    float* ssq = (float*)(ws + WS_SSQ);
    bf16_t* Wgu1 = (bf16_t*)(ws + WS_WGU1); bf16_t* Wd1 = (bf16_t*)(ws + WS_WD1); bf16_t* Win = (bf16_t*)(ws + WS_WIN); bf16_t* Wout = (bf16_t*)(ws + WS_WOUT);
    bf16_t* Wcq = (bf16_t*)(ws + WS_WCQ); bf16_t* Wckv = (bf16_t*)(ws + WS_WCKV); bf16_t* Wco = (bf16_t*)(ws + WS_WCO); bf16_t* Wgu2 = (bf16_t*)(ws + WS_WGU2); bf16_t* Wd2 = (bf16_t*)(ws + WS_WD2);
    bf16_t* EgT = (bf16_t*)(ws + WS_EGT); bf16_t* GTt = (bf16_t*)(ws + WS_GTT);
    bf16_t* memb = (bf16_t*)(ws + WS_MEMB); bf16_t* kb = (bf16_t*)(ws + WS_KB); bf16_t* vbT = (bf16_t*)(ws + WS_VBT);
    bf16_t* xb = (bf16_t*)(ws + WS_XB); bf16_t* hb = (bf16_t*)(ws + WS_HB); float* hres = (float*)(ws + WS_H);
    bf16_t* act = (bf16_t*)(ws + WS_ACT); bf16_t* Pb = (bf16_t*)(ws + WS_ACT);
    bf16_t* mix = (bf16_t*)(ws + WS_MIX); bf16_t* qb = (bf16_t*)(ws + WS_Q); bf16_t* ob = (bf16_t*)(ws + WS_O);
    float* glaD = (float*)(ws + WS_GLAD); float* glaDec = (float*)(ws + WS_GLADEC); float* glaS = (float*)(ws + WS_XB);
    float* s5e = (float*)(ws + WS_S5E); bf16_t* s5x = (bf16_t*)(ws + WS_S5X);

    const int lo = args.ph_lo, hi = args.ph_hi;
    if (tid0 < 16) ((LAS unsigned*)(ldsl + LDS_BARST))[tid0] = 0u;
    __syncthreads();
    const XcdBarrier xbar = xcd_barrier_post((unsigned*)(ws + WS_BAR), (volatile LAS unsigned*)(ldsl + LDS_BARST));
    if (lo < 0) grid.sync();
#ifndef PHASE_MASK
#define PHASE_MASK 0xffffffffu
#endif
#define IN(k) (((PHASE_MASK >> (k)) & 1u) && lo <= (k) && (k) < hi)
#ifndef REPEAT_MASK
#define REPEAT_MASK 0u
#endif
#define PHASE(k) if (IN(k)) for (int rep_ = 0; rep_ < 1 + (int)((REPEAT_MASK >> (k)) & 1u); ++rep_)
#define PHASE_G(k) if (IN(k))
#define GREP(k) (1 + (int)((REPEAT_MASK >> (k)) & 1u))
#define SUBREP(bit) for (int sr_ = 0; sr_ < 1 + (int)((REPEAT_MASK >> (bit)) & 1u); ++sr_)
#define REP_SYNC() do { if (rep_) xcd_barrier(xbar); } while (0)
#define SEAM(k) do { if (IN(k) && IN((k) + 1)) xcd_barrier(xbar); } while (0)

    PHASE(0) {
        REP_SYNC();
        PHASE_LOCALS;
        float* scr = fl + wave * (64 * 33);
        constexpr int I_GU = 16 * 176, I_D = 44 * 32, I_IN = 16 * 65, I_SQ = 16 * 32, I_CKV = 16 * 64;
        constexpr int NITEMS = 2 * I_GU + 2 * I_D + I_IN + 3 * I_SQ + I_CKV;
        for (int it = gw; it < NITEMS; it += NGW) {
            int r = it;
            if (r < I_GU) { p0_transpose_item(args.in[9], args.in[8], D, NGU, Wgu1, 1, scr, r, lane); continue; } r -= I_GU;
            if (r < I_GU) { p0_transpose_item(args.in[33], args.in[32], D, NGU, Wgu2, 1, scr, r, lane); continue; } r -= I_GU;
            if (r < I_D) { p0_transpose_item(args.in[10], nullptr, FF, D, Wd1, 0, scr, r, lane); continue; } r -= I_D;
            if (r < I_D) { p0_transpose_item(args.in[34], nullptr, FF, D, Wd2, 0, scr, r, lane); continue; } r -= I_D;
            if (r < I_IN) { p0_transpose_item(args.in[12], args.in[11], D, NIN, Win, 2, scr, r, lane); continue; } r -= I_IN;
            if (r < I_SQ) { p0_transpose_item(args.in[26], nullptr, D, D, Wout, 0, scr, r, lane); continue; } r -= I_SQ;
            if (r < I_SQ) { p0_transpose_item(args.in[29], args.in[27], D, D, Wcq, 0, scr, r, lane); continue; } r -= I_SQ;
            if (r < I_SQ) { p0_transpose_item(args.in[31], nullptr, D, D, Wco, 0, scr, r, lane); continue; } r -= I_SQ;
            p0_transpose_item(args.in[30], args.in[28], D, 2 * D, Wckv, 0, scr, r, lane);
        }
        for (int i = gt; i < (NINP - NIN) * D / 8; i += NGT) ((u32x4*)(Win + (size_t)NIN * D))[i] = (u32x4){0u, 0u, 0u, 0u};
        for (int i = gt; i < 3 * M; i += NGT) ssq[SSQ_H1 + i] = 0.f;
        for (int m = gw; m < M; m += NGW) { const float* xr = m < MP ? x_prompt + (size_t)m * D : x_sample + (size_t)(m - MP) * D; row_to_bf16_ssq(xr, xb + (size_t)m * D, ssq + SSQ_X + m, lane); }
        for (int m = gw; m < MEMR; m += NGW) row_to_bf16_ssq(mem_prompt + (size_t)m * D, memb + (size_t)m * D, ssq + SSQ_MEM + m, lane);
        for (int it = gt; it < 32 * 64 * 8; it += NGT) {
            const int g = it >> 9, n = (it >> 3) & 63, s = it & 7;
            const S5P p = s5_par(s5_lre, s5_lim, s5_logdt, g, n);
            const f32x2 mm = cmul(s5_pow(p, 7 - s), s5_coef(p));
            unsigned wre[8], wim[8];
#pragma unroll
            for (int pp = 0; pp < 8; ++pp) {
                const f32x2 b0 = (f32x2){s5_bre[(g * 64 + n) * 16 + 2 * pp], s5_bim[(g * 64 + n) * 16 + 2 * pp]}, b1 = (f32x2){s5_bre[(g * 64 + n) * 16 + 2 * pp + 1], s5_bim[(g * 64 + n) * 16 + 2 * pp + 1]};
                const f32x2 v0 = cmul(mm, b0), v1 = cmul(mm, b1);
                wre[pp] = pk2(v0.x, v1.x); wim[pp] = pk2(v0.y, v1.y);
            }
            u32x4* dre = (u32x4*)(EgT + ((size_t)(g * 128 + n) * 128 + s * 16)); u32x4* dim = (u32x4*)(EgT + ((size_t)(g * 128 + 64 + n) * 128 + s * 16));
            dre[0] = (u32x4){wre[0], wre[1], wre[2], wre[3]}; dre[1] = (u32x4){wre[4], wre[5], wre[6], wre[7]};
            dim[0] = (u32x4){wim[0], wim[1], wim[2], wim[3]}; dim[1] = (u32x4){wim[4], wim[5], wim[6], wim[7]};
        }
        for (int it = gt; it < 32 * 8 * 64; it += NGT) {
            const int g = it >> 9, t = (it >> 6) & 7, n = it & 63;
            const S5P p = s5_par(s5_lre, s5_lim, s5_logdt, g, n);
            const f32x2 pw = s5_pow(p, t + 1);
#pragma unroll
            for (int pp = 0; pp < 16; ++pp) {
                const f32x2 c = (f32x2){s5_cre[(g * 16 + pp) * 64 + n], s5_cim[(g * 16 + pp) * 64 + n]};
                const f32x2 v = cmul(c, pw);
                bf16_t* dst = GTt + (size_t)(g * 128 + t * 16 + pp) * 256;
                dst[n] = (bf16_t)f2bf(v.x); dst[64 + n] = (bf16_t)f2bf(-v.y);
            }
        }
        for (int it = gt; it < 32 * 8 * 8 * 16; it += NGT) {
            const int g = it >> 10, t = (it >> 7) & 7, s = (it >> 4) & 7, pp = it & 15;
            float a[16];
#pragma unroll
            for (int q = 0; q < 16; ++q) a[q] = 0.f;
            if (s <= t) {
                for (int n = 0; n < 64; ++n) {
                    const S5P p = s5_par(s5_lre, s5_lim, s5_logdt, g, n);
                    const f32x2 c = (f32x2){s5_cre[(g * 16 + pp) * 64 + n], s5_cim[(g * 16 + pp) * 64 + n]};
                    const f32x2 cc = cmul(cmul(c, s5_pow(p, t - s)), s5_coef(p));
                    const f32x4* br = (const f32x4*)(s5_bre + (g * 64 + n) * 16); const f32x4* bi = (const f32x4*)(s5_bim + (g * 64 + n) * 16);
#pragma unroll
                    for (int q4 = 0; q4 < 4; ++q4) { const f32x4 r4 = br[q4], i4 = bi[q4];
#pragma unroll
                        for (int e = 0; e < 4; ++e) a[q4 * 4 + e] += cc.x * r4[e] - cc.y * i4[e]; }
                }
            }
            u32x4* dst = (u32x4*)(GTt + (size_t)(g * 128 + t * 16 + pp) * 256 + 128 + s * 16);
            dst[0] = (u32x4){pk2(a[0], a[1]), pk2(a[2], a[3]), pk2(a[4], a[5]), pk2(a[6], a[7])};
            dst[1] = (u32x4){pk2(a[8], a[9]), pk2(a[10], a[11]), pk2(a[12], a[13]), pk2(a[14], a[15])};
        }
    }
    SEAM(0);

    for (int i_ = 0; i_ < 20 * (int)((REPEAT_MASK >> 23) & 1u); ++i_) xcd_barrier(xbar);
    PHASE_G(1) {
        pg8::Gemm g{xb, Wgu1, M, NGU, D}; pg8::StaticOrder S; S.init(M, NGU, G, bx, GREP(1));
        pg8::EpiSwiGLU E{act, FF, ssq + SSQ_X};
        pg8::gemm_phase<pg8::EpiSwiGLU, pg8::StaticOrder, true, true>(ldsl, g, S, E);
    }
    SEAM(1);
    PHASE_G(2) {
        pg8::Gemm g{act, Wd1, MP, D, FF}; pg8::StaticOrder S; S.init(MP, D, G, bx);
        pg8::EpiResid<false> E{xb, hb, nullptr, ssq + SSQ_H1, 0.5f};
        pg8::gemm_phase<pg8::EpiResid<false>, pg8::StaticOrder, true, true>(ldsl, g, S, E);
        SEpiResid<false> SE{xb, hb, nullptr, ssq + SSQ_H1, 0.5f};
        small_gemm(act + (size_t)MP * FF, Wd1, FF, fl, G, bx, wave, tid0, SE);
    }
    SEAM(2);
    PHASE_G(3) {
        { pg8::Gemm g{hb, Win, M, NINP, D}; pg8::StaticOrder S; S.init(M, NINP, G, bx, GREP(3));
          pg8::EpiScaleBf16 E{Pb, NINP, ssq + SSQ_H1, 1.f};
          pg8::gemm_phase<pg8::EpiScaleBf16, pg8::StaticOrder, true, true>(ldsl, g, S, E); }
        { pg8::Gemm g{memb, Wckv, MEMR, 2 * D, D}; pg8::StaticOrder S; S.init(MEMR, 2 * D, G, (bx + 64) % G);
          pg8::EpiMemKV E{out + O_MKP, out + O_MVP, kb, vbT, ssq + SSQ_MEM};
          pg8::gemm_phase<pg8::EpiMemKV, pg8::StaticOrder, true, true>(ldsl, g, S, E); }
    }
    SEAM(3);

    PHASE(4) {
        REP_SYNC();
        PHASE_LOCALS;
        SUBREP(16)
        {
            float* zg = fl; float* kk = zg + 64 * 16; float* vv = kk + 64 * 65; float* bb = vv + 64 * 129; float* seg = bb + 64 * 65;
            const int fr = lane & 15, fq = lane >> 4;
            for (int unit = bx; unit < 1024; unit += G) {
                const int bh = unit >> 5, c = unit & 31, b = bh >> 2, h = bh & 3;
                const size_t r0 = (size_t)b * 2048 + c * 64;
                if (tid < 128) { const int t = tid >> 1, hf = tid & 1; const u32x4 w = *(const u32x4*)(Pb + (r0 + t) * NINP + PC_ZG + hf * 8);
                    float* z = zg + t * 16 + hf * 8; z[0] = bflo(w.x); z[1] = bfhi(w.x); z[2] = bflo(w.y); z[3] = bfhi(w.y); z[4] = bflo(w.z); z[5] = bfhi(w.z); z[6] = bflo(w.w); z[7] = bfhi(w.w); }
                const u32x4 kw = *(const u32x4*)(Pb + (r0 + (tid >> 3)) * NINP + PC_K + h * 64 + (tid & 7) * 8);
#pragma unroll
                for (int i = 0; i < 2; ++i) { const int ch = tid + i * 512, t = ch >> 4, c8 = ch & 15; const u32x4 w = *(const u32x4*)(Pb + (r0 + t) * NINP + PC_V + h * 128 + c8 * 8);
                    float* z = vv + t * 129 + c8 * 8; z[0] = bflo(w.x); z[1] = bfhi(w.x); z[2] = bflo(w.y); z[3] = bfhi(w.y); z[4] = bflo(w.z); z[5] = bfhi(w.z); z[6] = bflo(w.w); z[7] = bfhi(w.w); }
                __syncthreads();
                gla_gate_cumsum<64>(zg, bb, seg, w_gate, b_gate, h, tid);
                { const int t = tid >> 3, d0 = (tid & 7) * 8; float* z = kk + t * 65 + d0; const float* bl = bb + 63 * 65 + d0; const float* bt = bb + t * 65 + d0;
                    z[0] = bflo(kw.x) * __expf(bl[0] - bt[0]); z[1] = bfhi(kw.x) * __expf(bl[1] - bt[1]); z[2] = bflo(kw.y) * __expf(bl[2] - bt[2]); z[3] = bfhi(kw.y) * __expf(bl[3] - bt[3]);
                    z[4] = bflo(kw.z) * __expf(bl[4] - bt[4]); z[5] = bfhi(kw.z) * __expf(bl[5] - bt[5]); z[6] = bflo(kw.w) * __expf(bl[6] - bt[6]); z[7] = bfhi(kw.w) * __expf(bl[7] - bt[7]); }
                __syncthreads();
                {
                    f32x4 acc[4];
#pragma unroll
                    for (int db = 0; db < 4; ++db) acc[db] = (f32x4){0.f, 0.f, 0.f, 0.f};
#pragma unroll
                    for (int ks = 0; ks < 2; ++ks) {
                        float av[8];
#pragma unroll
                        for (int j = 0; j < 8; ++j) av[j] = vv[(ks * 32 + fq * 8 + j) * 129 + wave * 16 + fr];
                        const u32x4 ap = (u32x4){pk2(av[0], av[1]), pk2(av[2], av[3]), pk2(av[4], av[5]), pk2(av[6], av[7])};
#pragma unroll
                        for (int db = 0; db < 4; ++db) {
                            float bv[8];
#pragma unroll
                            for (int j = 0; j < 8; ++j) bv[j] = kk[(ks * 32 + fq * 8 + j) * 65 + db * 16 + fr];
                            const u32x4 bp = (u32x4){pk2(bv[0], bv[1]), pk2(bv[2], bv[3]), pk2(bv[4], bv[5]), pk2(bv[6], bv[7])};
                            acc[db] = __builtin_amdgcn_mfma_f32_16x16x32_bf16(__builtin_bit_cast(bf16x8, ap), __builtin_bit_cast(bf16x8, bp), acc[db], 0, 0, 0);
                        }
                    }
                    float* dp = glaD + (size_t)unit * 8192;
#pragma unroll
                    for (int db = 0; db < 4; ++db)
#pragma unroll
                        for (int r = 0; r < 4; ++r) dp[(wave * 16 + fq * 4 + r) * 64 + db * 16 + fr] = acc[db][r];
                }
                if (tid < 64) glaDec[unit * 64 + tid] = __expf(bb[63 * 65 + tid]);
                __syncthreads();
            }
        }
        SUBREP(17)
        {
            float* zg = fl; float* qq = zg + 8 * 16; float* kk = qq + 8 * 65; float* kt = kk + 8 * 65; float* vv = kt + 8 * 65; float* bb = vv + 8 * 128; float* sc = bb + 8 * 65; float* S0 = sc + 64;
            for (int unit = bx; unit < 512; unit += G) {
                const int b = unit >> 2, h = unit & 3; const size_t r0 = (size_t)MP + b * 8;
                if (tid < 128) { const int t = tid >> 4, r = tid & 15; zg[t * 16 + r] = bf2f(Pb[(r0 + t) * NINP + PC_ZG + r]); }
                { const int t = tid >> 6, d = tid & 63; qq[t * 65 + d] = bf2f(Pb[(r0 + t) * NINP + PC_Q + h * 64 + d]); kk[t * 65 + d] = bf2f(Pb[(r0 + t) * NINP + PC_K + h * 64 + d]); }
#pragma unroll
                for (int i = 0; i < 2; ++i) { const int idx = tid + i * 512, t = idx >> 7, e = idx & 127; vv[t * 128 + e] = bf2f(Pb[(r0 + t) * NINP + PC_V + h * 128 + e]); }
                { const f32x4* sp = (const f32x4*)(state_gla + (size_t)unit * 8192); f32x4* dp = (f32x4*)S0;
#pragma unroll
                    for (int i = 0; i < 4; ++i) dp[tid + i * 512] = sp[tid + i * 512]; }
                __syncthreads();
                gla_gate_cumsum<8>(zg, bb, nullptr, w_gate, b_gate, h, tid);
                { const int t = tid >> 6, d = tid & 63; const float bt = bb[t * 65 + d], b7 = bb[7 * 65 + d]; const float kv = kk[t * 65 + d];
                    qq[t * 65 + d] *= __expf(bt) * 0.125f; kk[t * 65 + d] = kv * __expf(-bt); kt[t * 65 + d] = kv * __expf(b7 - bt); }
                __syncthreads();
                if (tid < 64) { const int t = tid >> 3, s = tid & 7; float a = 0.f; if (s <= t) { for (int d = 0; d < 64; ++d) a += qq[t * 65 + d] * kk[s * 65 + d]; } sc[t * 8 + s] = a; }
                __syncthreads();
                {
                    const int t = wave, e0 = lane * 2; float o0 = 0.f, o1 = 0.f;
                    for (int d = 0; d < 64; ++d) { const float qd = qq[t * 65 + d]; o0 += qd * S0[d * 128 + e0]; o1 += qd * S0[d * 128 + e0 + 1]; }
                    for (int s = 0; s <= t; ++s) { const float w = sc[t * 8 + s]; o0 += w * vv[s * 128 + e0]; o1 += w * vv[s * 128 + e0 + 1]; }
                    const float ss = wave_sum(o0 * o0 + o1 * o1); const float rs = rsqrtf(ss * (1.f / 128.f) + EPS);
                    const unsigned rw = *(const unsigned*)(Pb + (r0 + t) * NINP + PC_R + h * 128 + e0);
                    const float y0 = o0 * rs * g_gla_out[e0] * siluf(bflo(rw)), y1 = o1 * rs * g_gla_out[e0 + 1] * siluf(bfhi(rw));
                    *(unsigned*)(mix + (r0 + t) * D + h * 128 + e0) = pk2(y0, y1);
                }
                {
                    const int d = tid >> 3, e0 = (tid & 7) * 16; const float dec = __expf(bb[7 * 65 + d]);
                    f32x4 a[4];
#pragma unroll
                    for (int i = 0; i < 4; ++i) a[i] = ((const f32x4*)(S0 + d * 128 + e0))[i] * dec;
#pragma unroll
                    for (int s = 0; s < 8; ++s) { const float kd = kt[s * 65 + d]; const f32x4* vp = (const f32x4*)(vv + s * 128 + e0);
#pragma unroll
                        for (int i = 0; i < 4; ++i) a[i] += vp[i] * kd; }
                    f32x4* dp = (f32x4*)(out + O_GLAS + (size_t)unit * 8192 + d * 128 + e0);
#pragma unroll
                    for (int i = 0; i < 4; ++i) dp[i] = a[i];
                }
                __syncthreads();
            }
        }
        SUBREP(18)
        for (int it = gw; it < 136 * 32; it += NGW) {
            const int rb = it >> 5, g = it & 31, fr = lane & 15, fq = lane >> 4; const int R0 = rb * 16;
            f32x4 acc[8];
#pragma unroll
            for (int nb = 0; nb < 8; ++nb) acc[nb] = (f32x4){0.f, 0.f, 0.f, 0.f};
#pragma unroll
            for (int ks = 0; ks < 4; ++ks) {
                const bf16x8 a = *(const bf16x8*)(Pb + ((size_t)(R0 + fr) * 8 + ks * 2 + (fq >> 1)) * NINP + PC_U + g * 16 + (fq & 1) * 8);
#pragma unroll
                for (int nb = 0; nb < 8; ++nb) { const bf16x8 bfr = *(const bf16x8*)(EgT + (size_t)(g * 128 + nb * 16 + fr) * 128 + ks * 32 + fq * 8);
                    acc[nb] = __builtin_amdgcn_mfma_f32_16x16x32_bf16(a, bfr, acc[nb], 0, 0, 0); }
            }
#pragma unroll
            for (int nb = 0; nb < 8; ++nb)
#pragma unroll
                for (int r = 0; r < 4; ++r) s5e[((size_t)(R0 + fq * 4 + r) * 32 + g) * 128 + nb * 16 + fr] = acc[nb][r];
        }
    }
    SEAM(4);

    PHASE(5) {
        REP_SYNC();
        PHASE_LOCALS;
        for (int idx = gt; idx < 32 * 8192; idx += NGT) {
            const int bh = idx >> 13, de = idx & 8191, d = de & 63, e = de >> 6;
            float Dv[32], dc[32];
#pragma unroll
            for (int c = 0; c < 32; ++c) { const int unit = bh * 32 + c; Dv[c] = glaD[(size_t)unit * 8192 + de]; dc[c] = glaDec[unit * 64 + d]; }
            float S = 0.f;
#pragma unroll
            for (int c = 0; c < 32; ++c) { glaS[(size_t)(bh * 32 + c) * 8192 + de] = S; S = dc[c] * S + Dv[c]; }
            out[O_GLAP + (size_t)bh * 8192 + d * 128 + e] = S;
        }
        for (int it = bx; it < 256; it += G) {
            const int b = it >> 5, g = it & 31, n = tid & 63, sgm = wave;
            const S5P p = s5_par(s5_lre, s5_lim, s5_logdt, g, n); const f32x2 a8 = s5_pow(p, 8);
            f32x2 a256 = a8;
#pragma unroll
            for (int i = 0; i < 5; ++i) a256 = cmul(a256, a256);
            float er[32], ei[32];
            const size_t o0 = (((size_t)b * 256 + sgm * 32) * 32 + g) * 128;
#pragma unroll
            for (int i = 0; i < 32; ++i) { er[i] = s5e[o0 + (size_t)i * 4096 + n]; ei[i] = s5e[o0 + (size_t)i * 4096 + 64 + n]; }
            float yr = 0.f, yi = 0.f;
#pragma unroll
            for (int i = 0; i < 32; ++i) { const float pr = yr, pi = yi; yr = a8.x * pr - a8.y * pi + er[i]; yi = a8.x * pi + a8.y * pr + ei[i]; er[i] = pr; ei[i] = pi; }
            fl[sgm * 64 + n] = yr; fl[512 + sgm * 64 + n] = yi;
            __syncthreads();
            float xr = 0.f, xi = 0.f;
            for (int j = 0; j < sgm; ++j) { const float tr = fl[j * 64 + n], ti = fl[512 + j * 64 + n]; const float nr = a256.x * xr - a256.y * xi + tr, ni = a256.x * xi + a256.y * xr + ti; xr = nr; xi = ni; }
            f32x2 pw = (f32x2){1.f, 0.f};
#pragma unroll
            for (int i = 0; i < 32; ++i) {
                s5x[o0 + (size_t)i * 4096 + n] = (bf16_t)f2bf(er[i] + pw.x * xr - pw.y * xi); s5x[o0 + (size_t)i * 4096 + 64 + n] = (bf16_t)f2bf(ei[i] + pw.x * xi + pw.y * xr);
                pw = cmul(pw, a8);
            }
            if (sgm == 7) { out[O_REP + (b * 32 + g) * 64 + n] = yr + a256.x * xr - a256.y * xi; out[O_IMP + (b * 32 + g) * 64 + n] = yi + a256.x * xi + a256.y * xr; }
            __syncthreads();
        }
        for (int idx = gt; idx < 128 * 32 * 64; idx += NGT) {
            const int b = idx >> 11, g = (idx >> 6) & 31, n = idx & 63;
            const S5P p = s5_par(s5_lre, s5_lim, s5_logdt, g, n); const f32x2 a8 = s5_pow(p, 8);
            const float xr = st_re[idx], xi = st_im[idx];
            const size_t R = 2048 + b; const size_t o = (R * 32 + g) * 128;
            s5x[o + n] = (bf16_t)f2bf(xr); s5x[o + 64 + n] = (bf16_t)f2bf(xi);
            out[O_RES + idx] = a8.x * xr - a8.y * xi + s5e[o + n]; out[O_IMS + idx] = a8.x * xi + a8.y * xr + s5e[o + 64 + n];
        }
    }
    SEAM(5);

    PHASE(6) {
        REP_SYNC();
        PHASE_LOCALS;
        SUBREP(19)
        {
            float* zg = fl; float* bb = zg + 64 * 16; float* seg = bb + 64 * 65; float* vv = seg + 512; float* red = vv + 64 * 129;
            bf16_t* qq = (bf16_t*)(red + 512); bf16_t* kk = qq + 64 * 72; bf16_t* sc = kk + 64 * 72;
            const int fr = lane & 15, fq = lane >> 4;
            for (int unit = bx; unit < 1024; unit += G) {
                const int bh = unit >> 5, c = unit & 31, b = bh >> 2, h = bh & 3;
                const size_t r0 = (size_t)b * 2048 + c * 64;
                if (tid < 128) { const int t = tid >> 1, hf = tid & 1; const u32x4 w = *(const u32x4*)(Pb + (r0 + t) * NINP + PC_ZG + hf * 8);
                    float* z = zg + t * 16 + hf * 8; z[0] = bflo(w.x); z[1] = bfhi(w.x); z[2] = bflo(w.y); z[3] = bfhi(w.y); z[4] = bflo(w.z); z[5] = bfhi(w.z); z[6] = bflo(w.w); z[7] = bfhi(w.w); }
                const u32x4 kw = *(const u32x4*)(Pb + (r0 + (tid >> 3)) * NINP + PC_K + h * 64 + (tid & 7) * 8);
                const u32x4 qw = *(const u32x4*)(Pb + (r0 + (tid >> 3)) * NINP + PC_Q + h * 64 + (tid & 7) * 8);
#pragma unroll
                for (int i = 0; i < 2; ++i) { const int ch = tid + i * 512, t = ch >> 4, c8 = ch & 15; const u32x4 w = *(const u32x4*)(Pb + (r0 + t) * NINP + PC_V + h * 128 + c8 * 8);
                    float* z = vv + t * 129 + c8 * 8; z[0] = bflo(w.x); z[1] = bfhi(w.x); z[2] = bflo(w.y); z[3] = bfhi(w.y); z[4] = bflo(w.z); z[5] = bfhi(w.z); z[6] = bflo(w.w); z[7] = bfhi(w.w); }
                __syncthreads();
                gla_gate_cumsum<64>(zg, bb, seg, w_gate, b_gate, h, tid);
                {
                    const int t = tid >> 3, d0 = (tid & 7) * 8; const float* bt = bb + t * 65 + d0;
                    float eb[8];
#pragma unroll
                    for (int j = 0; j < 8; ++j) eb[j] = __expf(bt[j]);
                    u32x4 qo, ko;
                    qo.x = pk2(bflo(qw.x) * eb[0] * 0.125f, bfhi(qw.x) * eb[1] * 0.125f); qo.y = pk2(bflo(qw.y) * eb[2] * 0.125f, bfhi(qw.y) * eb[3] * 0.125f);
                    qo.z = pk2(bflo(qw.z) * eb[4] * 0.125f, bfhi(qw.z) * eb[5] * 0.125f); qo.w = pk2(bflo(qw.w) * eb[6] * 0.125f, bfhi(qw.w) * eb[7] * 0.125f);
#pragma unroll
                    for (int j = 0; j < 8; ++j) eb[j] = __builtin_amdgcn_rcpf(eb[j]);
                    ko.x = pk2(bflo(kw.x) * eb[0], bfhi(kw.x) * eb[1]); ko.y = pk2(bflo(kw.y) * eb[2], bfhi(kw.y) * eb[3]);
                    ko.z = pk2(bflo(kw.z) * eb[4], bfhi(kw.z) * eb[5]); ko.w = pk2(bflo(kw.w) * eb[6], bfhi(kw.w) * eb[7]);
                    *(u32x4*)(qq + t * 72 + d0) = qo; *(u32x4*)(kk + t * 72 + d0) = ko;
                }
                __syncthreads();
                {
                    const int tb = wave >> 1;
#pragma unroll
                    for (int i = 0; i < 2; ++i) {
                        const int sb = (wave & 1) * 2 + i;
                        f32x4 a = (f32x4){0.f, 0.f, 0.f, 0.f};
                        if (sb <= tb) {
#pragma unroll
                            for (int ks = 0; ks < 2; ++ks) { const bf16x8 af = *(const bf16x8*)(qq + (tb * 16 + fr) * 72 + ks * 32 + fq * 8), bf = *(const bf16x8*)(kk + (sb * 16 + fr) * 72 + ks * 32 + fq * 8);
                                a = __builtin_amdgcn_mfma_f32_16x16x32_bf16(af, bf, a, 0, 0, 0); }
                            if (sb == tb) {
#pragma unroll
                                for (int r = 0; r < 4; ++r) if (fr > fq * 4 + r) a[r] = 0.f;
                            }
                        }
#pragma unroll
                        for (int r = 0; r < 4; ++r) sc[(tb * 16 + fq * 4 + r) * 72 + sb * 16 + fr] = (bf16_t)f2bf(a[r]);
                    }
                }
                __syncthreads();
                {
                    bf16x8 bS[2], bV[2];
                    const float* sp = glaS + (size_t)unit * 8192 + (size_t)(wave * 16 + fr) * 64 + fq * 8;
#pragma unroll
                    for (int ks = 0; ks < 2; ++ks) {
                        const f32x4 x0 = *(const f32x4*)(sp + ks * 32), x1 = *(const f32x4*)(sp + ks * 32 + 4);
                        const u32x4 p = (u32x4){pk2(x0[0], x0[1]), pk2(x0[2], x0[3]), pk2(x1[0], x1[1]), pk2(x1[2], x1[3])}; bS[ks] = __builtin_bit_cast(bf16x8, p);
                        float av[8];
#pragma unroll
                        for (int j = 0; j < 8; ++j) av[j] = vv[(ks * 32 + fq * 8 + j) * 129 + wave * 16 + fr];
                        const u32x4 pv = (u32x4){pk2(av[0], av[1]), pk2(av[2], av[3]), pk2(av[4], av[5]), pk2(av[6], av[7])}; bV[ks] = __builtin_bit_cast(bf16x8, pv);
                    }
                    f32x4 oa[4];
#pragma unroll
                    for (int tb = 0; tb < 4; ++tb) {
                        oa[tb] = (f32x4){0.f, 0.f, 0.f, 0.f};
#pragma unroll
                        for (int ks = 0; ks < 2; ++ks) {
                            const bf16x8 aq = *(const bf16x8*)(qq + (tb * 16 + fr) * 72 + ks * 32 + fq * 8), as = *(const bf16x8*)(sc + (tb * 16 + fr) * 72 + ks * 32 + fq * 8);
                            oa[tb] = __builtin_amdgcn_mfma_f32_16x16x32_bf16(aq, bS[ks], oa[tb], 0, 0, 0);
                            oa[tb] = __builtin_amdgcn_mfma_f32_16x16x32_bf16(as, bV[ks], oa[tb], 0, 0, 0);
                        }
                    }
#pragma unroll
                    for (int tb = 0; tb < 4; ++tb)
#pragma unroll
                        for (int r = 0; r < 4; ++r) { float q2 = oa[tb][r] * oa[tb][r]; q2 += __shfl_xor(q2, 1); q2 += __shfl_xor(q2, 2); q2 += __shfl_xor(q2, 4); q2 += __shfl_xor(q2, 8);
                            if (fr == 0) red[(tb * 16 + fq * 4 + r) * 8 + wave] = q2; }
                    __syncthreads();
                    const float gcol = g_gla_out[wave * 16 + fr];
#pragma unroll
                    for (int tb = 0; tb < 4; ++tb)
#pragma unroll
                        for (int r = 0; r < 4; ++r) { const int t = tb * 16 + fq * 4 + r; const f32x4 s0 = *(const f32x4*)(red + t * 8), s1 = *(const f32x4*)(red + t * 8 + 4);
                            const float rs = rsqrtf((((s0[0] + s0[1]) + (s0[2] + s0[3])) + ((s1[0] + s1[1]) + (s1[2] + s1[3]))) * (1.f / 128.f) + EPS);
                            const float rv = bf2f(Pb[(r0 + t) * NINP + PC_R + h * 128 + wave * 16 + fr]);
                            mix[(r0 + t) * D + h * 128 + wave * 16 + fr] = (bf16_t)f2bf(oa[tb][r] * rs * gcol * siluf(rv)); }
                }
                __syncthreads();
            }
        }
        SUBREP(20)
        for (int it = gw; it < 136 * 32; it += NGW) {
            const int rb = it >> 5, g = it & 31, fr = lane & 15, fq = lane >> 4; const int R0 = rb * 16;
            f32x4 acc[8];
#pragma unroll
            for (int nb = 0; nb < 8; ++nb) acc[nb] = (f32x4){0.f, 0.f, 0.f, 0.f};
#pragma unroll 1
            for (int ks = 0; ks < 8; ++ks) {
                bf16x8 a;
                if (ks < 4) a = *(const bf16x8*)(s5x + ((size_t)(R0 + fr) * 32 + g) * 128 + ks * 32 + fq * 8);
                else a = *(const bf16x8*)(Pb + ((size_t)(R0 + fr) * 8 + (ks - 4) * 2 + (fq >> 1)) * NINP + PC_U + g * 16 + (fq & 1) * 8);
#pragma unroll
                for (int nb = 0; nb < 8; ++nb) { const bf16x8 bfr = *(const bf16x8*)(GTt + (size_t)(g * 128 + nb * 16 + fr) * 256 + ks * 32 + fq * 8);
                    acc[nb] = __builtin_amdgcn_mfma_f32_16x16x32_bf16(bfr, a, acc[nb], 0, 0, 0); }
            }
            bf16x4 wA;
#pragma unroll
            for (int i = 0; i < 4; ++i) wA[i] = (short)f2bf(s5_wglu[(g * 16 + fq * 4 + i) * 16 + fr]);
            const f32x4 dsk = *(const f32x4*)(s5_d + g * 16 + fq * 4), bgl = *(const f32x4*)(s5_bglu + g * 16 + fq * 4);
#pragma unroll
            for (int nb = 0; nb < 8; ++nb) {
                const size_t row = (size_t)(R0 + fr) * 8 + nb;
                const u32x2 uw = *(const u32x2*)(Pb + row * NINP + PC_U + g * 16 + fq * 4);
                f32x4 z;
                z[0] = gelu_tanh(acc[nb][0] + dsk[0] * bflo(uw.x)); z[1] = gelu_tanh(acc[nb][1] + dsk[1] * bfhi(uw.x));
                z[2] = gelu_tanh(acc[nb][2] + dsk[2] * bflo(uw.y)); z[3] = gelu_tanh(acc[nb][3] + dsk[3] * bfhi(uw.y));
                const u32x2 zp = (u32x2){pk2(z[0], z[1]), pk2(z[2], z[3])};
                const f32x4 pre = __builtin_amdgcn_mfma_f32_16x16x16bf16_1k(wA, __builtin_bit_cast(bf16x4, zp), bgl, 0, 0, 0);
                u32x2 o; o.x = pk2(z[0] * sigmoidf_fast(pre[0]), z[1] * sigmoidf_fast(pre[1])); o.y = pk2(z[2] * sigmoidf_fast(pre[2]), z[3] * sigmoidf_fast(pre[3]));
                *(u32x2*)(mix + row * D + 512 + g * 16 + fq * 4) = o;
            }
        }
    }
    SEAM(6);

    PHASE_G(7) {
        pg8::Gemm g{mix, Wout, MP, D, D}; pg8::StaticOrder S; S.init(MP, D, G, bx);
        pg8::EpiResid<false> E{hb, hb, nullptr, ssq + SSQ_H2, 1.f};
        pg8::gemm_phase<pg8::EpiResid<false>, pg8::StaticOrder, true, true>(ldsl, g, S, E);
        SEpiResid<false> SE{hb, hb, nullptr, ssq + SSQ_H2, 1.f};
        small_gemm(mix + (size_t)MP * D, Wout, D, fl, G, bx, wave, tid0, SE);
    }
    SEAM(7);
    PHASE_G(8) {
        pg8::Gemm g{hb, Wcq, MP, D, D}; pg8::StaticOrder S; S.init(MP, D, G, bx, GREP(8));
        pg8::EpiScaleBf16 E{qb, D, ssq + SSQ_H2, 0.0625f};
        pg8::gemm_phase<pg8::EpiScaleBf16, pg8::StaticOrder, true, true>(ldsl, g, S, E);
        SEpiScaleBf16 SE{qb, ssq + SSQ_H2, 0.0625f};
        SUBREP(22)
        small_gemm(hb + (size_t)MP * D, Wcq, D, fl, G, bx, wave, tid0, SE);
    }
    SEAM(8);

    PHASE(9) {
        REP_SYNC();
        PHASE_LOCALS;
        constexpr int QS = 264;
        bf16_t* Qs = (bf16_t*)lds; bf16_t* Ps = Qs + 64 * QS; float* redmax = (float*)(Ps + 64 * QS); float* redsum = redmax + 64 * 8;
        const int fr = lane & 15, fq = lane >> 4, w = wave;
        for (int unit = bx; unit < 1024 + 512; unit += G) {
            const bool smp = unit >= 1024;
            int b, h; size_t r0; int nrows;
            if (!smp) { const int qt = unit & 31; h = (unit >> 5) & 3; b = unit >> 7; r0 = (size_t)b * 2048 + qt * 64; nrows = 64; }
            else { const int u2 = unit - 1024; h = u2 & 3; b = u2 >> 2; r0 = (size_t)MP + b * 8; nrows = 8; }
            const int MB = smp ? 1 : 4;
            for (int ch = tid; ch < MB * 16 * 32; ch += NTHREADS) { const int row = ch >> 5, c8 = ch & 31; u32x4 v = (u32x4){0u, 0u, 0u, 0u};
                if (row < nrows) v = *(const u32x4*)(qb + (r0 + row) * D + h * 256 + c8 * 8);
                *(u32x4*)(Qs + row * QS + c8 * 8) = v; }
            __syncthreads();
            f32x4 sa[4][2];
#pragma unroll
            for (int mb = 0; mb < 4; ++mb) { sa[mb][0] = (f32x4){0.f, 0.f, 0.f, 0.f}; sa[mb][1] = sa[mb][0]; }
            if (!smp) {
                const bf16_t* kbase = kb + ((size_t)b * 256 + w * 32 + fr) * D + h * 256 + fq * 8;
#pragma unroll
                for (int ks = 0; ks < 8; ++ks) {
                    const bf16x8 b0 = *(const bf16x8*)(kbase + ks * 32), b1 = *(const bf16x8*)(kbase + (size_t)16 * D + ks * 32);
#pragma unroll
                    for (int mb = 0; mb < 4; ++mb) { const bf16x8 a = *(const bf16x8*)(Qs + (mb * 16 + fr) * QS + ks * 32 + fq * 8);
                        sa[mb][0] = __builtin_amdgcn_mfma_f32_16x16x32_bf16(a, b0, sa[mb][0], 0, 0, 0); sa[mb][1] = __builtin_amdgcn_mfma_f32_16x16x32_bf16(a, b1, sa[mb][1], 0, 0, 0); }
                }
            } else {
                const float* kbase = cache_k + ((size_t)b * 256 + w * 32 + fr) * D + h * 256 + fq * 8;
#pragma unroll
                for (int ks = 0; ks < 8; ++ks) {
                    u32x4 p0, p1;
                    { const f32x4 x0 = *(const f32x4*)(kbase + ks * 32), x1 = *(const f32x4*)(kbase + ks * 32 + 4); p0 = (u32x4){pk2(x0[0], x0[1]), pk2(x0[2], x0[3]), pk2(x1[0], x1[1]), pk2(x1[2], x1[3])}; }
                    { const f32x4 x0 = *(const f32x4*)(kbase + (size_t)16 * D + ks * 32), x1 = *(const f32x4*)(kbase + (size_t)16 * D + ks * 32 + 4); p1 = (u32x4){pk2(x0[0], x0[1]), pk2(x0[2], x0[3]), pk2(x1[0], x1[1]), pk2(x1[2], x1[3])}; }
                    const bf16x8 a = *(const bf16x8*)(Qs + fr * QS + ks * 32 + fq * 8);
                    sa[0][0] = __builtin_amdgcn_mfma_f32_16x16x32_bf16(a, __builtin_bit_cast(bf16x8, p0), sa[0][0], 0, 0, 0);
                    sa[0][1] = __builtin_amdgcn_mfma_f32_16x16x32_bf16(a, __builtin_bit_cast(bf16x8, p1), sa[0][1], 0, 0, 0);
                }
            }
#pragma unroll
            for (int mb = 0; mb < 4; ++mb) if (mb < MB) {
#pragma unroll
                for (int r = 0; r < 4; ++r) { float mx = fmaxf(sa[mb][0][r], sa[mb][1][r]);
                    mx = fmaxf(mx, __shfl_xor(mx, 1)); mx = fmaxf(mx, __shfl_xor(mx, 2)); mx = fmaxf(mx, __shfl_xor(mx, 4)); mx = fmaxf(mx, __shfl_xor(mx, 8));
                    if (fr == 0) redmax[(mb * 16 + fq * 4 + r) * 8 + w] = mx; }
            }
            __syncthreads();
#pragma unroll
            for (int mb = 0; mb < 4; ++mb) if (mb < MB) {
#pragma unroll
                for (int r = 0; r < 4; ++r) { const int q = mb * 16 + fq * 4 + r; const f32x4 m0 = *(const f32x4*)(redmax + q * 8), m1 = *(const f32x4*)(redmax + q * 8 + 4);
                    const float mx = fmaxf(fmaxf(fmaxf(m0[0], m0[1]), fmaxf(m0[2], m0[3])), fmaxf(fmaxf(m1[0], m1[1]), fmaxf(m1[2], m1[3])));
                    const float p0 = __expf(sa[mb][0][r] - mx), p1 = __expf(sa[mb][1][r] - mx);
                    Ps[q * QS + w * 32 + fr] = (bf16_t)f2bf(p0); Ps[q * QS + w * 32 + 16 + fr] = (bf16_t)f2bf(p1);
                    float sm = p0 + p1; sm += __shfl_xor(sm, 1); sm += __shfl_xor(sm, 2); sm += __shfl_xor(sm, 4); sm += __shfl_xor(sm, 8);
                    if (fr == 0) redsum[q * 8 + w] = sm; }
            }
            __syncthreads();
            f32x4 oa[4][2];
#pragma unroll
            for (int mb = 0; mb < 4; ++mb) { oa[mb][0] = (f32x4){0.f, 0.f, 0.f, 0.f}; oa[mb][1] = oa[mb][0]; }
            if (!smp) {
                const bf16_t* vbase = vbT + ((size_t)b * D + h * 256 + w * 32 + fr) * 256 + fq * 8;
#pragma unroll
                for (int ks = 0; ks < 8; ++ks) {
                    const bf16x8 b0 = *(const bf16x8*)(vbase + ks * 32), b1 = *(const bf16x8*)(vbase + 16 * 256 + ks * 32);
#pragma unroll
                    for (int mb = 0; mb < 4; ++mb) { const bf16x8 a = *(const bf16x8*)(Ps + (mb * 16 + fr) * QS + ks * 32 + fq * 8);
                        oa[mb][0] = __builtin_amdgcn_mfma_f32_16x16x32_bf16(a, b0, oa[mb][0], 0, 0, 0); oa[mb][1] = __builtin_amdgcn_mfma_f32_16x16x32_bf16(a, b1, oa[mb][1], 0, 0, 0); }
                }
            } else {
                const float* vbase = cache_v + ((size_t)b * 256 + fq * 8) * D + h * 256 + w * 32 + fr;
#pragma unroll
                for (int ks = 0; ks < 8; ++ks) {
                    float x0[8], x1[8];
#pragma unroll
                    for (int j = 0; j < 8; ++j) { x0[j] = vbase[(size_t)(ks * 32 + j) * D]; x1[j] = vbase[(size_t)(ks * 32 + j) * D + 16]; }
                    const u32x4 p0 = (u32x4){pk2(x0[0], x0[1]), pk2(x0[2], x0[3]), pk2(x0[4], x0[5]), pk2(x0[6], x0[7])};
                    const u32x4 p1 = (u32x4){pk2(x1[0], x1[1]), pk2(x1[2], x1[3]), pk2(x1[4], x1[5]), pk2(x1[6], x1[7])};
                    const bf16x8 a = *(const bf16x8*)(Ps + fr * QS + ks * 32 + fq * 8);
                    oa[0][0] = __builtin_amdgcn_mfma_f32_16x16x32_bf16(a, __builtin_bit_cast(bf16x8, p0), oa[0][0], 0, 0, 0);
                    oa[0][1] = __builtin_amdgcn_mfma_f32_16x16x32_bf16(a, __builtin_bit_cast(bf16x8, p1), oa[0][1], 0, 0, 0);
                }
            }
#pragma unroll
            for (int mb = 0; mb < 4; ++mb) if (mb < MB) {
#pragma unroll
                for (int r = 0; r < 4; ++r) { const int q = mb * 16 + fq * 4 + r; if (q < nrows) {
                    const f32x4 s0 = *(const f32x4*)(redsum + q * 8), s1 = *(const f32x4*)(redsum + q * 8 + 4);
                    const float inv = 1.f / (((s0[0] + s0[1]) + (s0[2] + s0[3])) + ((s1[0] + s1[1]) + (s1[2] + s1[3])));
                    bf16_t* op = ob + (r0 + q) * D + h * 256 + w * 32 + fr;
                    op[0] = (bf16_t)f2bf(oa[mb][0][r] * inv); op[16] = (bf16_t)f2bf(oa[mb][1][r] * inv); } }
            }
            __syncthreads();
        }
    }
    SEAM(9);

    PHASE_G(10) {
        pg8::Gemm g{ob, Wco, MP, D, D}; pg8::StaticOrder S; S.init(MP, D, G, bx);
        pg8::EpiResid<false> E{hb, hb, nullptr, ssq + SSQ_H3, 1.f};
        pg8::gemm_phase<pg8::EpiResid<false>, pg8::StaticOrder, true, true>(ldsl, g, S, E);
        SEpiResid<false> SE{hb, hb, nullptr, ssq + SSQ_H3, 1.f};
        small_gemm(ob + (size_t)MP * D, Wco, D, fl, G, bx, wave, tid0, SE);
    }
    SEAM(10);
    PHASE_G(11) {
        pg8::Gemm g{hb, Wgu2, M, NGU, D}; pg8::StaticOrder S; S.init(M, NGU, G, bx, GREP(11));
        pg8::EpiSwiGLU E{act, FF, ssq + SSQ_H3};
        pg8::gemm_phase<pg8::EpiSwiGLU, pg8::StaticOrder, true, true>(ldsl, g, S, E);
    }
    SEAM(11);
    PHASE_G(12) {
        pg8::Gemm g{act, Wd2, MP, D, FF}; pg8::StaticOrder S; S.init(MP, D, G, bx, GREP(12));
        pg8::EpiResid<true> E{hb, nullptr, hres, nullptr, 0.5f};
        pg8::gemm_phase<pg8::EpiResid<true>, pg8::StaticOrder, true, true>(ldsl, g, S, E);
        SEpiResid<true> SE{hb, nullptr, hres, nullptr, 0.5f};
        SUBREP(21)
        small_gemm(act + (size_t)MP * FF, Wd2, FF, fl, G, bx, wave, tid0, SE);
    }
    SEAM(12);
    PHASE(13) {
        REP_SYNC();
        PHASE_LOCALS;
        for (int m = gw; m < M; m += NGW) {
            f32x4* yr = (f32x4*)(out + O_Y + (size_t)m * D) + lane; const f32x4* hr = (const f32x4*)(hres + (size_t)m * D) + lane; f32x4 v[4]; float s = 0.f;
#pragma unroll
            for (int j = 0; j < 4; ++j) { v[j] = hr[64 * j]; s += (v[j].x * v[j].x + v[j].y * v[j].y) + (v[j].z * v[j].z + v[j].w * v[j].w); }
            const float rs = rsqrtf(wave_sum(s) * (1.f / D) + EPS);
#pragma unroll
            for (int j = 0; j < 4; ++j) { const f32x4 gq = ((const f32x4*)g_final)[lane + 64 * j]; yr[64 * j] = v[j] * rs * gq; }
        }
    }
#undef IN
#undef SEAM
}

extern "C" void kernel_launch(void* const* d_in, const int* in_sizes, int n_in, void* d_out, int out_size, void* d_ws, size_t ws_size, hipStream_t stream) {
    static int grid = 0;
    if (grid == 0) {
        if (n_in != 36 || (size_t)out_size != O_TOTAL || ws_size < WS_END) { fprintf(stderr, "kernel_launch: unexpected shapes (n_in %d, out %d, ws %zu)\n", n_in, out_size, ws_size); grid = -1; return; }
        int dev = 0, cus = 0, per_cu = 0;
        hipGetDevice(&dev); hipDeviceGetAttribute(&cus, hipDeviceAttributeMultiprocessorCount, dev);
        hipFuncSetAttribute((const void*)hymba_fwd, hipFuncAttributeMaxDynamicSharedMemorySize, LDS_BYTES);
        hipOccupancyMaxActiveBlocksPerMultiprocessor(&per_cu, (const void*)hymba_fwd, NTHREADS, LDS_BYTES);
        if (per_cu < 1) { fprintf(stderr, "kernel_launch: occupancy query says %d blocks per CU\n", per_cu); per_cu = 1; }
        grid = cus;
        (void)hipGetLastError();
    }
    if (grid < 0) return;
    if (hipMemsetAsync((char*)d_ws + WS_BAR, 0, BAR_BYTES, stream) != hipSuccess) { fprintf(stderr, "kernel_launch: memset failed\n"); return; }
    Args a{};
    for (int i = 0; i < 36; ++i) a.in[i] = (const float*)d_in[i];
    a.out = (float*)d_out; a.ws = (unsigned char*)d_ws; a.ph_lo = 0; a.ph_hi = 14;
    void* params[] = {&a};
    hipError_t e = hipLaunchCooperativeKernel((const void*)hymba_fwd, dim3(grid), dim3(NTHREADS), params, LDS_BYTES, stream);
    if (e != hipSuccess) fprintf(stderr, "kernel_launch: cooperative launch failed: %s (grid %d)\n", hipGetErrorString(e), grid);
}
```

```cpp
#include <hip/hip_runtime.h>
#include <hip/hip_cooperative_groups.h>
#include <cstdio>
#include <cstdint>
namespace cg = cooperative_groups;

constexpr int D = 1024, MP = 16384, MS = 1024, M = MP + MS, FF = 2816, NGU = 2 * FF, NIN = 2064, NINP = 2304;
constexpr int MEMR = 2048;
constexpr float EPS = 1e-6f;
constexpr int PC_Q = 0, PC_K = 256, PC_V = 512, PC_R = 1024, PC_U = 1536, PC_ZG = 2048;
constexpr size_t O_Y = 0, O_GLAP = 17825792, O_REP = 18087936, O_IMP = 18104320, O_MKP = 18120704, O_MVP = 20217856,
                 O_GLAS = 22315008, O_RES = 26509312, O_IMS = 26771456, O_TOTAL = 27033600;
constexpr size_t MiB = 1u << 20;
constexpr int XCD_BAR_WORDS_C = 3456;
constexpr size_t WS_SSQ = 0;
constexpr size_t WS_WGU1 = 1 * MiB, WS_WD1 = 12 * MiB, WS_WIN = 18 * MiB, WS_WOUT = 23 * MiB, WS_WCQ = 25 * MiB, WS_WCKV = 27 * MiB,
                 WS_WCO = 31 * MiB, WS_WGU2 = 33 * MiB, WS_WD2 = 44 * MiB, WS_EGT = 50 * MiB, WS_GTT = 51 * MiB, WS_MEMB = 53 * MiB,
                 WS_KB = 57 * MiB, WS_VBT = 61 * MiB, WS_XB = 65 * MiB, WS_HB = 99 * MiB, WS_H = 133 * MiB, WS_ACT = 201 * MiB,
                 WS_MIX = 295 * MiB, WS_Q = 329 * MiB, WS_O = 363 * MiB, WS_GLAD = 397 * MiB, WS_GLADEC = 429 * MiB, WS_S5E = 430 * MiB,
                 WS_S5X = 464 * MiB, WS_END = 481 * MiB;
constexpr int SSQ_X = 0, SSQ_MEM = M, SSQ_H1 = M + 2048, SSQ_H2 = 2 * M + 2048, SSQ_H3 = 3 * M + 2048, SSQ_WORDS = 4 * M + 2048;
static_assert((size_t)SSQ_WORDS * 4 <= MiB, "ssq region");
static_assert(WS_XB + (size_t)1024 * 8192 * 4 <= WS_HB, "glaS over xb");
static_assert(WS_ACT + (size_t)M * FF * 2 <= WS_MIX && WS_ACT + (size_t)M * NINP * 2 <= WS_MIX, "act / P region");

constexpr size_t WS_BAR = 512 * 1024, BAR_BYTES = 16384;
static_assert((size_t)SSQ_WORDS * 4 <= WS_BAR && XCD_BAR_WORDS_C * 4 <= BAR_BYTES, "ctl map");
constexpr int NWAVES = 8, NTHREADS = 512;
constexpr int LDS_BYTES = 147456;
constexpr int LDS_BARST = LDS_BYTES - 64;

#define LAS __attribute__((address_space(3)))
typedef unsigned short bf16_t;
typedef short bf16x8 __attribute__((ext_vector_type(8)));
typedef short bf16x4 __attribute__((ext_vector_type(4)));
typedef float f32x4 __attribute__((ext_vector_type(4)));
typedef float f32x2 __attribute__((ext_vector_type(2)));
typedef unsigned u32x4 __attribute__((ext_vector_type(4)));
typedef unsigned u32x2 __attribute__((ext_vector_type(2)));
#define DI __device__ __forceinline__

DI unsigned f2bf(float f) { unsigned u = __builtin_bit_cast(unsigned, f); return (u + 0x7fffu + ((u >> 16) & 1u)) >> 16; }
DI unsigned pk2(float lo, float hi) { return f2bf(lo) | (f2bf(hi) << 16); }
DI float bf2f(unsigned b) { return __builtin_bit_cast(float, b << 16); }
DI float bflo(unsigned w) { return __builtin_bit_cast(float, w << 16); }
DI float bfhi(unsigned w) { return __builtin_bit_cast(float, w & 0xffff0000u); }
DI float wave_sum(float v) {
#pragma unroll
    for (int o = 1; o < 64; o <<= 1) v += __shfl_xor(v, o);
    return v;
}
DI float sigmoidf_fast(float x) { return __builtin_amdgcn_rcpf(1.f + __expf(-x)); }
DI float siluf(float x) { return x * sigmoidf_fast(x); }
DI float logsigmoidf(float x) { return fminf(x, 0.f) - log1pf(__expf(-fabsf(x))); }
DI float gelu_tanh(float y) { const float a = 0.7978845608028654f * (y + 0.044715f * y * y * y); const float e = __expf(2.f * a); const float th = 1.f - 2.f * __builtin_amdgcn_rcpf(e + 1.f); return 0.5f * y * (1.f + th); }

namespace pg8 {
#define PG8_LAS __attribute__((address_space(3)))
constexpr int BM = 256, BK = 64, HALF = 128, HTB = HALF * BK * 2  , STAGE_BYTES = 8 * HTB, NXCD = 8, WGM = 8;

__host__ __device__ __forceinline__ int lds_byte(int r, int c) { const int st = (r >> 4) * 2 + (c >> 5), rr = r & 15, cc = c & 31, ob = rr * 64 + cc * 2; return st * 1024 + (ob ^ (((ob >> 9) & 1) << 5)); }
__host__ __device__ __forceinline__ void stage_rc(int b, int& R, int& C) { const int st = b / 1024, sb = b % 1024, swz = sb ^ (((sb >> 9) & 1) << 5); R = (st >> 1) * 16 + swz / 64; C = (st & 1) * 32 + (swz % 64) / 2; }
__host__ __device__ __forceinline__ int perm32(int rho) { const int n = rho >> 4, i = rho & 15; return 8 * (i >> 2) + 4 * n + (i & 3); }

struct Unit { int pm, pn; };
struct Gemm { const bf16_t* A; const bf16_t* Bt; int M, N, K; };

struct StaticOrder {
    int nM, nN, nwg, G, c, rep;
    __host__ __device__ void init(int M_, int N_, int G_, int c_, int rep_ = 1) { nM = M_ / BM; nN = N_ / BM; nwg = nM * nN; G = G_; c = c_; rep = rep_; }
    __host__ __device__ bool next(int i, Unit& u) const {
        const long L = (long)i * G + c; if (L >= (long)nwg * rep) return false;
        int wgid = (int)(L % nwg); { const int q = nwg / NXCD, r = nwg % NXCD, xcd = wgid % NXCD, off = wgid / NXCD; wgid = (xcd < r ? xcd * (q + 1) : r * (q + 1) + (xcd - r) * q) + off; }
        const int nig = WGM * nN, gid = wgid / nig, fm = gid * WGM, gsz = (nM - fm) < WGM ? (nM - fm) : WGM;
        u.pm = fm + ((wgid % nig) % gsz); u.pn = (wgid % nig) / gsz; return true;
    }
    __device__ __forceinline__ void a_ready(const Unit&) const {}
    __device__ __forceinline__ void done(const Unit&) const {}
};

__device__ __forceinline__ unsigned cvt_pk_bf16(float lo, float hi) { unsigned r; asm volatile("v_cvt_pk_bf16_f32 %0, %1, %2" : "=v"(r) : "v"(lo), "v"(hi)); return r; }


struct EpiSwiGLU {
    static constexpr bool PERM = true, AFTER_DRAIN = false;
    bf16_t* O; int ldc; const float* ssq;
    __device__ __forceinline__ void operator()(const f32x4 (&acc)[2][2][4][2], const Unit& u, int wr, int wc, int fr, int fq) const {
        const int row0 = u.pm * BM + wr * 64 + fr, col0 = u.pn * HALF + wc * 32 + 8 * fq;
#pragma unroll
        for (int ai = 0; ai < 2; ++ai)
#pragma unroll
            for (int m = 0; m < 4; ++m) {
                const int row = row0 + ai * HALF + m * 16;
                const float rs = rsqrtf(ssq[row] * (1.f / D) + EPS);
                const f32x4 g0 = acc[ai][0][m][0] * rs, g1 = acc[ai][0][m][1] * rs, u0 = acc[ai][1][m][0] * rs, u1 = acc[ai][1][m][1] * rs;
                u32x4 w;
                w.x = cvt_pk_bf16(siluf(g0[0]) * u0[0], siluf(g0[1]) * u0[1]); w.y = cvt_pk_bf16(siluf(g0[2]) * u0[2], siluf(g0[3]) * u0[3]);
                w.z = cvt_pk_bf16(siluf(g1[0]) * u1[0], siluf(g1[1]) * u1[1]); w.w = cvt_pk_bf16(siluf(g1[2]) * u1[2], siluf(g1[3]) * u1[3]);
                *(u32x4*)(O + (size_t)row * ldc + col0) = w;
            }
    }
};
template <bool OUT_F32> struct EpiResid {
    static constexpr bool PERM = true, AFTER_DRAIN = false;
    const bf16_t* base; bf16_t* hbo; float* outf; float* ssq; float alpha;
    __device__ __forceinline__ void operator()(const f32x4 (&acc)[2][2][4][2], const Unit& u, int wr, int wc, int fr, int fq) const {
        const int row0 = u.pm * BM + wr * 64 + fr, col0 = u.pn * BM + wc * 32 + 8 * fq;
#pragma unroll
        for (int ai = 0; ai < 2; ++ai)
#pragma unroll
            for (int m = 0; m < 4; ++m) {
                const int row = row0 + ai * HALF + m * 16;
                float s = 0.f;
#pragma unroll
                for (int bj = 0; bj < 2; ++bj) {
                    const int c = col0 + bj * HALF;
                    const u32x4 bw = *(const u32x4*)(base + (size_t)row * D + c);
                    f32x4 v0 = acc[ai][bj][m][0] * alpha, v1 = acc[ai][bj][m][1] * alpha;
                    v0[0] += bflo(bw.x); v0[1] += bfhi(bw.x); v0[2] += bflo(bw.y); v0[3] += bfhi(bw.y); v1[0] += bflo(bw.z); v1[1] += bfhi(bw.z); v1[2] += bflo(bw.w); v1[3] += bfhi(bw.w);
                    if constexpr (OUT_F32) { *(f32x4*)(outf + (size_t)row * D + c) = v0; *(f32x4*)(outf + (size_t)row * D + c + 4) = v1; }
                    else {
                        s += ((v0[0] * v0[0] + v0[1] * v0[1]) + (v0[2] * v0[2] + v0[3] * v0[3])) + ((v1[0] * v1[0] + v1[1] * v1[1]) + (v1[2] * v1[2] + v1[3] * v1[3]));
                        u32x4 w; w.x = cvt_pk_bf16(v0[0], v0[1]); w.y = cvt_pk_bf16(v0[2], v0[3]); w.z = cvt_pk_bf16(v1[0], v1[1]); w.w = cvt_pk_bf16(v1[2], v1[3]);
                        *(u32x4*)(hbo + (size_t)row * D + c) = w;
                    }
                }
                if constexpr (!OUT_F32) { s += __shfl_xor(s, 16); s += __shfl_xor(s, 32); if (fq == 0) atomicAdd(ssq + row, s); }
            }
    }
};
struct EpiScaleBf16 {
    static constexpr bool PERM = true, AFTER_DRAIN = false;
    bf16_t* O; int ldc; const float* ssq; float scale;
    __device__ __forceinline__ void operator()(const f32x4 (&acc)[2][2][4][2], const Unit& u, int wr, int wc, int fr, int fq) const {
        const int row0 = u.pm * BM + wr * 64 + fr, col0 = u.pn * BM + wc * 32 + 8 * fq;
#pragma unroll
        for (int ai = 0; ai < 2; ++ai)
#pragma unroll
            for (int m = 0; m < 4; ++m) {
                const int row = row0 + ai * HALF + m * 16;
                const float rs = rsqrtf(ssq[row] * (1.f / D) + EPS) * scale;
#pragma unroll
                for (int bj = 0; bj < 2; ++bj) {
                    const f32x4 v0 = acc[ai][bj][m][0] * rs, v1 = acc[ai][bj][m][1] * rs;
                    u32x4 w; w.x = cvt_pk_bf16(v0[0], v0[1]); w.y = cvt_pk_bf16(v0[2], v0[3]); w.z = cvt_pk_bf16(v1[0], v1[1]); w.w = cvt_pk_bf16(v1[2], v1[3]);
                    *(u32x4*)(O + (size_t)row * ldc + col0 + bj * HALF) = w;
                }
            }
    }
};
struct EpiMemKV {
    static constexpr bool PERM = false, AFTER_DRAIN = false;
    float* outK; float* outV; bf16_t* kb; bf16_t* vbT; const float* ssq;
    __device__ __forceinline__ void operator()(const f32x4 (&acc)[2][2][4][2], const Unit& u, int wr, int wc, int fr, int fq) const {
        const int row0 = u.pm * BM + wr * 64 + fr; const bool isV = u.pn >= 4; const int col0 = (u.pn & 3) * BM + wc * 32 + 4 * fq;
        float* outp = isV ? outV : outK;
#pragma unroll
        for (int ai = 0; ai < 2; ++ai)
#pragma unroll
            for (int m = 0; m < 4; ++m) {
                const int row = row0 + ai * HALF + m * 16;
                const float rs = rsqrtf(ssq[row] * (1.f / D) + EPS);
                const int b = row >> 8, key = row & 255;
#pragma unroll
                for (int bj = 0; bj < 2; ++bj)
#pragma unroll
                    for (int n = 0; n < 2; ++n) {
                        const int c = col0 + bj * HALF + n * 16;
                        const f32x4 v = acc[ai][bj][m][n] * rs;
                        *(f32x4*)(outp + (size_t)row * D + c) = v;
                        if (!isV) { u32x2 w; w.x = cvt_pk_bf16(v[0], v[1]); w.y = cvt_pk_bf16(v[2], v[3]); *(u32x2*)(kb + (size_t)row * D + c) = w; }
                        else {
#pragma unroll
                            for (int i = 0; i < 4; ++i) vbT[((size_t)b * D + c + i) * 256 + key] = (bf16_t)f2bf(v[i]);
                        }
                    }
            }
    }
};

template <class Epi, class Sched, bool ALIGN_EPI = false, bool SP2 = false>
__device__ __forceinline__ void gemm_phase(PG8_LAS unsigned char* lds, const Gemm g, const Sched& S, const Epi& E) {
    const int tid = threadIdx.x, wid = __builtin_amdgcn_readfirstlane(tid >> 6), lane = tid & 63, wr = wid >> 2, wc = wid & 3, fr = lane & 15, fq = lane >> 4;
    const int K = g.K, nt = K / BK;
    unsigned voffA[2], voffB[2];
#pragma unroll
    for (int i = 0; i < 2; ++i) { int R, C; stage_rc(tid * 16 + i * 8192, R, C); const int Rb = Epi::PERM ? ((R & ~31) + perm32(R & 31)) : R;
        voffA[i] = (unsigned)(R * K + C) * 2u; voffB[i] = (unsigned)(Rb * K + C) * 2u; }
    const size_t kstep = (size_t)(BK * 2);
    const size_t hstep = (size_t)HALF * K * 2;
    const size_t tstep = 2 * hstep;
    const unsigned ldsw = (unsigned)wid * 1024u;
    const int aoff = lds_byte(wr * 64 + fr, fq * 8), boff = lds_byte(wc * 32 + fr, fq * 8);
#define PG8_SA(b, h) (((b) * 2 + (h)) * HTB)
#define PG8_SB(b, h) ((4 + (b) * 2 + (h)) * HTB)
#define PG8_STAGE(bufoff, gbase, voff) do { _Pragma("unroll") for (int _i = 0; _i < 2; ++_i) \
        __builtin_amdgcn_global_load_lds((const unsigned*)((const char*)(gbase) + (voff)[_i]), (PG8_LAS unsigned*)(lds + (bufoff) + ldsw + _i * 8192), 16, 0, 0); } while (0)
#define PG8_LDA(dst, b, h) do { _Pragma("unroll") for (int m = 0; m < 4; ++m) _Pragma("unroll") for (int k = 0; k < 2; ++k) dst[m][k] = *(const PG8_LAS bf16x8*)(lds + PG8_SA(b, h) + aoff + m * 2048 + k * 1024); } while (0)
#define PG8_LDB(dst, b, h) do { _Pragma("unroll") for (int n = 0; n < 2; ++n) _Pragma("unroll") for (int k = 0; k < 2; ++k) dst[n][k] = *(const PG8_LAS bf16x8*)(lds + PG8_SB(b, h) + boff + n * 2048 + k * 1024); } while (0)
#define PG8_MMA(ai, bj, At, Bt) do { __builtin_amdgcn_s_setprio(1); _Pragma("unroll") for (int m = 0; m < 4; ++m) _Pragma("unroll") for (int n = 0; n < 2; ++n) _Pragma("unroll") for (int k = 0; k < 2; ++k) \
        acc[ai][bj][m][n] = __builtin_amdgcn_mfma_f32_16x16x32_bf16(Bt[n][k], At[m][k], acc[ai][bj][m][n], 0, 0, 0); __builtin_amdgcn_s_setprio(0); } while (0)
#define PG8_WAIT_V(n) asm volatile("s_waitcnt vmcnt(" #n ")" ::: "memory")
#define PG8_WAIT_L(n) asm volatile("s_waitcnt lgkmcnt(" #n ")" ::: "memory")
#define PG8_BAR __builtin_amdgcn_s_barrier()
#define PG8_SCHED __builtin_amdgcn_sched_barrier(0)
    Unit cur, nxt; int ui = 0;
    if (!S.next(0, cur)) return;
    f32x4 acc[2][2][4][2];
#pragma unroll
    for (int a = 0; a < 2; ++a)
#pragma unroll
        for (int b = 0; b < 2; ++b)
#pragma unroll
            for (int m = 0; m < 4; ++m)
#pragma unroll
                for (int n = 0; n < 2; ++n) acc[a][b][m][n] = (f32x4){0.f, 0.f, 0.f, 0.f};
    bf16x8 At[4][2], B0[2][2], B1[2][2];
    const char* cA = (const char*)g.A + (size_t)cur.pm * tstep; const char* cB = (const char*)g.Bt + (size_t)cur.pn * tstep;
    S.a_ready(cur);
    if constexpr (SP2) {
        PG8_STAGE(PG8_SB(0, 0), cB, voffB); PG8_STAGE(PG8_SB(0, 1), cB + hstep, voffB); PG8_STAGE(PG8_SA(0, 0), cA, voffA); PG8_STAGE(PG8_SA(0, 1), cA + hstep, voffA);
        if (wr == 1) PG8_BAR;
        PG8_WAIT_V(2); PG8_BAR;
        PG8_STAGE(PG8_SB(1, 0), cB + kstep, voffB); PG8_STAGE(PG8_SA(1, 0), cA + kstep, voffA); PG8_STAGE(PG8_SB(1, 1), cB + hstep + kstep, voffB);
        PG8_WAIT_V(6); PG8_BAR;
    } else {
        PG8_STAGE(PG8_SB(0, 0), cB, voffB); PG8_STAGE(PG8_SA(0, 0), cA, voffA); PG8_STAGE(PG8_SB(0, 1), cB + hstep, voffB); PG8_STAGE(PG8_SA(0, 1), cA + hstep, voffA);
        if (wr == 1) PG8_BAR;
        PG8_WAIT_V(4); PG8_BAR;
        PG8_STAGE(PG8_SB(1, 0), cB + kstep, voffB); PG8_STAGE(PG8_SA(1, 0), cA + kstep, voffA); PG8_STAGE(PG8_SB(1, 1), cB + hstep + kstep, voffB);
        PG8_WAIT_V(6); PG8_BAR;
    }
    for (;;) {
        const bool has_next = S.next(ui + 1, nxt);
        const char* nA = has_next ? (const char*)g.A + (size_t)nxt.pm * tstep : cA; const char* nB = has_next ? (const char*)g.Bt + (size_t)nxt.pn * tstep : cB;
        for (int t = 0; t < nt; t += 2) {
            const bool last = (t == nt - 2);
            const char* a1 = cA + (size_t)(t + 1) * kstep;
            const char* a2 = last ? nA : cA + (size_t)(t + 2) * kstep; const char* b2 = last ? nB : cB + (size_t)(t + 2) * kstep;
            const char* a3 = a2 + kstep; const char* b3 = b2 + kstep;
            if (last && has_next) S.a_ready(nxt);
            if constexpr (SP2) {
            PG8_LDB(B0, 0, 0); PG8_LDB(B1, 0, 1); PG8_SCHED; PG8_LDA(At, 0, 0); PG8_STAGE(PG8_SA(1, 1), a1 + hstep, voffA);
            PG8_WAIT_V(8); PG8_WAIT_L(0); PG8_BAR; PG8_MMA(0, 0, At, B0); PG8_MMA(0, 1, At, B1); PG8_BAR; PG8_SCHED;
            PG8_LDA(At, 0, 1); PG8_STAGE(PG8_SB(0, 0), b2, voffB); PG8_STAGE(PG8_SB(0, 1), b2 + hstep, voffB); PG8_STAGE(PG8_SA(0, 0), a2, voffA);
            PG8_WAIT_V(8); PG8_WAIT_L(0); PG8_BAR; PG8_MMA(1, 0, At, B0); PG8_MMA(1, 1, At, B1); PG8_BAR; PG8_SCHED;
            PG8_LDB(B0, 1, 0); PG8_LDB(B1, 1, 1); PG8_SCHED; PG8_LDA(At, 1, 0); PG8_STAGE(PG8_SA(0, 1), a2 + hstep, voffA);
            PG8_WAIT_V(8); PG8_WAIT_L(0); PG8_BAR; PG8_MMA(0, 0, At, B0); PG8_MMA(0, 1, At, B1); PG8_BAR; PG8_SCHED;
            PG8_LDA(At, 1, 1); PG8_STAGE(PG8_SB(1, 0), b3, voffB); PG8_STAGE(PG8_SB(1, 1), b3 + hstep, voffB); PG8_STAGE(PG8_SA(1, 0), a3, voffA);
            PG8_WAIT_V(8); PG8_WAIT_L(0); PG8_BAR; PG8_MMA(1, 0, At, B0); PG8_MMA(1, 1, At, B1); PG8_BAR; PG8_SCHED;
            } else {
            PG8_LDB(B0, 0, 0); PG8_SCHED; PG8_LDA(At, 0, 0); PG8_STAGE(PG8_SA(1, 1), a1 + hstep, voffA);
            PG8_WAIT_L(8); PG8_BAR; PG8_WAIT_L(0); PG8_MMA(0, 0, At, B0); PG8_BAR; PG8_SCHED;
            PG8_LDB(B1, 0, 1); PG8_STAGE(PG8_SB(0, 0), b2, voffB);
            PG8_BAR; PG8_WAIT_L(0); PG8_MMA(0, 1, At, B1); PG8_BAR;
            PG8_LDA(At, 0, 1); PG8_STAGE(PG8_SA(0, 0), a2, voffA);
            PG8_BAR; PG8_WAIT_L(0); PG8_MMA(1, 0, At, B0); PG8_BAR; PG8_SCHED;
            PG8_STAGE(PG8_SB(0, 1), b2 + hstep, voffB);
            PG8_WAIT_V(6); PG8_BAR; PG8_MMA(1, 1, At, B1); PG8_BAR;
            PG8_LDB(B0, 1, 0); PG8_SCHED; PG8_LDA(At, 1, 0); PG8_STAGE(PG8_SA(0, 1), a2 + hstep, voffA);
            PG8_WAIT_L(8); PG8_BAR; PG8_WAIT_L(0); PG8_MMA(0, 0, At, B0); PG8_BAR; PG8_SCHED;
            PG8_LDB(B1, 1, 1); PG8_STAGE(PG8_SB(1, 0), b3, voffB);
            PG8_BAR; PG8_WAIT_L(0); PG8_MMA(0, 1, At, B1); PG8_BAR;
            PG8_LDA(At, 1, 1); PG8_STAGE(PG8_SA(1, 0), a3, voffA);
            PG8_BAR; PG8_WAIT_L(0); PG8_MMA(1, 0, At, B0); PG8_BAR; PG8_SCHED;
            PG8_STAGE(PG8_SB(1, 1), b3 + hstep, voffB);
            PG8_WAIT_V(6); PG8_BAR; PG8_MMA(1, 1, At, B1); PG8_BAR;
            }
        }
        if constexpr (ALIGN_EPI) { if (wr == 0) PG8_BAR; }
        if constexpr (!Epi::AFTER_DRAIN) { E(acc, cur, wr, wc, fr, fq); S.done(cur); }
        if (!has_next) break;
#pragma unroll
        for (int a = 0; a < 2; ++a)
#pragma unroll
            for (int b = 0; b < 2; ++b)
#pragma unroll
                for (int m = 0; m < 4; ++m)
#pragma unroll
                    for (int n = 0; n < 2; ++n) acc[a][b][m][n] = (f32x4){0.f, 0.f, 0.f, 0.f};
        cur = nxt; cA = nA; cB = nB; ++ui;
        if constexpr (ALIGN_EPI) { if (wr == 1) PG8_BAR; }
    }
    PG8_WAIT_V(0);
    if constexpr (!ALIGN_EPI) { if (wr == 0) PG8_BAR; }
    PG8_BAR;
#undef PG8_SA
#undef PG8_SB
#undef PG8_STAGE
#undef PG8_LDA
#undef PG8_LDB
#undef PG8_MMA
#undef PG8_WAIT_V
#undef PG8_WAIT_L
#undef PG8_BAR
#undef PG8_SCHED
}
}


#define XB_TMO      128
#define XB_XCNT(j)  (256  + 64 * (j))
#define XB_XSUB(j)  (1280 + 64 * (j))
#define XB_XGEN(j)  (2304 + 64 * (j))
#define XB_TOP      3328
#define XB_TOPGEN   3392
#define XCD_BAR_WORDS 3456
#define XB_SPIN_CAP (1u << 18)
__device__ __forceinline__ unsigned xb_ld(unsigned* p)              { return __hip_atomic_load(p, __ATOMIC_RELAXED, __HIP_MEMORY_SCOPE_AGENT); }
__device__ __forceinline__ unsigned xb_add(unsigned* p, unsigned v) { return __hip_atomic_fetch_add(p, v, __ATOMIC_RELAXED, __HIP_MEMORY_SCOPE_AGENT); }
__device__ __forceinline__ unsigned xb_xcc_id() { return (unsigned)__builtin_amdgcn_s_getreg((3 << 11) | 20) & 0xFu; }
#define XB_SPIN(cond, bar) do { unsigned _sp = 0; while (cond) { __builtin_amdgcn_s_sleep(1); \
    if ((++_sp & 255u) == 0u) { if (xb_ld(&(bar)[XB_TMO])) break; if (_sp > XB_SPIN_CAP) { atomicAdd(&(bar)[XB_TMO], 1u); break; } } } } while (0)
struct XcdBarrier { unsigned* bar; unsigned x; volatile LAS unsigned* st; };
__device__ __forceinline__ XcdBarrier xcd_barrier_post(unsigned* bar, volatile LAS unsigned* st) {
    XcdBarrier b; b.bar = bar; b.x = xb_xcc_id(); b.st = st;
    if (threadIdx.x == 0) (void)xb_add(&bar[XB_XCNT(b.x)], 1u);
    return b;
}
__device__ __forceinline__ void xcd_barrier_complete(unsigned* bar, unsigned x, unsigned& nloc, unsigned& nx) {
    const unsigned G = gridDim.x * gridDim.y * gridDim.z;
    unsigned sum, cnt, mine, sp = 0u;
    for (;;) {
        sum = 0u; cnt = 0u; mine = 0u;
#pragma unroll
        for (unsigned j = 0; j < 16; ++j) { const unsigned c = xb_ld(&bar[XB_XCNT(j)]); sum += c; cnt += (c > 0u) ? 1u : 0u; mine = (j == x) ? c : mine; }
        if (sum == G) break;
        __builtin_amdgcn_s_sleep(1);
        if ((++sp & 255u) == 0u) { if (xb_ld(&bar[XB_TMO])) break; if (sp > XB_SPIN_CAP) { atomicAdd(&bar[XB_TMO], 1u); break; } }
    }
    nloc = mine > 0u ? mine : 1u; nx = cnt > 0u ? cnt : 1u;
}
__device__ __forceinline__ void xcd_barrier(const XcdBarrier& b) {
    asm volatile("s_waitcnt vmcnt(0)" ::: "memory");
    __syncthreads();
    if (threadIdx.x == 0) {
        unsigned* bar = b.bar;
        __builtin_amdgcn_s_waitcnt(0);
        unsigned nloc = b.st[0], nx = b.st[1];
        if (nloc == 0u) { xcd_barrier_complete(bar, b.x, nloc, nx); b.st[0] = nloc; b.st[1] = nx; }
        const unsigned old = xb_add(&bar[XB_XSUB(b.x)], 1u);
        const unsigned gen = old / nloc;
        if (old + 1u == (gen + 1u) * nloc) {
            __builtin_amdgcn_fence(__ATOMIC_RELEASE, "agent");
            asm volatile("s_waitcnt vmcnt(0)" ::: "memory");
            const unsigned og = xb_add(&bar[XB_TOP], 1u);
            const unsigned tg = og / nx;
            if (og + 1u == (tg + 1u) * nx) xb_add(&bar[XB_TOPGEN], 1u);
            else XB_SPIN(xb_ld(&bar[XB_TOPGEN]) == tg, bar);
            __builtin_amdgcn_fence(__ATOMIC_ACQUIRE, "agent");
            xb_add(&bar[XB_XGEN(b.x)], 1u);
            asm volatile("s_waitcnt vmcnt(0)" ::: "memory");
        } else {
            XB_SPIN(xb_ld(&bar[XB_XGEN(b.x)]) == gen, bar);
            __builtin_amdgcn_fence(__ATOMIC_ACQUIRE, "agent");
            asm volatile("s_waitcnt vmcnt(0)" ::: "memory");
        }
    }
    __syncthreads();
}

struct Args { const float* in[36]; float* out; unsigned char* ws; int ph_lo, ph_hi; };
#define LDS_WAIT() asm volatile("s_waitcnt lgkmcnt(0)" ::: "memory")

DI int rowmap(int mode, int n) {
    if (mode == 1) { const int j = n < FF ? n : n - FF; return 256 * (j >> 7) + (n < FF ? 0 : 128) + (j & 127); }
    if (mode == 2) { if (n < 1024) return n; if (n < 1040) return n + 1024; return n - 16; }
    return n;
}
DI void p0_transpose_item(const float* W, const float* gain, int K, int N, bf16_t* WT, int mode, float* scr, int item, int lane) {
    const int nblk = (N + 31) / 32, kb = item / nblk, nb = item % nblk, k0 = 64 * kb, n0 = 32 * nb;
    const int nn = n0 + (lane & 31); const bool ok = nn < N;
#pragma unroll 8
    for (int i = 0; i < 32; ++i) { const int kk = 2 * i + (lane >> 5); float v = ok ? W[(size_t)(k0 + kk) * N + nn] : 0.f; if (gain) v *= gain[k0 + kk]; scr[kk * 33 + (lane & 31)] = v; }
    LDS_WAIT(); asm volatile("" ::: "memory");
    const int c = lane & 7;
#pragma unroll
    for (int j = 0; j < 4; ++j) { const int n = (lane >> 3) + 8 * j; const float* s = scr + (8 * c) * 33 + n;
        u32x4 o; o.x = pk2(s[0 * 33], s[1 * 33]); o.y = pk2(s[2 * 33], s[3 * 33]); o.z = pk2(s[4 * 33], s[5 * 33]); o.w = pk2(s[6 * 33], s[7 * 33]);
        if (n0 + n < N) *(u32x4*)(WT + (size_t)rowmap(mode, n0 + n) * K + k0 + 8 * c) = o; }
    LDS_WAIT(); asm volatile("" ::: "memory");
}
DI void row_to_bf16_ssq(const float* xrow, bf16_t* orow, float* ssq_slot, int lane) {
    const f32x4* xr = (const f32x4*)xrow + lane;
    f32x4 v[4]; float s = 0.f;
#pragma unroll
    for (int j = 0; j < 4; ++j) { v[j] = xr[64 * j]; s += (v[j].x * v[j].x + v[j].y * v[j].y) + (v[j].z * v[j].z + v[j].w * v[j].w); }
    s = wave_sum(s);
    unsigned long long* o8 = (unsigned long long*)orow + lane;
#pragma unroll
    for (int j = 0; j < 4; ++j) o8[64 * j] = (unsigned long long)pk2(v[j].x, v[j].y) | ((unsigned long long)pk2(v[j].z, v[j].w) << 32);
    if (lane == 0) *ssq_slot = s;
}
struct S5P { float dt, lr, li; };
DI S5P s5_par(const float* lre, const float* lim, const float* logdt, int g, int n) { S5P p; p.dt = expf(logdt[g]); p.lr = lre[g * 64 + n]; p.li = lim[g * 64 + n]; return p; }
DI f32x2 s5_pow(const S5P& p, int j) {
    const float mag = expf((float)j * (p.dt * p.lr)); float sn, cs; sincosf((float)j * (p.dt * p.li), &sn, &cs); return (f32x2){mag * cs, mag * sn};
}
DI f32x2 s5_coef(const S5P& p) {
    const f32x2 ab = s5_pow(p, 1); const float den = p.lr * p.lr + p.li * p.li;
    return (f32x2){((ab.x - 1.f) * p.lr + ab.y * p.li) / den, (ab.y * p.lr - (ab.x - 1.f) * p.li) / den};
}
DI f32x2 cmul(f32x2 a, f32x2 b) { return (f32x2){a.x * b.x - a.y * b.y, a.x * b.y + a.y * b.x}; }

template <int NT>
DI void gla_gate_cumsum(const float* zg, float* bb, float* seg, const float* wg, const float* bg, int h, int tid) {
    if constexpr (NT == 64) {
        const int d = tid & 63; float wr[16]; const float bias = bg[h * 64 + d];
#pragma unroll
        for (int r = 0; r < 16; ++r) wr[r] = wg[r * 256 + h * 64 + d];
#pragma unroll
        for (int k = 0; k < 8; ++k) { const int t = (tid >> 6) + 8 * k; const f32x4* zp = (const f32x4*)(zg + t * 16); float s = bias;
#pragma unroll
            for (int r4 = 0; r4 < 4; ++r4) { const f32x4 z = zp[r4]; s += z[0] * wr[r4 * 4] + z[1] * wr[r4 * 4 + 1] + z[2] * wr[r4 * 4 + 2] + z[3] * wr[r4 * 4 + 3]; }
            bb[t * 65 + d] = logsigmoidf(s) * (1.f / 16.f); }
    } else {
    for (int i = tid; i < NT * 64; i += NTHREADS) { const int t = i >> 6, d = i & 63; float s = bg[h * 64 + d];
#pragma unroll
        for (int r = 0; r < 16; ++r) s += zg[t * 16 + r] * wg[r * 256 + h * 64 + d];
        bb[t * 65 + d] = logsigmoidf(s) * (1.f / 16.f); }
    }
    __syncthreads();
    if constexpr (NT == 64) {
        const int d = tid & 63, sg = tid >> 6; float run = 0.f;
#pragma unroll
        for (int i = 0; i < 8; ++i) { run += bb[(sg * 8 + i) * 65 + d]; bb[(sg * 8 + i) * 65 + d] = run; }
        seg[sg * 64 + d] = run;
        __syncthreads();
        float pre = 0.f;
        for (int j = 0; j < sg; ++j) pre += seg[j * 64 + d];
#pragma unroll
        for (int i = 0; i < 8; ++i) bb[(sg * 8 + i) * 65 + d] += pre;
    } else {
        if (tid < 64) { float run = 0.f;
#pragma unroll
            for (int t = 0; t < NT; ++t) { run += bb[t * 65 + tid]; bb[t * 65 + tid] = run; } }
    }
    __syncthreads();
}


template <bool OUT_F32> struct SEpiResid {
    const bf16_t* base; bf16_t* hbo; float* outf; float* ssq; float alpha;
    DI void operator()(int row, int col, const f32x4& a0, const f32x4& a1, int tid) const {
        const u32x4 bw = *(const u32x4*)(base + (size_t)row * D + col);
        f32x4 v0 = a0 * alpha, v1 = a1 * alpha;
        v0[0] += bflo(bw.x); v0[1] += bfhi(bw.x); v0[2] += bflo(bw.y); v0[3] += bfhi(bw.y); v1[0] += bflo(bw.z); v1[1] += bfhi(bw.z); v1[2] += bflo(bw.w); v1[3] += bfhi(bw.w);
        if constexpr (OUT_F32) { *(f32x4*)(outf + (size_t)row * D + col) = v0; *(f32x4*)(outf + (size_t)row * D + col + 4) = v1; }
        else {
            u32x4 w; w.x = pk2(v0[0], v0[1]); w.y = pk2(v0[2], v0[3]); w.z = pk2(v1[0], v1[1]); w.w = pk2(v1[2], v1[3]); *(u32x4*)(hbo + (size_t)row * D + col) = w;
            float sq = (v0[0] * v0[0] + v0[1] * v0[1]) + (v0[2] * v0[2] + v0[3] * v0[3]) + (v1[0] * v1[0] + v1[1] * v1[1]) + (v1[2] * v1[2] + v1[3] * v1[3]);
            sq += __shfl_xor(sq, 1); sq += __shfl_xor(sq, 2); sq += __shfl_xor(sq, 4); if ((tid & 7) == 0) atomicAdd(ssq + row, sq);
        }
    }
};
struct SEpiScaleBf16 {
    bf16_t* O; const float* ssq; float scale;
    DI void operator()(int row, int col, const f32x4& a0, const f32x4& a1, int) const {
        const float rs = rsqrtf(ssq[row] * (1.f / D) + EPS) * scale; const f32x4 v0 = a0 * rs, v1 = a1 * rs;
        u32x4 w; w.x = pk2(v0[0], v0[1]); w.y = pk2(v0[2], v0[3]); w.z = pk2(v1[0], v1[1]); w.w = pk2(v1[2], v1[3]); *(u32x4*)(O + (size_t)row * D + col) = w;
    }
};
template <class F>
DI void small_gemm(const bf16_t* A, const bf16_t* Bt, int K, float* red, int G, int bx, int wave, int tid, const F& epi) {
    const int lane = tid & 63, fr = lane & 15, fq = lane >> 4, kw = K >> 3, nsteps = kw >> 5;
    for (int tile = bx; tile < 256; tile += G) {
        const int row0 = (tile >> 4) * 64, col0 = (tile & 15) * 64;
        f32x4 acc[4][4];
#pragma unroll
        for (int i = 0; i < 4; ++i)
#pragma unroll
            for (int j = 0; j < 4; ++j) acc[i][j] = (f32x4){0.f, 0.f, 0.f, 0.f};
        const bf16_t* ap = A + (size_t)(row0 + fr) * K + wave * kw + fq * 8;
        const bf16_t* bp = Bt + (size_t)(col0 + fr) * K + wave * kw + fq * 8;
#pragma unroll 2
        for (int st = 0; st < nsteps; ++st) {
            bf16x8 a[4], b[4];
#pragma unroll
            for (int i = 0; i < 4; ++i) { a[i] = *(const bf16x8*)(ap + (size_t)i * 16 * K + st * 32); b[i] = *(const bf16x8*)(bp + (size_t)i * 16 * K + st * 32); }
#pragma unroll
            for (int i = 0; i < 4; ++i)
#pragma unroll
                for (int j = 0; j < 4; ++j) acc[i][j] = __builtin_amdgcn_mfma_f32_16x16x32_bf16(a[i], b[j], acc[i][j], 0, 0, 0);
        }
        float* my = red + wave * (64 * 68);
#pragma unroll
        for (int i = 0; i < 4; ++i)
#pragma unroll
            for (int j = 0; j < 4; ++j)
#pragma unroll
                for (int r = 0; r < 4; ++r) my[(i * 16 + fq * 4 + r) * 68 + j * 16 + fr] = acc[i][j][r];
        __syncthreads();
        { const int row = tid >> 3, c8 = (tid & 7) * 8; f32x4 s0 = (f32x4){0.f, 0.f, 0.f, 0.f}, s1 = s0;
#pragma unroll
            for (int w = 0; w < 8; ++w) { const f32x4* p = (const f32x4*)(red + w * (64 * 68) + row * 68 + c8); s0 += p[0]; s1 += p[1]; }
            epi(MP + row0 + row, col0 + c8, s0, s1, tid); }
        __syncthreads();
    }
}

__global__ void __launch_bounds__(NTHREADS, 2) hymba_fwd(Args args) {
    extern __shared__ __attribute__((aligned(16))) unsigned char lds[];
    cg::grid_group grid = cg::this_grid();
    const int tid0 = threadIdx.x, wave = __builtin_amdgcn_readfirstlane(tid0 >> 6);
    const int G = gridDim.x, bx = blockIdx.x;
    const int gw = bx * NWAVES + wave, NGW = G * NWAVES;
    const int NGT = G * NTHREADS;
#define PHASE_LOCALS int tid_l_ = tid0; asm volatile("" : "+v"(tid_l_)); const int tid = tid_l_, lane = tid & 63, gt = bx * NTHREADS + tid; (void)lane; (void)gt
    unsigned char* ws = args.ws;
    float* out = args.out;
    float* fl = (float*)lds;
    LAS unsigned char* ldsl = (LAS unsigned char*)lds;

    const float* x_prompt = args.in[0]; const float* x_sample = args.in[1]; const float* state_gla = args.in[2];
    const float* st_re = args.in[3]; const float* st_im = args.in[4]; const float* cache_k = args.in[5]; const float* cache_v = args.in[6];
    const float* mem_prompt = args.in[7];
    const float* w_gate = args.in[13]; const float* b_gate = args.in[14]; const float* g_gla_out = args.in[15];
    const float* s5_lre = args.in[16]; const float* s5_lim = args.in[17]; const float* s5_logdt = args.in[18];
    const float* s5_bre = args.in[19]; const float* s5_bim = args.in[20]; const float* s5_cre = args.in[21]; const float* s5_cim = args.in[22];
    const float* s5_d = args.in[23]; const float* s5_wglu = args.in[24]; const float* s5_bglu = args.in[25];
    const float* g_final = args.in[35];

    float* ssq = (float*)(ws + WS_SSQ);
    bf16_t* Wgu1 = (bf16_t*)(ws + WS_WGU1); bf16_t* Wd1 = (bf16_t*)(ws + WS_WD1); bf16_t* Win = (bf16_t*)(ws + WS_WIN); bf16_t* Wout = (bf16_t*)(ws + WS_WOUT);
    bf16_t* Wcq = (bf16_t*)(ws + WS_WCQ); bf16_t* Wckv = (bf16_t*)(ws + WS_WCKV); bf16_t* Wco = (bf16_t*)(ws + WS_WCO); bf16_t* Wgu2 = (bf16_t*)(ws + WS_WGU2); bf16_t* Wd2 = (bf16_t*)(ws + WS_WD2);
    bf16_t* EgT = (bf16_t*)(ws + WS_EGT); bf16_t* GTt = (bf16_t*)(ws + WS_GTT);
    bf16_t* memb = (bf16_t*)(ws + WS_MEMB); bf16_t* kb = (bf16_t*)(ws + WS_KB); bf16_t* vbT = (bf16_t*)(ws + WS_VBT);
    bf16_t* xb = (bf16_t*)(ws + WS_XB); bf16_t* hb = (bf16_t*)(ws + WS_HB); float* hres = (float*)(ws + WS_H);
    bf16_t* act = (bf16_t*)(ws + WS_ACT); bf16_t* Pb = (bf16_t*)(ws + WS_ACT);
    bf16_t* mix = (bf16_t*)(ws + WS_MIX); bf16_t* qb = (bf16_t*)(ws + WS_Q); bf16_t* ob = (bf16_t*)(ws + WS_O);
    float* glaD = (float*)(ws + WS_GLAD); float* glaDec = (float*)(ws + WS_GLADEC); float* glaS = (float*)(ws + WS_XB);
    float* s5e = (float*)(ws + WS_S5E); bf16_t* s5x = (bf16_t*)(ws + WS_S5X);

    const int lo = args.ph_lo, hi = args.ph_hi;
    if (tid0 < 16) ((LAS unsigned*)(ldsl + LDS_BARST))[tid0] = 0u;
    __syncthreads();
    const XcdBarrier xbar = xcd_barrier_post((unsigned*)(ws + WS_BAR), (volatile LAS unsigned*)(ldsl + LDS_BARST));
    if (lo < 0) grid.sync();
#ifndef PHASE_MASK
#define PHASE_MASK 0xffffffffu
#endif
#define IN(k) (((PHASE_MASK >> (k)) & 1u) && lo <= (k) && (k) < hi)
#ifndef REPEAT_MASK
#define REPEAT_MASK 0u
#endif
#define PHASE(k) if (IN(k)) for (int rep_ = 0; rep_ < 1 + (int)((REPEAT_MASK >> (k)) & 1u); ++rep_)
#define PHASE_G(k) if (IN(k))
#define GREP(k) (1 + (int)((REPEAT_MASK >> (k)) & 1u))
#define SUBREP(bit) for (int sr_ = 0; sr_ < 1 + (int)((REPEAT_MASK >> (bit)) & 1u); ++sr_)
#define REP_SYNC() do { if (rep_) xcd_barrier(xbar); } while (0)
#define SEAM(k) do { if (IN(k) && IN((k) + 1)) xcd_barrier(xbar); } while (0)

    PHASE(0) {
        REP_SYNC();
        PHASE_LOCALS;
        float* scr = fl + wave * (64 * 33);
        constexpr int I_GU = 16 * 176, I_D = 44 * 32, I_IN = 16 * 65, I_SQ = 16 * 32, I_CKV = 16 * 64;
        constexpr int NITEMS = 2 * I_GU + 2 * I_D + I_IN + 3 * I_SQ + I_CKV;
        for (int it = gw; it < NITEMS; it += NGW) {
            int r = it;
            if (r < I_GU) { p0_transpose_item(args.in[9], args.in[8], D, NGU, Wgu1, 1, scr, r, lane); continue; } r -= I_GU;
            if (r < I_GU) { p0_transpose_item(args.in[33], args.in[32], D, NGU, Wgu2, 1, scr, r, lane); continue; } r -= I_GU;
            if (r < I_D) { p0_transpose_item(args.in[10], nullptr, FF, D, Wd1, 0, scr, r, lane); continue; } r -= I_D;
            if (r < I_D) { p0_transpose_item(args.in[34], nullptr, FF, D, Wd2, 0, scr, r, lane); continue; } r -= I_D;
            if (r < I_IN) { p0_transpose_item(args.in[12], args.in[11], D, NIN, Win, 2, scr, r, lane); continue; } r -= I_IN;
            if (r < I_SQ) { p0_transpose_item(args.in[26], nullptr, D, D, Wout, 0, scr, r, lane); continue; } r -= I_SQ;
            if (r < I_SQ) { p0_transpose_item(args.in[29], args.in[27], D, D, Wcq, 0, scr, r, lane); continue; } r -= I_SQ;
            if (r < I_SQ) { p0_transpose_item(args.in[31], nullptr, D, D, Wco, 0, scr, r, lane); continue; } r -= I_SQ;
            p0_transpose_item(args.in[30], args.in[28], D, 2 * D, Wckv, 0, scr, r, lane);
        }
        for (int i = gt; i < (NINP - NIN) * D / 8; i += NGT) ((u32x4*)(Win + (size_t)NIN * D))[i] = (u32x4){0u, 0u, 0u, 0u};
        for (int i = gt; i < 3 * M; i += NGT) ssq[SSQ_H1 + i] = 0.f;
        for (int m = gw; m < M; m += NGW) { const float* xr = m < MP ? x_prompt + (size_t)m * D : x_sample + (size_t)(m - MP) * D; row_to_bf16_ssq(xr, xb + (size_t)m * D, ssq + SSQ_X + m, lane); }
        for (int m = gw; m < MEMR; m += NGW) row_to_bf16_ssq(mem_prompt + (size_t)m * D, memb + (size_t)m * D, ssq + SSQ_MEM + m, lane);
        for (int it = gt; it < 32 * 64 * 8; it += NGT) {
            const int g = it >> 9, n = (it >> 3) & 63, s = it & 7;
            const S5P p = s5_par(s5_lre, s5_lim, s5_logdt, g, n);
            const f32x2 mm = cmul(s5_pow(p, 7 - s), s5_coef(p));
            unsigned wre[8], wim[8];
#pragma unroll
            for (int pp = 0; pp < 8; ++pp) {
                const f32x2 b0 = (f32x2){s5_bre[(g * 64 + n) * 16 + 2 * pp], s5_bim[(g * 64 + n) * 16 + 2 * pp]}, b1 = (f32x2){s5_bre[(g * 64 + n) * 16 + 2 * pp + 1], s5_bim[(g * 64 + n) * 16 + 2 * pp + 1]};
                const f32x2 v0 = cmul(mm, b0), v1 = cmul(mm, b1);
                wre[pp] = pk2(v0.x, v1.x); wim[pp] = pk2(v0.y, v1.y);
            }
            u32x4* dre = (u32x4*)(EgT + ((size_t)(g * 128 + n) * 128 + s * 16)); u32x4* dim = (u32x4*)(EgT + ((size_t)(g * 128 + 64 + n) * 128 + s * 16));
            dre[0] = (u32x4){wre[0], wre[1], wre[2], wre[3]}; dre[1] = (u32x4){wre[4], wre[5], wre[6], wre[7]};
            dim[0] = (u32x4){wim[0], wim[1], wim[2], wim[3]}; dim[1] = (u32x4){wim[4], wim[5], wim[6], wim[7]};
        }
        for (int it = gt; it < 32 * 8 * 64; it += NGT) {
            const int g = it >> 9, t = (it >> 6) & 7, n = it & 63;
            const S5P p = s5_par(s5_lre, s5_lim, s5_logdt, g, n);
            const f32x2 pw = s5_pow(p, t + 1);
#pragma unroll
            for (int pp = 0; pp < 16; ++pp) {
                const f32x2 c = (f32x2){s5_cre[(g * 16 + pp) * 64 + n], s5_cim[(g * 16 + pp) * 64 + n]};
                const f32x2 v = cmul(c, pw);
                bf16_t* dst = GTt + (size_t)(g * 128 + t * 16 + pp) * 256;
                dst[n] = (bf16_t)f2bf(v.x); dst[64 + n] = (bf16_t)f2bf(-v.y);
            }
        }
        for (int it = gt; it < 32 * 8 * 8 * 16; it += NGT) {
            const int g = it >> 10, t = (it >> 7) & 7, s = (it >> 4) & 7, pp = it & 15;
            float a[16];
#pragma unroll
            for (int q = 0; q < 16; ++q) a[q] = 0.f;
            if (s <= t) {
                for (int n = 0; n < 64; ++n) {
                    const S5P p = s5_par(s5_lre, s5_lim, s5_logdt, g, n);
                    const f32x2 c = (f32x2){s5_cre[(g * 16 + pp) * 64 + n], s5_cim[(g * 16 + pp) * 64 + n]};
                    const f32x2 cc = cmul(cmul(c, s5_pow(p, t - s)), s5_coef(p));
                    const f32x4* br = (const f32x4*)(s5_bre + (g * 64 + n) * 16); const f32x4* bi = (const f32x4*)(s5_bim + (g * 64 + n) * 16);
#pragma unroll
                    for (int q4 = 0; q4 < 4; ++q4) { const f32x4 r4 = br[q4], i4 = bi[q4];
#pragma unroll
                        for (int e = 0; e < 4; ++e) a[q4 * 4 + e] += cc.x * r4[e] - cc.y * i4[e]; }
                }
            }
            u32x4* dst = (u32x4*)(GTt + (size_t)(g * 128 + t * 16 + pp) * 256 + 128 + s * 16);
            dst[0] = (u32x4){pk2(a[0], a[1]), pk2(a[2], a[3]), pk2(a[4], a[5]), pk2(a[6], a[7])};
            dst[1] = (u32x4){pk2(a[8], a[9]), pk2(a[10], a[11]), pk2(a[12], a[13]), pk2(a[14], a[15])};
        }
    }
    SEAM(0);

    for (int i_ = 0; i_ < 20 * (int)((REPEAT_MASK >> 23) & 1u); ++i_) xcd_barrier(xbar);
    PHASE_G(1) {
        pg8::Gemm g{xb, Wgu1, M, NGU, D}; pg8::StaticOrder S; S.init(M, NGU, G, bx, GREP(1));
        pg8::EpiSwiGLU E{act, FF, ssq + SSQ_X};
        pg8::gemm_phase<pg8::EpiSwiGLU, pg8::StaticOrder, true, true>(ldsl, g, S, E);
    }
    SEAM(1);
    PHASE_G(2) {
        pg8::Gemm g{act, Wd1, MP, D, FF}; pg8::StaticOrder S; S.init(MP, D, G, bx);
        pg8::EpiResid<false> E{xb, hb, nullptr, ssq + SSQ_H1, 0.5f};
        pg8::gemm_phase<pg8::EpiResid<false>, pg8::StaticOrder, true, true>(ldsl, g, S, E);
        SEpiResid<false> SE{xb, hb, nullptr, ssq + SSQ_H1, 0.5f};
        small_gemm(act + (size_t)MP * FF, Wd1, FF, fl, G, bx, wave, tid0, SE);
    }
    SEAM(2);
    PHASE_G(3) {
        { pg8::Gemm g{hb, Win, M, NINP, D}; pg8::StaticOrder S; S.init(M, NINP, G, bx, GREP(3));
          pg8::EpiScaleBf16 E{Pb, NINP, ssq + SSQ_H1, 1.f};
          pg8::gemm_phase<pg8::EpiScaleBf16, pg8::StaticOrder, true, true>(ldsl, g, S, E); }
        { pg8::Gemm g{memb, Wckv, MEMR, 2 * D, D}; pg8::StaticOrder S; S.init(MEMR, 2 * D, G, (bx + 64) % G);
          pg8::EpiMemKV E{out + O_MKP, out + O_MVP, kb, vbT, ssq + SSQ_MEM};
          pg8::gemm_phase<pg8::EpiMemKV, pg8::StaticOrder, true, true>(ldsl, g, S, E); }
    }
    SEAM(3);

    PHASE(4) {
        REP_SYNC();
        PHASE_LOCALS;
        SUBREP(16)
        {
            float* zg = fl; float* kk = zg + 64 * 16; float* vv = kk + 64 * 65; float* bb = vv + 64 * 129; float* seg = bb + 64 * 65;
            const int fr = lane & 15, fq = lane >> 4;
            for (int unit = bx; unit < 1024; unit += G) {
                const int bh = unit >> 5, c = unit & 31, b = bh >> 2, h = bh & 3;
                const size_t r0 = (size_t)b * 2048 + c * 64;
                if (tid < 128) { const int t = tid >> 1, hf = tid & 1; const u32x4 w = *(const u32x4*)(Pb + (r0 + t) * NINP + PC_ZG + hf * 8);
                    float* z = zg + t * 16 + hf * 8; z[0] = bflo(w.x); z[1] = bfhi(w.x); z[2] = bflo(w.y); z[3] = bfhi(w.y); z[4] = bflo(w.z); z[5] = bfhi(w.z); z[6] = bflo(w.w); z[7] = bfhi(w.w); }
                const u32x4 kw = *(const u32x4*)(Pb + (r0 + (tid >> 3)) * NINP + PC_K + h * 64 + (tid & 7) * 8);
#pragma unroll
                for (int i = 0; i < 2; ++i) { const int ch = tid + i * 512, t = ch >> 4, c8 = ch & 15; const u32x4 w = *(const u32x4*)(Pb + (r0 + t) * NINP + PC_V + h * 128 + c8 * 8);
                    float* z = vv + t * 129 + c8 * 8; z[0] = bflo(w.x); z[1] = bfhi(w.x); z[2] = bflo(w.y); z[3] = bfhi(w.y); z[4] = bflo(w.z); z[5] = bfhi(w.z); z[6] = bflo(w.w); z[7] = bfhi(w.w); }
                __syncthreads();
                gla_gate_cumsum<64>(zg, bb, seg, w_gate, b_gate, h, tid);
                { const int t = tid >> 3, d0 = (tid & 7) * 8; float* z = kk + t * 65 + d0; const float* bl = bb + 63 * 65 + d0; const float* bt = bb + t * 65 + d0;
                    z[0] = bflo(kw.x) * __expf(bl[0] - bt[0]); z[1] = bfhi(kw.x) * __expf(bl[1] - bt[1]); z[2] = bflo(kw.y) * __expf(bl[2] - bt[2]); z[3] = bfhi(kw.y) * __expf(bl[3] - bt[3]);
                    z[4] = bflo(kw.z) * __expf(bl[4] - bt[4]); z[5] = bfhi(kw.z) * __expf(bl[5] - bt[5]); z[6] = bflo(kw.w) * __expf(bl[6] - bt[6]); z[7] = bfhi(kw.w) * __expf(bl[7] - bt[7]); }
                __syncthreads();
                {
                    f32x4 acc[4];
#pragma unroll
                    for (int db = 0; db < 4; ++db) acc[db] = (f32x4){0.f, 0.f, 0.f, 0.f};
#pragma unroll
                    for (int ks = 0; ks < 2; ++ks) {
                        float av[8];
#pragma unroll
                        for (int j = 0; j < 8; ++j) av[j] = vv[(ks * 32 + fq * 8 + j) * 129 + wave * 16 + fr];
                        const u32x4 ap = (u32x4){pk2(av[0], av[1]), pk2(av[2], av[3]), pk2(av[4], av[5]), pk2(av[6], av[7])};
#pragma unroll
                        for (int db = 0; db < 4; ++db) {
                            float bv[8];
#pragma unroll
                            for (int j = 0; j < 8; ++j) bv[j] = kk[(ks * 32 + fq * 8 + j) * 65 + db * 16 + fr];
                            const u32x4 bp = (u32x4){pk2(bv[0], bv[1]), pk2(bv[2], bv[3]), pk2(bv[4], bv[5]), pk2(bv[6], bv[7])};
                            acc[db] = __builtin_amdgcn_mfma_f32_16x16x32_bf16(__builtin_bit_cast(bf16x8, ap), __builtin_bit_cast(bf16x8, bp), acc[db], 0, 0, 0);
                        }
                    }
                    float* dp = glaD + (size_t)unit * 8192;
#pragma unroll
                    for (int db = 0; db < 4; ++db)
#pragma unroll
                        for (int r = 0; r < 4; ++r) dp[(wave * 16 + fq * 4 + r) * 64 + db * 16 + fr] = acc[db][r];
                }
                if (tid < 64) glaDec[unit * 64 + tid] = __expf(bb[63 * 65 + tid]);
                __syncthreads();
            }
        }
        SUBREP(17)
        {
            float* zg = fl; float* qq = zg + 8 * 16; float* kk = qq + 8 * 65; float* kt = kk + 8 * 65; float* vv = kt + 8 * 65; float* bb = vv + 8 * 128; float* sc = bb + 8 * 65; float* S0 = sc + 64;
            for (int unit = bx; unit < 512; unit += G) {
                const int b = unit >> 2, h = unit & 3; const size_t r0 = (size_t)MP + b * 8;
                if (tid < 128) { const int t = tid >> 4, r = tid & 15; zg[t * 16 + r] = bf2f(Pb[(r0 + t) * NINP + PC_ZG + r]); }
                { const int t = tid >> 6, d = tid & 63; qq[t * 65 + d] = bf2f(Pb[(r0 + t) * NINP + PC_Q + h * 64 + d]); kk[t * 65 + d] = bf2f(Pb[(r0 + t) * NINP + PC_K + h * 64 + d]); }
#pragma unroll
                for (int i = 0; i < 2; ++i) { const int idx = tid + i * 512, t = idx >> 7, e = idx & 127; vv[t * 128 + e] = bf2f(Pb[(r0 + t) * NINP + PC_V + h * 128 + e]); }
                { const f32x4* sp = (const f32x4*)(state_gla + (size_t)unit * 8192); f32x4* dp = (f32x4*)S0;
#pragma unroll
                    for (int i = 0; i < 4; ++i) dp[tid + i * 512] = sp[tid + i * 512]; }
                __syncthreads();
                gla_gate_cumsum<8>(zg, bb, nullptr, w_gate, b_gate, h, tid);
                { const int t = tid >> 6, d = tid & 63; const float bt = bb[t * 65 + d], b7 = bb[7 * 65 + d]; const float kv = kk[t * 65 + d];
                    qq[t * 65 + d] *= __expf(bt) * 0.125f; kk[t * 65 + d] = kv * __expf(-bt); kt[t * 65 + d] = kv * __expf(b7 - bt); }
                __syncthreads();
                if (tid < 64) { const int t = tid >> 3, s = tid & 7; float a = 0.f; if (s <= t) { for (int d = 0; d < 64; ++d) a += qq[t * 65 + d] * kk[s * 65 + d]; } sc[t * 8 + s] = a; }
                __syncthreads();
                {
                    const int t = wave, e0 = lane * 2; float o0 = 0.f, o1 = 0.f;
                    for (int d = 0; d < 64; ++d) { const float qd = qq[t * 65 + d]; o0 += qd * S0[d * 128 + e0]; o1 += qd * S0[d * 128 + e0 + 1]; }
                    for (int s = 0; s <= t; ++s) { const float w = sc[t * 8 + s]; o0 += w * vv[s * 128 + e0]; o1 += w * vv[s * 128 + e0 + 1]; }
                    const float ss = wave_sum(o0 * o0 + o1 * o1); const float rs = rsqrtf(ss * (1.f / 128.f) + EPS);
                    const unsigned rw = *(const unsigned*)(Pb + (r0 + t) * NINP + PC_R + h * 128 + e0);
                    const float y0 = o0 * rs * g_gla_out[e0] * siluf(bflo(rw)), y1 = o1 * rs * g_gla_out[e0 + 1] * siluf(bfhi(rw));
                    *(unsigned*)(mix + (r0 + t) * D + h * 128 + e0) = pk2(y0, y1);
                }
                {
                    const int d = tid >> 3, e0 = (tid & 7) * 16; const float dec = __expf(bb[7 * 65 + d]);
                    f32x4 a[4];
#pragma unroll
                    for (int i = 0; i < 4; ++i) a[i] = ((const f32x4*)(S0 + d * 128 + e0))[i] * dec;
#pragma unroll
                    for (int s = 0; s < 8; ++s) { const float kd = kt[s * 65 + d]; const f32x4* vp = (const f32x4*)(vv + s * 128 + e0);
#pragma unroll
                        for (int i = 0; i < 4; ++i) a[i] += vp[i] * kd; }
                    f32x4* dp = (f32x4*)(out + O_GLAS + (size_t)unit * 8192 + d * 128 + e0);
#pragma unroll
                    for (int i = 0; i < 4; ++i) dp[i] = a[i];
                }
                __syncthreads();
            }
        }
        SUBREP(18)
        for (int p = bx; p < 256; p += G) {
            const int g = p & 31, fr = lane & 15, fq = lane >> 4;
            bf16_t* Es = (bf16_t*)lds;
            for (int ch = tid; ch < 128 * 16; ch += NTHREADS) { const int row = ch >> 4, c8 = ch & 15; *(u32x4*)(Es + row * 136 + c8 * 8) = *(const u32x4*)(EgT + (size_t)(g * 128 + row) * 128 + c8 * 8); }
            __syncthreads();
            for (int rb = (p >> 5) + 8 * wave; rb < 136; rb += 64) {
                const int R0 = rb * 16;
                bf16x8 a[4];
#pragma unroll
                for (int ks = 0; ks < 4; ++ks) a[ks] = *(const bf16x8*)(Pb + ((size_t)(R0 + fr) * 8 + ks * 2 + (fq >> 1)) * NINP + PC_U + g * 16 + (fq & 1) * 8);
                f32x4 acc[8];
#pragma unroll
                for (int nb = 0; nb < 8; ++nb) acc[nb] = (f32x4){0.f, 0.f, 0.f, 0.f};
#pragma unroll
                for (int ks = 0; ks < 4; ++ks)
                {
#pragma unroll
                    for (int nb = 0; nb < 8; ++nb) { const bf16x8 bfr = *(const bf16x8*)(Es + (nb * 16 + fr) * 136 + ks * 32 + fq * 8);
                        acc[nb] = __builtin_amdgcn_mfma_f32_16x16x32_bf16(a[ks], bfr, acc[nb], 0, 0, 0); }
                    __builtin_amdgcn_sched_barrier(0); }
#pragma unroll
                for (int nb = 0; nb < 8; ++nb)
#pragma unroll
                    for (int r = 0; r < 4; ++r) s5e[((size_t)(R0 + fq * 4 + r) * 32 + g) * 128 + nb * 16 + fr] = acc[nb][r];
            }
            __syncthreads();
        }
    }
    SEAM(4);

    PHASE(5) {
        REP_SYNC();
        PHASE_LOCALS;
        for (int idx = gt; idx < 32 * 8192; idx += NGT) {
            const int bh = idx >> 13, de = idx & 8191, d = de & 63, e = de >> 6;
            float Dv[32], dc[32];
#pragma unroll
            for (int c = 0; c < 32; ++c) { const int unit = bh * 32 + c; Dv[c] = glaD[(size_t)unit * 8192 + de]; dc[c] = glaDec[unit * 64 + d]; }
            float S = 0.f;
#pragma unroll
            for (int c = 0; c < 32; ++c) { glaS[(size_t)(bh * 32 + c) * 8192 + de] = S; S = dc[c] * S + Dv[c]; }
            out[O_GLAP + (size_t)bh * 8192 + d * 128 + e] = S;
        }
        for (int it = bx; it < 256; it += G) {
            const int b = it >> 5, g = it & 31, n = tid & 63, sgm = wave;
            const S5P p = s5_par(s5_lre, s5_lim, s5_logdt, g, n); const f32x2 a8 = s5_pow(p, 8);
            f32x2 a256 = a8;
#pragma unroll
            for (int i = 0; i < 5; ++i) a256 = cmul(a256, a256);
            float er[32], ei[32];
            const size_t o0 = (((size_t)b * 256 + sgm * 32) * 32 + g) * 128;
#pragma unroll
            for (int i = 0; i < 32; ++i) { er[i] = s5e[o0 + (size_t)i * 4096 + n]; ei[i] = s5e[o0 + (size_t)i * 4096 + 64 + n]; }
            float yr = 0.f, yi = 0.f;
#pragma unroll
            for (int i = 0; i < 32; ++i) { const float pr = yr, pi = yi; yr = a8.x * pr - a8.y * pi + er[i]; yi = a8.x * pi + a8.y * pr + ei[i]; er[i] = pr; ei[i] = pi; }
            fl[sgm * 64 + n] = yr; fl[512 + sgm * 64 + n] = yi;
            __syncthreads();
            float xr = 0.f, xi = 0.f;
            for (int j = 0; j < sgm; ++j) { const float tr = fl[j * 64 + n], ti = fl[512 + j * 64 + n]; const float nr = a256.x * xr - a256.y * xi + tr, ni = a256.x * xi + a256.y * xr + ti; xr = nr; xi = ni; }
            f32x2 pw = (f32x2){1.f, 0.f};
#pragma unroll
            for (int i = 0; i < 32; ++i) {
                s5x[o0 + (size_t)i * 4096 + n] = (bf16_t)f2bf(er[i] + pw.x * xr - pw.y * xi); s5x[o0 + (size_t)i * 4096 + 64 + n] = (bf16_t)f2bf(ei[i] + pw.x * xi + pw.y * xr);
                pw = cmul(pw, a8);
            }
            if (sgm == 7) { out[O_REP + (b * 32 + g) * 64 + n] = yr + a256.x * xr - a256.y * xi; out[O_IMP + (b * 32 + g) * 64 + n] = yi + a256.x * xi + a256.y * xr; }
            __syncthreads();
        }
        for (int idx = gt; idx < 128 * 32 * 64; idx += NGT) {
            const int b = idx >> 11, g = (idx >> 6) & 31, n = idx & 63;
            const S5P p = s5_par(s5_lre, s5_lim, s5_logdt, g, n); const f32x2 a8 = s5_pow(p, 8);
            const float xr = st_re[idx], xi = st_im[idx];
            const size_t R = 2048 + b; const size_t o = (R * 32 + g) * 128;
            s5x[o + n] = (bf16_t)f2bf(xr); s5x[o + 64 + n] = (bf16_t)f2bf(xi);
            out[O_RES + idx] = a8.x * xr - a8.y * xi + s5e[o + n]; out[O_IMS + idx] = a8.x * xi + a8.y * xr + s5e[o + 64 + n];
        }
    }
    SEAM(5);

    PHASE(6) {
        REP_SYNC();
        PHASE_LOCALS;
        SUBREP(19)
        {
            float* zg = fl; float* bb = zg + 64 * 16; float* seg = bb + 64 * 65; float* vv = seg + 512; float* red = vv + 64 * 129;
            bf16_t* qq = (bf16_t*)(red + 512); bf16_t* kk = qq + 64 * 72; bf16_t* sc = kk + 64 * 72;
            const int fr = lane & 15, fq = lane >> 4;
            for (int unit = bx; unit < 1024; unit += G) {
                const int bh = unit >> 5, c = unit & 31, b = bh >> 2, h = bh & 3;
                const size_t r0 = (size_t)b * 2048 + c * 64;
                if (tid < 128) { const int t = tid >> 1, hf = tid & 1; const u32x4 w = *(const u32x4*)(Pb + (r0 + t) * NINP + PC_ZG + hf * 8);
                    float* z = zg + t * 16 + hf * 8; z[0] = bflo(w.x); z[1] = bfhi(w.x); z[2] = bflo(w.y); z[3] = bfhi(w.y); z[4] = bflo(w.z); z[5] = bfhi(w.z); z[6] = bflo(w.w); z[7] = bfhi(w.w); }
                const u32x4 kw = *(const u32x4*)(Pb + (r0 + (tid >> 3)) * NINP + PC_K + h * 64 + (tid & 7) * 8);
                const u32x4 qw = *(const u32x4*)(Pb + (r0 + (tid >> 3)) * NINP + PC_Q + h * 64 + (tid & 7) * 8);
#pragma unroll
                for (int i = 0; i < 2; ++i) { const int ch = tid + i * 512, t = ch >> 4, c8 = ch & 15; const u32x4 w = *(const u32x4*)(Pb + (r0 + t) * NINP + PC_V + h * 128 + c8 * 8);
                    float* z = vv + t * 129 + c8 * 8; z[0] = bflo(w.x); z[1] = bfhi(w.x); z[2] = bflo(w.y); z[3] = bfhi(w.y); z[4] = bflo(w.z); z[5] = bfhi(w.z); z[6] = bflo(w.w); z[7] = bfhi(w.w); }
                __syncthreads();
                gla_gate_cumsum<64>(zg, bb, seg, w_gate, b_gate, h, tid);
                {
                    const int t = tid >> 3, d0 = (tid & 7) * 8; const float* bt = bb + t * 65 + d0;
                    float eb[8];
#pragma unroll
                    for (int j = 0; j < 8; ++j) eb[j] = __expf(bt[j]);
                    u32x4 qo, ko;
                    qo.x = pk2(bflo(qw.x) * eb[0] * 0.125f, bfhi(qw.x) * eb[1] * 0.125f); qo.y = pk2(bflo(qw.y) * eb[2] * 0.125f, bfhi(qw.y) * eb[3] * 0.125f);
                    qo.z = pk2(bflo(qw.z) * eb[4] * 0.125f, bfhi(qw.z) * eb[5] * 0.125f); qo.w = pk2(bflo(qw.w) * eb[6] * 0.125f, bfhi(qw.w) * eb[7] * 0.125f);
#pragma unroll
                    for (int j = 0; j < 8; ++j) eb[j] = __builtin_amdgcn_rcpf(eb[j]);
                    ko.x = pk2(bflo(kw.x) * eb[0], bfhi(kw.x) * eb[1]); ko.y = pk2(bflo(kw.y) * eb[2], bfhi(kw.y) * eb[3]);
                    ko.z = pk2(bflo(kw.z) * eb[4], bfhi(kw.z) * eb[5]); ko.w = pk2(bflo(kw.w) * eb[6], bfhi(kw.w) * eb[7]);
                    *(u32x4*)(qq + t * 72 + d0) = qo; *(u32x4*)(kk + t * 72 + d0) = ko;
                }
                __syncthreads();
                {
                    const int tb = wave >> 1;
#pragma unroll
                    for (int i = 0; i < 2; ++i) {
                        const int sb = (wave & 1) * 2 + i;
                        f32x4 a = (f32x4){0.f, 0.f, 0.f, 0.f};
                        if (sb <= tb) {
#pragma unroll
                            for (int ks = 0; ks < 2; ++ks) { const bf16x8 af = *(const bf16x8*)(qq + (tb * 16 + fr) * 72 + ks * 32 + fq * 8), bf = *(const bf16x8*)(kk + (sb * 16 + fr) * 72 + ks * 32 + fq * 8);
                                a = __builtin_amdgcn_mfma_f32_16x16x32_bf16(af, bf, a, 0, 0, 0); }
                            if (sb == tb) {
#pragma unroll
                                for (int r = 0; r < 4; ++r) if (fr > fq * 4 + r) a[r] = 0.f;
                            }
                        }
#pragma unroll
                        for (int r = 0; r < 4; ++r) sc[(tb * 16 + fq * 4 + r) * 72 + sb * 16 + fr] = (bf16_t)f2bf(a[r]);
                    }
                }
                __syncthreads();
                {
                    bf16x8 bS[2], bV[2];
                    const float* sp = glaS + (size_t)unit * 8192 + (size_t)(wave * 16 + fr) * 64 + fq * 8;
#pragma unroll
                    for (int ks = 0; ks < 2; ++ks) {
                        const f32x4 x0 = *(const f32x4*)(sp + ks * 32), x1 = *(const f32x4*)(sp + ks * 32 + 4);
                        const u32x4 p = (u32x4){pk2(x0[0], x0[1]), pk2(x0[2], x0[3]), pk2(x1[0], x1[1]), pk2(x1[2], x1[3])}; bS[ks] = __builtin_bit_cast(bf16x8, p);
                        float av[8];
#pragma unroll
                        for (int j = 0; j < 8; ++j) av[j] = vv[(ks * 32 + fq * 8 + j) * 129 + wave * 16 + fr];
                        const u32x4 pv = (u32x4){pk2(av[0], av[1]), pk2(av[2], av[3]), pk2(av[4], av[5]), pk2(av[6], av[7])}; bV[ks] = __builtin_bit_cast(bf16x8, pv);
                    }
                    f32x4 oa[4];
#pragma unroll
                    for (int tb = 0; tb < 4; ++tb) {
                        oa[tb] = (f32x4){0.f, 0.f, 0.f, 0.f};
#pragma unroll
                        for (int ks = 0; ks < 2; ++ks) {
                            const bf16x8 aq = *(const bf16x8*)(qq + (tb * 16 + fr) * 72 + ks * 32 + fq * 8), as = *(const bf16x8*)(sc + (tb * 16 + fr) * 72 + ks * 32 + fq * 8);
                            oa[tb] = __builtin_amdgcn_mfma_f32_16x16x32_bf16(aq, bS[ks], oa[tb], 0, 0, 0);
                            oa[tb] = __builtin_amdgcn_mfma_f32_16x16x32_bf16(as, bV[ks], oa[tb], 0, 0, 0);
                        }
                    }
#pragma unroll
                    for (int tb = 0; tb < 4; ++tb)
#pragma unroll
                        for (int r = 0; r < 4; ++r) { float q2 = oa[tb][r] * oa[tb][r]; q2 += __shfl_xor(q2, 1); q2 += __shfl_xor(q2, 2); q2 += __shfl_xor(q2, 4); q2 += __shfl_xor(q2, 8);
                            if (fr == 0) red[(tb * 16 + fq * 4 + r) * 8 + wave] = q2; }
                    __syncthreads();
                    const float gcol = g_gla_out[wave * 16 + fr];
#pragma unroll
                    for (int tb = 0; tb < 4; ++tb)
#pragma unroll
                        for (int r = 0; r < 4; ++r) { const int t = tb * 16 + fq * 4 + r; const f32x4 s0 = *(const f32x4*)(red + t * 8), s1 = *(const f32x4*)(red + t * 8 + 4);
                            const float rs = rsqrtf((((s0[0] + s0[1]) + (s0[2] + s0[3])) + ((s1[0] + s1[1]) + (s1[2] + s1[3]))) * (1.f / 128.f) + EPS);
                            const float rv = bf2f(Pb[(r0 + t) * NINP + PC_R + h * 128 + wave * 16 + fr]);
                            mix[(r0 + t) * D + h * 128 + wave * 16 + fr] = (bf16_t)f2bf(oa[tb][r] * rs * gcol * siluf(rv)); }
                }
                __syncthreads();
            }
        }
        SUBREP(20)
        for (int p = bx; p < 256; p += G) {
            const int g = p & 31, fr = lane & 15, fq = lane >> 4;
            bf16_t* Gs = (bf16_t*)lds;
            for (int ch = tid; ch < 128 * 32; ch += NTHREADS) { const int row = ch >> 5, c8 = ch & 31; *(u32x4*)(Gs + row * 264 + c8 * 8) = *(const u32x4*)(GTt + (size_t)(g * 128 + row) * 256 + c8 * 8); }
            bf16x4 wA;
#pragma unroll
            for (int i = 0; i < 4; ++i) wA[i] = (short)f2bf(s5_wglu[(g * 16 + fq * 4 + i) * 16 + fr]);
            const f32x4 dsk = *(const f32x4*)(s5_d + g * 16 + fq * 4), bgl = *(const f32x4*)(s5_bglu + g * 16 + fq * 4);
            __syncthreads();
            for (int rb = (p >> 5) + 8 * wave; rb < 136; rb += 64) {
                const int R0 = rb * 16;
                bf16x8 a[8];
#pragma unroll
                for (int ks = 0; ks < 4; ++ks) a[ks] = *(const bf16x8*)(s5x + ((size_t)(R0 + fr) * 32 + g) * 128 + ks * 32 + fq * 8);
#pragma unroll
                for (int ks = 0; ks < 4; ++ks) a[4 + ks] = *(const bf16x8*)(Pb + ((size_t)(R0 + fr) * 8 + ks * 2 + (fq >> 1)) * NINP + PC_U + g * 16 + (fq & 1) * 8);
                f32x4 acc[8];
#pragma unroll
                for (int nb = 0; nb < 8; ++nb) acc[nb] = (f32x4){0.f, 0.f, 0.f, 0.f};
#pragma unroll
                for (int ks = 0; ks < 8; ++ks)
                {
#pragma unroll
                    for (int nb = 0; nb < 8; ++nb) { const bf16x8 bfr = *(const bf16x8*)(Gs + (nb * 16 + fr) * 264 + ks * 32 + fq * 8);
                        acc[nb] = __builtin_amdgcn_mfma_f32_16x16x32_bf16(bfr, a[ks], acc[nb], 0, 0, 0); }
                    __builtin_amdgcn_sched_barrier(0); }
#pragma unroll
                for (int nb = 0; nb < 8; ++nb) {
                    const size_t row = (size_t)(R0 + fr) * 8 + nb;
                    const u32x2 uw = *(const u32x2*)(Pb + row * NINP + PC_U + g * 16 + fq * 4);
                    f32x4 z;
                    z[0] = gelu_tanh(acc[nb][0] + dsk[0] * bflo(uw.x)); z[1] = gelu_tanh(acc[nb][1] + dsk[1] * bfhi(uw.x));
                    z[2] = gelu_tanh(acc[nb][2] + dsk[2] * bflo(uw.y)); z[3] = gelu_tanh(acc[nb][3] + dsk[3] * bfhi(uw.y));
                    const u32x2 zp = (u32x2){pk2(z[0], z[1]), pk2(z[2], z[3])};
                    const f32x4 pre = __builtin_amdgcn_mfma_f32_16x16x16bf16_1k(wA, __builtin_bit_cast(bf16x4, zp), bgl, 0, 0, 0);
                    u32x2 o; o.x = pk2(z[0] * sigmoidf_fast(pre[0]), z[1] * sigmoidf_fast(pre[1])); o.y = pk2(z[2] * sigmoidf_fast(pre[2]), z[3] * sigmoidf_fast(pre[3]));
                    *(u32x2*)(mix + row * D + 512 + g * 16 + fq * 4) = o;
                }
            }
            __syncthreads();
        }
    }
    SEAM(6);

    PHASE_G(7) {
        pg8::Gemm g{mix, Wout, MP, D, D}; pg8::StaticOrder S; S.init(MP, D, G, bx);
        pg8::EpiResid<false> E{hb, hb, nullptr, ssq + SSQ_H2, 1.f};
        pg8::gemm_phase<pg8::EpiResid<false>, pg8::StaticOrder, true, true>(ldsl, g, S, E);
        SEpiResid<false> SE{hb, hb, nullptr, ssq + SSQ_H2, 1.f};
        small_gemm(mix + (size_t)MP * D, Wout, D, fl, G, bx, wave, tid0, SE);
    }
    SEAM(7);
    PHASE_G(8) {
        pg8::Gemm g{hb, Wcq, MP, D, D}; pg8::StaticOrder S; S.init(MP, D, G, bx, GREP(8));
        pg8::EpiScaleBf16 E{qb, D, ssq + SSQ_H2, 0.0625f};
        pg8::gemm_phase<pg8::EpiScaleBf16, pg8::StaticOrder, true, true>(ldsl, g, S, E);
        SEpiScaleBf16 SE{qb, ssq + SSQ_H2, 0.0625f};
        SUBREP(22)
        small_gemm(hb + (size_t)MP * D, Wcq, D, fl, G, bx, wave, tid0, SE);
    }
    SEAM(8);

    PHASE(9) {
        REP_SYNC();
        PHASE_LOCALS;
        constexpr int QS = 264;
        bf16_t* Qs = (bf16_t*)lds; bf16_t* Ps = Qs + 64 * QS; float* redmax = (float*)(Ps + 64 * QS); float* redsum = redmax + 64 * 8;
        const int fr = lane & 15, fq = lane >> 4, w = wave;
        for (int unit = bx; unit < 1024 + 512; unit += G) {
            const bool smp = unit >= 1024;
            int b, h; size_t r0; int nrows;
            if (!smp) { const int p = unit & 255, i = unit >> 8, bh = p >> 3, qt = (p & 7) * 4 + i; h = bh & 3; b = bh >> 2; r0 = (size_t)b * 2048 + qt * 64; nrows = 64; }
            else { const int u2 = unit - 1024; h = u2 & 3; b = u2 >> 2; r0 = (size_t)MP + b * 8; nrows = 8; }
            const int MB = smp ? 1 : 4;
            for (int ch = tid; ch < MB * 16 * 32; ch += NTHREADS) { const int row = ch >> 5, c8 = ch & 31; u32x4 v = (u32x4){0u, 0u, 0u, 0u};
                if (row < nrows) v = *(const u32x4*)(qb + (r0 + row) * D + h * 256 + c8 * 8);
                *(u32x4*)(Qs + row * QS + c8 * 8) = v; }
            __syncthreads();
            f32x4 sa[4][2];
#pragma unroll
            for (int mb = 0; mb < 4; ++mb) { sa[mb][0] = (f32x4){0.f, 0.f, 0.f, 0.f}; sa[mb][1] = sa[mb][0]; }
            if (!smp) {
                const bf16_t* kbase = kb + ((size_t)b * 256 + w * 32 + fr) * D + h * 256 + fq * 8;
#pragma unroll
                for (int ks = 0; ks < 8; ++ks) {
                    const bf16x8 b0 = *(const bf16x8*)(kbase + ks * 32), b1 = *(const bf16x8*)(kbase + (size_t)16 * D + ks * 32);
#pragma unroll
                    for (int mb = 0; mb < 4; ++mb) { const bf16x8 a = *(const bf16x8*)(Qs + (mb * 16 + fr) * QS + ks * 32 + fq * 8);
                        sa[mb][0] = __builtin_amdgcn_mfma_f32_16x16x32_bf16(a, b0, sa[mb][0], 0, 0, 0); sa[mb][1] = __builtin_amdgcn_mfma_f32_16x16x32_bf16(a, b1, sa[mb][1], 0, 0, 0); }
                }
            } else {
                const float* kbase = cache_k + ((size_t)b * 256 + w * 32 + fr) * D + h * 256 + fq * 8;
#pragma unroll
                for (int ks = 0; ks < 8; ++ks) {
                    u32x4 p0, p1;
                    { const f32x4 x0 = *(const f32x4*)(kbase + ks * 32), x1 = *(const f32x4*)(kbase + ks * 32 + 4); p0 = (u32x4){pk2(x0[0], x0[1]), pk2(x0[2], x0[3]), pk2(x1[0], x1[1]), pk2(x1[2], x1[3])}; }
                    { const f32x4 x0 = *(const f32x4*)(kbase + (size_t)16 * D + ks * 32), x1 = *(const f32x4*)(kbase + (size_t)16 * D + ks * 32 + 4); p1 = (u32x4){pk2(x0[0], x0[1]), pk2(x0[2], x0[3]), pk2(x1[0], x1[1]), pk2(x1[2], x1[3])}; }
                    const bf16x8 a = *(const bf16x8*)(Qs + fr * QS + ks * 32 + fq * 8);
                    sa[0][0] = __builtin_amdgcn_mfma_f32_16x16x32_bf16(a, __builtin_bit_cast(bf16x8, p0), sa[0][0], 0, 0, 0);
                    sa[0][1] = __builtin_amdgcn_mfma_f32_16x16x32_bf16(a, __builtin_bit_cast(bf16x8, p1), sa[0][1], 0, 0, 0);
                }
            }
#pragma unroll
            for (int mb = 0; mb < 4; ++mb) if (mb < MB) {
#pragma unroll
                for (int r = 0; r < 4; ++r) { float mx = fmaxf(sa[mb][0][r], sa[mb][1][r]);
                    mx = fmaxf(mx, __shfl_xor(mx, 1)); mx = fmaxf(mx, __shfl_xor(mx, 2)); mx = fmaxf(mx, __shfl_xor(mx, 4)); mx = fmaxf(mx, __shfl_xor(mx, 8));
                    if (fr == 0) redmax[(mb * 16 + fq * 4 + r) * 8 + w] = mx; }
            }
            __syncthreads();
#pragma unroll
            for (int mb = 0; mb < 4; ++mb) if (mb < MB) {
#pragma unroll
                for (int r = 0; r < 4; ++r) { const int q = mb * 16 + fq * 4 + r; const f32x4 m0 = *(const f32x4*)(redmax + q * 8), m1 = *(const f32x4*)(redmax + q * 8 + 4);
                    const float mx = fmaxf(fmaxf(fmaxf(m0[0], m0[1]), fmaxf(m0[2], m0[3])), fmaxf(fmaxf(m1[0], m1[1]), fmaxf(m1[2], m1[3])));
                    const float p0 = __expf(sa[mb][0][r] - mx), p1 = __expf(sa[mb][1][r] - mx);
                    Ps[q * QS + w * 32 + fr] = (bf16_t)f2bf(p0); Ps[q * QS + w * 32 + 16 + fr] = (bf16_t)f2bf(p1);
                    float sm = p0 + p1; sm += __shfl_xor(sm, 1); sm += __shfl_xor(sm, 2); sm += __shfl_xor(sm, 4); sm += __shfl_xor(sm, 8);
                    if (fr == 0) redsum[q * 8 + w] = sm; }
            }
            __syncthreads();
            f32x4 oa[4][2];
#pragma unroll
            for (int mb = 0; mb < 4; ++mb) { oa[mb][0] = (f32x4){0.f, 0.f, 0.f, 0.f}; oa[mb][1] = oa[mb][0]; }
            if (!smp) {
                const bf16_t* vbase = vbT + ((size_t)b * D + h * 256 + w * 32 + fr) * 256 + fq * 8;
#pragma unroll
                for (int ks = 0; ks < 8; ++ks) {
                    const bf16x8 b0 = *(const bf16x8*)(vbase + ks * 32), b1 = *(const bf16x8*)(vbase + 16 * 256 + ks * 32);
#pragma unroll
                    for (int mb = 0; mb < 4; ++mb) { const bf16x8 a = *(const bf16x8*)(Ps + (mb * 16 + fr) * QS + ks * 32 + fq * 8);
                        oa[mb][0] = __builtin_amdgcn_mfma_f32_16x16x32_bf16(a, b0, oa[mb][0], 0, 0, 0); oa[mb][1] = __builtin_amdgcn_mfma_f32_16x16x32_bf16(a, b1, oa[mb][1], 0, 0, 0); }
                }
            } else {
                const float* vbase = cache_v + ((size_t)b * 256 + fq * 8) * D + h * 256 + w * 32 + fr;
#pragma unroll
                for (int ks = 0; ks < 8; ++ks) {
                    float x0[8], x1[8];
#pragma unroll
                    for (int j = 0; j < 8; ++j) { x0[j] = vbase[(size_t)(ks * 32 + j) * D]; x1[j] = vbase[(size_t)(ks * 32 + j) * D + 16]; }
                    const u32x4 p0 = (u32x4){pk2(x0[0], x0[1]), pk2(x0[2], x0[3]), pk2(x0[4], x0[5]), pk2(x0[6], x0[7])};
                    const u32x4 p1 = (u32x4){pk2(x1[0], x1[1]), pk2(x1[2], x1[3]), pk2(x1[4], x1[5]), pk2(x1[6], x1[7])};
                    const bf16x8 a = *(const bf16x8*)(Ps + fr * QS + ks * 32 + fq * 8);
                    oa[0][0] = __builtin_amdgcn_mfma_f32_16x16x32_bf16(a, __builtin_bit_cast(bf16x8, p0), oa[0][0], 0, 0, 0);
                    oa[0][1] = __builtin_amdgcn_mfma_f32_16x16x32_bf16(a, __builtin_bit_cast(bf16x8, p1), oa[0][1], 0, 0, 0);
                }
            }
#pragma unroll
            for (int mb = 0; mb < 4; ++mb) if (mb < MB) {
#pragma unroll
                for (int r = 0; r < 4; ++r) { const int q = mb * 16 + fq * 4 + r; if (q < nrows) {
                    const f32x4 s0 = *(const f32x4*)(redsum + q * 8), s1 = *(const f32x4*)(redsum + q * 8 + 4);
                    const float inv = 1.f / (((s0[0] + s0[1]) + (s0[2] + s0[3])) + ((s1[0] + s1[1]) + (s1[2] + s1[3])));
                    bf16_t* op = ob + (r0 + q) * D + h * 256 + w * 32 + fr;
                    op[0] = (bf16_t)f2bf(oa[mb][0][r] * inv); op[16] = (bf16_t)f2bf(oa[mb][1][r] * inv); } }
            }
            __syncthreads();
        }
    }
    SEAM(9);

    PHASE_G(10) {
        pg8::Gemm g{ob, Wco, MP, D, D}; pg8::StaticOrder S; S.init(MP, D, G, bx);
        pg8::EpiResid<false> E{hb, hb, nullptr, ssq + SSQ_H3, 1.f};
        pg8::gemm_phase<pg8::EpiResid<false>, pg8::StaticOrder, true, true>(ldsl, g, S, E);
        SEpiResid<false> SE{hb, hb, nullptr, ssq + SSQ_H3, 1.f};
        small_gemm(ob + (size_t)MP * D, Wco, D, fl, G, bx, wave, tid0, SE);
    }
    SEAM(10);
    PHASE_G(11) {
        pg8::Gemm g{hb, Wgu2, M, NGU, D}; pg8::StaticOrder S; S.init(M, NGU, G, bx, GREP(11));
        pg8::EpiSwiGLU E{act, FF, ssq + SSQ_H3};
        pg8::gemm_phase<pg8::EpiSwiGLU, pg8::StaticOrder, true, true>(ldsl, g, S, E);
    }
    SEAM(11);
    PHASE_G(12) {
        pg8::Gemm g{act, Wd2, MP, D, FF}; pg8::StaticOrder S; S.init(MP, D, G, bx, GREP(12));
        pg8::EpiResid<true> E{hb, nullptr, hres, nullptr, 0.5f};
        pg8::gemm_phase<pg8::EpiResid<true>, pg8::StaticOrder, true, true>(ldsl, g, S, E);
        SEpiResid<true> SE{hb, nullptr, hres, nullptr, 0.5f};
        SUBREP(21)
        small_gemm(act + (size_t)MP * FF, Wd2, FF, fl, G, bx, wave, tid0, SE);
    }
    SEAM(12);
    PHASE(13) {
        REP_SYNC();
        PHASE_LOCALS;
        for (int m = gw; m < M; m += NGW) {
            f32x4* yr = (f32x4*)(out + O_Y + (size_t)m * D) + lane; const f32x4* hr = (const f32x4*)(hres + (size_t)m * D) + lane; f32x4 v[4]; float s = 0.f;
#pragma unroll
            for (int j = 0; j < 4; ++j) { v[j] = hr[64 * j]; s += (v[j].x * v[j].x + v[j].y * v[j].y) + (v[j].z * v[j].z + v[j].w * v[j].w); }
            const float rs = rsqrtf(wave_sum(s) * (1.f / D) + EPS);
#pragma unroll
            for (int j = 0; j < 4; ++j) { const f32x4 gq = ((const f32x4*)g_final)[lane + 64 * j]; yr[64 * j] = v[j] * rs * gq; }
        }
    }
#undef IN
#undef SEAM
}

extern "C" void kernel_launch(void* const* d_in, const int* in_sizes, int n_in, void* d_out, int out_size, void* d_ws, size_t ws_size, hipStream_t stream) {
    static int grid = 0;
    if (grid == 0) {
        if (n_in != 36 || (size_t)out_size != O_TOTAL || ws_size < WS_END) { fprintf(stderr, "kernel_launch: unexpected shapes (n_in %d, out %d, ws %zu)\n", n_in, out_size, ws_size); grid = -1; return; }
        int dev = 0, cus = 0, per_cu = 0;
        hipGetDevice(&dev); hipDeviceGetAttribute(&cus, hipDeviceAttributeMultiprocessorCount, dev);
        hipFuncSetAttribute((const void*)hymba_fwd, hipFuncAttributeMaxDynamicSharedMemorySize, LDS_BYTES);
        hipOccupancyMaxActiveBlocksPerMultiprocessor(&per_cu, (const void*)hymba_fwd, NTHREADS, LDS_BYTES);
        if (per_cu < 1) { fprintf(stderr, "kernel_launch: occupancy query says %d blocks per CU\n", per_cu); per_cu = 1; }
        grid = cus;
        (void)hipGetLastError();
    }
    if (grid < 0) return;
    if (hipMemsetAsync((char*)d_ws + WS_BAR, 0, BAR_BYTES, stream) != hipSuccess) { fprintf(stderr, "kernel_launch: memset failed\n"); return; }
    Args a{};
    for (int i = 0; i < 36; ++i) a.in[i] = (const float*)d_in[i];
    a.out = (float*)d_out; a.ws = (unsigned char*)d_ws; a.ph_lo = 0; a.ph_hi = 14;
    void* params[] = {&a};
    hipError_t e = hipLaunchCooperativeKernel((const void*)hymba_fwd, dim3(grid), dim3(NTHREADS), params, LDS_BYTES, stream);
    if (e != hipSuccess) fprintf(stderr, "kernel_launch: cooperative launch failed: %s (grid %d)\n", hipGetErrorString(e), grid);
}
```

```cpp
#include <hip/hip_runtime.h>
#include <hip/hip_cooperative_groups.h>
#include <cstdio>
#include <cstdint>
namespace cg = cooperative_groups;

constexpr int D = 1024, MP = 16384, MS = 1024, M = MP + MS, FF = 2816, NGU = 2 * FF, NIN = 2064, NINP = 2304;
constexpr int MEMR = 2048;
constexpr float EPS = 1e-6f;
constexpr int PC_Q = 0, PC_K = 256, PC_V = 512, PC_R = 1024, PC_U = 1536, PC_ZG = 2048;
constexpr size_t O_Y = 0, O_GLAP = 17825792, O_REP = 18087936, O_IMP = 18104320, O_MKP = 18120704, O_MVP = 20217856,
                 O_GLAS = 22315008, O_RES = 26509312, O_IMS = 26771456, O_TOTAL = 27033600;
constexpr size_t MiB = 1u << 20;
constexpr int XCD_BAR_WORDS_C = 3456;
constexpr size_t WS_SSQ = 0;
constexpr size_t WS_WGU1 = 1 * MiB, WS_WD1 = 12 * MiB, WS_WIN = 18 * MiB, WS_WOUT = 23 * MiB, WS_WCQ = 25 * MiB, WS_WCKV = 27 * MiB,
                 WS_WCO = 31 * MiB, WS_WGU2 = 33 * MiB, WS_WD2 = 44 * MiB, WS_EGT = 50 * MiB, WS_GTT = 51 * MiB, WS_MEMB = 53 * MiB,
                 WS_KB = 57 * MiB, WS_VBT = 61 * MiB, WS_XB = 65 * MiB, WS_HB = 99 * MiB, WS_H = 133 * MiB, WS_ACT = 201 * MiB,
                 WS_MIX = 295 * MiB, WS_Q = 329 * MiB, WS_O = 363 * MiB, WS_GLAD = 397 * MiB, WS_GLADEC = 429 * MiB, WS_S5E = 430 * MiB,
                 WS_S5X = 464 * MiB, WS_END = 481 * MiB;
constexpr int SSQ_X = 0, SSQ_MEM = M, SSQ_H1 = M + 2048, SSQ_H2 = 2 * M + 2048, SSQ_H3 = 3 * M + 2048, SSQ_WORDS = 4 * M + 2048;
static_assert((size_t)SSQ_WORDS * 4 <= MiB, "ssq region");
static_assert(WS_XB + (size_t)1024 * 8192 * 4 <= WS_HB, "glaS over xb");
static_assert(WS_ACT + (size_t)M * FF * 2 <= WS_MIX && WS_ACT + (size_t)M * NINP * 2 <= WS_MIX, "act / P region");

constexpr size_t WS_BAR = 512 * 1024, BAR_BYTES = 16384;
static_assert((size_t)SSQ_WORDS * 4 <= WS_BAR && XCD_BAR_WORDS_C * 4 <= BAR_BYTES, "ctl map");
constexpr int NWAVES = 8, NTHREADS = 512;
constexpr int LDS_BYTES = 147456;
constexpr int LDS_BARST = LDS_BYTES - 64;

#define LAS __attribute__((address_space(3)))
typedef unsigned short bf16_t;
typedef short bf16x8 __attribute__((ext_vector_type(8)));
typedef short bf16x4 __attribute__((ext_vector_type(4)));
typedef float f32x4 __attribute__((ext_vector_type(4)));
typedef float f32x2 __attribute__((ext_vector_type(2)));
typedef unsigned u32x4 __attribute__((ext_vector_type(4)));
typedef unsigned u32x2 __attribute__((ext_vector_type(2)));
#define DI __device__ __forceinline__

DI unsigned f2bf(float f) { unsigned u = __builtin_bit_cast(unsigned, f); return (u + 0x7fffu + ((u >> 16) & 1u)) >> 16; }
DI unsigned pk2(float lo, float hi) { return f2bf(lo) | (f2bf(hi) << 16); }
DI float bf2f(unsigned b) { return __builtin_bit_cast(float, b << 16); }
DI float bflo(unsigned w) { return __builtin_bit_cast(float, w << 16); }
DI float bfhi(unsigned w) { return __builtin_bit_cast(float, w & 0xffff0000u); }
DI float wave_sum(float v) {
#pragma unroll
    for (int o = 1; o < 64; o <<= 1) v += __shfl_xor(v, o);
    return v;
}
DI float sigmoidf_fast(float x) { return __builtin_amdgcn_rcpf(1.f + __expf(-x)); }
DI float siluf(float x) { return x * sigmoidf_fast(x); }
DI float logsigmoidf(float x) { return fminf(x, 0.f) - log1pf(__expf(-fabsf(x))); }
DI float gelu_tanh(float y) { const float a = 0.7978845608028654f * (y + 0.044715f * y * y * y); const float e = __expf(2.f * a); const float th = 1.f - 2.f * __builtin_amdgcn_rcpf(e + 1.f); return 0.5f * y * (1.f + th); }

namespace pg8 {
#define PG8_LAS __attribute__((address_space(3)))
constexpr int BM = 256, BK = 64, HALF = 128, HTB = HALF * BK * 2  , STAGE_BYTES = 8 * HTB, NXCD = 8, WGM = 8;

__host__ __device__ __forceinline__ int lds_byte(int r, int c) { const int st = (r >> 4) * 2 + (c >> 5), rr = r & 15, cc = c & 31, ob = rr * 64 + cc * 2; return st * 1024 + (ob ^ (((ob >> 9) & 1) << 5)); }
__host__ __device__ __forceinline__ void stage_rc(int b, int& R, int& C) { const int st = b / 1024, sb = b % 1024, swz = sb ^ (((sb >> 9) & 1) << 5); R = (st >> 1) * 16 + swz / 64; C = (st & 1) * 32 + (swz % 64) / 2; }
__host__ __device__ __forceinline__ int perm32(int rho) { const int n = rho >> 4, i = rho & 15; return 8 * (i >> 2) + 4 * n + (i & 3); }

struct Unit { int pm, pn; };
struct Gemm { const bf16_t* A; const bf16_t* Bt; int M, N, K; };

struct StaticOrder {
    int nM, nN, nwg, G, c, rep;
    __host__ __device__ void init(int M_, int N_, int G_, int c_, int rep_ = 1) { nM = M_ / BM; nN = N_ / BM; nwg = nM * nN; G = G_; c = c_; rep = rep_; }
    __host__ __device__ bool next(int i, Unit& u) const {
        const long L = (long)i * G + c; if (L >= (long)nwg * rep) return false;
        int wgid = (int)(L % nwg); { const int q = nwg / NXCD, r = nwg % NXCD, xcd = wgid % NXCD, off = wgid / NXCD; wgid = (xcd < r ? xcd * (q + 1) : r * (q + 1) + (xcd - r) * q) + off; }
        const int nig = WGM * nN, gid = wgid / nig, fm = gid * WGM, gsz = (nM - fm) < WGM ? (nM - fm) : WGM;
        u.pm = fm + ((wgid % nig) % gsz); u.pn = (wgid % nig) / gsz; return true;
    }
    __device__ __forceinline__ void a_ready(const Unit&) const {}
    __device__ __forceinline__ void done(const Unit&) const {}
};

__device__ __forceinline__ unsigned cvt_pk_bf16(float lo, float hi) { unsigned r; asm volatile("v_cvt_pk_bf16_f32 %0, %1, %2" : "=v"(r) : "v"(lo), "v"(hi)); return r; }


struct EpiSwiGLU {
    static constexpr bool PERM = true, AFTER_DRAIN = false;
    bf16_t* O; int ldc; const float* ssq;
    __device__ __forceinline__ void operator()(const f32x4 (&acc)[2][2][4][2], const Unit& u, int wr, int wc, int fr, int fq) const {
        const int row0 = u.pm * BM + wr * 64 + fr, col0 = u.pn * HALF + wc * 32 + 8 * fq;
#pragma unroll
        for (int ai = 0; ai < 2; ++ai)
#pragma unroll
            for (int m = 0; m < 4; ++m) {
                const int row = row0 + ai * HALF + m * 16;
                const float rs = rsqrtf(ssq[row] * (1.f / D) + EPS);
                const f32x4 g0 = acc[ai][0][m][0] * rs, g1 = acc[ai][0][m][1] * rs, u0 = acc[ai][1][m][0] * rs, u1 = acc[ai][1][m][1] * rs;
                u32x4 w;
                w.x = cvt_pk_bf16(siluf(g0[0]) * u0[0], siluf(g0[1]) * u0[1]); w.y = cvt_pk_bf16(siluf(g0[2]) * u0[2], siluf(g0[3]) * u0[3]);
                w.z = cvt_pk_bf16(siluf(g1[0]) * u1[0], siluf(g1[1]) * u1[1]); w.w = cvt_pk_bf16(siluf(g1[2]) * u1[2], siluf(g1[3]) * u1[3]);
                *(u32x4*)(O + (size_t)row * ldc + col0) = w;
            }
    }
};
template <bool OUT_F32> struct EpiResid {
    static constexpr bool PERM = true, AFTER_DRAIN = false;
    const bf16_t* base; bf16_t* hbo; float* outf; float* ssq; float alpha;
    __device__ __forceinline__ void operator()(const f32x4 (&acc)[2][2][4][2], const Unit& u, int wr, int wc, int fr, int fq) const {
        const int row0 = u.pm * BM + wr * 64 + fr, col0 = u.pn * BM + wc * 32 + 8 * fq;
#pragma unroll
        for (int ai = 0; ai < 2; ++ai)
#pragma unroll
            for (int m = 0; m < 4; ++m) {
                const int row = row0 + ai * HALF + m * 16;
                float s = 0.f;
#pragma unroll
                for (int bj = 0; bj < 2; ++bj) {
                    const int c = col0 + bj * HALF;
                    const u32x4 bw = *(const u32x4*)(base + (size_t)row * D + c);
                    f32x4 v0 = acc[ai][bj][m][0] * alpha, v1 = acc[ai][bj][m][1] * alpha;
                    v0[0] += bflo(bw.x); v0[1] += bfhi(bw.x); v0[2] += bflo(bw.y); v0[3] += bfhi(bw.y); v1[0] += bflo(bw.z); v1[1] += bfhi(bw.z); v1[2] += bflo(bw.w); v1[3] += bfhi(bw.w);
                    if constexpr (OUT_F32) { *(f32x4*)(outf + (size_t)row * D + c) = v0; *(f32x4*)(outf + (size_t)row * D + c + 4) = v1; }
                    else {
                        s += ((v0[0] * v0[0] + v0[1] * v0[1]) + (v0[2] * v0[2] + v0[3] * v0[3])) + ((v1[0] * v1[0] + v1[1] * v1[1]) + (v1[2] * v1[2] + v1[3] * v1[3]));
                        u32x4 w; w.x = cvt_pk_bf16(v0[0], v0[1]); w.y = cvt_pk_bf16(v0[2], v0[3]); w.z = cvt_pk_bf16(v1[0], v1[1]); w.w = cvt_pk_bf16(v1[2], v1[3]);
                        *(u32x4*)(hbo + (size_t)row * D + c) = w;
                    }
                }
                if constexpr (!OUT_F32) { s += __shfl_xor(s, 16); s += __shfl_xor(s, 32); if (fq == 0) atomicAdd(ssq + row, s); }
            }
    }
};
struct EpiScaleBf16 {
    static constexpr bool PERM = true, AFTER_DRAIN = false;
    bf16_t* O; int ldc; const float* ssq; float scale;
    __device__ __forceinline__ void operator()(const f32x4 (&acc)[2][2][4][2], const Unit& u, int wr, int wc, int fr, int fq) const {
        const int row0 = u.pm * BM + wr * 64 + fr, col0 = u.pn * BM + wc * 32 + 8 * fq;
#pragma unroll
        for (int ai = 0; ai < 2; ++ai)
#pragma unroll
            for (int m = 0; m < 4; ++m) {
                const int row = row0 + ai * HALF + m * 16;
                const float rs = rsqrtf(ssq[row] * (1.f / D) + EPS) * scale;
#pragma unroll
                for (int bj = 0; bj < 2; ++bj) {
                    const f32x4 v0 = acc[ai][bj][m][0] * rs, v1 = acc[ai][bj][m][1] * rs;
                    u32x4 w; w.x = cvt_pk_bf16(v0[0], v0[1]); w.y = cvt_pk_bf16(v0[2], v0[3]); w.z = cvt_pk_bf16(v1[0], v1[1]); w.w = cvt_pk_bf16(v1[2], v1[3]);
                    *(u32x4*)(O + (size_t)row * ldc + col0 + bj * HALF) = w;
                }
            }
    }
};
struct EpiMemKV {
    static constexpr bool PERM = false, AFTER_DRAIN = false;
    float* outK; float* outV; bf16_t* kb; bf16_t* vbT; const float* ssq;
    __device__ __forceinline__ void operator()(const f32x4 (&acc)[2][2][4][2], const Unit& u, int wr, int wc, int fr, int fq) const {
        const int row0 = u.pm * BM + wr * 64 + fr; const bool isV = u.pn >= 4; const int col0 = (u.pn & 3) * BM + wc * 32 + 4 * fq;
        float* outp = isV ? outV : outK;
#pragma unroll
        for (int ai = 0; ai < 2; ++ai)
#pragma unroll
            for (int m = 0; m < 4; ++m) {
                const int row = row0 + ai * HALF + m * 16;
                const float rs = rsqrtf(ssq[row] * (1.f / D) + EPS);
                const int b = row >> 8, key = row & 255;
#pragma unroll
                for (int bj = 0; bj < 2; ++bj)
#pragma unroll
                    for (int n = 0; n < 2; ++n) {
                        const int c = col0 + bj * HALF + n * 16;
                        const f32x4 v = acc[ai][bj][m][n] * rs;
                        *(f32x4*)(outp + (size_t)row * D + c) = v;
                        if (!isV) { u32x2 w; w.x = cvt_pk_bf16(v[0], v[1]); w.y = cvt_pk_bf16(v[2], v[3]); *(u32x2*)(kb + (size_t)row * D + c) = w; }
                        else {
#pragma unroll
                            for (int i = 0; i < 4; ++i) vbT[((size_t)b * D + c + i) * 256 + key] = (bf16_t)f2bf(v[i]);
                        }
                    }
            }
    }
};

template <class Epi, class Sched, bool ALIGN_EPI = false, bool SP2 = false>
__device__ __forceinline__ void gemm_phase(PG8_LAS unsigned char* lds, const Gemm g, const Sched& S, const Epi& E) {
    const int tid = threadIdx.x, wid = __builtin_amdgcn_readfirstlane(tid >> 6), lane = tid & 63, wr = wid >> 2, wc = wid & 3, fr = lane & 15, fq = lane >> 4;
    const int K = g.K, nt = K / BK;
    unsigned voffA[2], voffB[2];
#pragma unroll
    for (int i = 0; i < 2; ++i) { int R, C; stage_rc(tid * 16 + i * 8192, R, C); const int Rb = Epi::PERM ? ((R & ~31) + perm32(R & 31)) : R;
        voffA[i] = (unsigned)(R * K + C) * 2u; voffB[i] = (unsigned)(Rb * K + C) * 2u; }
    const size_t kstep = (size_t)(BK * 2);
    const size_t hstep = (size_t)HALF * K * 2;
    const size_t tstep = 2 * hstep;
    const unsigned ldsw = (unsigned)wid * 1024u;
    const int aoff = lds_byte(wr * 64 + fr, fq * 8), boff = lds_byte(wc * 32 + fr, fq * 8);
#define PG8_SA(b, h) (((b) * 2 + (h)) * HTB)
#define PG8_SB(b, h) ((4 + (b) * 2 + (h)) * HTB)
#define PG8_STAGE(bufoff, gbase, voff) do { _Pragma("unroll") for (int _i = 0; _i < 2; ++_i) \
        __builtin_amdgcn_global_load_lds((const unsigned*)((const char*)(gbase) + (voff)[_i]), (PG8_LAS unsigned*)(lds + (bufoff) + ldsw + _i * 8192), 16, 0, 0); } while (0)
#define PG8_LDA(dst, b, h) do { _Pragma("unroll") for (int m = 0; m < 4; ++m) _Pragma("unroll") for (int k = 0; k < 2; ++k) dst[m][k] = *(const PG8_LAS bf16x8*)(lds + PG8_SA(b, h) + aoff + m * 2048 + k * 1024); } while (0)
#define PG8_LDB(dst, b, h) do { _Pragma("unroll") for (int n = 0; n < 2; ++n) _Pragma("unroll") for (int k = 0; k < 2; ++k) dst[n][k] = *(const PG8_LAS bf16x8*)(lds + PG8_SB(b, h) + boff + n * 2048 + k * 1024); } while (0)
#define PG8_MMA(ai, bj, At, Bt) do { __builtin_amdgcn_s_setprio(1); _Pragma("unroll") for (int m = 0; m < 4; ++m) _Pragma("unroll") for (int n = 0; n < 2; ++n) _Pragma("unroll") for (int k = 0; k < 2; ++k) \
        acc[ai][bj][m][n] = __builtin_amdgcn_mfma_f32_16x16x32_bf16(Bt[n][k], At[m][k], acc[ai][bj][m][n], 0, 0, 0); __builtin_amdgcn_s_setprio(0); } while (0)
#define PG8_WAIT_V(n) asm volatile("s_waitcnt vmcnt(" #n ")" ::: "memory")
#define PG8_WAIT_L(n) asm volatile("s_waitcnt lgkmcnt(" #n ")" ::: "memory")
#define PG8_BAR __builtin_amdgcn_s_barrier()
#define PG8_SCHED __builtin_amdgcn_sched_barrier(0)
    Unit cur, nxt; int ui = 0;
    if (!S.next(0, cur)) return;
    f32x4 acc[2][2][4][2];
#pragma unroll
    for (int a = 0; a < 2; ++a)
#pragma unroll
        for (int b = 0; b < 2; ++b)
#pragma unroll
            for (int m = 0; m < 4; ++m)
#pragma unroll
                for (int n = 0; n < 2; ++n) acc[a][b][m][n] = (f32x4){0.f, 0.f, 0.f, 0.f};
    bf16x8 At[4][2], B0[2][2], B1[2][2];
    const char* cA = (const char*)g.A + (size_t)cur.pm * tstep; const char* cB = (const char*)g.Bt + (size_t)cur.pn * tstep;
    S.a_ready(cur);
    if constexpr (SP2) {
        PG8_STAGE(PG8_SB(0, 0), cB, voffB); PG8_STAGE(PG8_SB(0, 1), cB + hstep, voffB); PG8_STAGE(PG8_SA(0, 0), cA, voffA); PG8_STAGE(PG8_SA(0, 1), cA + hstep, voffA);
        if (wr == 1) PG8_BAR;
        PG8_WAIT_V(2); PG8_BAR;
        PG8_STAGE(PG8_SB(1, 0), cB + kstep, voffB); PG8_STAGE(PG8_SA(1, 0), cA + kstep, voffA); PG8_STAGE(PG8_SB(1, 1), cB + hstep + kstep, voffB);
        PG8_WAIT_V(6); PG8_BAR;
    } else {
        PG8_STAGE(PG8_SB(0, 0), cB, voffB); PG8_STAGE(PG8_SA(0, 0), cA, voffA); PG8_STAGE(PG8_SB(0, 1), cB + hstep, voffB); PG8_STAGE(PG8_SA(0, 1), cA + hstep, voffA);
        if (wr == 1) PG8_BAR;
        PG8_WAIT_V(4); PG8_BAR;
        PG8_STAGE(PG8_SB(1, 0), cB + kstep, voffB); PG8_STAGE(PG8_SA(1, 0), cA + kstep, voffA); PG8_STAGE(PG8_SB(1, 1), cB + hstep + kstep, voffB);
        PG8_WAIT_V(6); PG8_BAR;
    }
    for (;;) {
        const bool has_next = S.next(ui + 1, nxt);
        const char* nA = has_next ? (const char*)g.A + (size_t)nxt.pm * tstep : cA; const char* nB = has_next ? (const char*)g.Bt + (size_t)nxt.pn * tstep : cB;
        for (int t = 0; t < nt; t += 2) {
            const bool last = (t == nt - 2);
            const char* a1 = cA + (size_t)(t + 1) * kstep;
            const char* a2 = last ? nA : cA + (size_t)(t + 2) * kstep; const char* b2 = last ? nB : cB + (size_t)(t + 2) * kstep;
            const char* a3 = a2 + kstep; const char* b3 = b2 + kstep;
            if (last && has_next) S.a_ready(nxt);
            if constexpr (SP2) {
            PG8_LDB(B0, 0, 0); PG8_LDB(B1, 0, 1); PG8_SCHED; PG8_LDA(At, 0, 0); PG8_STAGE(PG8_SA(1, 1), a1 + hstep, voffA);
            PG8_WAIT_V(8); PG8_WAIT_L(0); PG8_BAR; PG8_MMA(0, 0, At, B0); PG8_MMA(0, 1, At, B1); PG8_BAR; PG8_SCHED;
            PG8_LDA(At, 0, 1); PG8_STAGE(PG8_SB(0, 0), b2, voffB); PG8_STAGE(PG8_SB(0, 1), b2 + hstep, voffB); PG8_STAGE(PG8_SA(0, 0), a2, voffA);
            PG8_WAIT_V(8); PG8_WAIT_L(0); PG8_BAR; PG8_MMA(1, 0, At, B0); PG8_MMA(1, 1, At, B1); PG8_BAR; PG8_SCHED;
            PG8_LDB(B0, 1, 0); PG8_LDB(B1, 1, 1); PG8_SCHED; PG8_LDA(At, 1, 0); PG8_STAGE(PG8_SA(0, 1), a2 + hstep, voffA);
            PG8_WAIT_V(8); PG8_WAIT_L(0); PG8_BAR; PG8_MMA(0, 0, At, B0); PG8_MMA(0, 1, At, B1); PG8_BAR; PG8_SCHED;
            PG8_LDA(At, 1, 1); PG8_STAGE(PG8_SB(1, 0), b3, voffB); PG8_STAGE(PG8_SB(1, 1), b3 + hstep, voffB); PG8_STAGE(PG8_SA(1, 0), a3, voffA);
            PG8_WAIT_V(8); PG8_WAIT_L(0); PG8_BAR; PG8_MMA(1, 0, At, B0); PG8_MMA(1, 1, At, B1); PG8_BAR; PG8_SCHED;
            } else {
            PG8_LDB(B0, 0, 0); PG8_SCHED; PG8_LDA(At, 0, 0); PG8_STAGE(PG8_SA(1, 1), a1 + hstep, voffA);
            PG8_WAIT_L(8); PG8_BAR; PG8_WAIT_L(0); PG8_MMA(0, 0, At, B0); PG8_BAR; PG8_SCHED;
            PG8_LDB(B1, 0, 1); PG8_STAGE(PG8_SB(0, 0), b2, voffB);
            PG8_BAR; PG8_WAIT_L(0); PG8_MMA(0, 1, At, B1); PG8_BAR;
            PG8_LDA(At, 0, 1); PG8_STAGE(PG8_SA(0, 0), a2, voffA);
            PG8_BAR; PG8_WAIT_L(0); PG8_MMA(1, 0, At, B0); PG8_BAR; PG8_SCHED;
            PG8_STAGE(PG8_SB(0, 1), b2 + hstep, voffB);
            PG8_WAIT_V(6); PG8_BAR; PG8_MMA(1, 1, At, B1); PG8_BAR;
            PG8_LDB(B0, 1, 0); PG8_SCHED; PG8_LDA(At, 1, 0); PG8_STAGE(PG8_SA(0, 1), a2 + hstep, voffA);
            PG8_WAIT_L(8); PG8_BAR; PG8_WAIT_L(0); PG8_MMA(0, 0, At, B0); PG8_BAR; PG8_SCHED;
            PG8_LDB(B1, 1, 1); PG8_STAGE(PG8_SB(1, 0), b3, voffB);
            PG8_BAR; PG8_WAIT_L(0); PG8_MMA(0, 1, At, B1); PG8_BAR;
            PG8_LDA(At, 1, 1); PG8_STAGE(PG8_SA(1, 0), a3, voffA);
            PG8_BAR; PG8_WAIT_L(0); PG8_MMA(1, 0, At, B0); PG8_BAR; PG8_SCHED;
            PG8_STAGE(PG8_SB(1, 1), b3 + hstep, voffB);
            PG8_WAIT_V(6); PG8_BAR; PG8_MMA(1, 1, At, B1); PG8_BAR;
            }
        }
        if constexpr (ALIGN_EPI) { if (wr == 0) PG8_BAR; }
        if constexpr (!Epi::AFTER_DRAIN) { E(acc, cur, wr, wc, fr, fq); S.done(cur); }
        if (!has_next) break;
#pragma unroll
        for (int a = 0; a < 2; ++a)
#pragma unroll
            for (int b = 0; b < 2; ++b)
#pragma unroll
                for (int m = 0; m < 4; ++m)
#pragma unroll
                    for (int n = 0; n < 2; ++n) acc[a][b][m][n] = (f32x4){0.f, 0.f, 0.f, 0.f};
        cur = nxt; cA = nA; cB = nB; ++ui;
        if constexpr (ALIGN_EPI) { if (wr == 1) PG8_BAR; }
    }
    PG8_WAIT_V(0);
    if constexpr (!ALIGN_EPI) { if (wr == 0) PG8_BAR; }
    PG8_BAR;
#undef PG8_SA
#undef PG8_SB
#undef PG8_STAGE
#undef PG8_LDA
#undef PG8_LDB
#undef PG8_MMA
#undef PG8_WAIT_V
#undef PG8_WAIT_L
#undef PG8_BAR
#undef PG8_SCHED
}
}


#define XB_TMO      128
#define XB_XCNT(j)  (256  + 64 * (j))
#define XB_XSUB(j)  (1280 + 64 * (j))
#define XB_XGEN(j)  (2304 + 64 * (j))
#define XB_TOP      3328
#define XB_TOPGEN   3392
#define XCD_BAR_WORDS 3456
#define XB_SPIN_CAP (1u << 18)
__device__ __forceinline__ unsigned xb_ld(unsigned* p)              { return __hip_atomic_load(p, __ATOMIC_RELAXED, __HIP_MEMORY_SCOPE_AGENT); }
__device__ __forceinline__ unsigned xb_add(unsigned* p, unsigned v) { return __hip_atomic_fetch_add(p, v, __ATOMIC_RELAXED, __HIP_MEMORY_SCOPE_AGENT); }
__device__ __forceinline__ unsigned xb_xcc_id() { return (unsigned)__builtin_amdgcn_s_getreg((3 << 11) | 20) & 0xFu; }
#define XB_SPIN(cond, bar) do { unsigned _sp = 0; while (cond) { __builtin_amdgcn_s_sleep(1); \
    if ((++_sp & 255u) == 0u) { if (xb_ld(&(bar)[XB_TMO])) break; if (_sp > XB_SPIN_CAP) { atomicAdd(&(bar)[XB_TMO], 1u); break; } } } } while (0)
struct XcdBarrier { unsigned* bar; unsigned x; volatile LAS unsigned* st; };
__device__ __forceinline__ XcdBarrier xcd_barrier_post(unsigned* bar, volatile LAS unsigned* st) {
    XcdBarrier b; b.bar = bar; b.x = xb_xcc_id(); b.st = st;
    if (threadIdx.x == 0) (void)xb_add(&bar[XB_XCNT(b.x)], 1u);
    return b;
}
__device__ __forceinline__ void xcd_barrier_complete(unsigned* bar, unsigned x, unsigned& nloc, unsigned& nx) {
    const unsigned G = gridDim.x * gridDim.y * gridDim.z;
    unsigned sum, cnt, mine, sp = 0u;
    for (;;) {
        sum = 0u; cnt = 0u; mine = 0u;
#pragma unroll
        for (unsigned j = 0; j < 16; ++j) { const unsigned c = xb_ld(&bar[XB_XCNT(j)]); sum += c; cnt += (c > 0u) ? 1u : 0u; mine = (j == x) ? c : mine; }
        if (sum == G) break;
        __builtin_amdgcn_s_sleep(1);
        if ((++sp & 255u) == 0u) { if (xb_ld(&bar[XB_TMO])) break; if (sp > XB_SPIN_CAP) { atomicAdd(&bar[XB_TMO], 1u); break; } }
    }
    nloc = mine > 0u ? mine : 1u; nx = cnt > 0u ? cnt : 1u;
}
__device__ __forceinline__ void xcd_barrier(const XcdBarrier& b) {
    asm volatile("s_waitcnt vmcnt(0)" ::: "memory");
    __syncthreads();
    if (threadIdx.x == 0) {
        unsigned* bar = b.bar;
        __builtin_amdgcn_s_waitcnt(0);
        unsigned nloc = b.st[0], nx = b.st[1];
        if (nloc == 0u) { xcd_barrier_complete(bar, b.x, nloc, nx); b.st[0] = nloc; b.st[1] = nx; }
        const unsigned old = xb_add(&bar[XB_XSUB(b.x)], 1u);
        const unsigned gen = old / nloc;
        if (old + 1u == (gen + 1u) * nloc) {
            __builtin_amdgcn_fence(__ATOMIC_RELEASE, "agent");
            asm volatile("s_waitcnt vmcnt(0)" ::: "memory");
            const unsigned og = xb_add(&bar[XB_TOP], 1u);
            const unsigned tg = og / nx;
            if (og + 1u == (tg + 1u) * nx) xb_add(&bar[XB_TOPGEN], 1u);
            else XB_SPIN(xb_ld(&bar[XB_TOPGEN]) == tg, bar);
            __builtin_amdgcn_fence(__ATOMIC_ACQUIRE, "agent");
            xb_add(&bar[XB_XGEN(b.x)], 1u);
            asm volatile("s_waitcnt vmcnt(0)" ::: "memory");
        } else {
            XB_SPIN(xb_ld(&bar[XB_XGEN(b.x)]) == gen, bar);
            __builtin_amdgcn_fence(__ATOMIC_ACQUIRE, "agent");
            asm volatile("s_waitcnt vmcnt(0)" ::: "memory");
        }
    }
    __syncthreads();
}

struct Args { const float* in[36]; float* out; unsigned char* ws; int ph_lo, ph_hi; };
#define LDS_WAIT() asm volatile("s_waitcnt lgkmcnt(0)" ::: "memory")

DI int rowmap(int mode, int n) {
    if (mode == 1) { const int j = n < FF ? n : n - FF; return 256 * (j >> 7) + (n < FF ? 0 : 128) + (j & 127); }
    if (mode == 2) { if (n < 1024) return n; if (n < 1040) return n + 1024; return n - 16; }
    return n;
}
DI void p0_transpose_item(const float* W, const float* gain, int K, int N, bf16_t* WT, int mode, float* scr, int item, int lane) {
    const int nblk = (N + 31) / 32, kb = item / nblk, nb = item % nblk, k0 = 64 * kb, n0 = 32 * nb;
    const int nn = n0 + (lane & 31); const bool ok = nn < N;
    float wv[32];
#pragma unroll
    for (int i = 0; i < 32; ++i) { const int kk = 2 * i + (lane >> 5); wv[i] = ok ? W[(size_t)(k0 + kk) * N + nn] : 0.f; }
    if (gain) {
#pragma unroll
        for (int i = 0; i < 32; ++i) wv[i] *= gain[k0 + 2 * i + (lane >> 5)];
    }
#pragma unroll
    for (int i = 0; i < 32; ++i) scr[(2 * i + (lane >> 5)) * 33 + (lane & 31)] = wv[i];
    LDS_WAIT(); asm volatile("" ::: "memory");
    const int c = lane & 7;
#pragma unroll
    for (int j = 0; j < 4; ++j) { const int n = (lane >> 3) + 8 * j; const float* s = scr + (8 * c) * 33 + n;
        u32x4 o; o.x = pk2(s[0 * 33], s[1 * 33]); o.y = pk2(s[2 * 33], s[3 * 33]); o.z = pk2(s[4 * 33], s[5 * 33]); o.w = pk2(s[6 * 33], s[7 * 33]);
        if (n0 + n < N) *(u32x4*)(WT + (size_t)rowmap(mode, n0 + n) * K + k0 + 8 * c) = o; }
    LDS_WAIT(); asm volatile("" ::: "memory");
}
DI void row_to_bf16_ssq(const float* xrow, bf16_t* orow, float* ssq_slot, int lane) {
    const f32x4* xr = (const f32x4*)xrow + lane;
    f32x4 v[4]; float s = 0.f;
#pragma unroll
    for (int j = 0; j < 4; ++j) { v[j] = xr[64 * j]; s += (v[j].x * v[j].x + v[j].y * v[j].y) + (v[j].z * v[j].z + v[j].w * v[j].w); }
    s = wave_sum(s);
    unsigned long long* o8 = (unsigned long long*)orow + lane;
#pragma unroll
    for (int j = 0; j < 4; ++j) o8[64 * j] = (unsigned long long)pk2(v[j].x, v[j].y) | ((unsigned long long)pk2(v[j].z, v[j].w) << 32);
    if (lane == 0) *ssq_slot = s;
}
struct S5P { float dt, lr, li; };
DI S5P s5_par(const float* lre, const float* lim, const float* logdt, int g, int n) { S5P p; p.dt = expf(logdt[g]); p.lr = lre[g * 64 + n]; p.li = lim[g * 64 + n]; return p; }
DI f32x2 s5_pow(const S5P& p, int j) {
    const float mag = expf((float)j * (p.dt * p.lr)); float sn, cs; sincosf((float)j * (p.dt * p.li), &sn, &cs); return (f32x2){mag * cs, mag * sn};
}
DI f32x2 s5_coef(const S5P& p) {
    const f32x2 ab = s5_pow(p, 1); const float den = p.lr * p.lr + p.li * p.li;
    return (f32x2){((ab.x - 1.f) * p.lr + ab.y * p.li) / den, (ab.y * p.lr - (ab.x - 1.f) * p.li) / den};
}
DI f32x2 cmul(f32x2 a, f32x2 b) { return (f32x2){a.x * b.x - a.y * b.y, a.x * b.y + a.y * b.x}; }

template <int NT>
DI void gla_gate_cumsum(const float* zg, float* bb, float* seg, const float* wg, const float* bg, int h, int tid) {
    if constexpr (NT == 64) {
        const int d = tid & 63; float wr[16]; const float bias = bg[h * 64 + d];
#pragma unroll
        for (int r = 0; r < 16; ++r) wr[r] = wg[r * 256 + h * 64 + d];
#pragma unroll
        for (int k = 0; k < 8; ++k) { const int t = (tid >> 6) + 8 * k; const f32x4* zp = (const f32x4*)(zg + t * 16); float s = bias;
#pragma unroll
            for (int r4 = 0; r4 < 4; ++r4) { const f32x4 z = zp[r4]; s += z[0] * wr[r4 * 4] + z[1] * wr[r4 * 4 + 1] + z[2] * wr[r4 * 4 + 2] + z[3] * wr[r4 * 4 + 3]; }
            bb[t * 65 + d] = logsigmoidf(s) * (1.f / 16.f); }
    } else {
    for (int i = tid; i < NT * 64; i += NTHREADS) { const int t = i >> 6, d = i & 63; float s = bg[h * 64 + d];
#pragma unroll
        for (int r = 0; r < 16; ++r) s += zg[t * 16 + r] * wg[r * 256 + h * 64 + d];
        bb[t * 65 + d] = logsigmoidf(s) * (1.f / 16.f); }
    }
    __syncthreads();
    if constexpr (NT == 64) {
        const int d = tid & 63, sg = tid >> 6; float run = 0.f;
#pragma unroll
        for (int i = 0; i < 8; ++i) { run += bb[(sg * 8 + i) * 65 + d]; bb[(sg * 8 + i) * 65 + d] = run; }
        seg[sg * 64 + d] = run;
        __syncthreads();
        float pre = 0.f;
        for (int j = 0; j < sg; ++j) pre += seg[j * 64 + d];
#pragma unroll
        for (int i = 0; i < 8; ++i) bb[(sg * 8 + i) * 65 + d] += pre;
    } else {
        if (tid < 64) { float run = 0.f;
#pragma unroll
            for (int t = 0; t < NT; ++t) { run += bb[t * 65 + tid]; bb[t * 65 + tid] = run; } }
    }
    __syncthreads();
}


template <bool OUT_F32> struct SEpiResid {
    const bf16_t* base; bf16_t* hbo; float* outf; float* ssq; float alpha;
    DI void operator()(int row, int col, const f32x4& a0, const f32x4& a1, int tid) const {
        const u32x4 bw = *(const u32x4*)(base + (size_t)row * D + col);
        f32x4 v0 = a0 * alpha, v1 = a1 * alpha;
        v0[0] += bflo(bw.x); v0[1] += bfhi(bw.x); v0[2] += bflo(bw.y); v0[3] += bfhi(bw.y); v1[0] += bflo(bw.z); v1[1] += bfhi(bw.z); v1[2] += bflo(bw.w); v1[3] += bfhi(bw.w);
        if constexpr (OUT_F32) { *(f32x4*)(outf + (size_t)row * D + col) = v0; *(f32x4*)(outf + (size_t)row * D + col + 4) = v1; }
        else {
            u32x4 w; w.x = pk2(v0[0], v0[1]); w.y = pk2(v0[2], v0[3]); w.z = pk2(v1[0], v1[1]); w.w = pk2(v1[2], v1[3]); *(u32x4*)(hbo + (size_t)row * D + col) = w;
            float sq = (v0[0] * v0[0] + v0[1] * v0[1]) + (v0[2] * v0[2] + v0[3] * v0[3]) + (v1[0] * v1[0] + v1[1] * v1[1]) + (v1[2] * v1[2] + v1[3] * v1[3]);
            sq += __shfl_xor(sq, 1); sq += __shfl_xor(sq, 2); sq += __shfl_xor(sq, 4); if ((tid & 7) == 0) atomicAdd(ssq + row, sq);
        }
    }
};
struct SEpiScaleBf16 {
    bf16_t* O; const float* ssq; float scale;
    DI void operator()(int row, int col, const f32x4& a0, const f32x4& a1, int) const {
        const float rs = rsqrtf(ssq[row] * (1.f / D) + EPS) * scale; const f32x4 v0 = a0 * rs, v1 = a1 * rs;
        u32x4 w; w.x = pk2(v0[0], v0[1]); w.y = pk2(v0[2], v0[3]); w.z = pk2(v1[0], v1[1]); w.w = pk2(v1[2], v1[3]); *(u32x4*)(O + (size_t)row * D + col) = w;
    }
};
template <class F>
DI void small_gemm(const bf16_t* A, const bf16_t* Bt, int K, float* red, int G, int bx, int wave, int tid, const F& epi) {
    const int lane = tid & 63, fr = lane & 15, fq = lane >> 4, kw = K >> 3, nsteps = kw >> 5;
    for (int tile = bx; tile < 256; tile += G) {
        const int row0 = (tile >> 4) * 64, col0 = (tile & 15) * 64;
        f32x4 acc[4][4];
#pragma unroll
        for (int i = 0; i < 4; ++i)
#pragma unroll
            for (int j = 0; j < 4; ++j) acc[i][j] = (f32x4){0.f, 0.f, 0.f, 0.f};
        const bf16_t* ap = A + (size_t)(row0 + fr) * K + wave * kw + fq * 8;
        const bf16_t* bp = Bt + (size_t)(col0 + fr) * K + wave * kw + fq * 8;
#pragma unroll 2
        for (int st = 0; st < nsteps; ++st) {
            bf16x8 a[4], b[4];
#pragma unroll
            for (int i = 0; i < 4; ++i) { a[i] = *(const bf16x8*)(ap + (size_t)i * 16 * K + st * 32); b[i] = *(const bf16x8*)(bp + (size_t)i * 16 * K + st * 32); }
#pragma unroll
            for (int i = 0; i < 4; ++i)
#pragma unroll
                for (int j = 0; j < 4; ++j) acc[i][j] = __builtin_amdgcn_mfma_f32_16x16x32_bf16(a[i], b[j], acc[i][j], 0, 0, 0);
        }
        float* my = red + wave * (64 * 68);
#pragma unroll
        for (int i = 0; i < 4; ++i)
#pragma unroll
            for (int j = 0; j < 4; ++j)
#pragma unroll
                for (int r = 0; r < 4; ++r) my[(i * 16 + fq * 4 + r) * 68 + j * 16 + fr] = acc[i][j][r];
        __syncthreads();
        { const int row = tid >> 3, c8 = (tid & 7) * 8; f32x4 s0 = (f32x4){0.f, 0.f, 0.f, 0.f}, s1 = s0;
#pragma unroll
            for (int w = 0; w < 8; ++w) { const f32x4* p = (const f32x4*)(red + w * (64 * 68) + row * 68 + c8); s0 += p[0]; s1 += p[1]; }
            epi(MP + row0 + row, col0 + c8, s0, s1, tid); }
        __syncthreads();
    }
}

__global__ void __launch_bounds__(NTHREADS, 2) hymba_fwd(Args args) {
    extern __shared__ __attribute__((aligned(16))) unsigned char lds[];
    cg::grid_group grid = cg::this_grid();
    const int tid0 = threadIdx.x, wave = __builtin_amdgcn_readfirstlane(tid0 >> 6);
    const int G = gridDim.x, bx = blockIdx.x;
    const int gw = bx * NWAVES + wave, NGW = G * NWAVES;
    const int NGT = G * NTHREADS;
#define PHASE_LOCALS int tid_l_ = tid0; asm volatile("" : "+v"(tid_l_)); const int tid = tid_l_, lane = tid & 63, gt = bx * NTHREADS + tid; (void)lane; (void)gt
    unsigned char* ws = args.ws;
    float* out = args.out;
    float* fl = (float*)lds;
    LAS unsigned char* ldsl = (LAS unsigned char*)lds;

    const float* x_prompt = args.in[0]; const float* x_sample = args.in[1]; const float* state_gla = args.in[2];
    const float* st_re = args.in[3]; const float* st_im = args.in[4]; const float* cache_k = args.in[5]; const float* cache_v = args.in[6];
    const float* mem_prompt = args.in[7];
    const float* w_gate = args.in[13]; const float* b_gate = args.in[14]; const float* g_gla_out = args.in[15];
    const float* s5_lre = args.in[16]; const float* s5_lim = args.in[17]; const float* s5_logdt = args.in[18];
    const float* s5_bre = args.in[19]; const float* s5_bim = args.in[20]; const float* s5_cre = args.in[21]; const float* s5_cim = args.in[22];
    const float* s5_d = args.in[23]; const float* s5_wglu = args.in[24]; const float* s5_bglu = args.in[25];
    const float* g_final = args.in[35];

    float* ssq = (float*)(ws + WS_SSQ);
    bf16_t* Wgu1 = (bf16_t*)(ws + WS_WGU1); bf16_t* Wd1 = (bf16_t*)(ws + WS_WD1); bf16_t* Win = (bf16_t*)(ws + WS_WIN); bf16_t* Wout = (bf16_t*)(ws + WS_WOUT);
    bf16_t* Wcq = (bf16_t*)(ws + WS_WCQ); bf16_t* Wckv = (bf16_t*)(ws + WS_WCKV); bf16_t* Wco = (bf16_t*)(ws + WS_WCO); bf16_t* Wgu2 = (bf16_t*)(ws + WS_WGU2); bf16_t* Wd2 = (bf16_t*)(ws + WS_WD2);
    bf16_t* EgT = (bf16_t*)(ws + WS_EGT); bf16_t* GTt = (bf16_t*)(ws + WS_GTT);
    bf16_t* memb = (bf16_t*)(ws + WS_MEMB); bf16_t* kb = (bf16_t*)(ws + WS_KB); bf16_t* vbT = (bf16_t*)(ws + WS_VBT);
    bf16_t* xb = (bf16_t*)(ws + WS_XB); bf16_t* hb = (bf16_t*)(ws + WS_HB); float* hres = (float*)(ws + WS_H);
    bf16_t* act = (bf16_t*)(ws + WS_ACT); bf16_t* Pb = (bf16_t*)(ws + WS_ACT);
    bf16_t* mix = (bf16_t*)(ws + WS_MIX); bf16_t* qb = (bf16_t*)(ws + WS_Q); bf16_t* ob = (bf16_t*)(ws + WS_O);
    float* glaD = (float*)(ws + WS_GLAD); float* glaDec = (float*)(ws + WS_GLADEC); float* glaS = (float*)(ws + WS_XB);
    float* s5e = (float*)(ws + WS_S5E); bf16_t* s5x = (bf16_t*)(ws + WS_S5X);

    const int lo = args.ph_lo, hi = args.ph_hi;
    if (tid0 < 16) ((LAS unsigned*)(ldsl + LDS_BARST))[tid0] = 0u;
    __syncthreads();
    const XcdBarrier xbar = xcd_barrier_post((unsigned*)(ws + WS_BAR), (volatile LAS unsigned*)(ldsl + LDS_BARST));
    if (lo < 0) grid.sync();
#ifndef PHASE_MASK
#define PHASE_MASK 0xffffffffu
#endif
#define IN(k) (((PHASE_MASK >> (k)) & 1u) && lo <= (k) && (k) < hi)
#ifndef REPEAT_MASK
#define REPEAT_MASK 0u
#endif
#define PHASE(k) if (IN(k)) for (int rep_ = 0; rep_ < 1 + (int)((REPEAT_MASK >> (k)) & 1u); ++rep_)
#define PHASE_G(k) if (IN(k))
#define GREP(k) (1 + (int)((REPEAT_MASK >> (k)) & 1u))
#define SUBREP(bit) for (int sr_ = 0; sr_ < 1 + (int)((REPEAT_MASK >> (bit)) & 1u); ++sr_)
#define REP_SYNC() do { if (rep_) xcd_barrier(xbar); } while (0)
#define SEAM(k) do { if (IN(k) && IN((k) + 1)) xcd_barrier(xbar); } while (0)

    PHASE(0) {
        REP_SYNC();
        PHASE_LOCALS;
        float* scr = fl + wave * (64 * 33);
        constexpr int I_GU = 16 * 176, I_D = 44 * 32, I_IN = 16 * 65, I_SQ = 16 * 32, I_CKV = 16 * 64;
        constexpr int NITEMS = 2 * I_GU + 2 * I_D + I_IN + 3 * I_SQ + I_CKV;
        for (int it = gw; it < NITEMS; it += NGW) {
            int r = it;
            if (r < I_GU) { p0_transpose_item(args.in[9], args.in[8], D, NGU, Wgu1, 1, scr, r, lane); continue; } r -= I_GU;
            if (r < I_GU) { p0_transpose_item(args.in[33], args.in[32], D, NGU, Wgu2, 1, scr, r, lane); continue; } r -= I_GU;
            if (r < I_D) { p0_transpose_item(args.in[10], nullptr, FF, D, Wd1, 0, scr, r, lane); continue; } r -= I_D;
            if (r < I_D) { p0_transpose_item(args.in[34], nullptr, FF, D, Wd2, 0, scr, r, lane); continue; } r -= I_D;
            if (r < I_IN) { p0_transpose_item(args.in[12], args.in[11], D, NIN, Win, 2, scr, r, lane); continue; } r -= I_IN;
            if (r < I_SQ) { p0_transpose_item(args.in[26], nullptr, D, D, Wout, 0, scr, r, lane); continue; } r -= I_SQ;
            if (r < I_SQ) { p0_transpose_item(args.in[29], args.in[27], D, D, Wcq, 0, scr, r, lane); continue; } r -= I_SQ;
            if (r < I_SQ) { p0_transpose_item(args.in[31], nullptr, D, D, Wco, 0, scr, r, lane); continue; } r -= I_SQ;
            p0_transpose_item(args.in[30], args.in[28], D, 2 * D, Wckv, 0, scr, r, lane);
        }
        for (int i = gt; i < (NINP - NIN) * D / 8; i += NGT) ((u32x4*)(Win + (size_t)NIN * D))[i] = (u32x4){0u, 0u, 0u, 0u};
        for (int i = gt; i < 3 * M; i += NGT) ssq[SSQ_H1 + i] = 0.f;
        for (int m2 = gw; m2 < M / 2; m2 += NGW) {
            const int m = 2 * m2; const float* xr = m < MP ? x_prompt + (size_t)m * D : x_sample + (size_t)(m - MP) * D;
            const f32x4* xp = (const f32x4*)xr + lane; f32x4 v[8]; float s0 = 0.f, s1 = 0.f;
#pragma unroll
            for (int j = 0; j < 8; ++j) v[j] = xp[64 * j];
#pragma unroll
            for (int j = 0; j < 4; ++j) { s0 += (v[j].x * v[j].x + v[j].y * v[j].y) + (v[j].z * v[j].z + v[j].w * v[j].w); s1 += (v[4 + j].x * v[4 + j].x + v[4 + j].y * v[4 + j].y) + (v[4 + j].z * v[4 + j].z + v[4 + j].w * v[4 + j].w); }
            s0 = wave_sum(s0); s1 = wave_sum(s1);
            unsigned long long* o8 = (unsigned long long*)(xb + (size_t)m * D) + lane;
#pragma unroll
            for (int j = 0; j < 8; ++j) o8[64 * j] = (unsigned long long)pk2(v[j].x, v[j].y) | ((unsigned long long)pk2(v[j].z, v[j].w) << 32);
            if (lane == 0) { ssq[SSQ_X + m] = s0; ssq[SSQ_X + m + 1] = s1; }
        }
        for (int m = gw; m < MEMR; m += NGW) row_to_bf16_ssq(mem_prompt + (size_t)m * D, memb + (size_t)m * D, ssq + SSQ_MEM + m, lane);
        __syncthreads();
        for (int p = bx; p < 256; p += G) {
            const int g = p & 31, sub = p >> 5;
            f32x2* pw = (f32x2*)fl; f32x2* cf = pw + 64 * 9;
            { const int n = tid >> 3, j = tid & 7; const S5P sp = s5_par(s5_lre, s5_lim, s5_logdt, g, n);
              pw[n * 9 + j] = s5_pow(sp, j); if (j == 7) pw[n * 9 + 8] = s5_pow(sp, 8); if (j == 1) cf[n] = s5_coef(sp); }
            __syncthreads();
            const int q = sub * NTHREADS + tid;
            if (q < 512) {
                const int n = q >> 3, sx = q & 7;
                const f32x2 mm = cmul(pw[n * 9 + 7 - sx], cf[n]);
                unsigned wre[8], wim[8];
#pragma unroll
                for (int pp = 0; pp < 8; ++pp) {
                    const f32x2 b0 = (f32x2){s5_bre[(g * 64 + n) * 16 + 2 * pp], s5_bim[(g * 64 + n) * 16 + 2 * pp]}, b1 = (f32x2){s5_bre[(g * 64 + n) * 16 + 2 * pp + 1], s5_bim[(g * 64 + n) * 16 + 2 * pp + 1]};
                    const f32x2 v0 = cmul(mm, b0), v1 = cmul(mm, b1);
                    wre[pp] = pk2(v0.x, v1.x); wim[pp] = pk2(v0.y, v1.y);
                }
                u32x4* dre = (u32x4*)(EgT + ((size_t)(g * 128 + n) * 128 + sx * 16)); u32x4* dim = (u32x4*)(EgT + ((size_t)(g * 128 + 64 + n) * 128 + sx * 16));
                dre[0] = (u32x4){wre[0], wre[1], wre[2], wre[3]}; dre[1] = (u32x4){wre[4], wre[5], wre[6], wre[7]};
                dim[0] = (u32x4){wim[0], wim[1], wim[2], wim[3]}; dim[1] = (u32x4){wim[4], wim[5], wim[6], wim[7]};
            } else if (q < 1024) {
                const int t = (q >> 6) & 7, n = q & 63;
                const f32x2 pwt = pw[n * 9 + t + 1];
#pragma unroll
                for (int pp = 0; pp < 16; ++pp) {
                    const f32x2 c = (f32x2){s5_cre[(g * 16 + pp) * 64 + n], s5_cim[(g * 16 + pp) * 64 + n]};
                    const f32x2 v = cmul(c, pwt);
                    bf16_t* dst = GTt + (size_t)(g * 128 + t * 16 + pp) * 256;
                    dst[n] = (bf16_t)f2bf(v.x); dst[64 + n] = (bf16_t)f2bf(-v.y);
                }
            } else if (q < 2048) {
                const int t = (q >> 7) & 7, sx = (q >> 4) & 7, pp = q & 15;
                float a[16];
#pragma unroll
                for (int i = 0; i < 16; ++i) a[i] = 0.f;
                if (sx <= t) {
                    for (int n = 0; n < 64; ++n) {
                        const f32x2 c = (f32x2){s5_cre[(g * 16 + pp) * 64 + n], s5_cim[(g * 16 + pp) * 64 + n]};
                        const f32x2 cc = cmul(cmul(c, pw[n * 9 + t - sx]), cf[n]);
                        const f32x4* br = (const f32x4*)(s5_bre + (g * 64 + n) * 16); const f32x4* bi = (const f32x4*)(s5_bim + (g * 64 + n) * 16);
#pragma unroll
                        for (int q4 = 0; q4 < 4; ++q4) { const f32x4 r4 = br[q4], i4 = bi[q4];
#pragma unroll
                            for (int e = 0; e < 4; ++e) a[q4 * 4 + e] += cc.x * r4[e] - cc.y * i4[e]; }
                    }
                }
                u32x4* dst = (u32x4*)(GTt + (size_t)(g * 128 + t * 16 + pp) * 256 + 128 + sx * 16);
                dst[0] = (u32x4){pk2(a[0], a[1]), pk2(a[2], a[3]), pk2(a[4], a[5]), pk2(a[6], a[7])};
                dst[1] = (u32x4){pk2(a[8], a[9]), pk2(a[10], a[11]), pk2(a[12], a[13]), pk2(a[14], a[15])};
            }
            __syncthreads();
        }
    }
    SEAM(0);

    for (int i_ = 0; i_ < 20 * (int)((REPEAT_MASK >> 23) & 1u); ++i_) xcd_barrier(xbar);
    PHASE_G(1) {
        pg8::Gemm g{xb, Wgu1, M, NGU, D}; pg8::StaticOrder S; S.init(M, NGU, G, bx, GREP(1));
        pg8::EpiSwiGLU E{act, FF, ssq + SSQ_X};
        pg8::gemm_phase<pg8::EpiSwiGLU, pg8::StaticOrder, true, true>(ldsl, g, S, E);
    }
    SEAM(1);
    PHASE_G(2) {
        pg8::Gemm g{act, Wd1, MP, D, FF}; pg8::StaticOrder S; S.init(MP, D, G, bx);
        pg8::EpiResid<false> E{xb, hb, nullptr, ssq + SSQ_H1, 0.5f};
        pg8::gemm_phase<pg8::EpiResid<false>, pg8::StaticOrder, true, true>(ldsl, g, S, E);
        SEpiResid<false> SE{xb, hb, nullptr, ssq + SSQ_H1, 0.5f};
        small_gemm(act + (size_t)MP * FF, Wd1, FF, fl, G, bx, wave, tid0, SE);
    }
    SEAM(2);
    PHASE_G(3) {
        { pg8::Gemm g{hb, Win, M, NINP, D}; pg8::StaticOrder S; S.init(M, NINP, G, bx, GREP(3));
          pg8::EpiScaleBf16 E{Pb, NINP, ssq + SSQ_H1, 1.f};
          pg8::gemm_phase<pg8::EpiScaleBf16, pg8::StaticOrder, true, true>(ldsl, g, S, E); }
        { pg8::Gemm g{memb, Wckv, MEMR, 2 * D, D}; pg8::StaticOrder S; S.init(MEMR, 2 * D, G, (bx + 64) % G);
          pg8::EpiMemKV E{out + O_MKP, out + O_MVP, kb, vbT, ssq + SSQ_MEM};
          pg8::gemm_phase<pg8::EpiMemKV, pg8::StaticOrder, true, true>(ldsl, g, S, E); }
    }
    SEAM(3);

    PHASE(4) {
        REP_SYNC();
        PHASE_LOCALS;
        SUBREP(16)
        {
            float* zg = fl; float* kk = zg + 64 * 16; float* vv = kk + 64 * 65; float* bb = vv + 64 * 129; float* seg = bb + 64 * 65;
            const int fr = lane & 15, fq = lane >> 4;
            for (int unit = bx; unit < 1024; unit += G) {
                const int bh = unit >> 5, c = unit & 31, b = bh >> 2, h = bh & 3;
                const size_t r0 = (size_t)b * 2048 + c * 64;
                if (tid < 128) { const int t = tid >> 1, hf = tid & 1; const u32x4 w = *(const u32x4*)(Pb + (r0 + t) * NINP + PC_ZG + hf * 8);
                    float* z = zg + t * 16 + hf * 8; z[0] = bflo(w.x); z[1] = bfhi(w.x); z[2] = bflo(w.y); z[3] = bfhi(w.y); z[4] = bflo(w.z); z[5] = bfhi(w.z); z[6] = bflo(w.w); z[7] = bfhi(w.w); }
                const u32x4 kw = *(const u32x4*)(Pb + (r0 + (tid >> 3)) * NINP + PC_K + h * 64 + (tid & 7) * 8);
#pragma unroll
                for (int i = 0; i < 2; ++i) { const int ch = tid + i * 512, t = ch >> 4, c8 = ch & 15; const u32x4 w = *(const u32x4*)(Pb + (r0 + t) * NINP + PC_V + h * 128 + c8 * 8);
                    float* z = vv + t * 129 + c8 * 8; z[0] = bflo(w.x); z[1] = bfhi(w.x); z[2] = bflo(w.y); z[3] = bfhi(w.y); z[4] = bflo(w.z); z[5] = bfhi(w.z); z[6] = bflo(w.w); z[7] = bfhi(w.w); }
                __syncthreads();
                gla_gate_cumsum<64>(zg, bb, seg, w_gate, b_gate, h, tid);
                { const int t = tid >> 3, d0 = (tid & 7) * 8; float* z = kk + t * 65 + d0; const float* bl = bb + 63 * 65 + d0; const float* bt = bb + t * 65 + d0;
                    z[0] = bflo(kw.x) * __expf(bl[0] - bt[0]); z[1] = bfhi(kw.x) * __expf(bl[1] - bt[1]); z[2] = bflo(kw.y) * __expf(bl[2] - bt[2]); z[3] = bfhi(kw.y) * __expf(bl[3] - bt[3]);
                    z[4] = bflo(kw.z) * __expf(bl[4] - bt[4]); z[5] = bfhi(kw.z) * __expf(bl[5] - bt[5]); z[6] = bflo(kw.w) * __expf(bl[6] - bt[6]); z[7] = bfhi(kw.w) * __expf(bl[7] - bt[7]); }
                __syncthreads();
                {
                    f32x4 acc[4];
#pragma unroll
                    for (int db = 0; db < 4; ++db) acc[db] = (f32x4){0.f, 0.f, 0.f, 0.f};
#pragma unroll
                    for (int ks = 0; ks < 2; ++ks) {
                        float av[8];
#pragma unroll
                        for (int j = 0; j < 8; ++j) av[j] = vv[(ks * 32 + fq * 8 + j) * 129 + wave * 16 + fr];
                        const u32x4 ap = (u32x4){pk2(av[0], av[1]), pk2(av[2], av[3]), pk2(av[4], av[5]), pk2(av[6], av[7])};
#pragma unroll
                        for (int db = 0; db < 4; ++db) {
                            float bv[8];
#pragma unroll
                            for (int j = 0; j < 8; ++j) bv[j] = kk[(ks * 32 + fq * 8 + j) * 65 + db * 16 + fr];
                            const u32x4 bp = (u32x4){pk2(bv[0], bv[1]), pk2(bv[2], bv[3]), pk2(bv[4], bv[5]), pk2(bv[6], bv[7])};
                            acc[db] = __builtin_amdgcn_mfma_f32_16x16x32_bf16(__builtin_bit_cast(bf16x8, ap), __builtin_bit_cast(bf16x8, bp), acc[db], 0, 0, 0);
                        }
                    }
                    float* dp = glaD + (size_t)unit * 8192;
#pragma unroll
                    for (int db = 0; db < 4; ++db)
#pragma unroll
                        for (int r = 0; r < 4; ++r) dp[(wave * 16 + fq * 4 + r) * 64 + db * 16 + fr] = acc[db][r];
                }
                if (tid < 64) glaDec[unit * 64 + tid] = __expf(bb[63 * 65 + tid]);
                __syncthreads();
            }
        }
        SUBREP(17)
        {
            float* zg = fl; float* qq = zg + 8 * 16; float* kk = qq + 8 * 65; float* kt = kk + 8 * 65; float* vv = kt + 8 * 65; float* bb = vv + 8 * 128; float* sc = bb + 8 * 65; float* S0 = sc + 64;
            for (int unit = bx; unit < 512; unit += G) {
                const int b = unit >> 2, h = unit & 3; const size_t r0 = (size_t)MP + b * 8;
                if (tid < 128) { const int t = tid >> 4, r = tid & 15; zg[t * 16 + r] = bf2f(Pb[(r0 + t) * NINP + PC_ZG + r]); }
                { const int t = tid >> 6, d = tid & 63; qq[t * 65 + d] = bf2f(Pb[(r0 + t) * NINP + PC_Q + h * 64 + d]); kk[t * 65 + d] = bf2f(Pb[(r0 + t) * NINP + PC_K + h * 64 + d]); }
#pragma unroll
                for (int i = 0; i < 2; ++i) { const int idx = tid + i * 512, t = idx >> 7, e = idx & 127; vv[t * 128 + e] = bf2f(Pb[(r0 + t) * NINP + PC_V + h * 128 + e]); }
                { const f32x4* sp = (const f32x4*)(state_gla + (size_t)unit * 8192); f32x4* dp = (f32x4*)S0;
#pragma unroll
                    for (int i = 0; i < 4; ++i) dp[tid + i * 512] = sp[tid + i * 512]; }
                __syncthreads();
                gla_gate_cumsum<8>(zg, bb, nullptr, w_gate, b_gate, h, tid);
                { const int t = tid >> 6, d = tid & 63; const float bt = bb[t * 65 + d], b7 = bb[7 * 65 + d]; const float kv = kk[t * 65 + d];
                    qq[t * 65 + d] *= __expf(bt) * 0.125f; kk[t * 65 + d] = kv * __expf(-bt); kt[t * 65 + d] = kv * __expf(b7 - bt); }
                __syncthreads();
                if (tid < 64) { const int t = tid >> 3, s = tid & 7; float a = 0.f; if (s <= t) { for (int d = 0; d < 64; ++d) a += qq[t * 65 + d] * kk[s * 65 + d]; } sc[t * 8 + s] = a; }
                __syncthreads();
                {
                    const int t = wave, e0 = lane * 2; float o0 = 0.f, o1 = 0.f;
                    for (int d = 0; d < 64; ++d) { const float qd = qq[t * 65 + d]; o0 += qd * S0[d * 128 + e0]; o1 += qd * S0[d * 128 + e0 + 1]; }
                    for (int s = 0; s <= t; ++s) { const float w = sc[t * 8 + s]; o0 += w * vv[s * 128 + e0]; o1 += w * vv[s * 128 + e0 + 1]; }
                    const float ss = wave_sum(o0 * o0 + o1 * o1); const float rs = rsqrtf(ss * (1.f / 128.f) + EPS);
                    const unsigned rw = *(const unsigned*)(Pb + (r0 + t) * NINP + PC_R + h * 128 + e0);
                    const float y0 = o0 * rs * g_gla_out[e0] * siluf(bflo(rw)), y1 = o1 * rs * g_gla_out[e0 + 1] * siluf(bfhi(rw));
                    *(unsigned*)(mix + (r0 + t) * D + h * 128 + e0) = pk2(y0, y1);
                }
                {
                    const int d = tid >> 3, e0 = (tid & 7) * 16; const float dec = __expf(bb[7 * 65 + d]);
                    f32x4 a[4];
#pragma unroll
                    for (int i = 0; i < 4; ++i) a[i] = ((const f32x4*)(S0 + d * 128 + e0))[i] * dec;
#pragma unroll
                    for (int s = 0; s < 8; ++s) { const float kd = kt[s * 65 + d]; const f32x4* vp = (const f32x4*)(vv + s * 128 + e0);
#pragma unroll
                        for (int i = 0; i < 4; ++i) a[i] += vp[i] * kd; }
                    f32x4* dp = (f32x4*)(out + O_GLAS + (size_t)unit * 8192 + d * 128 + e0);
#pragma unroll
                    for (int i = 0; i < 4; ++i) dp[i] = a[i];
                }
                __syncthreads();
            }
        }
        SUBREP(18)
        for (int p = bx; p < 256; p += G) {
            const int g = p & 31, fr = lane & 15, fq = lane >> 4;
            bf16_t* Es = (bf16_t*)lds;
            for (int ch = tid; ch < 128 * 16; ch += NTHREADS) { const int row = ch >> 4, c8 = ch & 15; *(u32x4*)(Es + row * 136 + c8 * 8) = *(const u32x4*)(EgT + (size_t)(g * 128 + row) * 128 + c8 * 8); }
            __syncthreads();
            for (int rb = (p >> 5) + 8 * wave; rb < 136; rb += 64) {
                const int R0 = rb * 16;
                bf16x8 a[4];
#pragma unroll
                for (int ks = 0; ks < 4; ++ks) a[ks] = *(const bf16x8*)(Pb + ((size_t)(R0 + fr) * 8 + ks * 2 + (fq >> 1)) * NINP + PC_U + g * 16 + (fq & 1) * 8);
                f32x4 acc[8];
#pragma unroll
                for (int nb = 0; nb < 8; ++nb) acc[nb] = (f32x4){0.f, 0.f, 0.f, 0.f};
#pragma unroll
                for (int ks = 0; ks < 4; ++ks)
                {
#pragma unroll
                    for (int nb = 0; nb < 8; ++nb) { const bf16x8 bfr = *(const bf16x8*)(Es + (nb * 16 + fr) * 136 + ks * 32 + fq * 8);
                        acc[nb] = __builtin_amdgcn_mfma_f32_16x16x32_bf16(a[ks], bfr, acc[nb], 0, 0, 0); }
                    __builtin_amdgcn_sched_barrier(0); }
#pragma unroll
                for (int nb = 0; nb < 8; ++nb)
#pragma unroll
                    for (int r = 0; r < 4; ++r) s5e[((size_t)(R0 + fq * 4 + r) * 32 + g) * 128 + nb * 16 + fr] = acc[nb][r];
            }
            __syncthreads();
        }
    }
    SEAM(4);

    PHASE(5) {
        REP_SYNC();
        PHASE_LOCALS;
        for (int idx = gt; idx < 32 * 8192; idx += NGT) {
            const int bh = idx >> 13, de = idx & 8191, d = de & 63, e = de >> 6;
            float Dv[32], dc[32];
#pragma unroll
            for (int c = 0; c < 32; ++c) { const int unit = bh * 32 + c; Dv[c] = glaD[(size_t)unit * 8192 + de]; dc[c] = glaDec[unit * 64 + d]; }
            float S = 0.f;
#pragma unroll
            for (int c = 0; c < 32; ++c) { glaS[(size_t)(bh * 32 + c) * 8192 + de] = S; S = dc[c] * S + Dv[c]; }
            out[O_GLAP + (size_t)bh * 8192 + d * 128 + e] = S;
        }
        for (int it = bx; it < 256; it += G) {
            const int b = it >> 5, g = it & 31, n = tid & 63, sgm = wave;
            const S5P p = s5_par(s5_lre, s5_lim, s5_logdt, g, n); const f32x2 a8 = s5_pow(p, 8);
            f32x2 a256 = a8;
#pragma unroll
            for (int i = 0; i < 5; ++i) a256 = cmul(a256, a256);
            float er[32], ei[32];
            const size_t o0 = (((size_t)b * 256 + sgm * 32) * 32 + g) * 128;
#pragma unroll
            for (int i = 0; i < 32; ++i) { er[i] = s5e[o0 + (size_t)i * 4096 + n]; ei[i] = s5e[o0 + (size_t)i * 4096 + 64 + n]; }
            float yr = 0.f, yi = 0.f;
#pragma unroll
            for (int i = 0; i < 32; ++i) { const float pr = yr, pi = yi; yr = a8.x * pr - a8.y * pi + er[i]; yi = a8.x * pi + a8.y * pr + ei[i]; er[i] = pr; ei[i] = pi; }
            fl[sgm * 64 + n] = yr; fl[512 + sgm * 64 + n] = yi;
            __syncthreads();
            float xr = 0.f, xi = 0.f;
            for (int j = 0; j < sgm; ++j) { const float tr = fl[j * 64 + n], ti = fl[512 + j * 64 + n]; const float nr = a256.x * xr - a256.y * xi + tr, ni = a256.x * xi + a256.y * xr + ti; xr = nr; xi = ni; }
            f32x2 pw = (f32x2){1.f, 0.f};
#pragma unroll
            for (int i = 0; i < 32; ++i) {
                s5x[o0 + (size_t)i * 4096 + n] = (bf16_t)f2bf(er[i] + pw.x * xr - pw.y * xi); s5x[o0 + (size_t)i * 4096 + 64 + n] = (bf16_t)f2bf(ei[i] + pw.x * xi + pw.y * xr);
                pw = cmul(pw, a8);
            }
            if (sgm == 7) { out[O_REP + (b * 32 + g) * 64 + n] = yr + a256.x * xr - a256.y * xi; out[O_IMP + (b * 32 + g) * 64 + n] = yi + a256.x * xi + a256.y * xr; }
            __syncthreads();
        }
        for (int idx = gt; idx < 128 * 32 * 64; idx += NGT) {
            const int b = idx >> 11, g = (idx >> 6) & 31, n = idx & 63;
            const S5P p = s5_par(s5_lre, s5_lim, s5_logdt, g, n); const f32x2 a8 = s5_pow(p, 8);
            const float xr = st_re[idx], xi = st_im[idx];
            const size_t R = 2048 + b; const size_t o = (R * 32 + g) * 128;
            s5x[o + n] = (bf16_t)f2bf(xr); s5x[o + 64 + n] = (bf16_t)f2bf(xi);
            out[O_RES + idx] = a8.x * xr - a8.y * xi + s5e[o + n]; out[O_IMS + idx] = a8.x * xi + a8.y * xr + s5e[o + 64 + n];
        }
    }
    SEAM(5);

    PHASE(6) {
        REP_SYNC();
        PHASE_LOCALS;
        SUBREP(19)
        {
            float* zg = fl; float* bb = zg + 64 * 16; float* seg = bb + 64 * 65; float* vv = seg + 512; float* red = vv + 64 * 129;
            bf16_t* qq = (bf16_t*)(red + 512); bf16_t* kk = qq + 64 * 72; bf16_t* sc = kk + 64 * 72;
            const int fr = lane & 15, fq = lane >> 4;
            for (int unit = bx; unit < 1024; unit += G) {
                const int bh = unit >> 5, c = unit & 31, b = bh >> 2, h = bh & 3;
                const size_t r0 = (size_t)b * 2048 + c * 64;
                if (tid < 128) { const int t = tid >> 1, hf = tid & 1; const u32x4 w = *(const u32x4*)(Pb + (r0 + t) * NINP + PC_ZG + hf * 8);
                    float* z = zg + t * 16 + hf * 8; z[0] = bflo(w.x); z[1] = bfhi(w.x); z[2] = bflo(w.y); z[3] = bfhi(w.y); z[4] = bflo(w.z); z[5] = bfhi(w.z); z[6] = bflo(w.w); z[7] = bfhi(w.w); }
                const u32x4 kw = *(const u32x4*)(Pb + (r0 + (tid >> 3)) * NINP + PC_K + h * 64 + (tid & 7) * 8);
                const u32x4 qw = *(const u32x4*)(Pb + (r0 + (tid >> 3)) * NINP + PC_Q + h * 64 + (tid & 7) * 8);
#pragma unroll
                for (int i = 0; i < 2; ++i) { const int ch = tid + i * 512, t = ch >> 4, c8 = ch & 15; const u32x4 w = *(const u32x4*)(Pb + (r0 + t) * NINP + PC_V + h * 128 + c8 * 8);
                    float* z = vv + t * 129 + c8 * 8; z[0] = bflo(w.x); z[1] = bfhi(w.x); z[2] = bflo(w.y); z[3] = bfhi(w.y); z[4] = bflo(w.z); z[5] = bfhi(w.z); z[6] = bflo(w.w); z[7] = bfhi(w.w); }
                __syncthreads();
                gla_gate_cumsum<64>(zg, bb, seg, w_gate, b_gate, h, tid);
                {
                    const int t = tid >> 3, d0 = (tid & 7) * 8; const float* bt = bb + t * 65 + d0;
                    float eb[8];
#pragma unroll
                    for (int j = 0; j < 8; ++j) eb[j] = __expf(bt[j]);
                    u32x4 qo, ko;
                    qo.x = pk2(bflo(qw.x) * eb[0] * 0.125f, bfhi(qw.x) * eb[1] * 0.125f); qo.y = pk2(bflo(qw.y) * eb[2] * 0.125f, bfhi(qw.y) * eb[3] * 0.125f);
                    qo.z = pk2(bflo(qw.z) * eb[4] * 0.125f, bfhi(qw.z) * eb[5] * 0.125f); qo.w = pk2(bflo(qw.w) * eb[6] * 0.125f, bfhi(qw.w) * eb[7] * 0.125f);
#pragma unroll
                    for (int j = 0; j < 8; ++j) eb[j] = __builtin_amdgcn_rcpf(eb[j]);
                    ko.x = pk2(bflo(kw.x) * eb[0], bfhi(kw.x) * eb[1]); ko.y = pk2(bflo(kw.y) * eb[2], bfhi(kw.y) * eb[3]);
                    ko.z = pk2(bflo(kw.z) * eb[4], bfhi(kw.z) * eb[5]); ko.w = pk2(bflo(kw.w) * eb[6], bfhi(kw.w) * eb[7]);
                    *(u32x4*)(qq + t * 72 + d0) = qo; *(u32x4*)(kk + t * 72 + d0) = ko;
                }
                __syncthreads();
                {
                    const int tb = wave >> 1;
#pragma unroll
                    for (int i = 0; i < 2; ++i) {
                        const int sb = (wave & 1) * 2 + i;
                        f32x4 a = (f32x4){0.f, 0.f, 0.f, 0.f};
                        if (sb <= tb) {
#pragma unroll
                            for (int ks = 0; ks < 2; ++ks) { const bf16x8 af = *(const bf16x8*)(qq + (tb * 16 + fr) * 72 + ks * 32 + fq * 8), bf = *(const bf16x8*)(kk + (sb * 16 + fr) * 72 + ks * 32 + fq * 8);
                                a = __builtin_amdgcn_mfma_f32_16x16x32_bf16(af, bf, a, 0, 0, 0); }
                            if (sb == tb) {
#pragma unroll
                                for (int r = 0; r < 4; ++r) if (fr > fq * 4 + r) a[r] = 0.f;
                            }
                        }
#pragma unroll
                        for (int r = 0; r < 4; ++r) sc[(tb * 16 + fq * 4 + r) * 72 + sb * 16 + fr] = (bf16_t)f2bf(a[r]);
                    }
                }
                __syncthreads();
                {
                    bf16x8 bS[2], bV[2];
                    const float* sp = glaS + (size_t)unit * 8192 + (size_t)(wave * 16 + fr) * 64 + fq * 8;
#pragma unroll
                    for (int ks = 0; ks < 2; ++ks) {
                        const f32x4 x0 = *(const f32x4*)(sp + ks * 32), x1 = *(const f32x4*)(sp + ks * 32 + 4);
                        const u32x4 p = (u32x4){pk2(x0[0], x0[1]), pk2(x0[2], x0[3]), pk2(x1[0], x1[1]), pk2(x1[2], x1[3])}; bS[ks] = __builtin_bit_cast(bf16x8, p);
                        float av[8];
#pragma unroll
                        for (int j = 0; j < 8; ++j) av[j] = vv[(ks * 32 + fq * 8 + j) * 129 + wave * 16 + fr];
                        const u32x4 pv = (u32x4){pk2(av[0], av[1]), pk2(av[2], av[3]), pk2(av[4], av[5]), pk2(av[6], av[7])}; bV[ks] = __builtin_bit_cast(bf16x8, pv);
                    }
                    f32x4 oa[4];
#pragma unroll
                    for (int tb = 0; tb < 4; ++tb) {
                        oa[tb] = (f32x4){0.f, 0.f, 0.f, 0.f};
#pragma unroll
                        for (int ks = 0; ks < 2; ++ks) {
                            const bf16x8 aq = *(const bf16x8*)(qq + (tb * 16 + fr) * 72 + ks * 32 + fq * 8), as = *(const bf16x8*)(sc + (tb * 16 + fr) * 72 + ks * 32 + fq * 8);
                            oa[tb] = __builtin_amdgcn_mfma_f32_16x16x32_bf16(aq, bS[ks], oa[tb], 0, 0, 0);
                            oa[tb] = __builtin_amdgcn_mfma_f32_16x16x32_bf16(as, bV[ks], oa[tb], 0, 0, 0);
                        }
                    }
#pragma unroll
                    for (int tb = 0; tb < 4; ++tb)
#pragma unroll
                        for (int r = 0; r < 4; ++r) { float q2 = oa[tb][r] * oa[tb][r]; q2 += __shfl_xor(q2, 1); q2 += __shfl_xor(q2, 2); q2 += __shfl_xor(q2, 4); q2 += __shfl_xor(q2, 8);
                            if (fr == 0) red[(tb * 16 + fq * 4 + r) * 8 + wave] = q2; }
                    __syncthreads();
                    const float gcol = g_gla_out[wave * 16 + fr];
#pragma unroll
                    for (int tb = 0; tb < 4; ++tb)
#pragma unroll
                        for (int r = 0; r < 4; ++r) { const int t = tb * 16 + fq * 4 + r; const f32x4 s0 = *(const f32x4*)(red + t * 8), s1 = *(const f32x4*)(red + t * 8 + 4);
                            const float rs = rsqrtf((((s0[0] + s0[1]) + (s0[2] + s0[3])) + ((s1[0] + s1[1]) + (s1[2] + s1[3]))) * (1.f / 128.f) + EPS);
                            const float rv = bf2f(Pb[(r0 + t) * NINP + PC_R + h * 128 + wave * 16 + fr]);
                            mix[(r0 + t) * D + h * 128 + wave * 16 + fr] = (bf16_t)f2bf(oa[tb][r] * rs * gcol * siluf(rv)); }
                }
                __syncthreads();
            }
        }
        SUBREP(20)
        for (int p = bx; p < 256; p += G) {
            const int g = p & 31, fr = lane & 15, fq = lane >> 4;
            bf16_t* Gs = (bf16_t*)lds;
            for (int ch = tid; ch < 128 * 32; ch += NTHREADS) { const int row = ch >> 5, c8 = ch & 31; *(u32x4*)(Gs + row * 264 + c8 * 8) = *(const u32x4*)(GTt + (size_t)(g * 128 + row) * 256 + c8 * 8); }
            bf16x4 wA;
#pragma unroll
            for (int i = 0; i < 4; ++i) wA[i] = (short)f2bf(s5_wglu[(g * 16 + fq * 4 + i) * 16 + fr]);
            const f32x4 dsk = *(const f32x4*)(s5_d + g * 16 + fq * 4), bgl = *(const f32x4*)(s5_bglu + g * 16 + fq * 4);
            __syncthreads();
            for (int rb = (p >> 5) + 8 * wave; rb < 136; rb += 64) {
                const int R0 = rb * 16;
                bf16x8 a[8];
#pragma unroll
                for (int ks = 0; ks < 4; ++ks) a[ks] = *(const bf16x8*)(s5x + ((size_t)(R0 + fr) * 32 + g) * 128 + ks * 32 + fq * 8);
#pragma unroll
                for (int ks = 0; ks < 4; ++ks) a[4 + ks] = *(const bf16x8*)(Pb + ((size_t)(R0 + fr) * 8 + ks * 2 + (fq >> 1)) * NINP + PC_U + g * 16 + (fq & 1) * 8);
                f32x4 acc[8];
#pragma unroll
                for (int nb = 0; nb < 8; ++nb) acc[nb] = (f32x4){0.f, 0.f, 0.f, 0.f};
#pragma unroll
                for (int ks = 0; ks < 8; ++ks)
                {
#pragma unroll
                    for (int nb = 0; nb < 8; ++nb) { const bf16x8 bfr = *(const bf16x8*)(Gs + (nb * 16 + fr) * 264 + ks * 32 + fq * 8);
                        acc[nb] = __builtin_amdgcn_mfma_f32_16x16x32_bf16(bfr, a[ks], acc[nb], 0, 0, 0); }
                    __builtin_amdgcn_sched_barrier(0); }
#pragma unroll
                for (int nb = 0; nb < 8; ++nb) {
                    const size_t row = (size_t)(R0 + fr) * 8 + nb;
                    const u32x2 uw = *(const u32x2*)(Pb + row * NINP + PC_U + g * 16 + fq * 4);
                    f32x4 z;
                    z[0] = gelu_tanh(acc[nb][0] + dsk[0] * bflo(uw.x)); z[1] = gelu_tanh(acc[nb][1] + dsk[1] * bfhi(uw.x));
                    z[2] = gelu_tanh(acc[nb][2] + dsk[2] * bflo(uw.y)); z[3] = gelu_tanh(acc[nb][3] + dsk[3] * bfhi(uw.y));
                    const u32x2 zp = (u32x2){pk2(z[0], z[1]), pk2(z[2], z[3])};
                    const f32x4 pre = __builtin_amdgcn_mfma_f32_16x16x16bf16_1k(wA, __builtin_bit_cast(bf16x4, zp), bgl, 0, 0, 0);
                    u32x2 o; o.x = pk2(z[0] * sigmoidf_fast(pre[0]), z[1] * sigmoidf_fast(pre[1])); o.y = pk2(z[2] * sigmoidf_fast(pre[2]), z[3] * sigmoidf_fast(pre[3]));
                    *(u32x2*)(mix + row * D + 512 + g * 16 + fq * 4) = o;
                }
            }
            __syncthreads();
        }
    }
    SEAM(6);

    PHASE_G(7) {
        pg8::Gemm g{mix, Wout, MP, D, D}; pg8::StaticOrder S; S.init(MP, D, G, bx);
        pg8::EpiResid<false> E{hb, hb, nullptr, ssq + SSQ_H2, 1.f};
        pg8::gemm_phase<pg8::EpiResid<false>, pg8::StaticOrder, true, true>(ldsl, g, S, E);
        SEpiResid<false> SE{hb, hb, nullptr, ssq + SSQ_H2, 1.f};
        small_gemm(mix + (size_t)MP * D, Wout, D, fl, G, bx, wave, tid0, SE);
    }
    SEAM(7);
    PHASE_G(8) {
        pg8::Gemm g{hb, Wcq, MP, D, D}; pg8::StaticOrder S; S.init(MP, D, G, bx, GREP(8));
        pg8::EpiScaleBf16 E{qb, D, ssq + SSQ_H2, 0.0625f};
        pg8::gemm_phase<pg8::EpiScaleBf16, pg8::StaticOrder, true, true>(ldsl, g, S, E);
        SEpiScaleBf16 SE{qb, ssq + SSQ_H2, 0.0625f};
        SUBREP(22)
        small_gemm(hb + (size_t)MP * D, Wcq, D, fl, G, bx, wave, tid0, SE);
    }
    SEAM(8);

    PHASE(9) {
        REP_SYNC();
        PHASE_LOCALS;
        constexpr int QS = 264;
        bf16_t* Qs = (bf16_t*)lds; bf16_t* Ps = Qs + 64 * QS; float* redmax = (float*)(Ps + 64 * QS); float* redsum = redmax + 64 * 8;
        const int fr = lane & 15, fq = lane >> 4, w = wave;
        for (int unit = bx; unit < 1024 + 512; unit += G) {
            const bool smp = unit >= 1024;
            int b, h; size_t r0; int nrows;
            if (!smp) { const int p = unit & 255, i = unit >> 8, bh = p >> 3, qt = (p & 7) * 4 + i; h = bh & 3; b = bh >> 2; r0 = (size_t)b * 2048 + qt * 64; nrows = 64; }
            else { const int u2 = unit - 1024; h = u2 & 3; b = u2 >> 2; r0 = (size_t)MP + b * 8; nrows = 8; }
            const int MB = smp ? 1 : 4;
            for (int ch = tid; ch < MB * 16 * 32; ch += NTHREADS) { const int row = ch >> 5, c8 = ch & 31; u32x4 v = (u32x4){0u, 0u, 0u, 0u};
                if (row < nrows) v = *(const u32x4*)(qb + (r0 + row) * D + h * 256 + c8 * 8);
                *(u32x4*)(Qs + row * QS + c8 * 8) = v; }
            __syncthreads();
            f32x4 sa[4][2];
#pragma unroll
            for (int mb = 0; mb < 4; ++mb) { sa[mb][0] = (f32x4){0.f, 0.f, 0.f, 0.f}; sa[mb][1] = sa[mb][0]; }
            if (!smp) {
                const bf16_t* kbase = kb + ((size_t)b * 256 + w * 32 + fr) * D + h * 256 + fq * 8;
#pragma unroll
                for (int ks = 0; ks < 8; ++ks) {
                    const bf16x8 b0 = *(const bf16x8*)(kbase + ks * 32), b1 = *(const bf16x8*)(kbase + (size_t)16 * D + ks * 32);
#pragma unroll
                    for (int mb = 0; mb < 4; ++mb) { const bf16x8 a = *(const bf16x8*)(Qs + (mb * 16 + fr) * QS + ks * 32 + fq * 8);
                        sa[mb][0] = __builtin_amdgcn_mfma_f32_16x16x32_bf16(a, b0, sa[mb][0], 0, 0, 0); sa[mb][1] = __builtin_amdgcn_mfma_f32_16x16x32_bf16(a, b1, sa[mb][1], 0, 0, 0); }
                }
            } else {
                const float* kbase = cache_k + ((size_t)b * 256 + w * 32 + fr) * D + h * 256 + fq * 8;
#pragma unroll
                for (int ks = 0; ks < 8; ++ks) {
                    u32x4 p0, p1;
                    { const f32x4 x0 = *(const f32x4*)(kbase + ks * 32), x1 = *(const f32x4*)(kbase + ks * 32 + 4); p0 = (u32x4){pk2(x0[0], x0[1]), pk2(x0[2], x0[3]), pk2(x1[0], x1[1]), pk2(x1[2], x1[3])}; }
                    { const f32x4 x0 = *(const f32x4*)(kbase + (size_t)16 * D + ks * 32), x1 = *(const f32x4*)(kbase + (size_t)16 * D + ks * 32 + 4); p1 = (u32x4){pk2(x0[0], x0[1]), pk2(x0[2], x0[3]), pk2(x1[0], x1[1]), pk2(x1[2], x1[3])}; }
                    const bf16x8 a = *(const bf16x8*)(Qs + fr * QS + ks * 32 + fq * 8);
                    sa[0][0] = __builtin_amdgcn_mfma_f32_16x16x32_bf16(a, __builtin_bit_cast(bf16x8, p0), sa[0][0], 0, 0, 0);
                    sa[0][1] = __builtin_amdgcn_mfma_f32_16x16x32_bf16(a, __builtin_bit_cast(bf16x8, p1), sa[0][1], 0, 0, 0);
                }
            }
#pragma unroll
            for (int mb = 0; mb < 4; ++mb) if (mb < MB) {
#pragma unroll
                for (int r = 0; r < 4; ++r) { float mx = fmaxf(sa[mb][0][r], sa[mb][1][r]);
                    mx = fmaxf(mx, __shfl_xor(mx, 1)); mx = fmaxf(mx, __shfl_xor(mx, 2)); mx = fmaxf(mx, __shfl_xor(mx, 4)); mx = fmaxf(mx, __shfl_xor(mx, 8));
                    if (fr == 0) redmax[(mb * 16 + fq * 4 + r) * 8 + w] = mx; }
            }
            __syncthreads();
#pragma unroll
            for (int mb = 0; mb < 4; ++mb) if (mb < MB) {
#pragma unroll
                for (int r = 0; r < 4; ++r) { const int q = mb * 16 + fq * 4 + r; const f32x4 m0 = *(const f32x4*)(redmax + q * 8), m1 = *(const f32x4*)(redmax + q * 8 + 4);
                    const float mx = fmaxf(fmaxf(fmaxf(m0[0], m0[1]), fmaxf(m0[2], m0[3])), fmaxf(fmaxf(m1[0], m1[1]), fmaxf(m1[2], m1[3])));
                    const float p0 = __expf(sa[mb][0][r] - mx), p1 = __expf(sa[mb][1][r] - mx);
                    Ps[q * QS + w * 32 + fr] = (bf16_t)f2bf(p0); Ps[q * QS + w * 32 + 16 + fr] = (bf16_t)f2bf(p1);
                    float sm = p0 + p1; sm += __shfl_xor(sm, 1); sm += __shfl_xor(sm, 2); sm += __shfl_xor(sm, 4); sm += __shfl_xor(sm, 8);
                    if (fr == 0) redsum[q * 8 + w] = sm; }
            }
            __syncthreads();
            f32x4 oa[4][2];
#pragma unroll
            for (int mb = 0; mb < 4; ++mb) { oa[mb][0] = (f32x4){0.f, 0.f, 0.f, 0.f}; oa[mb][1] = oa[mb][0]; }
            if (!smp) {
                const bf16_t* vbase = vbT + ((size_t)b * D + h * 256 + w * 32 + fr) * 256 + fq * 8;
#pragma unroll
                for (int ks = 0; ks < 8; ++ks) {
                    const bf16x8 b0 = *(const bf16x8*)(vbase + ks * 32), b1 = *(const bf16x8*)(vbase + 16 * 256 + ks * 32);
#pragma unroll
                    for (int mb = 0; mb < 4; ++mb) { const bf16x8 a = *(const bf16x8*)(Ps + (mb * 16 + fr) * QS + ks * 32 + fq * 8);
                        oa[mb][0] = __builtin_amdgcn_mfma_f32_16x16x32_bf16(a, b0, oa[mb][0], 0, 0, 0); oa[mb][1] = __builtin_amdgcn_mfma_f32_16x16x32_bf16(a, b1, oa[mb][1], 0, 0, 0); }
                }
            } else {
                const float* vbase = cache_v + ((size_t)b * 256 + fq * 8) * D + h * 256 + w * 32 + fr;
#pragma unroll
                for (int ks = 0; ks < 8; ++ks) {
                    float x0[8], x1[8];
#pragma unroll
                    for (int j = 0; j < 8; ++j) { x0[j] = vbase[(size_t)(ks * 32 + j) * D]; x1[j] = vbase[(size_t)(ks * 32 + j) * D + 16]; }
                    const u32x4 p0 = (u32x4){pk2(x0[0], x0[1]), pk2(x0[2], x0[3]), pk2(x0[4], x0[5]), pk2(x0[6], x0[7])};
                    const u32x4 p1 = (u32x4){pk2(x1[0], x1[1]), pk2(x1[2], x1[3]), pk2(x1[4], x1[5]), pk2(x1[6], x1[7])};
                    const bf16x8 a = *(const bf16x8*)(Ps + fr * QS + ks * 32 + fq * 8);
                    oa[0][0] = __builtin_amdgcn_mfma_f32_16x16x32_bf16(a, __builtin_bit_cast(bf16x8, p0), oa[0][0], 0, 0, 0);
                    oa[0][1] = __builtin_amdgcn_mfma_f32_16x16x32_bf16(a, __builtin_bit_cast(bf16x8, p1), oa[0][1], 0, 0, 0);
                }
            }
#pragma unroll
            for (int mb = 0; mb < 4; ++mb) if (mb < MB) {
#pragma unroll
                for (int r = 0; r < 4; ++r) { const int q = mb * 16 + fq * 4 + r; if (q < nrows) {
                    const f32x4 s0 = *(const f32x4*)(redsum + q * 8), s1 = *(const f32x4*)(redsum + q * 8 + 4);
                    const float inv = 1.f / (((s0[0] + s0[1]) + (s0[2] + s0[3])) + ((s1[0] + s1[1]) + (s1[2] + s1[3])));
                    bf16_t* op = ob + (r0 + q) * D + h * 256 + w * 32 + fr;
                    op[0] = (bf16_t)f2bf(oa[mb][0][r] * inv); op[16] = (bf16_t)f2bf(oa[mb][1][r] * inv); } }
            }
            __syncthreads();
        }
    }
    SEAM(9);

    PHASE_G(10) {
        pg8::Gemm g{ob, Wco, MP, D, D}; pg8::StaticOrder S; S.init(MP, D, G, bx);
        pg8::EpiResid<false> E{hb, hb, nullptr, ssq + SSQ_H3, 1.f};
        pg8::gemm_phase<pg8::EpiResid<false>, pg8::StaticOrder, true, true>(ldsl, g, S, E);
        SEpiResid<false> SE{hb, hb, nullptr, ssq + SSQ_H3, 1.f};
        small_gemm(ob + (size_t)MP * D, Wco, D, fl, G, bx, wave, tid0, SE);
    }
    SEAM(10);
    PHASE_G(11) {
        pg8::Gemm g{hb, Wgu2, M, NGU, D}; pg8::StaticOrder S; S.init(M, NGU, G, bx, GREP(11));
        pg8::EpiSwiGLU E{act, FF, ssq + SSQ_H3};
        pg8::gemm_phase<pg8::EpiSwiGLU, pg8::StaticOrder, true, true>(ldsl, g, S, E);
    }
    SEAM(11);
    PHASE_G(12) {
        pg8::Gemm g{act, Wd2, MP, D, FF}; pg8::StaticOrder S; S.init(MP, D, G, bx, GREP(12));
        pg8::EpiResid<true> E{hb, nullptr, hres, nullptr, 0.5f};
        pg8::gemm_phase<pg8::EpiResid<true>, pg8::StaticOrder, true, true>(ldsl, g, S, E);
        SEpiResid<true> SE{hb, nullptr, hres, nullptr, 0.5f};
        SUBREP(21)
        small_gemm(act + (size_t)MP * FF, Wd2, FF, fl, G, bx, wave, tid0, SE);
    }
    SEAM(12);
    PHASE(13) {
        REP_SYNC();
        PHASE_LOCALS;
        for (int m = gw; m < M; m += NGW) {
            f32x4* yr = (f32x4*)(out + O_Y + (size_t)m * D) + lane; const f32x4* hr = (const f32x4*)(hres + (size_t)m * D) + lane; f32x4 v[4]; float s = 0.f;
#pragma unroll
            for (int j = 0; j < 4; ++j) { v[j] = hr[64 * j]; s += (v[j].x * v[j].x + v[j].y * v[j].y) + (v[j].z * v[j].z + v[j].w * v[j].w); }
            const float rs = rsqrtf(wave_sum(s) * (1.f / D) + EPS);
#pragma unroll
            for (int j = 0; j < 4; ++j) { const f32x4 gq = ((const f32x4*)g_final)[lane + 64 * j]; yr[64 * j] = v[j] * rs * gq; }
        }
    }
#undef IN
#undef SEAM
}

extern "C" void kernel_launch(void* const* d_in, const int* in_sizes, int n_in, void* d_out, int out_size, void* d_ws, size_t ws_size, hipStream_t stream) {
    static int grid = 0;
    if (grid == 0) {
        if (n_in != 36 || (size_t)out_size != O_TOTAL || ws_size < WS_END) { fprintf(stderr, "kernel_launch: unexpected shapes (n_in %d, out %d, ws %zu)\n", n_in, out_size, ws_size); grid = -1; return; }
        int dev = 0, cus = 0, per_cu = 0;
        hipGetDevice(&dev); hipDeviceGetAttribute(&cus, hipDeviceAttributeMultiprocessorCount, dev);
        hipFuncSetAttribute((const void*)hymba_fwd, hipFuncAttributeMaxDynamicSharedMemorySize, LDS_BYTES);
        hipOccupancyMaxActiveBlocksPerMultiprocessor(&per_cu, (const void*)hymba_fwd, NTHREADS, LDS_BYTES);
        if (per_cu < 1) { fprintf(stderr, "kernel_launch: occupancy query says %d blocks per CU\n", per_cu); per_cu = 1; }
        grid = cus;
        (void)hipGetLastError();
    }
    if (grid < 0) return;
    if (hipMemsetAsync((char*)d_ws + WS_BAR, 0, BAR_BYTES, stream) != hipSuccess) { fprintf(stderr, "kernel_launch: memset failed\n"); return; }
    Args a{};
    for (int i = 0; i < 36; ++i) a.in[i] = (const float*)d_in[i];
    a.out = (float*)d_out; a.ws = (unsigned char*)d_ws; a.ph_lo = 0; a.ph_hi = 14;
    void* params[] = {&a};
    hipError_t e = hipLaunchCooperativeKernel((const void*)hymba_fwd, dim3(grid), dim3(NTHREADS), params, LDS_BYTES, stream);
    if (e != hipSuccess) fprintf(stderr, "kernel_launch: cooperative launch failed: %s (grid %d)\n", hipGetErrorString(e), grid);
}
```

```cpp
#include <hip/hip_runtime.h>
#include <hip/hip_cooperative_groups.h>
#include <cstdio>
#include <cstdint>
namespace cg = cooperative_groups;

constexpr int D = 1024, MP = 16384, MS = 1024, M = MP + MS, FF = 2816, NGU = 2 * FF, NIN = 2064, NINP = 2304;
constexpr int MEMR = 2048;
constexpr float EPS = 1e-6f;
constexpr int PC_Q = 0, PC_K = 256, PC_V = 512, PC_R = 1024, PC_U = 1536, PC_ZG = 2048;
constexpr size_t O_Y = 0, O_GLAP = 17825792, O_REP = 18087936, O_IMP = 18104320, O_MKP = 18120704, O_MVP = 20217856,
                 O_GLAS = 22315008, O_RES = 26509312, O_IMS = 26771456, O_TOTAL = 27033600;
constexpr size_t MiB = 1u << 20;
constexpr int XCD_BAR_WORDS_C = 3456;
constexpr size_t WS_SSQ = 0;
constexpr size_t WS_WGU1 = 1 * MiB, WS_WD1 = 12 * MiB, WS_WIN = 18 * MiB, WS_WOUT = 23 * MiB, WS_WCQ = 25 * MiB, WS_WCKV = 27 * MiB,
                 WS_WCO = 31 * MiB, WS_WGU2 = 33 * MiB, WS_WD2 = 44 * MiB, WS_EGT = 50 * MiB, WS_GTT = 51 * MiB, WS_MEMB = 53 * MiB,
                 WS_KB = 57 * MiB, WS_VBT = 61 * MiB, WS_XB = 65 * MiB, WS_HB = 99 * MiB, WS_H = 133 * MiB, WS_ACT = 201 * MiB,
                 WS_MIX = 295 * MiB, WS_Q = 329 * MiB, WS_O = 363 * MiB, WS_GLAD = 397 * MiB, WS_GLADEC = 429 * MiB, WS_S5E = 430 * MiB,
                 WS_S5X = 464 * MiB, WS_GLAB = 481 * MiB, WS_END = 497 * MiB;
constexpr int SSQ_X = 0, SSQ_MEM = M, SSQ_H1 = M + 2048, SSQ_H2 = 2 * M + 2048, SSQ_H3 = 3 * M + 2048, SSQ_Y = 4 * M + 2048, SSQ_WORDS = 5 * M + 2048;
static_assert((size_t)SSQ_WORDS * 4 <= MiB, "ssq region");
static_assert(WS_XB + (size_t)1024 * 8192 * 4 <= WS_HB, "glaS over xb");
static_assert(WS_ACT + (size_t)M * FF * 2 <= WS_MIX && WS_ACT + (size_t)M * NINP * 2 <= WS_MIX, "act / P region");

constexpr size_t WS_BAR = 512 * 1024, BAR_BYTES = 16384;
static_assert((size_t)SSQ_WORDS * 4 <= WS_BAR && XCD_BAR_WORDS_C * 4 <= BAR_BYTES, "ctl map");
constexpr int NWAVES = 8, NTHREADS = 512;
constexpr int LDS_BYTES = 147456;
constexpr int LDS_BARST = LDS_BYTES - 64;

#define LAS __attribute__((address_space(3)))
typedef unsigned short bf16_t;
typedef short bf16x8 __attribute__((ext_vector_type(8)));
typedef short bf16x4 __attribute__((ext_vector_type(4)));
typedef float f32x4 __attribute__((ext_vector_type(4)));
typedef float f32x2 __attribute__((ext_vector_type(2)));
typedef unsigned u32x4 __attribute__((ext_vector_type(4)));
typedef unsigned u32x2 __attribute__((ext_vector_type(2)));
#define DI __device__ __forceinline__

typedef __bf16 bf16x2_t __attribute__((ext_vector_type(2)));
DI unsigned f2bf(float f) { return (unsigned)__builtin_bit_cast(unsigned short, (__bf16)f); }
DI unsigned pk2(float lo, float hi) { const bf16x2_t v = {(__bf16)lo, (__bf16)hi}; return __builtin_bit_cast(unsigned, v); }
DI float bf2f(unsigned b) { return __builtin_bit_cast(float, b << 16); }
DI float bflo(unsigned w) { return __builtin_bit_cast(float, w << 16); }
DI float bfhi(unsigned w) { return __builtin_bit_cast(float, w & 0xffff0000u); }
DI float wave_sum(float v) {
#pragma unroll
    for (int o = 1; o < 64; o <<= 1) v += __shfl_xor(v, o);
    return v;
}
template <int CTRL> DI float dpp_mov(float v) { return __builtin_bit_cast(float, __builtin_amdgcn_update_dpp(0, __builtin_bit_cast(int, v), CTRL, 0xf, 0xf, true)); }
DI float row16_sum(float v) { v += dpp_mov<0xB1>(v); v += dpp_mov<0x4E>(v); v += dpp_mov<0x141>(v); v += dpp_mov<0x140>(v); return v; }
DI float row16_max(float v) { v = fmaxf(v, dpp_mov<0xB1>(v)); v = fmaxf(v, dpp_mov<0x4E>(v)); v = fmaxf(v, dpp_mov<0x141>(v)); v = fmaxf(v, dpp_mov<0x140>(v)); return v; }
DI float sigmoidf_fast(float x) { return __builtin_amdgcn_rcpf(1.f + __expf(-x)); }
DI float siluf(float x) { return x * sigmoidf_fast(x); }
DI float logsigmoidf(float x) { return fminf(x, 0.f) - __logf(1.f + __expf(-fabsf(x))); }
DI float gelu_tanh(float y) { const float a = 0.7978845608028654f * (y + 0.044715f * y * y * y); const float e = __expf(2.f * a); const float th = 1.f - 2.f * __builtin_amdgcn_rcpf(e + 1.f); return 0.5f * y * (1.f + th); }

namespace pg8 {
#define PG8_LAS __attribute__((address_space(3)))
constexpr int BM = 256, BK = 64, HALF = 128, HTB = HALF * BK * 2  , STAGE_BYTES = 8 * HTB, NXCD = 8, WGM = 4;

__host__ __device__ __forceinline__ int lds_byte(int r, int c) { const int st = (r >> 4) * 2 + (c >> 5), rr = r & 15, cc = c & 31, ob = rr * 64 + cc * 2; return st * 1024 + (ob ^ (((ob >> 9) & 1) << 5)); }
__host__ __device__ __forceinline__ void stage_rc(int b, int& R, int& C) { const int st = b / 1024, sb = b % 1024, swz = sb ^ (((sb >> 9) & 1) << 5); R = (st >> 1) * 16 + swz / 64; C = (st & 1) * 32 + (swz % 64) / 2; }
__host__ __device__ __forceinline__ int perm32(int rho) { const int n = rho >> 4, i = rho & 15; return 8 * (i >> 2) + 4 * n + (i & 3); }

struct Unit { int pm, pn; };
struct Gemm { const bf16_t* A; const bf16_t* Bt; int M, N, K; };

struct StaticOrder {
    int nM, nN, nwg, G, c, rep;
    __host__ __device__ void init(int M_, int N_, int G_, int c_, int rep_ = 1) { nM = M_ / BM; nN = N_ / BM; nwg = nM * nN; G = G_; c = c_; rep = rep_; }
    __host__ __device__ bool next(int i, Unit& u) const {
        const long L = (long)i * G + c; if (L >= (long)nwg * rep) return false;
        int wgid = (int)(L % nwg); { const int q = nwg / NXCD, r = nwg % NXCD, xcd = wgid % NXCD, off = wgid / NXCD; wgid = (xcd < r ? xcd * (q + 1) : r * (q + 1) + (xcd - r) * q) + off; }
        const int nig = WGM * nN, gid = wgid / nig, fm = gid * WGM, gsz = (nM - fm) < WGM ? (nM - fm) : WGM;
        u.pm = fm + ((wgid % nig) % gsz); u.pn = (wgid % nig) / gsz; return true;
    }
    __device__ __forceinline__ void a_ready(const Unit&) const {}
    __device__ __forceinline__ void done(const Unit&) const {}
};

__device__ __forceinline__ unsigned cvt_pk_bf16(float lo, float hi) { unsigned r; asm volatile("v_cvt_pk_bf16_f32 %0, %1, %2" : "=v"(r) : "v"(lo), "v"(hi)); return r; }


struct EpiSwiGLU {
    static constexpr bool PERM = true, AFTER_DRAIN = false;
    bf16_t* O; int ldc; const float* ssq;
    __device__ __forceinline__ void operator()(const f32x4 (&acc)[2][2][4][2], const Unit& u, int wr, int wc, int fr, int fq) const {
        const int row0 = u.pm * BM + wr * 64 + fr, col0 = u.pn * HALF + wc * 32 + 8 * fq;
        float sq8[8];
#pragma unroll
        for (int i = 0; i < 8; ++i) sq8[i] = ssq[row0 + (i >> 2) * HALF + (i & 3) * 16];
        __builtin_amdgcn_sched_barrier(0);
#pragma unroll
        for (int ai = 0; ai < 2; ++ai)
#pragma unroll
            for (int m = 0; m < 4; ++m) {
                const int row = row0 + ai * HALF + m * 16;
                const float rs = rsqrtf(sq8[ai * 4 + m] * (1.f / D) + EPS);
                const f32x4 g0 = acc[ai][0][m][0] * rs, g1 = acc[ai][0][m][1] * rs, u0 = acc[ai][1][m][0] * rs, u1 = acc[ai][1][m][1] * rs;
                u32x4 w;
                w.x = cvt_pk_bf16(siluf(g0[0]) * u0[0], siluf(g0[1]) * u0[1]); w.y = cvt_pk_bf16(siluf(g0[2]) * u0[2], siluf(g0[3]) * u0[3]);
                w.z = cvt_pk_bf16(siluf(g1[0]) * u1[0], siluf(g1[1]) * u1[1]); w.w = cvt_pk_bf16(siluf(g1[2]) * u1[2], siluf(g1[3]) * u1[3]);
                *(u32x4*)(O + (size_t)row * ldc + col0) = w;
            }
    }
};
template <bool OUT_F32> struct EpiResid {
    static constexpr bool PERM = true, AFTER_DRAIN = false;
    const bf16_t* base; bf16_t* hbo; float* outf; float* ssq; float alpha;
    __device__ __forceinline__ void operator()(const f32x4 (&acc)[2][2][4][2], const Unit& u, int wr, int wc, int fr, int fq) const {
        const int row0 = u.pm * BM + wr * 64 + fr, col0 = u.pn * BM + wc * 32 + 8 * fq;
#pragma unroll
        for (int ai = 0; ai < 2; ++ai) {
            u32x4 bpre[4][2];
#pragma unroll
            for (int m = 0; m < 4; ++m)
#pragma unroll
                for (int bj = 0; bj < 2; ++bj) bpre[m][bj] = *(const u32x4*)(base + (size_t)(row0 + ai * HALF + m * 16) * D + col0 + bj * HALF);
            __builtin_amdgcn_sched_barrier(0);
#pragma unroll
            for (int m = 0; m < 4; ++m) {
                const int row = row0 + ai * HALF + m * 16;
                float s = 0.f;
#pragma unroll
                for (int bj = 0; bj < 2; ++bj) {
                    const int c = col0 + bj * HALF;
                    const u32x4 bw = bpre[m][bj];
                    f32x4 v0 = acc[ai][bj][m][0] * alpha, v1 = acc[ai][bj][m][1] * alpha;
                    v0[0] += bflo(bw.x); v0[1] += bfhi(bw.x); v0[2] += bflo(bw.y); v0[3] += bfhi(bw.y); v1[0] += bflo(bw.z); v1[1] += bfhi(bw.z); v1[2] += bflo(bw.w); v1[3] += bfhi(bw.w);
                    if constexpr (OUT_F32) { *(f32x4*)(outf + (size_t)row * D + c) = v0; *(f32x4*)(outf + (size_t)row * D + c + 4) = v1; }
                    else {
                        s += ((v0[0] * v0[0] + v0[1] * v0[1]) + (v0[2] * v0[2] + v0[3] * v0[3])) + ((v1[0] * v1[0] + v1[1] * v1[1]) + (v1[2] * v1[2] + v1[3] * v1[3]));
                        u32x4 w; w.x = cvt_pk_bf16(v0[0], v0[1]); w.y = cvt_pk_bf16(v0[2], v0[3]); w.z = cvt_pk_bf16(v1[0], v1[1]); w.w = cvt_pk_bf16(v1[2], v1[3]);
                        *(u32x4*)(hbo + (size_t)row * D + c) = w;
                    }
                }
                if constexpr (!OUT_F32) { s += __shfl_xor(s, 16); s += __shfl_xor(s, 32); if (fq == 0) atomicAdd(ssq + row, s); }
            }
        }
    }
};
struct EpiScaleBf16 {
    static constexpr bool PERM = true, AFTER_DRAIN = false;
    bf16_t* O; int ldc; const float* ssq; float scale;
    __device__ __forceinline__ void operator()(const f32x4 (&acc)[2][2][4][2], const Unit& u, int wr, int wc, int fr, int fq) const {
        const int row0 = u.pm * BM + wr * 64 + fr, col0 = u.pn * BM + wc * 32 + 8 * fq;
        float sq8[8];
#pragma unroll
        for (int i = 0; i < 8; ++i) sq8[i] = ssq[row0 + (i >> 2) * HALF + (i & 3) * 16];
        __builtin_amdgcn_sched_barrier(0);
#pragma unroll
        for (int ai = 0; ai < 2; ++ai)
#pragma unroll
            for (int m = 0; m < 4; ++m) {
                const int row = row0 + ai * HALF + m * 16;
                const float rs = rsqrtf(sq8[ai * 4 + m] * (1.f / D) + EPS) * scale;
#pragma unroll
                for (int bj = 0; bj < 2; ++bj) {
                    const f32x4 v0 = acc[ai][bj][m][0] * rs, v1 = acc[ai][bj][m][1] * rs;
                    u32x4 w; w.x = cvt_pk_bf16(v0[0], v0[1]); w.y = cvt_pk_bf16(v0[2], v0[3]); w.z = cvt_pk_bf16(v1[0], v1[1]); w.w = cvt_pk_bf16(v1[2], v1[3]);
                    *(u32x4*)(O + (size_t)row * ldc + col0 + bj * HALF) = w;
                }
            }
    }
};
struct EpiMemKV {
    static constexpr bool PERM = false, AFTER_DRAIN = false;
    float* outK; float* outV; bf16_t* kb; bf16_t* vbT; const float* ssq;
    __device__ __forceinline__ void operator()(const f32x4 (&acc)[2][2][4][2], const Unit& u, int wr, int wc, int fr, int fq) const {
        const int row0 = u.pm * BM + wr * 64 + fr; const bool isV = u.pn >= 4; const int col0 = (u.pn & 3) * BM + wc * 32 + 4 * fq;
        float* outp = isV ? outV : outK;
        float sq8[8];
#pragma unroll
        for (int i = 0; i < 8; ++i) sq8[i] = ssq[row0 + (i >> 2) * HALF + (i & 3) * 16];
        __builtin_amdgcn_sched_barrier(0);
#pragma unroll
        for (int ai = 0; ai < 2; ++ai)
#pragma unroll
            for (int m = 0; m < 4; ++m) {
                const int row = row0 + ai * HALF + m * 16;
                const float rs = rsqrtf(sq8[ai * 4 + m] * (1.f / D) + EPS);
                const int b = row >> 8, key = row & 255;
#pragma unroll
                for (int bj = 0; bj < 2; ++bj)
#pragma unroll
                    for (int n = 0; n < 2; ++n) {
                        const int c = col0 + bj * HALF + n * 16;
                        const f32x4 v = acc[ai][bj][m][n] * rs;
                        __builtin_nontemporal_store(v, (f32x4*)(outp + (size_t)row * D + c));
                        if (!isV) { u32x2 w; w.x = cvt_pk_bf16(v[0], v[1]); w.y = cvt_pk_bf16(v[2], v[3]); *(u32x2*)(kb + (size_t)row * D + c) = w; }
                        else {
#pragma unroll
                            for (int i = 0; i < 4; ++i) vbT[((size_t)b * D + c + i) * 256 + key] = (bf16_t)f2bf(v[i]);
                        }
                    }
            }
    }
};

template <class Epi, class Sched, bool ALIGN_EPI = false, bool SP2 = false>
__device__ __forceinline__ void gemm_phase(PG8_LAS unsigned char* lds, const Gemm g, const Sched& S, const Epi& E) {
    const int tid = threadIdx.x, wid = __builtin_amdgcn_readfirstlane(tid >> 6), lane = tid & 63, wr = wid >> 2, wc = wid & 3, fr = lane & 15, fq = lane >> 4;
    const int K = g.K, nt = K / BK;
    unsigned voffA[2], voffB[2];
#pragma unroll
    for (int i = 0; i < 2; ++i) { int R, C; stage_rc(tid * 16 + i * 8192, R, C); const int Rb = Epi::PERM ? ((R & ~31) + perm32(R & 31)) : R;
        voffA[i] = (unsigned)(R * K + C) * 2u; voffB[i] = (unsigned)(Rb * K + C) * 2u; }
    const size_t kstep = (size_t)(BK * 2);
    const size_t hstep = (size_t)HALF * K * 2;
    const size_t tstep = 2 * hstep;
    const unsigned ldsw = (unsigned)wid * 1024u;
    const int aoff = lds_byte(wr * 64 + fr, fq * 8), boff = lds_byte(wc * 32 + fr, fq * 8);
#define PG8_SA(b, h) (((b) * 2 + (h)) * HTB)
#define PG8_SB(b, h) ((4 + (b) * 2 + (h)) * HTB)
#define PG8_STAGE(bufoff, gbase, voff) do { _Pragma("unroll") for (int _i = 0; _i < 2; ++_i) \
        __builtin_amdgcn_global_load_lds((const unsigned*)((const char*)(gbase) + (voff)[_i]), (PG8_LAS unsigned*)(lds + (bufoff) + ldsw + _i * 8192), 16, 0, 0); } while (0)
#define PG8_LDA(dst, b, h) do { _Pragma("unroll") for (int m = 0; m < 4; ++m) _Pragma("unroll") for (int k = 0; k < 2; ++k) dst[m][k] = *(const PG8_LAS bf16x8*)(lds + PG8_SA(b, h) + aoff + m * 2048 + k * 1024); } while (0)
#define PG8_LDB(dst, b, h) do { _Pragma("unroll") for (int n = 0; n < 2; ++n) _Pragma("unroll") for (int k = 0; k < 2; ++k) dst[n][k] = *(const PG8_LAS bf16x8*)(lds + PG8_SB(b, h) + boff + n * 2048 + k * 1024); } while (0)
#define PG8_MMA(ai, bj, At, Bt) do { __builtin_amdgcn_s_setprio(1); _Pragma("unroll") for (int m = 0; m < 4; ++m) _Pragma("unroll") for (int n = 0; n < 2; ++n) _Pragma("unroll") for (int k = 0; k < 2; ++k) \
        acc[ai][bj][m][n] = __builtin_amdgcn_mfma_f32_16x16x32_bf16(Bt[n][k], At[m][k], acc[ai][bj][m][n], 0, 0, 0); __builtin_amdgcn_s_setprio(0); } while (0)
#define PG8_WAIT_V(n) asm volatile("s_waitcnt vmcnt(" #n ")" ::: "memory")
#define PG8_WAIT_L(n) asm volatile("s_waitcnt lgkmcnt(" #n ")" ::: "memory")
#define PG8_BAR __builtin_amdgcn_s_barrier()
#define PG8_SCHED __builtin_amdgcn_sched_barrier(0)
    Unit cur, nxt; int ui = 0;
    if (!S.next(0, cur)) return;
    f32x4 acc[2][2][4][2];
#pragma unroll
    for (int a = 0; a < 2; ++a)
#pragma unroll
        for (int b = 0; b < 2; ++b)
#pragma unroll
            for (int m = 0; m < 4; ++m)
#pragma unroll
                for (int n = 0; n < 2; ++n) acc[a][b][m][n] = (f32x4){0.f, 0.f, 0.f, 0.f};
    bf16x8 At[4][2], B0[2][2], B1[2][2];
    const char* cA = (const char*)g.A + (size_t)cur.pm * tstep; const char* cB = (const char*)g.Bt + (size_t)cur.pn * tstep;
    S.a_ready(cur);
    if constexpr (SP2) {
        PG8_STAGE(PG8_SB(0, 0), cB, voffB); PG8_STAGE(PG8_SB(0, 1), cB + hstep, voffB); PG8_STAGE(PG8_SA(0, 0), cA, voffA); PG8_STAGE(PG8_SA(0, 1), cA + hstep, voffA);
        if (wr == 1) PG8_BAR;
        PG8_WAIT_V(2); PG8_BAR;
        PG8_STAGE(PG8_SB(1, 0), cB + kstep, voffB); PG8_STAGE(PG8_SA(1, 0), cA + kstep, voffA); PG8_STAGE(PG8_SB(1, 1), cB + hstep + kstep, voffB);
        PG8_WAIT_V(6); PG8_BAR;
    } else {
        PG8_STAGE(PG8_SB(0, 0), cB, voffB); PG8_STAGE(PG8_SA(0, 0), cA, voffA); PG8_STAGE(PG8_SB(0, 1), cB + hstep, voffB); PG8_STAGE(PG8_SA(0, 1), cA + hstep, voffA);
        if (wr == 1) PG8_BAR;
        PG8_WAIT_V(4); PG8_BAR;
        PG8_STAGE(PG8_SB(1, 0), cB + kstep, voffB); PG8_STAGE(PG8_SA(1, 0), cA + kstep, voffA); PG8_STAGE(PG8_SB(1, 1), cB + hstep + kstep, voffB);
        PG8_WAIT_V(6); PG8_BAR;
    }
    for (;;) {
        const bool has_next = S.next(ui + 1, nxt);
        const char* nA = has_next ? (const char*)g.A + (size_t)nxt.pm * tstep : cA; const char* nB = has_next ? (const char*)g.Bt + (size_t)nxt.pn * tstep : cB;
        for (int t = 0; t < nt; t += 2) {
            const bool last = (t == nt - 2);
            const char* a1 = cA + (size_t)(t + 1) * kstep;
            const char* a2 = last ? nA : cA + (size_t)(t + 2) * kstep; const char* b2 = last ? nB : cB + (size_t)(t + 2) * kstep;
            const char* a3 = a2 + kstep; const char* b3 = b2 + kstep;
            if (last && has_next) S.a_ready(nxt);
            if constexpr (SP2) {
            PG8_LDB(B0, 0, 0); PG8_LDB(B1, 0, 1); PG8_SCHED; PG8_LDA(At, 0, 0); PG8_STAGE(PG8_SA(1, 1), a1 + hstep, voffA);
            PG8_WAIT_V(8); PG8_WAIT_L(0); PG8_BAR; PG8_MMA(0, 0, At, B0); PG8_MMA(0, 1, At, B1); PG8_BAR; PG8_SCHED;
            PG8_LDA(At, 0, 1); PG8_STAGE(PG8_SB(0, 0), b2, voffB); PG8_STAGE(PG8_SB(0, 1), b2 + hstep, voffB); PG8_STAGE(PG8_SA(0, 0), a2, voffA);
            PG8_WAIT_V(8); PG8_WAIT_L(0); PG8_BAR; PG8_MMA(1, 0, At, B0); PG8_MMA(1, 1, At, B1); PG8_BAR; PG8_SCHED;
            PG8_LDB(B0, 1, 0); PG8_LDB(B1, 1, 1); PG8_SCHED; PG8_LDA(At, 1, 0); PG8_STAGE(PG8_SA(0, 1), a2 + hstep, voffA);
            PG8_WAIT_V(8); PG8_WAIT_L(0); PG8_BAR; PG8_MMA(0, 0, At, B0); PG8_MMA(0, 1, At, B1); PG8_BAR; PG8_SCHED;
            PG8_LDA(At, 1, 1); PG8_STAGE(PG8_SB(1, 0), b3, voffB); PG8_STAGE(PG8_SB(1, 1), b3 + hstep, voffB); PG8_STAGE(PG8_SA(1, 0), a3, voffA);
            PG8_WAIT_V(8); PG8_WAIT_L(0); PG8_BAR; PG8_MMA(1, 0, At, B0); PG8_MMA(1, 1, At, B1); PG8_BAR; PG8_SCHED;
            } else {
            PG8_LDB(B0, 0, 0); PG8_SCHED; PG8_LDA(At, 0, 0); PG8_STAGE(PG8_SA(1, 1), a1 + hstep, voffA);
            PG8_WAIT_L(8); PG8_BAR; PG8_WAIT_L(0); PG8_MMA(0, 0, At, B0); PG8_BAR; PG8_SCHED;
            PG8_LDB(B1, 0, 1); PG8_STAGE(PG8_SB(0, 0), b2, voffB);
            PG8_BAR; PG8_WAIT_L(0); PG8_MMA(0, 1, At, B1); PG8_BAR;
            PG8_LDA(At, 0, 1); PG8_STAGE(PG8_SA(0, 0), a2, voffA);
            PG8_BAR; PG8_WAIT_L(0); PG8_MMA(1, 0, At, B0); PG8_BAR; PG8_SCHED;
            PG8_STAGE(PG8_SB(0, 1), b2 + hstep, voffB);
            PG8_WAIT_V(6); PG8_BAR; PG8_MMA(1, 1, At, B1); PG8_BAR;
            PG8_LDB(B0, 1, 0); PG8_SCHED; PG8_LDA(At, 1, 0); PG8_STAGE(PG8_SA(0, 1), a2 + hstep, voffA);
            PG8_WAIT_L(8); PG8_BAR; PG8_WAIT_L(0); PG8_MMA(0, 0, At, B0); PG8_BAR; PG8_SCHED;
            PG8_LDB(B1, 1, 1); PG8_STAGE(PG8_SB(1, 0), b3, voffB);
            PG8_BAR; PG8_WAIT_L(0); PG8_MMA(0, 1, At, B1); PG8_BAR;
            PG8_LDA(At, 1, 1); PG8_STAGE(PG8_SA(1, 0), a3, voffA);
            PG8_BAR; PG8_WAIT_L(0); PG8_MMA(1, 0, At, B0); PG8_BAR; PG8_SCHED;
            PG8_STAGE(PG8_SB(1, 1), b3 + hstep, voffB);
            PG8_WAIT_V(6); PG8_BAR; PG8_MMA(1, 1, At, B1); PG8_BAR;
            }
        }
        if constexpr (ALIGN_EPI) { if (wr == 0) PG8_BAR; }
        if constexpr (!Epi::AFTER_DRAIN) { E(acc, cur, wr, wc, fr, fq); S.done(cur); }
        if (!has_next) break;
#pragma unroll
        for (int a = 0; a < 2; ++a)
#pragma unroll
            for (int b = 0; b < 2; ++b)
#pragma unroll
                for (int m = 0; m < 4; ++m)
#pragma unroll
                    for (int n = 0; n < 2; ++n) acc[a][b][m][n] = (f32x4){0.f, 0.f, 0.f, 0.f};
        cur = nxt; cA = nA; cB = nB; ++ui;
        if constexpr (ALIGN_EPI) { if (wr == 1) PG8_BAR; }
    }
    PG8_WAIT_V(0);
    if constexpr (!ALIGN_EPI) { if (wr == 0) PG8_BAR; }
    PG8_BAR;
#undef PG8_SA
#undef PG8_SB
#undef PG8_STAGE
#undef PG8_LDA
#undef PG8_LDB
#undef PG8_MMA
#undef PG8_WAIT_V
#undef PG8_WAIT_L
#undef PG8_BAR
#undef PG8_SCHED
}
}


#define XB_TMO      128
#define XB_XCNT(j)  (256  + 64 * (j))
#define XB_XSUB(j)  (1280 + 64 * (j))
#define XB_XGEN(j)  (2304 + 64 * (j))
#define XB_TOP      3328
#define XB_TOPGEN   3392
#define XCD_BAR_WORDS 3456
#define XB_SPIN_CAP (1u << 18)
__device__ __forceinline__ unsigned xb_ld(unsigned* p)              { return __hip_atomic_load(p, __ATOMIC_RELAXED, __HIP_MEMORY_SCOPE_AGENT); }
__device__ __forceinline__ unsigned xb_add(unsigned* p, unsigned v) { return __hip_atomic_fetch_add(p, v, __ATOMIC_RELAXED, __HIP_MEMORY_SCOPE_AGENT); }
__device__ __forceinline__ unsigned xb_xcc_id() { return (unsigned)__builtin_amdgcn_s_getreg((3 << 11) | 20) & 0xFu; }
#define XB_SPIN(cond, bar) do { unsigned _sp = 0; while (cond) { __builtin_amdgcn_s_sleep(1); \
    if ((++_sp & 255u) == 0u) { if (xb_ld(&(bar)[XB_TMO])) break; if (_sp > XB_SPIN_CAP) { atomicAdd(&(bar)[XB_TMO], 1u); break; } } } } while (0)
struct XcdBarrier { unsigned* bar; unsigned x; volatile LAS unsigned* st; };
__device__ __forceinline__ XcdBarrier xcd_barrier_post(unsigned* bar, volatile LAS unsigned* st) {
    XcdBarrier b; b.bar = bar; b.x = xb_xcc_id(); b.st = st;
    if (threadIdx.x == 0) (void)xb_add(&bar[XB_XCNT(b.x)], 1u);
    return b;
}
__device__ __forceinline__ void xcd_barrier_complete(unsigned* bar, unsigned x, unsigned& nloc, unsigned& nx) {
    const unsigned G = gridDim.x * gridDim.y * gridDim.z;
    unsigned sum, cnt, mine, sp = 0u;
    for (;;) {
        sum = 0u; cnt = 0u; mine = 0u;
#pragma unroll
        for (unsigned j = 0; j < 16; ++j) { const unsigned c = xb_ld(&bar[XB_XCNT(j)]); sum += c; cnt += (c > 0u) ? 1u : 0u; mine = (j == x) ? c : mine; }
        if (sum == G) break;
        __builtin_amdgcn_s_sleep(1);
        if ((++sp & 255u) == 0u) { if (xb_ld(&bar[XB_TMO])) break; if (sp > XB_SPIN_CAP) { atomicAdd(&bar[XB_TMO], 1u); break; } }
    }
    nloc = mine > 0u ? mine : 1u; nx = cnt > 0u ? cnt : 1u;
}
__device__ __forceinline__ void xcd_barrier(const XcdBarrier& b) {
    asm volatile("s_waitcnt vmcnt(0)" ::: "memory");
    __syncthreads();
    if (threadIdx.x == 0) {
        unsigned* bar = b.bar;
        __builtin_amdgcn_s_waitcnt(0);
        unsigned nloc = b.st[0], nx = b.st[1];
        if (nloc == 0u) { xcd_barrier_complete(bar, b.x, nloc, nx); b.st[0] = nloc; b.st[1] = nx; }
        const unsigned old = xb_add(&bar[XB_XSUB(b.x)], 1u);
        const unsigned gen = old / nloc;
        if (old + 1u == (gen + 1u) * nloc) {
            __builtin_amdgcn_fence(__ATOMIC_RELEASE, "agent");
            asm volatile("s_waitcnt vmcnt(0)" ::: "memory");
            const unsigned og = xb_add(&bar[XB_TOP], 1u);
            const unsigned tg = og / nx;
            if (og + 1u == (tg + 1u) * nx) xb_add(&bar[XB_TOPGEN], 1u);
            else XB_SPIN(xb_ld(&bar[XB_TOPGEN]) == tg, bar);
            xb_add(&bar[XB_XGEN(b.x)], 1u);
            __builtin_amdgcn_fence(__ATOMIC_ACQUIRE, "agent");
            asm volatile("s_waitcnt vmcnt(0)" ::: "memory");
        } else {
            XB_SPIN(xb_ld(&bar[XB_XGEN(b.x)]) == gen, bar);
            __builtin_amdgcn_fence(__ATOMIC_ACQUIRE, "agent");
            asm volatile("s_waitcnt vmcnt(0)" ::: "memory");
        }
    }
    __syncthreads();
}

__device__ unsigned g_bar_words[XCD_BAR_WORDS + 64];
#define XB_EXIT XCD_BAR_WORDS

#ifndef PG_ALIGN
#define PG_ALIGN true
#define PG_SP2 true
#endif
struct Args { const float* in[36]; float* out; unsigned char* ws; int ph_lo, ph_hi; };
#define LDS_WAIT() asm volatile("s_waitcnt lgkmcnt(0)" ::: "memory")
#define LDS_BARRIER() do { asm volatile("s_waitcnt lgkmcnt(0)" ::: "memory"); __builtin_amdgcn_s_barrier(); asm volatile("" ::: "memory"); } while (0)

DI int rowmap(int mode, int n) {
    if (mode == 1) { const int j = n < FF ? n : n - FF; return 256 * (j >> 7) + (n < FF ? 0 : 128) + (j & 127); }
    if (mode == 2) { if (n < 1024) return n; if (n < 1040) return n + 1024; return n - 16; }
    return n;
}
DI void p0_transpose_tile(const float* W, const float* gain, int K, int N, bf16_t* WT, int mode, float* scr, int item, int tid) {
    const int nblk = (N + 255) / 256, kb = item / nblk, nb = item % nblk, k0 = 64 * kb, n0 = 256 * nb;
    f32x4 v[8];
#pragma unroll
    for (int i = 0; i < 8; ++i) { const int c = tid + i * NTHREADS, row = c >> 6, n4 = (c & 63) * 4;
        v[i] = (n0 + n4 < N) ? __builtin_nontemporal_load((const f32x4*)(W + (size_t)(k0 + row) * N + n0 + n4)) : (f32x4){0.f, 0.f, 0.f, 0.f}; }
    __builtin_amdgcn_sched_barrier(0);
#pragma unroll
    for (int i = 0; i < 8; ++i) { const int c = tid + i * NTHREADS, row = c >> 6, n4 = (c & 63) * 4;
        f32x4 x = v[i]; if (gain) x = x * gain[k0 + row];
        *(f32x4*)(scr + row * 260 + (n4 ^ (((row >> 3) & 7) << 2))) = x; }
    __syncthreads();
#pragma unroll
    for (int i = 0; i < 4; ++i) { const int id = tid + i * NTHREADS, n = id >> 3, c = id & 7;
        const float* sp = scr + (8 * c) * 260 + (n ^ (c << 2));
        u32x4 o; o.x = pk2(sp[0 * 260], sp[1 * 260]); o.y = pk2(sp[2 * 260], sp[3 * 260]); o.z = pk2(sp[4 * 260], sp[5 * 260]); o.w = pk2(sp[6 * 260], sp[7 * 260]);
        if (n0 + n < N) *(u32x4*)(WT + (size_t)rowmap(mode, n0 + n) * K + k0 + 8 * c) = o; }
    __syncthreads();
}
DI void row_to_bf16_ssq(const float* xrow, bf16_t* orow, float* ssq_slot, int lane) {
    const f32x4* xr = (const f32x4*)xrow + lane;
    f32x4 v[4]; float s = 0.f;
#pragma unroll
    for (int j = 0; j < 4; ++j) { v[j] = __builtin_nontemporal_load(xr + 64 * j); s += (v[j].x * v[j].x + v[j].y * v[j].y) + (v[j].z * v[j].z + v[j].w * v[j].w); }
    s = wave_sum(s);
    unsigned long long* o8 = (unsigned long long*)orow + lane;
#pragma unroll
    for (int j = 0; j < 4; ++j) o8[64 * j] = (unsigned long long)pk2(v[j].x, v[j].y) | ((unsigned long long)pk2(v[j].z, v[j].w) << 32);
    if (lane == 0) *ssq_slot = s;
}
struct S5P { float dt, lr, li; };
DI S5P s5_par(const float* lre, const float* lim, const float* logdt, int g, int n) { S5P p; p.dt = expf(logdt[g]); p.lr = lre[g * 64 + n]; p.li = lim[g * 64 + n]; return p; }
DI f32x2 s5_pow(const S5P& p, int j) {
    const float mag = expf((float)j * (p.dt * p.lr)); float sn, cs; sincosf((float)j * (p.dt * p.li), &sn, &cs); return (f32x2){mag * cs, mag * sn};
}
DI f32x2 s5_coef(const S5P& p) {
    const f32x2 ab = s5_pow(p, 1); const float den = p.lr * p.lr + p.li * p.li;
    return (f32x2){((ab.x - 1.f) * p.lr + ab.y * p.li) / den, (ab.y * p.lr - (ab.x - 1.f) * p.li) / den};
}
DI f32x2 cmul(f32x2 a, f32x2 b) { return (f32x2){a.x * b.x - a.y * b.y, a.x * b.y + a.y * b.x}; }

template <int NT>
DI void gla_gate_cumsum(const float* zg, float* bb, float* seg, const float* wg, const float* bg, int h, int tid, const float (&wr)[16], float bias) {
    if constexpr (NT == 64) {
        const int d = tid & 63;
#pragma unroll
        for (int k = 0; k < 8; ++k) { const int t = (tid >> 6) + 8 * k; const f32x4* zp = (const f32x4*)(zg + t * 16); float s = bias;
#pragma unroll
            for (int r4 = 0; r4 < 4; ++r4) { const f32x4 z = zp[r4]; s += z[0] * wr[r4 * 4] + z[1] * wr[r4 * 4 + 1] + z[2] * wr[r4 * 4 + 2] + z[3] * wr[r4 * 4 + 3]; }
            bb[t * 65 + d] = logsigmoidf(s) * (1.f / 16.f); }
    } else {
    for (int i = tid; i < NT * 64; i += NTHREADS) { const int t = i >> 6, d = i & 63; float s = bg[h * 64 + d];
#pragma unroll
        for (int r = 0; r < 16; ++r) s += zg[t * 16 + r] * wg[r * 256 + h * 64 + d];
        bb[t * 65 + d] = logsigmoidf(s) * (1.f / 16.f); }
    }
    LDS_BARRIER();
    if constexpr (NT == 64) {
        const int d = tid & 63, sg = tid >> 6; float run = 0.f;
#pragma unroll
        for (int i = 0; i < 8; ++i) { run += bb[(sg * 8 + i) * 65 + d]; bb[(sg * 8 + i) * 65 + d] = run; }
        seg[sg * 64 + d] = run;
        LDS_BARRIER();
        float pre = 0.f;
        for (int j = 0; j < sg; ++j) pre += seg[j * 64 + d];
#pragma unroll
        for (int i = 0; i < 8; ++i) bb[(sg * 8 + i) * 65 + d] += pre;
    } else {
        if (tid < 64) { float run = 0.f;
#pragma unroll
            for (int t = 0; t < NT; ++t) { run += bb[t * 65 + tid]; bb[t * 65 + tid] = run; } }
    }
    LDS_BARRIER();
}


template <bool OUT_F32> struct SEpiResid {
    const bf16_t* base; bf16_t* hbo; float* outf; float* ssq; float alpha;
    typedef u32x4 Pre;
    DI Pre pre(int row, int col) const { return *(const u32x4*)(base + (size_t)row * D + col); }
    DI void operator()(int row, int col, const f32x4& a0, const f32x4& a1, int tid, const Pre& bw) const {
        f32x4 v0 = a0 * alpha, v1 = a1 * alpha;
        v0[0] += bflo(bw.x); v0[1] += bfhi(bw.x); v0[2] += bflo(bw.y); v0[3] += bfhi(bw.y); v1[0] += bflo(bw.z); v1[1] += bfhi(bw.z); v1[2] += bflo(bw.w); v1[3] += bfhi(bw.w);
        if constexpr (OUT_F32) { *(f32x4*)(outf + (size_t)row * D + col) = v0; *(f32x4*)(outf + (size_t)row * D + col + 4) = v1; }
        else {
            u32x4 w; w.x = pk2(v0[0], v0[1]); w.y = pk2(v0[2], v0[3]); w.z = pk2(v1[0], v1[1]); w.w = pk2(v1[2], v1[3]); *(u32x4*)(hbo + (size_t)row * D + col) = w;
            float sq = (v0[0] * v0[0] + v0[1] * v0[1]) + (v0[2] * v0[2] + v0[3] * v0[3]) + (v1[0] * v1[0] + v1[1] * v1[1]) + (v1[2] * v1[2] + v1[3] * v1[3]);
            sq += __shfl_xor(sq, 1); sq += __shfl_xor(sq, 2); sq += __shfl_xor(sq, 4); if ((tid & 7) == 0) atomicAdd(ssq + row, sq);
        }
    }
};
struct SEpiScaleBf16 {
    bf16_t* O; const float* ssq; float scale;
    typedef float Pre;
    DI Pre pre(int row, int) const { return ssq[row]; }
    DI void operator()(int row, int col, const f32x4& a0, const f32x4& a1, int, const Pre& sq) const {
        const float rs = rsqrtf(sq * (1.f / D) + EPS) * scale; const f32x4 v0 = a0 * rs, v1 = a1 * rs;
        u32x4 w; w.x = pk2(v0[0], v0[1]); w.y = pk2(v0[2], v0[3]); w.z = pk2(v1[0], v1[1]); w.w = pk2(v1[2], v1[3]); *(u32x4*)(O + (size_t)row * D + col) = w;
    }
};
template <class F>
DI void small_gemm(const bf16_t* A, const bf16_t* Bt, int K, float* red, int G, int bx, int wave, int tid, const F& epi) {
    const int lane = tid & 63, fr = lane & 15, fq = lane >> 4, kw = K >> 3, nsteps = kw >> 5;
    for (int tile = bx; tile < 256; tile += G) {
        const int row0 = (tile >> 4) * 64, col0 = (tile & 15) * 64;
        f32x4 acc[4][4];
#pragma unroll
        for (int i = 0; i < 4; ++i)
#pragma unroll
            for (int j = 0; j < 4; ++j) acc[i][j] = (f32x4){0.f, 0.f, 0.f, 0.f};
        const bf16_t* ap = A + (size_t)(row0 + fr) * K + wave * kw + fq * 8;
        const bf16_t* bp = Bt + (size_t)(col0 + fr) * K + wave * kw + fq * 8;
        for (int st0 = 0; st0 < nsteps; st0 += 4) {
            bf16x8 a[4][4], b[4][4];
#pragma unroll
            for (int s4 = 0; s4 < 4; ++s4) if (st0 + s4 < nsteps) {
#pragma unroll
                for (int i = 0; i < 4; ++i) { a[s4][i] = *(const bf16x8*)(ap + (size_t)i * 16 * K + (st0 + s4) * 32); b[s4][i] = *(const bf16x8*)(bp + (size_t)i * 16 * K + (st0 + s4) * 32); } }
            __builtin_amdgcn_sched_barrier(0);
#pragma unroll
            for (int s4 = 0; s4 < 4; ++s4) if (st0 + s4 < nsteps) {
#pragma unroll
                for (int i = 0; i < 4; ++i)
#pragma unroll
                    for (int j = 0; j < 4; ++j) acc[i][j] = __builtin_amdgcn_mfma_f32_16x16x32_bf16(b[s4][j], a[s4][i], acc[i][j], 0, 0, 0); }
            __builtin_amdgcn_sched_barrier(0);
        }
        const typename F::Pre epre = epi.pre(MP + row0 + (tid >> 3), col0 + (tid & 7) * 8);
        float* my = red + wave * (64 * 68);
#pragma unroll
        for (int i = 0; i < 4; ++i)
#pragma unroll
            for (int j = 0; j < 4; ++j) *(f32x4*)(my + (i * 16 + fr) * 68 + j * 16 + fq * 4) = acc[i][j];
        LDS_BARRIER();
        { const int row = tid >> 3, c8 = (tid & 7) * 8; f32x4 s0 = (f32x4){0.f, 0.f, 0.f, 0.f}, s1 = s0;
#pragma unroll
            for (int w = 0; w < 8; ++w) { const f32x4* p = (const f32x4*)(red + w * (64 * 68) + row * 68 + c8); s0 += p[0]; s1 += p[1]; }
            epi(MP + row0 + row, col0 + c8, s0, s1, tid, epre); }
        __syncthreads();
    }
}

__global__ void __launch_bounds__(NTHREADS, 2) hymba_fwd(Args args) {
    extern __shared__ __attribute__((aligned(16))) unsigned char lds[];
    cg::grid_group grid = cg::this_grid();
    const int tid0 = threadIdx.x, wave = __builtin_amdgcn_readfirstlane(tid0 >> 6);
    const int G = gridDim.x, bx = blockIdx.x;
    const int gw = bx * NWAVES + wave, NGW = G * NWAVES;
    const int NGT = G * NTHREADS;
#define PHASE_LOCALS int tid_l_ = tid0; asm volatile("" : "+v"(tid_l_)); const int tid = tid_l_, lane = tid & 63, gt = bx * NTHREADS + tid; (void)lane; (void)gt
    unsigned char* ws = args.ws;
    float* out = args.out;
    float* fl = (float*)lds;
    LAS unsigned char* ldsl = (LAS unsigned char*)lds;

    const float* x_prompt = args.in[0]; const float* x_sample = args.in[1]; const float* state_gla = args.in[2];
    const float* st_re = args.in[3]; const float* st_im = args.in[4]; const float* cache_k = args.in[5]; const float* cache_v = args.in[6];
    const float* mem_prompt = args.in[7];
    const float* w_gate = args.in[13]; const float* b_gate = args.in[14]; const float* g_gla_out = args.in[15];
    const float* s5_lre = args.in[16]; const float* s5_lim = args.in[17]; const float* s5_logdt = args.in[18];
    const float* s5_bre = args.in[19]; const float* s5_bim = args.in[20]; const float* s5_cre = args.in[21]; const float* s5_cim = args.in[22];
    const float* s5_d = args.in[23]; const float* s5_wglu = args.in[24]; const float* s5_bglu = args.in[25];
    const float* g_final = args.in[35];

    float* ssq = (float*)(ws + WS_SSQ);
    bf16_t* Wgu1 = (bf16_t*)(ws + WS_WGU1); bf16_t* Wd1 = (bf16_t*)(ws + WS_WD1); bf16_t* Win = (bf16_t*)(ws + WS_WIN); bf16_t* Wout = (bf16_t*)(ws + WS_WOUT);
    bf16_t* Wcq = (bf16_t*)(ws + WS_WCQ); bf16_t* Wckv = (bf16_t*)(ws + WS_WCKV); bf16_t* Wco = (bf16_t*)(ws + WS_WCO); bf16_t* Wgu2 = (bf16_t*)(ws + WS_WGU2); bf16_t* Wd2 = (bf16_t*)(ws + WS_WD2);
    bf16_t* EgT = (bf16_t*)(ws + WS_EGT); bf16_t* GTt = (bf16_t*)(ws + WS_GTT);
    bf16_t* memb = (bf16_t*)(ws + WS_MEMB); bf16_t* kb = (bf16_t*)(ws + WS_KB); bf16_t* vbT = (bf16_t*)(ws + WS_VBT);
    bf16_t* xb = (bf16_t*)(ws + WS_XB); bf16_t* hb = (bf16_t*)(ws + WS_HB); float* hres = (float*)(ws + WS_H);
    bf16_t* act = (bf16_t*)(ws + WS_ACT); bf16_t* Pb = (bf16_t*)(ws + WS_ACT);
    bf16_t* mix = (bf16_t*)(ws + WS_MIX); bf16_t* qb = (bf16_t*)(ws + WS_Q); bf16_t* ob = (bf16_t*)(ws + WS_O);
    bf16_t* glaD = (bf16_t*)(ws + WS_GLAD); float* glaDec = (float*)(ws + WS_GLADEC); bf16_t* glaS = (bf16_t*)(ws + WS_XB);
    float* glaB = (float*)(ws + WS_GLAB);
    bf16_t* s5e = (bf16_t*)(ws + WS_S5E); bf16_t* s5x = (bf16_t*)(ws + WS_S5X);

    const int lo = args.ph_lo, hi = args.ph_hi;
    constexpr int I_GU = 16 * 22, I_D = 44 * 4, I_IN = 16 * 9, I_SQ = 16 * 4, I_CKV = 16 * 8;
    constexpr int N_TL0 = I_GU + I_IN + I_CKV, N_TL1 = I_D, N_TL3 = I_GU + I_D + 3 * I_SQ;
    if (tid0 < 16) ((LAS unsigned*)(ldsl + LDS_BARST))[tid0] = 0u;
    __syncthreads();
    const XcdBarrier xbar = xcd_barrier_post(g_bar_words, (volatile LAS unsigned*)(ldsl + LDS_BARST));
    if (lo < 0) grid.sync();
#ifndef PHASE_MASK
#define PHASE_MASK 0xffffffffu
#endif
#define IN(k) (((PHASE_MASK >> (k)) & 1u) && lo <= (k) && (k) < hi)
#ifndef REPEAT_MASK
#define REPEAT_MASK 0u
#endif
#define PHASE(k) if (IN(k)) for (int rep_ = 0; rep_ < 1 + (int)((REPEAT_MASK >> (k)) & 1u); ++rep_)
#define PHASE_G(k) if (IN(k))
#define GREP(k) (1 + (int)((REPEAT_MASK >> (k)) & 1u))
#define SUBREP(bit) for (int sr_ = 0; sr_ < 1 + (int)((REPEAT_MASK >> (bit)) & 1u); ++sr_)
#define REP_SYNC() do { if (rep_) xcd_barrier(xbar); } while (0)
#ifndef PROBE_T_LO
#define PROBE_T_LO (-1)
#define PROBE_T_HI (-1)
#endif
#define STAMP(k) do { if (PROBE_T_LO >= 0 && ((k) == PROBE_T_LO || (k) == PROBE_T_HI) && bx == 0 && tid0 == 0) { ((volatile LAS unsigned long long*)(ldsl + LDS_BARST + 16))[(k) == PROBE_T_HI ? 1 : 0] = __builtin_amdgcn_s_memrealtime(); } } while (0)
#define SEAM(k) do { if (IN(k) && IN((k) + 1)) xcd_barrier(xbar); STAMP((k) + 1); } while (0)

    STAMP(0);
    PHASE(0) {
        REP_SYNC();
        PHASE_LOCALS;
#define TL_0(r_) do { int r = (r_); if (r < I_GU) { p0_transpose_tile(args.in[9], args.in[8], D, NGU, Wgu1, 1, fl, r, tid); break; } r -= I_GU; \
            if (r < I_IN) { p0_transpose_tile(args.in[12], args.in[11], D, NIN, Win, 2, fl, r, tid); break; } r -= I_IN; \
            p0_transpose_tile(args.in[30], args.in[28], D, 2 * D, Wckv, 0, fl, r, tid); } while (0)
#define TL_1(r_) do { p0_transpose_tile(args.in[10], nullptr, FF, D, Wd1, 0, fl, (r_), tid); } while (0)
#define TL_3(r_) do { int r = (r_); if (r < I_GU) { p0_transpose_tile(args.in[33], args.in[32], D, NGU, Wgu2, 1, fl, r, tid); break; } r -= I_GU; \
            if (r < I_D) { p0_transpose_tile(args.in[34], nullptr, FF, D, Wd2, 0, fl, r, tid); break; } r -= I_D; \
            if (r < I_SQ) { p0_transpose_tile(args.in[26], nullptr, D, D, Wout, 0, fl, r, tid); break; } r -= I_SQ; \
            if (r < I_SQ) { p0_transpose_tile(args.in[29], args.in[27], D, D, Wcq, 0, fl, r, tid); break; } r -= I_SQ; \
            p0_transpose_tile(args.in[31], nullptr, D, D, Wco, 0, fl, r, tid); } while (0)
        for (int it = bx; it < N_TL0; it += G) TL_0(it);
        if (G != 256) { for (int it = bx; it < N_TL1; it += G) TL_1(it); for (int it = bx; it < N_TL3; it += G) TL_3(it); }
        STAMP(120);
        for (int i = gt; i < (NINP - NIN) * D / 8; i += NGT) ((u32x4*)(Win + (size_t)NIN * D))[i] = (u32x4){0u, 0u, 0u, 0u};
        for (int i = gt; i < 4 * M; i += NGT) ssq[SSQ_H1 + i] = 0.f;
        for (int m4 = gw; m4 < M / 4; m4 += NGW) {
            const int m = 4 * m4; const float* xr = m < MP ? x_prompt + (size_t)m * D : x_sample + (size_t)(m - MP) * D;
            const f32x4* xp = (const f32x4*)xr + lane; f32x4 v[16];
#pragma unroll
            for (int j = 0; j < 16; ++j) v[j] = __builtin_nontemporal_load(xp + 64 * j);
            __builtin_amdgcn_sched_barrier(0);
            unsigned long long* o8 = (unsigned long long*)(xb + (size_t)m * D) + lane;
#pragma unroll
            for (int r = 0; r < 4; ++r) { float sq = 0.f;
#pragma unroll
                for (int j = 0; j < 4; ++j) { const f32x4 a = v[r * 4 + j]; sq += (a.x * a.x + a.y * a.y) + (a.z * a.z + a.w * a.w); o8[64 * (r * 4 + j)] = (unsigned long long)pk2(a.x, a.y) | ((unsigned long long)pk2(a.z, a.w) << 32); }
                sq = wave_sum(sq); if (lane == 0) ssq[SSQ_X + m + r] = sq; }
        }
        STAMP(121);
        for (int m = gw; m < MEMR; m += NGW) row_to_bf16_ssq(mem_prompt + (size_t)m * D, memb + (size_t)m * D, ssq + SSQ_MEM + m, lane);
        STAMP(122);
        __syncthreads();
        for (int p = bx; p < 256; p += G) {
            const int g = p & 31, sub = p >> 5;
            f32x2* pw = (f32x2*)fl; f32x2* cf = pw + 64 * 9;
            { const int n = tid >> 3, j = tid & 7; const S5P sp = s5_par(s5_lre, s5_lim, s5_logdt, g, n);
              pw[n * 9 + j] = s5_pow(sp, j); if (j == 7) pw[n * 9 + 8] = s5_pow(sp, 8); if (j == 1) cf[n] = s5_coef(sp); }
            __syncthreads();
            if (tid < 256) {
                const int pp = tid >> 4, part = tid & 15, j = sub;
                float a[16];
#pragma unroll
                for (int i = 0; i < 16; ++i) a[i] = 0.f;
#pragma unroll
                for (int i = 0; i < 4; ++i) { const int n = part * 4 + i;
                    const f32x2 c = (f32x2){s5_cre[(g * 16 + pp) * 64 + n], s5_cim[(g * 16 + pp) * 64 + n]};
                    const f32x2 cc = cmul(cmul(c, pw[n * 9 + j]), cf[n]);
                    const f32x4* br = (const f32x4*)(s5_bre + (g * 64 + n) * 16); const f32x4* bi = (const f32x4*)(s5_bim + (g * 64 + n) * 16);
#pragma unroll
                    for (int q4 = 0; q4 < 4; ++q4) { const f32x4 r4 = br[q4], i4 = bi[q4];
#pragma unroll
                        for (int e = 0; e < 4; ++e) a[q4 * 4 + e] += cc.x * r4[e] - cc.y * i4[e]; } }
#pragma unroll
                for (int i = 0; i < 16; ++i) a[i] = row16_sum(a[i]);
                if (part < 8 - j) { const int t = j + part, sx = part;
                    u32x4* dst = (u32x4*)(GTt + (size_t)(g * 128 + t * 16 + pp) * 256 + 128 + sx * 16);
                    dst[0] = (u32x4){pk2(a[0], a[1]), pk2(a[2], a[3]), pk2(a[4], a[5]), pk2(a[6], a[7])};
                    dst[1] = (u32x4){pk2(a[8], a[9]), pk2(a[10], a[11]), pk2(a[12], a[13]), pk2(a[14], a[15])}; }
            } else if (tid < 320) {
                const int q = sub * 64 + (tid - 256), n = q >> 3, sx = q & 7;
                const f32x2 mm = cmul(pw[n * 9 + 7 - sx], cf[n]);
                unsigned wre[8], wim[8];
#pragma unroll
                for (int pp = 0; pp < 8; ++pp) {
                    const f32x2 b0 = (f32x2){s5_bre[(g * 64 + n) * 16 + 2 * pp], s5_bim[(g * 64 + n) * 16 + 2 * pp]}, b1 = (f32x2){s5_bre[(g * 64 + n) * 16 + 2 * pp + 1], s5_bim[(g * 64 + n) * 16 + 2 * pp + 1]};
                    const f32x2 v0 = cmul(mm, b0), v1 = cmul(mm, b1);
                    wre[pp] = pk2(v0.x, v1.x); wim[pp] = pk2(v0.y, v1.y);
                }
                u32x4* dre = (u32x4*)(EgT + ((size_t)(g * 128 + n) * 128 + sx * 16)); u32x4* dim = (u32x4*)(EgT + ((size_t)(g * 128 + 64 + n) * 128 + sx * 16));
                dre[0] = (u32x4){wre[0], wre[1], wre[2], wre[3]}; dre[1] = (u32x4){wre[4], wre[5], wre[6], wre[7]};
                dim[0] = (u32x4){wim[0], wim[1], wim[2], wim[3]}; dim[1] = (u32x4){wim[4], wim[5], wim[6], wim[7]};
            } else if (tid < 384) {
                const int q = sub * 64 + (tid - 320), t = q >> 6, n = q & 63;
                const f32x2 pwt = pw[n * 9 + t + 1];
#pragma unroll
                for (int pp = 0; pp < 16; ++pp) {
                    const f32x2 c = (f32x2){s5_cre[(g * 16 + pp) * 64 + n], s5_cim[(g * 16 + pp) * 64 + n]};
                    const f32x2 v = cmul(c, pwt);
                    bf16_t* dst = GTt + (size_t)(g * 128 + t * 16 + pp) * 256;
                    dst[n] = (bf16_t)f2bf(v.x); dst[64 + n] = (bf16_t)f2bf(-v.y);
                }
            } else {
                const int pair = (tid - 384) >> 4, pp = (tid - 384) & 15;
                if (sub >= 1 && pair < 8 - sub) { const int t = pair, sx = pair + sub;
                    u32x4* dst = (u32x4*)(GTt + (size_t)(g * 128 + t * 16 + pp) * 256 + 128 + sx * 16);
                    dst[0] = (u32x4){0u, 0u, 0u, 0u}; dst[1] = (u32x4){0u, 0u, 0u, 0u}; }
            }
            __syncthreads();
        }
    }
    SEAM(0);

    for (int i_ = 0; i_ < 20 * (int)((REPEAT_MASK >> 23) & 1u); ++i_) xcd_barrier(xbar);
    PHASE_G(1) {
        pg8::Gemm g{xb, Wgu1, M, NGU, D}; pg8::StaticOrder S; S.init(M, NGU, G, bx, GREP(1));
        pg8::EpiSwiGLU E{act, FF, ssq + SSQ_X};
        pg8::gemm_phase<pg8::EpiSwiGLU, pg8::StaticOrder, PG_ALIGN, PG_SP2>(ldsl, g, S, E);
        if (G == 256 && bx >= 216) { const int tid = tid0; for (int it = bx - 216; it < N_TL1; it += 40) TL_1(it); }
    }
    SEAM(1);
    PHASE_G(2) {
        pg8::Gemm g{act, Wd1, MP, D, FF}; pg8::StaticOrder S; S.init(MP, D, G, bx);
        pg8::EpiResid<false> E{xb, hb, nullptr, ssq + SSQ_H1, 0.5f};
        pg8::gemm_phase<pg8::EpiResid<false>, pg8::StaticOrder, PG_ALIGN, PG_SP2>(ldsl, g, S, E);
        SEpiResid<false> SE{xb, hb, nullptr, ssq + SSQ_H1, 0.5f};
        small_gemm(act + (size_t)MP * FF, Wd1, FF, fl, G, bx, wave, tid0, SE);
    }
    SEAM(2);
    PHASE_G(3) {
        { pg8::Gemm g{hb, Win, M, NINP, D}; pg8::StaticOrder S; S.init(M, NINP, G, bx, GREP(3));
          pg8::EpiScaleBf16 E{Pb, NINP, ssq + SSQ_H1, 1.f};
          pg8::gemm_phase<pg8::EpiScaleBf16, pg8::StaticOrder, PG_ALIGN, PG_SP2>(ldsl, g, S, E); }
        { pg8::Gemm g{memb, Wckv, MEMR, 2 * D, D}; pg8::StaticOrder S; S.init(MEMR, 2 * D, G, (bx + 64) % G);
          pg8::EpiMemKV E{out + O_MKP, out + O_MVP, kb, vbT, ssq + SSQ_MEM};
          pg8::gemm_phase<pg8::EpiMemKV, pg8::StaticOrder, PG_ALIGN, PG_SP2>(ldsl, g, S, E); }
        if (G == 256 && bx >= 100 && bx < 192) { const int tid = tid0; for (int it = bx - 100; it < N_TL3; it += 92) TL_3(it); }
    }
    SEAM(3);

    PHASE(4) {
        REP_SYNC();
        PHASE_LOCALS;
        SUBREP(16)
        {
            float* zg = fl; float* kk = zg + 64 * 16; float* vv = kk + 64 * 65; float* bb = vv + 64 * 129; float* seg = bb + 64 * 65;
            const int fr = lane & 15, fq = lane >> 4;
            u32x4 zw = (u32x4){0u, 0u, 0u, 0u}, kn = zw, vw[2] = {zw, zw};
#define GLA_A_LOAD(u_) do { const int bh_ = (u_) >> 5, c_ = (u_) & 31; const size_t rr_ = (size_t)(bh_ >> 2) * 2048 + c_ * 64; const int h_ = bh_ & 3; \
                if (tid < 128) zw = *(const u32x4*)(Pb + (rr_ + (tid >> 1)) * NINP + PC_ZG + (tid & 1) * 8); \
                kn = *(const u32x4*)(Pb + (rr_ + (tid >> 3)) * NINP + PC_K + h_ * 64 + (tid & 7) * 8); \
                _Pragma("unroll") for (int i_ = 0; i_ < 2; ++i_) { const int ch_ = tid + i_ * 512; vw[i_] = *(const u32x4*)(Pb + (rr_ + (ch_ >> 4)) * NINP + PC_V + h_ * 128 + (ch_ & 15) * 8); } } while (0)
            float gwr[16]; float gbias = 0.f; int hcur = -1;
#pragma unroll
            for (int r = 0; r < 16; ++r) gwr[r] = 0.f;
            if (bx < 1024) GLA_A_LOAD(bx);
            for (int unit = bx; unit < 1024; unit += G) {
                const int bh = unit >> 5, c = unit & 31, b = bh >> 2, h = bh & 3;
                const size_t r0 = (size_t)b * 2048 + c * 64; (void)r0; (void)b; (void)c;
                if (tid < 128) { const int t = tid >> 1, hf = tid & 1; const u32x4 w = zw;
                    float* z = zg + t * 16 + hf * 8; z[0] = bflo(w.x); z[1] = bfhi(w.x); z[2] = bflo(w.y); z[3] = bfhi(w.y); z[4] = bflo(w.z); z[5] = bfhi(w.z); z[6] = bflo(w.w); z[7] = bfhi(w.w); }
                const u32x4 kw = kn;
#pragma unroll
                for (int i = 0; i < 2; ++i) { const int ch = tid + i * 512, t = ch >> 4, c8 = ch & 15; const u32x4 w = vw[i];
                    float* z = vv + t * 129 + c8 * 8; z[0] = bflo(w.x); z[1] = bfhi(w.x); z[2] = bflo(w.y); z[3] = bfhi(w.y); z[4] = bflo(w.z); z[5] = bfhi(w.z); z[6] = bflo(w.w); z[7] = bfhi(w.w); }
                if (unit + G < 1024) GLA_A_LOAD(unit + G);
                if (h != hcur) { const int dd = tid & 63; gbias = b_gate[h * 64 + dd];
#pragma unroll
                    for (int r = 0; r < 16; ++r) gwr[r] = w_gate[r * 256 + h * 64 + dd];
                    hcur = h; }
                LDS_BARRIER();
                gla_gate_cumsum<64>(zg, bb, seg, w_gate, b_gate, h, tid, gwr, gbias);
                { const int t = tid >> 3, d0 = (tid & 7) * 8; const float* bt = bb + t * 65 + d0; float* gb = glaB + (size_t)unit * 4096 + t * 64 + d0;
                    *(f32x4*)gb = (f32x4){bt[0], bt[1], bt[2], bt[3]}; *(f32x4*)(gb + 4) = (f32x4){bt[4], bt[5], bt[6], bt[7]}; }
                { const int t = tid >> 3, d0 = (tid & 7) * 8; float* z = kk + t * 65 + d0; const float* bl = bb + 63 * 65 + d0; const float* bt = bb + t * 65 + d0;
                    z[0] = bflo(kw.x) * __expf(bl[0] - bt[0]); z[1] = bfhi(kw.x) * __expf(bl[1] - bt[1]); z[2] = bflo(kw.y) * __expf(bl[2] - bt[2]); z[3] = bfhi(kw.y) * __expf(bl[3] - bt[3]);
                    z[4] = bflo(kw.z) * __expf(bl[4] - bt[4]); z[5] = bfhi(kw.z) * __expf(bl[5] - bt[5]); z[6] = bflo(kw.w) * __expf(bl[6] - bt[6]); z[7] = bfhi(kw.w) * __expf(bl[7] - bt[7]); }
                LDS_BARRIER();
                {
                    f32x4 acc[4];
#pragma unroll
                    for (int db = 0; db < 4; ++db) acc[db] = (f32x4){0.f, 0.f, 0.f, 0.f};
#pragma unroll
                    for (int ks = 0; ks < 2; ++ks) {
                        float av[8];
#pragma unroll
                        for (int j = 0; j < 8; ++j) av[j] = vv[(ks * 32 + fq * 8 + j) * 129 + wave * 16 + fr];
                        const u32x4 vp = (u32x4){pk2(av[0], av[1]), pk2(av[2], av[3]), pk2(av[4], av[5]), pk2(av[6], av[7])};
#pragma unroll
                        for (int db = 0; db < 4; ++db) {
                            float bv[8];
#pragma unroll
                            for (int j = 0; j < 8; ++j) bv[j] = kk[(ks * 32 + fq * 8 + j) * 65 + db * 16 + fr];
                            const u32x4 kp = (u32x4){pk2(bv[0], bv[1]), pk2(bv[2], bv[3]), pk2(bv[4], bv[5]), pk2(bv[6], bv[7])};
                            acc[db] = __builtin_amdgcn_mfma_f32_16x16x32_bf16(__builtin_bit_cast(bf16x8, kp), __builtin_bit_cast(bf16x8, vp), acc[db], 0, 0, 0);
                        }
                    }
                    bf16_t* dp = glaD + (size_t)unit * 8192 + (size_t)(wave * 16 + fr) * 64 + fq * 4;
#pragma unroll
                    for (int db = 0; db < 4; ++db) { u32x2 w2; w2.x = pk2(acc[db][0], acc[db][1]); w2.y = pk2(acc[db][2], acc[db][3]); *(u32x2*)(dp + db * 16) = w2; }
                }
                if (tid < 64) glaDec[unit * 64 + tid] = __expf(bb[63 * 65 + tid]);
                LDS_BARRIER();
            }
        }
#undef GLA_A_LOAD
        STAMP(104);
        SUBREP(17)
        {
            constexpr int SU = 11520;
            for (int unit0 = bx; unit0 < 512; unit0 += 2 * G) {
                const int nu = (unit0 + G < 512) ? 2 : 1;
                f32x4 s0r[2][4]; unsigned rw_pre[2] = {0u, 0u};
                const f32x2 gg_pre = *(const f32x2*)(g_gla_out + lane * 2);
#pragma unroll
                for (int u = 0; u < 2; ++u) {
#pragma unroll
                    for (int i = 0; i < 4; ++i) s0r[u][i] = (f32x4){0.f, 0.f, 0.f, 0.f};
                    if (u < nu) {
                        const int unit = unit0 + u * G, b = unit >> 2, h = unit & 3; const size_t r0 = (size_t)MP + b * 8;
                        float* zg = fl + u * SU; float* qq = zg + 128; float* kk = qq + 520; float* vv = kk + 1040;
                        if (tid < 128) { const int t = tid >> 4, r = tid & 15; zg[t * 16 + r] = bf2f(Pb[(r0 + t) * NINP + PC_ZG + r]); }
                        { const int t = tid >> 6, d = tid & 63; qq[t * 65 + d] = bf2f(Pb[(r0 + t) * NINP + PC_Q + h * 64 + d]); kk[t * 65 + d] = bf2f(Pb[(r0 + t) * NINP + PC_K + h * 64 + d]); }
#pragma unroll
                        for (int i = 0; i < 2; ++i) { const int idx = tid + i * 512, t = idx >> 7, e = idx & 127; vv[t * 128 + e] = bf2f(Pb[(r0 + t) * NINP + PC_V + h * 128 + e]); }
                        { const f32x4* sp = (const f32x4*)(state_gla + (size_t)unit * 8192);
#pragma unroll
                            for (int i = 0; i < 4; ++i) s0r[u][i] = __builtin_nontemporal_load(sp + tid + i * 512); }
                        rw_pre[u] = *(const unsigned*)(Pb + (r0 + wave) * NINP + PC_R + h * 128 + lane * 2);
                    }
                }
                LDS_BARRIER();
#pragma unroll
                for (int u = 0; u < 2; ++u) if (u < nu) {
                    const int h = (unit0 + u * G) & 3; const float* zg = fl + u * SU; float* bb = fl + u * SU + 2712;
                    const int t = tid >> 6, d = tid & 63; float sgt = b_gate[h * 64 + d];
#pragma unroll
                    for (int r = 0; r < 16; ++r) sgt += zg[t * 16 + r] * w_gate[r * 256 + h * 64 + d];
                    bb[t * 65 + d] = logsigmoidf(sgt) * (1.f / 16.f);
                }
                LDS_BARRIER();
                if (tid < 64 * nu) { float* bb = fl + (tid >> 6) * SU + 2712; const int d = tid & 63; float run = 0.f;
#pragma unroll
                    for (int t = 0; t < 8; ++t) { run += bb[t * 65 + d]; bb[t * 65 + d] = run; } }
                LDS_BARRIER();
#pragma unroll
                for (int u = 0; u < 2; ++u) if (u < nu) {
                    float* qq = fl + u * SU + 128; float* kk = qq + 520; float* kt = kk + 520; const float* bb = fl + u * SU + 2712;
                    const int t = tid >> 6, d = tid & 63; const float bt = bb[t * 65 + d], b7 = bb[7 * 65 + d]; const float kv = kk[t * 65 + d];
                    qq[t * 65 + d] *= __expf(bt) * 0.125f; kk[t * 65 + d] = kv * __expf(-bt); kt[t * 65 + d] = kv * __expf(b7 - bt);
                }
                LDS_BARRIER();
                {
                    const int u = tid >> 8, pr = (tid >> 2) & 63, t = pr >> 3, sx = pr & 7, sg4 = tid & 3;
                    const float* qq = fl + u * SU + 128; const float* kk = qq + 520; float* sc = fl + u * SU + 3232;
                    float a = 0.f;
                    if (u < nu && sx <= t) {
#pragma unroll
                        for (int d = 0; d < 16; ++d) a += qq[t * 65 + sg4 * 16 + d] * kk[sx * 65 + sg4 * 16 + d]; }
                    a += __shfl_xor(a, 1); a += __shfl_xor(a, 2);
                    if (u < nu && sg4 == 0) sc[t * 8 + sx] = a;
                }
#pragma unroll
                for (int u = 0; u < 2; ++u) if (u < nu) { f32x4* dp = (f32x4*)(fl + u * SU + 3296);
#pragma unroll
                    for (int i = 0; i < 4; ++i) dp[tid + i * 512] = s0r[u][i]; }
                LDS_BARRIER();
#pragma unroll
                for (int u = 0; u < 2; ++u) if (u < nu) {
                    const int unit = unit0 + u * G, b = unit >> 2, h = unit & 3; const size_t r0 = (size_t)MP + b * 8;
                    const float* qq = fl + u * SU + 128; const float* kt = qq + 1040; const float* vv = qq + 1560; const float* bb = fl + u * SU + 2712; const float* sc = fl + u * SU + 3232; const float* S0 = fl + u * SU + 3296;
                    {
                        const int t = wave, e0 = lane * 2; float o0 = 0.f, o1 = 0.f;
#pragma unroll 1
                        for (int d0 = 0; d0 < 64; d0 += 8) {
                            float qd[8]; f32x2 sv[8];
#pragma unroll
                            for (int j = 0; j < 8; ++j) { qd[j] = qq[t * 65 + d0 + j]; sv[j] = *(const f32x2*)(S0 + (d0 + j) * 128 + e0); }
#pragma unroll
                            for (int j = 0; j < 8; ++j) { o0 += qd[j] * sv[j].x; o1 += qd[j] * sv[j].y; }
                            __builtin_amdgcn_sched_barrier(0);
                        }
                        { float wv[8]; f32x2 vx[8];
#pragma unroll
                          for (int sx = 0; sx < 8; ++sx) { wv[sx] = sx <= t ? sc[t * 8 + sx] : 0.f; vx[sx] = *(const f32x2*)(vv + sx * 128 + e0); }
#pragma unroll
                          for (int sx = 0; sx < 8; ++sx) { o0 += wv[sx] * vx[sx].x; o1 += wv[sx] * vx[sx].y; } }
                        const float ss = wave_sum(o0 * o0 + o1 * o1); const float rs = rsqrtf(ss * (1.f / 128.f) + EPS);
                        const unsigned rw = rw_pre[u];
                        const float y0 = o0 * rs * gg_pre.x * siluf(bflo(rw)), y1 = o1 * rs * gg_pre.y * siluf(bfhi(rw));
                        *(unsigned*)(mix + (r0 + t) * D + h * 128 + e0) = pk2(y0, y1);
                    }
                    {
                        const int e4 = (tid & 31) * 4, dg = (tid >> 5) * 4;
                        f32x4 a[4];
#pragma unroll
                        for (int i = 0; i < 4; ++i) a[i] = *(const f32x4*)(S0 + (dg + i) * 128 + e4) * __expf(bb[7 * 65 + dg + i]);
#pragma unroll
                        for (int sx = 0; sx < 8; ++sx) { const f32x4 vr = *(const f32x4*)(vv + sx * 128 + e4);
#pragma unroll
                            for (int i = 0; i < 4; ++i) a[i] += vr * kt[sx * 65 + dg + i]; }
                        float* dp = out + O_GLAS + (size_t)unit * 8192 + dg * 128 + e4;
#pragma unroll
                        for (int i = 0; i < 4; ++i) __builtin_nontemporal_store(a[i], (f32x4*)(dp + i * 128));
                    }
                }
                LDS_BARRIER();
            }
        }
        STAMP(105);
        SUBREP(18)
        for (int p = bx; p < 256; p += G) {
            const int g = p & 31, fr = lane & 15, fq = lane >> 4;
            bf16_t* Es = (bf16_t*)lds;
            { u32x4 st_[4];
#pragma unroll
              for (int j = 0; j < 4; ++j) { const int ch = tid + j * NTHREADS; st_[j] = *(const u32x4*)(EgT + (size_t)(g * 128 + (ch >> 4)) * 128 + (ch & 15) * 8); }
#pragma unroll
              for (int j = 0; j < 4; ++j) { const int ch = tid + j * NTHREADS; *(u32x4*)(Es + (ch >> 4) * 136 + (ch & 15) * 8) = st_[j]; } }
            __syncthreads();
            for (int j = wave; j < 16; j += 8) {
                const int rb = (p >> 5) + 8 * j; const int R0 = rb * 16;
                bf16x8 a[4];
#pragma unroll
                for (int ks = 0; ks < 4; ++ks) a[ks] = *(const bf16x8*)(Pb + ((size_t)(R0 + fr) * 8 + ks * 2 + (fq >> 1)) * NINP + PC_U + g * 16 + (fq & 1) * 8);
                __builtin_amdgcn_sched_barrier(0);
                f32x4 acc[8];
#pragma unroll
                for (int nb = 0; nb < 8; ++nb) acc[nb] = (f32x4){0.f, 0.f, 0.f, 0.f};
#pragma unroll
                for (int ks = 0; ks < 4; ++ks)
                {
#pragma unroll
                    for (int nb = 0; nb < 8; ++nb) { const bf16x8 bfr = *(const bf16x8*)(Es + (nb * 16 + fr) * 136 + ks * 32 + fq * 8);
                        acc[nb] = __builtin_amdgcn_mfma_f32_16x16x32_bf16(bfr, a[ks], acc[nb], 0, 0, 0); }
                    __builtin_amdgcn_sched_barrier(0); }
#pragma unroll
                for (int nb = 0; nb < 8; ++nb) { u32x2 w2; w2.x = pk2(acc[nb][0], acc[nb][1]); w2.y = pk2(acc[nb][2], acc[nb][3]);
                    *(u32x2*)(s5e + ((size_t)(R0 + fr) * 32 + g) * 128 + nb * 16 + fq * 4) = w2; }
            }
            {
                const int R0 = ((p >> 5) + 128) * 16, nb = wave;
                f32x4 acc1 = (f32x4){0.f, 0.f, 0.f, 0.f};
#pragma unroll
                for (int ks = 0; ks < 4; ++ks) { const bf16x8 av = *(const bf16x8*)(Pb + ((size_t)(R0 + fr) * 8 + ks * 2 + (fq >> 1)) * NINP + PC_U + g * 16 + (fq & 1) * 8);
                    const bf16x8 bfr = *(const bf16x8*)(Es + (nb * 16 + fr) * 136 + ks * 32 + fq * 8); acc1 = __builtin_amdgcn_mfma_f32_16x16x32_bf16(bfr, av, acc1, 0, 0, 0); }
                u32x2 w2; w2.x = pk2(acc1[0], acc1[1]); w2.y = pk2(acc1[2], acc1[3]);
                *(u32x2*)(s5e + ((size_t)(R0 + fr) * 32 + g) * 128 + nb * 16 + fq * 4) = w2;
            }
            __syncthreads();
        }
    }
    STAMP(108);
    SEAM(4);

    PHASE(5) {
        REP_SYNC();
        PHASE_LOCALS;
        const bool s5s_two = (NGT * 2 == 128 * 32 * 64);
        float s5s_xr[2] = {0.f, 0.f}, s5s_xi[2] = {0.f, 0.f}, s5s_ldt[2] = {0.f, 0.f}, s5s_lr[2] = {0.f, 0.f}, s5s_li[2] = {0.f, 0.f}; bf16_t s5s_er[2] = {0, 0}, s5s_ei[2] = {0, 0};
        if (s5s_two) {
#pragma unroll
            for (int k = 0; k < 2; ++k) { const int idx = gt + k * NGT, b = idx >> 11, g = (idx >> 6) & 31, n = idx & 63; const size_t o = ((size_t)(2048 + b) * 32 + g) * 128;
                s5s_xr[k] = st_re[idx]; s5s_xi[k] = st_im[idx]; s5s_ldt[k] = s5_logdt[g]; s5s_lr[k] = s5_lre[g * 64 + n]; s5s_li[k] = s5_lim[g * 64 + n]; s5s_er[k] = s5e[o + n]; s5s_ei[k] = s5e[o + 64 + n]; }
        }
        for (int idx = gt; idx < 32 * 4096; idx += NGT) {
            const int bh = idx >> 12, pe = idx & 4095, d = (pe & 31) * 2, e = pe >> 5;
            unsigned Dv[32]; f32x2 dc[32];
#pragma unroll
            for (int c = 0; c < 32; ++c) { const int unit = bh * 32 + c; Dv[c] = *(const unsigned*)(glaD + (size_t)unit * 8192 + e * 64 + d); dc[c] = *(const f32x2*)(glaDec + unit * 64 + d); }
            __builtin_amdgcn_sched_barrier(0);
            float S0 = 0.f, S1 = 0.f;
#pragma unroll
            for (int c = 0; c < 32; ++c) { *(unsigned*)(glaS + (size_t)(bh * 32 + c) * 8192 + e * 64 + d) = pk2(S0, S1); S0 = dc[c].x * S0 + bflo(Dv[c]); S1 = dc[c].y * S1 + bfhi(Dv[c]); }
            out[O_GLAP + (size_t)bh * 8192 + d * 128 + e] = S0; out[O_GLAP + (size_t)bh * 8192 + (d + 1) * 128 + e] = S1;
        }
        STAMP(115);
        for (int it = bx; it < 256; it += G) {
            const int b = it >> 5, g = it & 31, n = tid & 63, sgm = wave;
            const S5P p = s5_par(s5_lre, s5_lim, s5_logdt, g, n); const f32x2 a8 = s5_pow(p, 8);
            f32x2 a256 = a8;
#pragma unroll
            for (int i = 0; i < 5; ++i) a256 = cmul(a256, a256);
            float er[32], ei[32];
            const size_t o0 = (((size_t)b * 256 + sgm * 32) * 32 + g) * 128;
#pragma unroll
            for (int i = 0; i < 32; ++i) { er[i] = bf2f(s5e[o0 + (size_t)i * 4096 + n]); ei[i] = bf2f(s5e[o0 + (size_t)i * 4096 + 64 + n]); }
            __builtin_amdgcn_sched_barrier(0);
            float yr = 0.f, yi = 0.f;
#pragma unroll
            for (int i = 0; i < 32; ++i) { const float pr = yr, pi = yi; yr = a8.x * pr - a8.y * pi + er[i]; yi = a8.x * pi + a8.y * pr + ei[i]; er[i] = pr; ei[i] = pi; }
            fl[sgm * 64 + n] = yr; fl[512 + sgm * 64 + n] = yi;
            __syncthreads();
            float xr = 0.f, xi = 0.f;
            for (int j = 0; j < sgm; ++j) { const float tr = fl[j * 64 + n], ti = fl[512 + j * 64 + n]; const float nr = a256.x * xr - a256.y * xi + tr, ni = a256.x * xi + a256.y * xr + ti; xr = nr; xi = ni; }
            f32x2 pw = (f32x2){1.f, 0.f};
#pragma unroll
            for (int i = 0; i < 32; ++i) {
                s5x[o0 + (size_t)i * 4096 + n] = (bf16_t)f2bf(er[i] + pw.x * xr - pw.y * xi); s5x[o0 + (size_t)i * 4096 + 64 + n] = (bf16_t)f2bf(ei[i] + pw.x * xi + pw.y * xr);
                pw = cmul(pw, a8);
            }
            if (sgm == 7) { out[O_REP + (b * 32 + g) * 64 + n] = yr + a256.x * xr - a256.y * xi; out[O_IMP + (b * 32 + g) * 64 + n] = yi + a256.x * xi + a256.y * xr; }
            __syncthreads();
        }
        STAMP(116);
        if (s5s_two) {
#pragma unroll
            for (int k = 0; k < 2; ++k) { const int idx = gt + k * NGT, b = idx >> 11, g = (idx >> 6) & 31, n = idx & 63; const size_t o = ((size_t)(2048 + b) * 32 + g) * 128;
                S5P p; p.dt = expf(s5s_ldt[k]); p.lr = s5s_lr[k]; p.li = s5s_li[k]; const f32x2 a8 = s5_pow(p, 8);
                const float xr = s5s_xr[k], xi = s5s_xi[k];
                s5x[o + n] = (bf16_t)f2bf(xr); s5x[o + 64 + n] = (bf16_t)f2bf(xi);
                out[O_RES + idx] = a8.x * xr - a8.y * xi + bf2f(s5s_er[k]); out[O_IMS + idx] = a8.x * xi + a8.y * xr + bf2f(s5s_ei[k]); }
        } else
        for (int idx = gt; idx < 128 * 32 * 64; idx += NGT) {
            const int b = idx >> 11, g = (idx >> 6) & 31, n = idx & 63;
            const S5P p = s5_par(s5_lre, s5_lim, s5_logdt, g, n); const f32x2 a8 = s5_pow(p, 8);
            const float xr = st_re[idx], xi = st_im[idx];
            const size_t R = 2048 + b; const size_t o = (R * 32 + g) * 128;
            s5x[o + n] = (bf16_t)f2bf(xr); s5x[o + 64 + n] = (bf16_t)f2bf(xi);
            out[O_RES + idx] = a8.x * xr - a8.y * xi + bf2f(s5e[o + n]); out[O_IMS + idx] = a8.x * xi + a8.y * xr + bf2f(s5e[o + 64 + n]);
        }
    }
    SEAM(5);

    PHASE(6) {
        REP_SYNC();
        PHASE_LOCALS;
        SUBREP(19)
        {
            float* vv = fl; float* ot = vv + 64 * 129; float* red = ot + 64 * 132;
            bf16_t* qq = (bf16_t*)(red + 512); bf16_t* kk = qq + 64 * 72; bf16_t* sc = kk + 64 * 72;
            const int fr = lane & 15, fq = lane >> 4;
            u32x4 kn = (u32x4){0u, 0u, 0u, 0u}, qn = kn, vw[2] = {kn, kn}, rn[2] = {kn, kn}; f32x4 bn[2] = {(f32x4){0.f, 0.f, 0.f, 0.f}, (f32x4){0.f, 0.f, 0.f, 0.f}};
#define GLA_C_LOAD(u_) do { const int bh_ = (u_) >> 5, c_ = (u_) & 31; const size_t rr_ = (size_t)(bh_ >> 2) * 2048 + c_ * 64; const int h_ = bh_ & 3; \
                kn = *(const u32x4*)(Pb + (rr_ + (tid >> 3)) * NINP + PC_K + h_ * 64 + (tid & 7) * 8); \
                qn = *(const u32x4*)(Pb + (rr_ + (tid >> 3)) * NINP + PC_Q + h_ * 64 + (tid & 7) * 8); \
                bn[0] = *(const f32x4*)(glaB + (size_t)(u_) * 4096 + (tid >> 3) * 64 + (tid & 7) * 8); bn[1] = *(const f32x4*)(glaB + (size_t)(u_) * 4096 + (tid >> 3) * 64 + (tid & 7) * 8 + 4); \
                rn[0] = *(const u32x4*)(Pb + (rr_ + (tid >> 3)) * NINP + PC_R + h_ * 128 + (tid & 7) * 16); rn[1] = *(const u32x4*)(Pb + (rr_ + (tid >> 3)) * NINP + PC_R + h_ * 128 + (tid & 7) * 16 + 8); \
                _Pragma("unroll") for (int i_ = 0; i_ < 2; ++i_) { const int ch_ = tid + i_ * 512; vw[i_] = *(const u32x4*)(Pb + (rr_ + (ch_ >> 4)) * NINP + PC_V + h_ * 128 + (ch_ & 15) * 8); } } while (0)
            f32x4 ggo[4];
#pragma unroll
            for (int i = 0; i < 4; ++i) ggo[i] = *(const f32x4*)(g_gla_out + (tid & 7) * 16 + i * 4);
            if (bx < 1024) GLA_C_LOAD(bx);
            for (int unit = bx; unit < 1024; unit += G) {
                const int bh = unit >> 5, c = unit & 31, b = bh >> 2, h = bh & 3;
                const size_t r0 = (size_t)b * 2048 + c * 64;
                const u32x4 kw = kn, qw = qn, rw0 = rn[0], rw1 = rn[1]; const f32x4 bt0 = bn[0], bt1 = bn[1];
#pragma unroll
                for (int i = 0; i < 2; ++i) { const int ch = tid + i * 512, t = ch >> 4, c8 = ch & 15; const u32x4 w = vw[i];
                    float* z = vv + t * 129 + c8 * 8; z[0] = bflo(w.x); z[1] = bfhi(w.x); z[2] = bflo(w.y); z[3] = bfhi(w.y); z[4] = bflo(w.z); z[5] = bfhi(w.z); z[6] = bflo(w.w); z[7] = bfhi(w.w); }
                bf16x8 bS[2];
                { const bf16_t* sp = glaS + (size_t)unit * 8192 + (size_t)(wave * 16 + fr) * 64 + fq * 8; bS[0] = *(const bf16x8*)sp; bS[1] = *(const bf16x8*)(sp + 32); }
                if (unit + G < 1024) GLA_C_LOAD(unit + G);
                {
                    const int t = tid >> 3, d0 = (tid & 7) * 8;
                    float eb[8];
#pragma unroll
                    for (int j = 0; j < 4; ++j) { eb[j] = __expf(bt0[j]); eb[4 + j] = __expf(bt1[j]); }
                    u32x4 qo, ko;
                    qo.x = pk2(bflo(qw.x) * eb[0] * 0.125f, bfhi(qw.x) * eb[1] * 0.125f); qo.y = pk2(bflo(qw.y) * eb[2] * 0.125f, bfhi(qw.y) * eb[3] * 0.125f);
                    qo.z = pk2(bflo(qw.z) * eb[4] * 0.125f, bfhi(qw.z) * eb[5] * 0.125f); qo.w = pk2(bflo(qw.w) * eb[6] * 0.125f, bfhi(qw.w) * eb[7] * 0.125f);
#pragma unroll
                    for (int j = 0; j < 8; ++j) eb[j] = __builtin_amdgcn_rcpf(eb[j]);
                    ko.x = pk2(bflo(kw.x) * eb[0], bfhi(kw.x) * eb[1]); ko.y = pk2(bflo(kw.y) * eb[2], bfhi(kw.y) * eb[3]);
                    ko.z = pk2(bflo(kw.z) * eb[4], bfhi(kw.z) * eb[5]); ko.w = pk2(bflo(kw.w) * eb[6], bfhi(kw.w) * eb[7]);
                    *(u32x4*)(qq + t * 72 + d0) = qo; *(u32x4*)(kk + t * 72 + d0) = ko;
                }
                LDS_BARRIER();
                {
                    const int tb = wave >> 1;
#pragma unroll
                    for (int i = 0; i < 2; ++i) {
                        const int sb = (wave & 1) * 2 + i;
                        f32x4 a = (f32x4){0.f, 0.f, 0.f, 0.f};
                        if (sb <= tb) {
#pragma unroll
                            for (int ks = 0; ks < 2; ++ks) { const bf16x8 af = *(const bf16x8*)(qq + (tb * 16 + fr) * 72 + ks * 32 + fq * 8), bf = *(const bf16x8*)(kk + (sb * 16 + fr) * 72 + ks * 32 + fq * 8);
                                a = __builtin_amdgcn_mfma_f32_16x16x32_bf16(af, bf, a, 0, 0, 0); }
                            if (sb == tb) {
#pragma unroll
                                for (int r = 0; r < 4; ++r) if (fr > fq * 4 + r) a[r] = 0.f;
                            }
                        }
#pragma unroll
                        for (int r = 0; r < 4; ++r) sc[(tb * 16 + fq * 4 + r) * 72 + sb * 16 + fr] = (bf16_t)f2bf(a[r]);
                    }
                }
                LDS_BARRIER();
                {
                    bf16x8 bV[2];
#pragma unroll
                    for (int ks = 0; ks < 2; ++ks) {
                        float av[8];
#pragma unroll
                        for (int j = 0; j < 8; ++j) av[j] = vv[(ks * 32 + fq * 8 + j) * 129 + wave * 16 + fr];
                        const u32x4 pv = (u32x4){pk2(av[0], av[1]), pk2(av[2], av[3]), pk2(av[4], av[5]), pk2(av[6], av[7])}; bV[ks] = __builtin_bit_cast(bf16x8, pv);
                    }
                    f32x4 oa[4];
#pragma unroll
                    for (int tb = 0; tb < 4; ++tb) {
                        oa[tb] = (f32x4){0.f, 0.f, 0.f, 0.f};
#pragma unroll
                        for (int ks = 0; ks < 2; ++ks) {
                            const bf16x8 aq = *(const bf16x8*)(qq + (tb * 16 + fr) * 72 + ks * 32 + fq * 8), as = *(const bf16x8*)(sc + (tb * 16 + fr) * 72 + ks * 32 + fq * 8);
                            oa[tb] = __builtin_amdgcn_mfma_f32_16x16x32_bf16(aq, bS[ks], oa[tb], 0, 0, 0);
                            oa[tb] = __builtin_amdgcn_mfma_f32_16x16x32_bf16(as, bV[ks], oa[tb], 0, 0, 0);
                        }
                    }
#pragma unroll
                    for (int tb = 0; tb < 4; ++tb)
#pragma unroll
                        for (int r = 0; r < 4; ++r) { const int t = tb * 16 + fq * 4 + r; ot[t * 132 + wave * 16 + fr] = oa[tb][r];
                            const float q2 = row16_sum(oa[tb][r] * oa[tb][r]); if (fr == 0) red[t * 8 + wave] = q2; }
                }
                LDS_BARRIER();
                {
                    const int t = tid >> 3, e0 = (tid & 7) * 16;
                    const f32x4 s0 = *(const f32x4*)(red + t * 8), s1 = *(const f32x4*)(red + t * 8 + 4);
                    const float rs = rsqrtf((((s0[0] + s0[1]) + (s0[2] + s0[3])) + ((s1[0] + s1[1]) + (s1[2] + s1[3]))) * (1.f / 128.f) + EPS);
                    u32x4* mp = (u32x4*)(mix + (r0 + t) * D + h * 128 + e0); const f32x4* op = (const f32x4*)(ot + t * 132 + e0);
#pragma unroll
                    for (int hf = 0; hf < 2; ++hf) { const u32x4 rw = hf ? rw1 : rw0; const f32x4 x0 = op[hf * 2] * rs * ggo[hf * 2], x1 = op[hf * 2 + 1] * rs * ggo[hf * 2 + 1];
                        u32x4 w; w.x = pk2(x0[0] * siluf(bflo(rw.x)), x0[1] * siluf(bfhi(rw.x))); w.y = pk2(x0[2] * siluf(bflo(rw.y)), x0[3] * siluf(bfhi(rw.y)));
                        w.z = pk2(x1[0] * siluf(bflo(rw.z)), x1[1] * siluf(bfhi(rw.z))); w.w = pk2(x1[2] * siluf(bflo(rw.w)), x1[3] * siluf(bfhi(rw.w))); mp[hf] = w; }
                }
                LDS_BARRIER();
            }
        }
#undef GLA_C_LOAD
        STAMP(106);
        SUBREP(20)
        for (int p = bx; p < 256; p += G) {
            const int g = p & 31, fr = lane & 15, fq = lane >> 4;
            bf16_t* Gs = (bf16_t*)lds;
            { u32x4 st_[8];
#pragma unroll
              for (int j = 0; j < 8; ++j) { const int ch = tid + j * NTHREADS; st_[j] = *(const u32x4*)(GTt + (size_t)(g * 128 + (ch >> 5)) * 256 + (ch & 31) * 8); }
#pragma unroll
              for (int j = 0; j < 8; ++j) { const int ch = tid + j * NTHREADS; *(u32x4*)(Gs + (ch >> 5) * 264 + (ch & 31) * 8) = st_[j]; } }
            bf16x4 wA;
#pragma unroll
            for (int i = 0; i < 4; ++i) wA[i] = (short)f2bf(s5_wglu[(g * 16 + fq * 4 + i) * 16 + fr]);
            const f32x4 dsk = *(const f32x4*)(s5_d + g * 16 + fq * 4), bgl = *(const f32x4*)(s5_bglu + g * 16 + fq * 4);
            __syncthreads();
            for (int j = wave; j < 16; j += 8) {
                const int rb = (p >> 5) + 8 * j; const int R0 = rb * 16;
                bf16x8 a[8];
#pragma unroll
                for (int ks = 0; ks < 4; ++ks) a[ks] = *(const bf16x8*)(s5x + ((size_t)(R0 + fr) * 32 + g) * 128 + ks * 32 + fq * 8);
#pragma unroll
                for (int ks = 0; ks < 4; ++ks) a[4 + ks] = *(const bf16x8*)(Pb + ((size_t)(R0 + fr) * 8 + ks * 2 + (fq >> 1)) * NINP + PC_U + g * 16 + (fq & 1) * 8);
                u32x2 uws[8];
#pragma unroll
                for (int nb = 0; nb < 8; ++nb) uws[nb] = *(const u32x2*)(Pb + ((size_t)(R0 + fr) * 8 + nb) * NINP + PC_U + g * 16 + fq * 4);
                __builtin_amdgcn_sched_barrier(0);
                f32x4 acc[8];
#pragma unroll
                for (int nb = 0; nb < 8; ++nb) acc[nb] = (f32x4){0.f, 0.f, 0.f, 0.f};
#pragma unroll
                for (int ks = 0; ks < 8; ++ks)
                {
#pragma unroll
                    for (int nb = 0; nb < 8; ++nb) { const bf16x8 bfr = *(const bf16x8*)(Gs + (nb * 16 + fr) * 264 + ks * 32 + fq * 8);
                        acc[nb] = __builtin_amdgcn_mfma_f32_16x16x32_bf16(bfr, a[ks], acc[nb], 0, 0, 0); }
                    __builtin_amdgcn_sched_barrier(0); }
#pragma unroll
                for (int nb = 0; nb < 8; ++nb) {
                    const size_t row = (size_t)(R0 + fr) * 8 + nb;
                    const u32x2 uw = uws[nb];
                    f32x4 z;
                    z[0] = gelu_tanh(acc[nb][0] + dsk[0] * bflo(uw.x)); z[1] = gelu_tanh(acc[nb][1] + dsk[1] * bfhi(uw.x));
                    z[2] = gelu_tanh(acc[nb][2] + dsk[2] * bflo(uw.y)); z[3] = gelu_tanh(acc[nb][3] + dsk[3] * bfhi(uw.y));
                    const u32x2 zp = (u32x2){pk2(z[0], z[1]), pk2(z[2], z[3])};
                    const f32x4 pre = __builtin_amdgcn_mfma_f32_16x16x16bf16_1k(wA, __builtin_bit_cast(bf16x4, zp), bgl, 0, 0, 0);
                    u32x2 o; o.x = pk2(z[0] * sigmoidf_fast(pre[0]), z[1] * sigmoidf_fast(pre[1])); o.y = pk2(z[2] * sigmoidf_fast(pre[2]), z[3] * sigmoidf_fast(pre[3]));
                    *(u32x2*)(mix + row * D + 512 + g * 16 + fq * 4) = o;
                }
            }
            {
                const int R0 = ((p >> 5) + 128) * 16, nb = wave;
                bf16x8 a[8];
#pragma unroll
                for (int ks = 0; ks < 4; ++ks) a[ks] = *(const bf16x8*)(s5x + ((size_t)(R0 + fr) * 32 + g) * 128 + ks * 32 + fq * 8);
#pragma unroll
                for (int ks = 0; ks < 4; ++ks) a[4 + ks] = *(const bf16x8*)(Pb + ((size_t)(R0 + fr) * 8 + ks * 2 + (fq >> 1)) * NINP + PC_U + g * 16 + (fq & 1) * 8);
                f32x4 acc1 = (f32x4){0.f, 0.f, 0.f, 0.f};
#pragma unroll
                for (int ks = 0; ks < 8; ++ks) { const bf16x8 bfr = *(const bf16x8*)(Gs + (nb * 16 + fr) * 264 + ks * 32 + fq * 8); acc1 = __builtin_amdgcn_mfma_f32_16x16x32_bf16(bfr, a[ks], acc1, 0, 0, 0); }
                const size_t row = (size_t)(R0 + fr) * 8 + nb;
                const u32x2 uw = *(const u32x2*)(Pb + row * NINP + PC_U + g * 16 + fq * 4);
                f32x4 z;
                z[0] = gelu_tanh(acc1[0] + dsk[0] * bflo(uw.x)); z[1] = gelu_tanh(acc1[1] + dsk[1] * bfhi(uw.x));
                z[2] = gelu_tanh(acc1[2] + dsk[2] * bflo(uw.y)); z[3] = gelu_tanh(acc1[3] + dsk[3] * bfhi(uw.y));
                const u32x2 zp = (u32x2){pk2(z[0], z[1]), pk2(z[2], z[3])};
                const f32x4 pre = __builtin_amdgcn_mfma_f32_16x16x16bf16_1k(wA, __builtin_bit_cast(bf16x4, zp), bgl, 0, 0, 0);
                u32x2 o; o.x = pk2(z[0] * sigmoidf_fast(pre[0]), z[1] * sigmoidf_fast(pre[1])); o.y = pk2(z[2] * sigmoidf_fast(pre[2]), z[3] * sigmoidf_fast(pre[3]));
                *(u32x2*)(mix + row * D + 512 + g * 16 + fq * 4) = o;
            }
            __syncthreads();
        }
    }
    STAMP(107);
    SEAM(6);

    PHASE_G(7) {
        pg8::Gemm g{mix, Wout, MP, D, D}; pg8::StaticOrder S; S.init(MP, D, G, bx);
        pg8::EpiResid<false> E{hb, hb, nullptr, ssq + SSQ_H2, 1.f};
        pg8::gemm_phase<pg8::EpiResid<false>, pg8::StaticOrder, PG_ALIGN, PG_SP2>(ldsl, g, S, E);
        SEpiResid<false> SE{hb, hb, nullptr, ssq + SSQ_H2, 1.f};
        small_gemm(mix + (size_t)MP * D, Wout, D, fl, G, bx, wave, tid0, SE);
    }
    SEAM(7);
    PHASE_G(8) {
        pg8::Gemm g{hb, Wcq, MP, D, D}; pg8::StaticOrder S; S.init(MP, D, G, bx, GREP(8));
        pg8::EpiScaleBf16 E{qb, D, ssq + SSQ_H2, 0.0625f};
        pg8::gemm_phase<pg8::EpiScaleBf16, pg8::StaticOrder, PG_ALIGN, PG_SP2>(ldsl, g, S, E);
        SEpiScaleBf16 SE{qb, ssq + SSQ_H2, 0.0625f};
        SUBREP(22)
        small_gemm(hb + (size_t)MP * D, Wcq, D, fl, G, bx, wave, tid0, SE);
    }
    SEAM(8);

    PHASE(9) {
        REP_SYNC();
        PHASE_LOCALS;
        constexpr int QS = 264;
        bf16_t* Qs = (bf16_t*)lds; bf16_t* Ps = Qs + 64 * QS; float* redmax = (float*)(Ps + 64 * QS); float* redsum = redmax + 64 * 8;
        const int fr = lane & 15, fq = lane >> 4, w = wave;
#pragma unroll 1
        for (int pass_ = 0; pass_ < 2; ++pass_) {
        if ((pass_ ^ (bx & 1)) == 0) {
        {
            bf16_t* T = (bf16_t*)lds;
            const int fr = lane & 15, fq = lane >> 4;
            SUBREP(24)
            for (int it0 = bx; it0 < 256; it0 += G) {
                const int item = (G == 256) ? ((it0 & 7) * 32 + (it0 >> 3)) : it0;
                const int bh = item >> 3, b = bh >> 2, h = bh & 3;
                const size_t row0 = (size_t)b * 2048 + (item & 7) * 256 + wave * 32;
                { const bf16_t* kg = kb + (size_t)b * 256 * D + h * 256;
                  int tc = wave * 64 + lane; asm volatile("" : "+v"(tc)); const unsigned cp_g = (unsigned)(((tc >> 5) * D + (tc & 31) * 8) * 2), cp_l = (unsigned)(((tc >> 5) * 264 + (tc & 31) * 8) * 2);
#pragma unroll
                  for (int j8 = 0; j8 < 2; ++j8) {
#pragma unroll
                      for (int jj = 0; jj < 8; ++jj) { const int j = j8 * 8 + jj; const char* kj = (const char*)(kg + (size_t)j * 16 * D); *(u32x4*)((char*)T + cp_l + j * (16 * 264 * 2)) = *(const u32x4*)(kj + cp_g); }
                      __builtin_amdgcn_sched_barrier(0); } }
                __syncthreads();
                u32x4 vpre[8];
                { const bf16_t* vg = vbT + ((size_t)b * D + h * 256) * 256;
                  int tc = wave * 64 + lane; asm volatile("" : "+v"(tc)); const unsigned cp_v = (unsigned)(((tc >> 5) * 256 + (tc & 31) * 8) * 2);
#pragma unroll
                  for (int j = 0; j < 8; ++j) { const char* vj = (const char*)(vg + (size_t)j * 16 * 256); vpre[j] = *(const u32x4*)(vj + cp_v); } }
                u32x2 pk[2][16];
                float mrun[2] = {0.f, 0.f}, lrun[2] = {0.f, 0.f}, alpha0[2] = {1.f, 1.f};
                unsigned qlo = (unsigned)(fr * D + fq * 8); asm volatile("" : "+v"(qlo));
                const bf16_t* qp0 = (qb + row0 * D + h * 256) + qlo; const bf16_t* qp1 = qp0 + 16 * D;
#pragma unroll
                for (int hf = 0; hf < 2; ++hf) {
                    f32x4 sT[2][8];
#pragma unroll
                    for (int c = 0; c < 2; ++c)
#pragma unroll
                        for (int k8 = 0; k8 < 8; ++k8) sT[c][k8] = (f32x4){0.f, 0.f, 0.f, 0.f};
                    bf16x8 qn0 = *(const bf16x8*)qp0, qn1 = *(const bf16x8*)qp1;
                    int lo_k = fr * 264 + fq * 8; asm volatile("" : "+v"(lo_k));
                    const bf16_t* Th = T + hf * (128 * 264) + lo_k;
#pragma unroll
                    for (int ks = 0; ks < 8; ++ks) {
                        const bf16x8 q0 = qn0, q1 = qn1;
                        if (ks < 7) { qn0 = *(const bf16x8*)(qp0 + (ks + 1) * 32); qn1 = *(const bf16x8*)(qp1 + (ks + 1) * 32); }
#pragma unroll
                        for (int k4 = 0; k4 < 2; ++k4) {
#pragma unroll
                            for (int kq = 0; kq < 4; ++kq) { const int k8 = k4 * 4 + kq; const bf16x8 af = *(const bf16x8*)(Th + k8 * (16 * 264) + ks * 32);
                                sT[0][k8] = __builtin_amdgcn_mfma_f32_16x16x32_bf16(af, q0, sT[0][k8], 0, 0, 0);
                                sT[1][k8] = __builtin_amdgcn_mfma_f32_16x16x32_bf16(af, q1, sT[1][k8], 0, 0, 0); }
                            __builtin_amdgcn_sched_barrier(0); }
                    }
#pragma unroll
                    for (int c = 0; c < 2; ++c) {
                        float mx = sT[c][0][0];
#pragma unroll
                        for (int k8 = 0; k8 < 8; ++k8) mx = fmaxf(fmaxf(fmaxf(mx, sT[c][k8][0]), fmaxf(sT[c][k8][1], sT[c][k8][2])), sT[c][k8][3]);
                        mx = fmaxf(mx, __shfl_xor(mx, 16)); mx = fmaxf(mx, __shfl_xor(mx, 32));
                        if (hf == 1) { const float mnew = fmaxf(mrun[c], mx); alpha0[c] = __expf(mrun[c] - mnew); mx = mnew; }
                        float sm = 0.f;
#pragma unroll
                        for (int k8 = 0; k8 < 8; ++k8) { const float p0 = __expf(sT[c][k8][0] - mx), p1 = __expf(sT[c][k8][1] - mx), p2 = __expf(sT[c][k8][2] - mx), p3 = __expf(sT[c][k8][3] - mx);
                            sm += (p0 + p1) + (p2 + p3); pk[c][hf * 8 + k8] = (u32x2){pk2(p0, p1), pk2(p2, p3)}; }
                        sm += __shfl_xor(sm, 16); sm += __shfl_xor(sm, 32);
                        lrun[c] = lrun[c] * alpha0[c] + sm; mrun[c] = mx;
                    }
                }
                __syncthreads();
                { const bf16_t* vg = vbT + ((size_t)b * D + h * 256) * 256;
                  int tc = wave * 64 + lane; asm volatile("" : "+v"(tc)); const unsigned cp_l = (unsigned)(((tc >> 5) * 264 + (tc & 31) * 8) * 2), cp_v = (unsigned)(((tc >> 5) * 256 + (tc & 31) * 8) * 2);
                  u32x4 vlate[8];
#pragma unroll
                  for (int j = 0; j < 8; ++j) { const char* vj = (const char*)(vg + (size_t)(8 + j) * 16 * 256); vlate[j] = *(const u32x4*)(vj + cp_v); }
#pragma unroll
                  for (int j = 0; j < 8; ++j) *(u32x4*)((char*)T + cp_l + j * (16 * 264 * 2)) = vpre[j];
#pragma unroll
                  for (int j = 0; j < 8; ++j) *(u32x4*)((char*)T + cp_l + (8 + j) * (16 * 264 * 2)) = vlate[j]; }
                __syncthreads();
                float* park = fl + (256 * 264 * 2) / 4 + tid;
                park[0] = alpha0[0]; park[512] = alpha0[1]; park[1024] = 1.f / lrun[0]; park[1536] = 1.f / lrun[1];
                unsigned olo = (unsigned)(fr * D + fq * 4); asm volatile("" : "+v"(olo));
                bf16_t* op0 = (ob + row0 * D + h * 256) + olo; bf16_t* op1 = op0 + 16 * D;
#pragma unroll
                for (int dh = 0; dh < 2; ++dh) {
                    f32x4 oT[2][8];
#pragma unroll
                    for (int c = 0; c < 2; ++c)
#pragma unroll
                        for (int d8 = 0; d8 < 8; ++d8) oT[c][d8] = (f32x4){0.f, 0.f, 0.f, 0.f};
                    int lo_v = fr * 264 + fq * 4; asm volatile("" : "+v"(lo_v));
                    const bf16_t* Tv = T + dh * (128 * 264) + lo_v;
#pragma unroll
                    for (int kk = 0; kk < 8; ++kk) {
                        if (kk == 4) {
#pragma unroll
                            for (int d8 = 0; d8 < 8; ++d8) { oT[0][d8] = oT[0][d8] * park[0]; oT[1][d8] = oT[1][d8] * park[512]; }
                        }
                        const u32x4 pw0 = (u32x4){pk[0][2 * kk].x, pk[0][2 * kk].y, pk[0][2 * kk + 1].x, pk[0][2 * kk + 1].y};
                        const u32x4 pw1 = (u32x4){pk[1][2 * kk].x, pk[1][2 * kk].y, pk[1][2 * kk + 1].x, pk[1][2 * kk + 1].y};
                        const bf16x8 pb0 = __builtin_bit_cast(bf16x8, pw0), pb1 = __builtin_bit_cast(bf16x8, pw1);
#pragma unroll
                        for (int d4 = 0; d4 < 2; ++d4) {
#pragma unroll
                            for (int dq = 0; dq < 4; ++dq) { const int d8 = d4 * 4 + dq; const bf16_t* tp = Tv + d8 * (16 * 264) + kk * 32;
                                const u32x2 lo = *(const u32x2*)tp, hi = *(const u32x2*)(tp + 16); const u32x4 av4 = (u32x4){lo.x, lo.y, hi.x, hi.y}; const bf16x8 av = __builtin_bit_cast(bf16x8, av4);
                                oT[0][d8] = __builtin_amdgcn_mfma_f32_16x16x32_bf16(av, pb0, oT[0][d8], 0, 0, 0);
                                oT[1][d8] = __builtin_amdgcn_mfma_f32_16x16x32_bf16(av, pb1, oT[1][d8], 0, 0, 0); }
                            __builtin_amdgcn_sched_barrier(0); }
                    }
                    const float inv0 = park[1024], inv1 = park[1536];
#pragma unroll
                    for (int d8 = 0; d8 < 8; ++d8) {
                        u32x2 w0, w1; w0.x = pk2(oT[0][d8][0] * inv0, oT[0][d8][1] * inv0); w0.y = pk2(oT[0][d8][2] * inv0, oT[0][d8][3] * inv0);
                        w1.x = pk2(oT[1][d8][0] * inv1, oT[1][d8][1] * inv1); w1.y = pk2(oT[1][d8][2] * inv1, oT[1][d8][3] * inv1);
                        *(u32x2*)(op0 + (dh * 8 + d8) * 16) = w0; *(u32x2*)(op1 + (dh * 8 + d8) * 16) = w1; }
                }
                __syncthreads();
            }
        }
        } else {
        STAMP(109);
        {
            bf16_t* Ts = (bf16_t*)lds; bf16_t* Qs16 = Ts + 128 * 264; bf16_t* Ps16 = Qs16 + 16 * 264; float* rmax = (float*)(Ps16 + 16 * 264); float* rsum = rmax + 128;
            int tid_s_ = wave * 64 + (int)__builtin_amdgcn_mbcnt_hi(~0u, __builtin_amdgcn_mbcnt_lo(~0u, 0u)); asm volatile("" : "+v"(tid_s_));
            SUBREP(25)
            for (int unit = 1024 + bx; unit < 1536; unit += G) {
                const int tid = tid_s_, lane = tid & 63, fr = lane & 15, fq = lane >> 4;
                const int u2 = unit - 1024, h = u2 & 3, b = u2 >> 2; const size_t r0 = (size_t)MP + b * 8;
                const float* kg = cache_k + ((size_t)b * 256 + (tid >> 6)) * D + h * 256 + (tid & 63) * 4;
                const float* vg = cache_v + ((size_t)b * 256 + (tid >> 6)) * D + h * 256 + (tid & 63) * 4;
                bf16_t* tdst = Ts + (tid >> 6) * 264 + (tid & 63) * 4;
                f32x4 st[16];
#pragma unroll
                for (int i = 0; i < 16; ++i) st[i] = __builtin_nontemporal_load((const f32x4*)(kg + (size_t)i * 8 * D));
                __builtin_amdgcn_sched_barrier(0);
                { const int row = tid >> 5, c8 = tid & 31; u32x4 v = (u32x4){0u, 0u, 0u, 0u};
                  if (row < 8) v = *(const u32x4*)(qb + (r0 + row) * D + h * 256 + c8 * 8);
                  *(u32x4*)(Qs16 + row * 264 + c8 * 8) = v; }
                f32x4 sa[2];
#pragma unroll
                for (int hv = 0; hv < 2; ++hv) {
                    {
                        const float* nx = hv == 0 ? kg + (size_t)128 * D : vg;
#pragma unroll
                        for (int i = 0; i < 16; ++i) { u32x2 w2; w2.x = pk2(st[i][0], st[i][1]); w2.y = pk2(st[i][2], st[i][3]); *(u32x2*)(tdst + i * 8 * 264) = w2;
                            st[i] = __builtin_nontemporal_load((const f32x4*)(nx + (size_t)i * 8 * D)); }
                    }
                    LDS_BARRIER();
                    f32x4 acc = (f32x4){0.f, 0.f, 0.f, 0.f};
#pragma unroll
                    for (int ks = 0; ks < 8; ++ks) { const bf16x8 af = *(const bf16x8*)(Qs16 + fr * 264 + ks * 32 + fq * 8), bf = *(const bf16x8*)(Ts + (w * 16 + fr) * 264 + ks * 32 + fq * 8);
                        acc = __builtin_amdgcn_mfma_f32_16x16x32_bf16(af, bf, acc, 0, 0, 0); }
                    sa[hv] = acc;
                    LDS_BARRIER();
                }
#pragma unroll
                for (int r = 0; r < 4; ++r) { const float mx = row16_max(fmaxf(sa[0][r], sa[1][r])); if (fr == 0) rmax[(fq * 4 + r) * 8 + w] = mx; }
                LDS_BARRIER();
#pragma unroll
                for (int r = 0; r < 4; ++r) { const int q = fq * 4 + r; const f32x4 m0 = *(const f32x4*)(rmax + q * 8), m1 = *(const f32x4*)(rmax + q * 8 + 4);
                    const float mx = fmaxf(fmaxf(fmaxf(m0[0], m0[1]), fmaxf(m0[2], m0[3])), fmaxf(fmaxf(m1[0], m1[1]), fmaxf(m1[2], m1[3])));
                    const float p0 = __expf(sa[0][r] - mx), p1 = __expf(sa[1][r] - mx);
                    Ps16[q * 264 + w * 16 + fr] = (bf16_t)f2bf(p0); Ps16[q * 264 + 128 + w * 16 + fr] = (bf16_t)f2bf(p1);
                    const float sm = row16_sum(p0 + p1); if (fr == 0) rsum[q * 8 + w] = sm; }
                f32x4 oa0 = (f32x4){0.f, 0.f, 0.f, 0.f}, oa1 = oa0;
#pragma unroll
                for (int hv = 0; hv < 2; ++hv) {
#pragma unroll
                    for (int i = 0; i < 16; ++i) { u32x2 w2; w2.x = pk2(st[i][0], st[i][1]); w2.y = pk2(st[i][2], st[i][3]); *(u32x2*)(tdst + i * 8 * 264) = w2;
                        if (hv == 0) st[i] = __builtin_nontemporal_load((const f32x4*)(vg + (size_t)(128 + i * 8) * D)); }
                    LDS_BARRIER();
                    const unsigned short* gs = (const unsigned short*)Ts + (fq * 8) * 264 + w * 32 + fr;
#pragma unroll
                    for (int ksl = 0; ksl < 4; ++ksl) {
                        const bf16x8 af = *(const bf16x8*)(Ps16 + fr * 264 + (hv * 4 + ksl) * 32 + fq * 8);
                        unsigned e0[8], e1[8];
#pragma unroll
                        for (int j = 0; j < 8; ++j) { e0[j] = gs[(ksl * 32 + j) * 264]; e1[j] = gs[(ksl * 32 + j) * 264 + 16]; }
                        const u32x4 b0 = (u32x4){e0[0] | (e0[1] << 16), e0[2] | (e0[3] << 16), e0[4] | (e0[5] << 16), e0[6] | (e0[7] << 16)};
                        const u32x4 b1 = (u32x4){e1[0] | (e1[1] << 16), e1[2] | (e1[3] << 16), e1[4] | (e1[5] << 16), e1[6] | (e1[7] << 16)};
                        oa0 = __builtin_amdgcn_mfma_f32_16x16x32_bf16(af, __builtin_bit_cast(bf16x8, b0), oa0, 0, 0, 0);
                        oa1 = __builtin_amdgcn_mfma_f32_16x16x32_bf16(af, __builtin_bit_cast(bf16x8, b1), oa1, 0, 0, 0);
                    }
                    LDS_BARRIER();
                    if (hv == 1) {
#pragma unroll
                        for (int r = 0; r < 4; ++r) { const int q = fq * 4 + r; if (q < 8) {
                            const f32x4 s0 = *(const f32x4*)(rsum + q * 8), s1 = *(const f32x4*)(rsum + q * 8 + 4);
                            const float inv = 1.f / (((s0[0] + s0[1]) + (s0[2] + s0[3])) + ((s1[0] + s1[1]) + (s1[2] + s1[3])));
                            bf16_t* op = ob + (r0 + q) * D + h * 256 + w * 32 + fr;
                            op[0] = (bf16_t)f2bf(oa0[r] * inv); op[16] = (bf16_t)f2bf(oa1[r] * inv); } }
                    }
                }
                LDS_BARRIER();
            }
        }
            }
        }
    }
    SEAM(9);

    PHASE_G(10) {
        pg8::Gemm g{ob, Wco, MP, D, D}; pg8::StaticOrder S; S.init(MP, D, G, bx);
        pg8::EpiResid<false> E{hb, hb, nullptr, ssq + SSQ_H3, 1.f};
        pg8::gemm_phase<pg8::EpiResid<false>, pg8::StaticOrder, PG_ALIGN, PG_SP2>(ldsl, g, S, E);
        SEpiResid<false> SE{hb, hb, nullptr, ssq + SSQ_H3, 1.f};
        small_gemm(ob + (size_t)MP * D, Wco, D, fl, G, bx, wave, tid0, SE);
    }
    SEAM(10);
    PHASE_G(11) {
        pg8::Gemm g{hb, Wgu2, M, NGU, D}; pg8::StaticOrder S; S.init(M, NGU, G, bx, GREP(11));
        pg8::EpiSwiGLU E{act, FF, ssq + SSQ_H3};
        pg8::gemm_phase<pg8::EpiSwiGLU, pg8::StaticOrder, PG_ALIGN, PG_SP2>(ldsl, g, S, E);
    }
    SEAM(11);
    PHASE_G(12) {
        pg8::Gemm g{act, Wd2, MP, D, FF}; pg8::StaticOrder S; S.init(MP, D, G, bx, GREP(12));
        pg8::EpiResid<false> E{hb, qb, nullptr, ssq + SSQ_Y, 0.5f};
        pg8::gemm_phase<pg8::EpiResid<false>, pg8::StaticOrder, PG_ALIGN, PG_SP2>(ldsl, g, S, E);
        STAMP(140);
        SEpiResid<false> SE{hb, qb, nullptr, ssq + SSQ_Y, 0.5f};
        SUBREP(21)
        small_gemm(act + (size_t)MP * FF, Wd2, FF, fl, G, bx, wave, tid0, SE);
    }
    SEAM(12);
    PHASE(13) {
        REP_SYNC();
        PHASE_LOCALS;
        for (int ch = gt; ch < M * (D / 8); ch += NGT) {
            const int row = ch >> 7, c8 = (ch & 127) * 8;
            const u32x4 w = __builtin_nontemporal_load((const u32x4*)(qb + (size_t)row * D + c8));
            const float rs = rsqrtf(ssq[SSQ_Y + row] * (1.f / D) + EPS);
            const f32x4 g0 = *(const f32x4*)(g_final + c8), g1 = *(const f32x4*)(g_final + c8 + 4);
            f32x4 o0, o1; o0[0] = bflo(w.x) * rs * g0[0]; o0[1] = bfhi(w.x) * rs * g0[1]; o0[2] = bflo(w.y) * rs * g0[2]; o0[3] = bfhi(w.y) * rs * g0[3];
            o1[0] = bflo(w.z) * rs * g1[0]; o1[1] = bfhi(w.z) * rs * g1[1]; o1[2] = bflo(w.w) * rs * g1[2]; o1[3] = bfhi(w.w) * rs * g1[3];
            f32x4* op = (f32x4*)(out + O_Y + (size_t)row * D + c8); __builtin_nontemporal_store(o0, op); __builtin_nontemporal_store(o1, op + 1);
        }
    }
    if (PROBE_T_LO >= 0) {
        xcd_barrier(xbar); STAMP(14);
        if (bx == 0) {
            if (tid0 == 0) { volatile LAS unsigned long long* tp_ = (volatile LAS unsigned long long*)(ldsl + LDS_BARST + 16); ((volatile float*)lds)[0] = 1.f + (float)(tp_[1] - tp_[0]) * 1e-5f; }
            __syncthreads();
            const float sc_ = ((volatile float*)lds)[0];
            for (int i = tid0; i < 128 * 32 * 64; i += NTHREADS) out[O_RES + i] *= sc_;
        }
    }
    __syncthreads();
    if (tid0 == 0) { const unsigned old_ = xb_add(&g_bar_words[XB_EXIT], 1u); ((volatile LAS unsigned*)(ldsl + LDS_BARST))[8] = (old_ + 1u == (unsigned)G) ? 1u : 0u; }
    __syncthreads();
    if (((volatile LAS unsigned*)(ldsl + LDS_BARST))[8]) { for (int i = tid0; i < XCD_BAR_WORDS + 64; i += NTHREADS) __hip_atomic_store(&g_bar_words[i], 0u, __ATOMIC_RELAXED, __HIP_MEMORY_SCOPE_AGENT); }
#undef IN
#undef SEAM
}

extern "C" void kernel_launch(void* const* d_in, const int* in_sizes, int n_in, void* d_out, int out_size, void* d_ws, size_t ws_size, hipStream_t stream) {
    static int grid = 0;
    if (grid == 0) {
        if (n_in != 36 || (size_t)out_size != O_TOTAL || ws_size < WS_END) { fprintf(stderr, "kernel_launch: unexpected shapes (n_in %d, out %d, ws %zu)\n", n_in, out_size, ws_size); grid = -1; return; }
        int dev = 0, cus = 0, per_cu = 0;
        hipGetDevice(&dev); hipDeviceGetAttribute(&cus, hipDeviceAttributeMultiprocessorCount, dev);
        hipFuncSetAttribute((const void*)hymba_fwd, hipFuncAttributeMaxDynamicSharedMemorySize, LDS_BYTES);
        hipOccupancyMaxActiveBlocksPerMultiprocessor(&per_cu, (const void*)hymba_fwd, NTHREADS, LDS_BYTES);
        if (per_cu < 1) { fprintf(stderr, "kernel_launch: occupancy query says %d blocks per CU\n", per_cu); per_cu = 1; }
        grid = cus;
        (void)hipGetLastError();
    }
    if (grid < 0) return;
    Args a{};
    for (int i = 0; i < 36; ++i) a.in[i] = (const float*)d_in[i];
    a.out = (float*)d_out; a.ws = (unsigned char*)d_ws; a.ph_lo = 0; a.ph_hi = 14;
    void* params[] = {&a};
    hipError_t e = hipLaunchCooperativeKernel((const void*)hymba_fwd, dim3(grid), dim3(NTHREADS), params, LDS_BYTES, stream);
    if (e != hipSuccess) fprintf(stderr, "kernel_launch: cooperative launch failed: %s (grid %d)\n", hipGetErrorString(e), grid);
}
```

```cpp
#include <hip/hip_runtime.h>
#include <hip/hip_cooperative_groups.h>
#include <cstdio>
#include <cstdint>
namespace cg = cooperative_groups;

constexpr int D = 1024, MP = 16384, MS = 1024, M = MP + MS, FF = 2816, NGU = 2 * FF, NIN = 2064, NINP = 2304;
constexpr int MEMR = 2048;
constexpr float EPS = 1e-6f;
constexpr int PC_Q = 0, PC_K = 256, PC_V = 512, PC_R = 1024, PC_U = 1536, PC_ZG = 2048;
constexpr size_t O_Y = 0, O_GLAP = 17825792, O_REP = 18087936, O_IMP = 18104320, O_MKP = 18120704, O_MVP = 20217856,
                 O_GLAS = 22315008, O_RES = 26509312, O_IMS = 26771456, O_TOTAL = 27033600;
constexpr size_t MiB = 1u << 20;
constexpr int XCD_BAR_WORDS_C = 3456;
constexpr size_t WS_SSQ = 0;
constexpr size_t WS_WGU1 = 1 * MiB, WS_WD1 = 12 * MiB, WS_WIN = 18 * MiB, WS_WOUT = 23 * MiB, WS_WCQ = 25 * MiB, WS_WCKV = 27 * MiB,
                 WS_WCO = 31 * MiB, WS_WGU2 = 33 * MiB, WS_WD2 = 44 * MiB, WS_EGT = 50 * MiB, WS_GTT = 51 * MiB, WS_MEMB = 53 * MiB,
                 WS_KB = 57 * MiB, WS_VBT = 61 * MiB, WS_XB = 65 * MiB, WS_HB = 99 * MiB, WS_H = 133 * MiB, WS_ACT = 201 * MiB,
                 WS_MIX = 295 * MiB, WS_Q = 329 * MiB, WS_O = 363 * MiB, WS_GLAD = 397 * MiB, WS_GLADEC = 429 * MiB, WS_S5E = 430 * MiB,
                 WS_S5X = 464 * MiB, WS_GLAB = 481 * MiB, WS_END = 497 * MiB;
constexpr int SSQ_X = 0, SSQ_MEM = M, SSQ_H1 = M + 2048, SSQ_H2 = 2 * M + 2048, SSQ_H3 = 3 * M + 2048, SSQ_Y = 4 * M + 2048, SSQ_WORDS = 5 * M + 2048;
static_assert((size_t)SSQ_WORDS * 4 <= MiB, "ssq region");
static_assert(WS_XB + (size_t)1024 * 8192 * 4 <= WS_HB, "glaS over xb");
static_assert(WS_ACT + (size_t)M * FF * 2 <= WS_MIX && WS_ACT + (size_t)M * NINP * 2 <= WS_MIX, "act / P region");

constexpr size_t WS_BAR = 512 * 1024, BAR_BYTES = 16384;
static_assert((size_t)SSQ_WORDS * 4 <= WS_BAR && XCD_BAR_WORDS_C * 4 <= BAR_BYTES, "ctl map");
constexpr int NWAVES = 8, NTHREADS = 512;
constexpr int LDS_BYTES = 147456;
constexpr int LDS_BARST = LDS_BYTES - 64;

#define LAS __attribute__((address_space(3)))
typedef unsigned short bf16_t;
typedef short bf16x8 __attribute__((ext_vector_type(8)));
typedef short bf16x4 __attribute__((ext_vector_type(4)));
typedef float f32x4 __attribute__((ext_vector_type(4)));
typedef float f32x2 __attribute__((ext_vector_type(2)));
typedef unsigned u32x4 __attribute__((ext_vector_type(4)));
typedef unsigned u32x2 __attribute__((ext_vector_type(2)));
#define DI __device__ __forceinline__

typedef __bf16 bf16x2_t __attribute__((ext_vector_type(2)));
DI unsigned f2bf(float f) { return (unsigned)__builtin_bit_cast(unsigned short, (__bf16)f); }
DI unsigned pk2(float lo, float hi) { const bf16x2_t v = {(__bf16)lo, (__bf16)hi}; return __builtin_bit_cast(unsigned, v); }
DI float bf2f(unsigned b) { return __builtin_bit_cast(float, b << 16); }
DI float bflo(unsigned w) { return __builtin_bit_cast(float, w << 16); }
DI float bfhi(unsigned w) { return __builtin_bit_cast(float, w & 0xffff0000u); }
DI float wave_sum(float v) {
#pragma unroll
    for (int o = 1; o < 64; o <<= 1) v += __shfl_xor(v, o);
    return v;
}
template <int CTRL> DI float dpp_mov(float v) { return __builtin_bit_cast(float, __builtin_amdgcn_update_dpp(0, __builtin_bit_cast(int, v), CTRL, 0xf, 0xf, true)); }
DI float row16_sum(float v) { v += dpp_mov<0xB1>(v); v += dpp_mov<0x4E>(v); v += dpp_mov<0x141>(v); v += dpp_mov<0x140>(v); return v; }
DI float row16_max(float v) { v = fmaxf(v, dpp_mov<0xB1>(v)); v = fmaxf(v, dpp_mov<0x4E>(v)); v = fmaxf(v, dpp_mov<0x141>(v)); v = fmaxf(v, dpp_mov<0x140>(v)); return v; }
DI float sigmoidf_fast(float x) { return __builtin_amdgcn_rcpf(1.f + __expf(-x)); }
DI float siluf(float x) { return x * sigmoidf_fast(x); }
DI float logsigmoidf(float x) { return fminf(x, 0.f) - __logf(1.f + __expf(-fabsf(x))); }
DI float gelu_tanh(float y) { const float t = __builtin_fmaf(0.044715f * y, y, 1.f); const float e = __builtin_amdgcn_exp2f(y * t * 2.3022081983f); const float r = __builtin_amdgcn_rcpf(e + 1.f); return __builtin_fmaf(-y, r, y); }

namespace pg8 {
#define PG8_LAS __attribute__((address_space(3)))
constexpr int BM = 256, BK = 64, HALF = 128, HTB = HALF * BK * 2  , STAGE_BYTES = 8 * HTB, NXCD = 8, WGM = 4;

__host__ __device__ __forceinline__ int lds_byte(int r, int c) { const int st = (r >> 4) * 2 + (c >> 5), rr = r & 15, cc = c & 31, ob = rr * 64 + cc * 2; return st * 1024 + (ob ^ (((ob >> 9) & 1) << 5)); }
__host__ __device__ __forceinline__ void stage_rc(int b, int& R, int& C) { const int st = b / 1024, sb = b % 1024, swz = sb ^ (((sb >> 9) & 1) << 5); R = (st >> 1) * 16 + swz / 64; C = (st & 1) * 32 + (swz % 64) / 2; }
__host__ __device__ __forceinline__ int perm32(int rho) { const int n = rho >> 4, i = rho & 15; return 8 * (i >> 2) + 4 * n + (i & 3); }

struct Unit { int pm, pn; };
struct Gemm { const bf16_t* A; const bf16_t* Bt; int M, N, K; };

struct StaticOrder {
    int nM, nN, nwg, G, c, rep;
    __host__ __device__ void init(int M_, int N_, int G_, int c_, int rep_ = 1) { nM = M_ / BM; nN = N_ / BM; nwg = nM * nN; G = G_; c = c_; rep = rep_; }
    __host__ __device__ bool next(int i, Unit& u) const {
        const long L = (long)i * G + c; if (L >= (long)nwg * rep) return false;
        int wgid = (int)(L % nwg); { const int q = nwg / NXCD, r = nwg % NXCD, xcd = wgid % NXCD, off = wgid / NXCD; wgid = (xcd < r ? xcd * (q + 1) : r * (q + 1) + (xcd - r) * q) + off; }
        const int nig = WGM * nN, gid = wgid / nig, fm = gid * WGM, gsz = (nM - fm) < WGM ? (nM - fm) : WGM;
        u.pm = fm + ((wgid % nig) % gsz); u.pn = (wgid % nig) / gsz; return true;
    }
    __device__ __forceinline__ void a_ready(const Unit&) const {}
    __device__ __forceinline__ void done(const Unit&) const {}
};

__device__ __forceinline__ unsigned cvt_pk_bf16(float lo, float hi) { unsigned r; asm volatile("v_cvt_pk_bf16_f32 %0, %1, %2" : "=v"(r) : "v"(lo), "v"(hi)); return r; }


struct EpiSwiGLU {
    static constexpr bool PERM = true, AFTER_DRAIN = false;
    bf16_t* O; int ldc; const float* ssq;
    __device__ __forceinline__ void operator()(const f32x4 (&acc)[2][2][4][2], const Unit& u, int wr, int wc, int fr, int fq) const {
        const int row0 = u.pm * BM + wr * 64 + fr, col0 = u.pn * HALF + wc * 32 + 8 * fq;
        float sq8[8];
#pragma unroll
        for (int i = 0; i < 8; ++i) sq8[i] = ssq[row0 + (i >> 2) * HALF + (i & 3) * 16];
        __builtin_amdgcn_sched_barrier(0);
#pragma unroll
        for (int ai = 0; ai < 2; ++ai)
#pragma unroll
            for (int m = 0; m < 4; ++m) {
                const int row = row0 + ai * HALF + m * 16;
                const float rs = rsqrtf(sq8[ai * 4 + m] * (1.f / D) + EPS);
                const f32x4 g0 = acc[ai][0][m][0] * rs, g1 = acc[ai][0][m][1] * rs, u0 = acc[ai][1][m][0] * rs, u1 = acc[ai][1][m][1] * rs;
                u32x4 w;
                w.x = cvt_pk_bf16(siluf(g0[0]) * u0[0], siluf(g0[1]) * u0[1]); w.y = cvt_pk_bf16(siluf(g0[2]) * u0[2], siluf(g0[3]) * u0[3]);
                w.z = cvt_pk_bf16(siluf(g1[0]) * u1[0], siluf(g1[1]) * u1[1]); w.w = cvt_pk_bf16(siluf(g1[2]) * u1[2], siluf(g1[3]) * u1[3]);
                *(u32x4*)(O + (size_t)row * ldc + col0) = w;
            }
    }
};
template <bool OUT_F32> struct EpiResid {
    static constexpr bool PERM = true, AFTER_DRAIN = false;
    const bf16_t* base; bf16_t* hbo; float* outf; float* ssq; float alpha;
    __device__ __forceinline__ void operator()(const f32x4 (&acc)[2][2][4][2], const Unit& u, int wr, int wc, int fr, int fq) const {
        const int row0 = u.pm * BM + wr * 64 + fr, col0 = u.pn * BM + wc * 32 + 8 * fq;
#pragma unroll
        for (int ai = 0; ai < 2; ++ai) {
            u32x4 bpre[4][2];
#pragma unroll
            for (int m = 0; m < 4; ++m)
#pragma unroll
                for (int bj = 0; bj < 2; ++bj) bpre[m][bj] = *(const u32x4*)(base + (size_t)(row0 + ai * HALF + m * 16) * D + col0 + bj * HALF);
            __builtin_amdgcn_sched_barrier(0);
#pragma unroll
            for (int m = 0; m < 4; ++m) {
                const int row = row0 + ai * HALF + m * 16;
                float s = 0.f;
#pragma unroll
                for (int bj = 0; bj < 2; ++bj) {
                    const int c = col0 + bj * HALF;
                    const u32x4 bw = bpre[m][bj];
                    f32x4 v0 = acc[ai][bj][m][0] * alpha, v1 = acc[ai][bj][m][1] * alpha;
                    v0[0] += bflo(bw.x); v0[1] += bfhi(bw.x); v0[2] += bflo(bw.y); v0[3] += bfhi(bw.y); v1[0] += bflo(bw.z); v1[1] += bfhi(bw.z); v1[2] += bflo(bw.w); v1[3] += bfhi(bw.w);
                    if constexpr (OUT_F32) { *(f32x4*)(outf + (size_t)row * D + c) = v0; *(f32x4*)(outf + (size_t)row * D + c + 4) = v1; }
                    else {
                        s += ((v0[0] * v0[0] + v0[1] * v0[1]) + (v0[2] * v0[2] + v0[3] * v0[3])) + ((v1[0] * v1[0] + v1[1] * v1[1]) + (v1[2] * v1[2] + v1[3] * v1[3]));
                        u32x4 w; w.x = cvt_pk_bf16(v0[0], v0[1]); w.y = cvt_pk_bf16(v0[2], v0[3]); w.z = cvt_pk_bf16(v1[0], v1[1]); w.w = cvt_pk_bf16(v1[2], v1[3]);
                        *(u32x4*)(hbo + (size_t)row * D + c) = w;
                    }
                }
                if constexpr (!OUT_F32) { s += __shfl_xor(s, 16); s += __shfl_xor(s, 32); if (fq == 0) atomicAdd(ssq + row, s); }
            }
        }
    }
};
struct EpiScaleBf16 {
    static constexpr bool PERM = true, AFTER_DRAIN = false;
    bf16_t* O; int ldc; const float* ssq; float scale;
    __device__ __forceinline__ void operator()(const f32x4 (&acc)[2][2][4][2], const Unit& u, int wr, int wc, int fr, int fq) const {
        const int row0 = u.pm * BM + wr * 64 + fr, col0 = u.pn * BM + wc * 32 + 8 * fq;
        float sq8[8];
#pragma unroll
        for (int i = 0; i < 8; ++i) sq8[i] = ssq[row0 + (i >> 2) * HALF + (i & 3) * 16];
        __builtin_amdgcn_sched_barrier(0);
#pragma unroll
        for (int ai = 0; ai < 2; ++ai)
#pragma unroll
            for (int m = 0; m < 4; ++m) {
                const int row = row0 + ai * HALF + m * 16;
                const float rs = rsqrtf(sq8[ai * 4 + m] * (1.f / D) + EPS) * scale;
#pragma unroll
                for (int bj = 0; bj < 2; ++bj) {
                    const f32x4 v0 = acc[ai][bj][m][0] * rs, v1 = acc[ai][bj][m][1] * rs;
                    u32x4 w; w.x = cvt_pk_bf16(v0[0], v0[1]); w.y = cvt_pk_bf16(v0[2], v0[3]); w.z = cvt_pk_bf16(v1[0], v1[1]); w.w = cvt_pk_bf16(v1[2], v1[3]);
                    *(u32x4*)(O + (size_t)row * ldc + col0 + bj * HALF) = w;
                }
            }
    }
};
struct EpiMemKV {
    static constexpr bool PERM = false, AFTER_DRAIN = false;
    float* outK; float* outV; bf16_t* kb; bf16_t* vbT; const float* ssq;
    __device__ __forceinline__ void operator()(const f32x4 (&acc)[2][2][4][2], const Unit& u, int wr, int wc, int fr, int fq) const {
        const int row0 = u.pm * BM + wr * 64 + fr; const bool isV = u.pn >= 4; const int col0 = (u.pn & 3) * BM + wc * 32 + 4 * fq;
        float* outp = isV ? outV : outK;
        float sq8[8];
#pragma unroll
        for (int i = 0; i < 8; ++i) sq8[i] = ssq[row0 + (i >> 2) * HALF + (i & 3) * 16];
        __builtin_amdgcn_sched_barrier(0);
#pragma unroll
        for (int ai = 0; ai < 2; ++ai)
#pragma unroll
            for (int m = 0; m < 4; ++m) {
                const int row = row0 + ai * HALF + m * 16;
                const float rs = rsqrtf(sq8[ai * 4 + m] * (1.f / D) + EPS);
                const int b = row >> 8, key = row & 255;
#pragma unroll
                for (int bj = 0; bj < 2; ++bj)
#pragma unroll
                    for (int n = 0; n < 2; ++n) {
                        const int c = col0 + bj * HALF + n * 16;
                        const f32x4 v = acc[ai][bj][m][n] * rs;
                        __builtin_nontemporal_store(v, (f32x4*)(outp + (size_t)row * D + c));
                        if (!isV) { u32x2 w; w.x = cvt_pk_bf16(v[0], v[1]); w.y = cvt_pk_bf16(v[2], v[3]); *(u32x2*)(kb + (size_t)row * D + c) = w; }
                        else {
#pragma unroll
                            for (int i = 0; i < 4; ++i) vbT[((size_t)b * D + c + i) * 256 + key] = (bf16_t)f2bf(v[i]);
                        }
                    }
            }
    }
};

template <class Epi, class Sched, bool ALIGN_EPI = false, bool SP2 = false>
__device__ __forceinline__ void gemm_phase(PG8_LAS unsigned char* lds, const Gemm g, const Sched& S, const Epi& E) {
    const int tid = threadIdx.x, wid = __builtin_amdgcn_readfirstlane(tid >> 6), lane = tid & 63, wr = wid >> 2, wc = wid & 3, fr = lane & 15, fq = lane >> 4;
    const int K = g.K, nt = K / BK;
    unsigned voffA[2], voffB[2];
#pragma unroll
    for (int i = 0; i < 2; ++i) { int R, C; stage_rc(tid * 16 + i * 8192, R, C); const int Rb = Epi::PERM ? ((R & ~31) + perm32(R & 31)) : R;
        voffA[i] = (unsigned)(R * K + C) * 2u; voffB[i] = (unsigned)(Rb * K + C) * 2u; }
    const size_t kstep = (size_t)(BK * 2);
    const size_t hstep = (size_t)HALF * K * 2;
    const size_t tstep = 2 * hstep;
    const unsigned ldsw = (unsigned)wid * 1024u;
    const int aoff = lds_byte(wr * 64 + fr, fq * 8), boff = lds_byte(wc * 32 + fr, fq * 8);
#define PG8_SA(b, h) (((b) * 2 + (h)) * HTB)
#define PG8_SB(b, h) ((4 + (b) * 2 + (h)) * HTB)
#define PG8_STAGE(bufoff, gbase, voff) do { _Pragma("unroll") for (int _i = 0; _i < 2; ++_i) \
        __builtin_amdgcn_global_load_lds((const unsigned*)((const char*)(gbase) + (voff)[_i]), (PG8_LAS unsigned*)(lds + (bufoff) + ldsw + _i * 8192), 16, 0, 0); } while (0)
#define PG8_LDA(dst, b, h) do { _Pragma("unroll") for (int m = 0; m < 4; ++m) _Pragma("unroll") for (int k = 0; k < 2; ++k) dst[m][k] = *(const PG8_LAS bf16x8*)(lds + PG8_SA(b, h) + aoff + m * 2048 + k * 1024); } while (0)
#define PG8_LDB(dst, b, h) do { _Pragma("unroll") for (int n = 0; n < 2; ++n) _Pragma("unroll") for (int k = 0; k < 2; ++k) dst[n][k] = *(const PG8_LAS bf16x8*)(lds + PG8_SB(b, h) + boff + n * 2048 + k * 1024); } while (0)
#define PG8_MMA(ai, bj, At, Bt) do { __builtin_amdgcn_s_setprio(1); _Pragma("unroll") for (int m = 0; m < 4; ++m) _Pragma("unroll") for (int n = 0; n < 2; ++n) _Pragma("unroll") for (int k = 0; k < 2; ++k) \
        acc[ai][bj][m][n] = __builtin_amdgcn_mfma_f32_16x16x32_bf16(Bt[n][k], At[m][k], acc[ai][bj][m][n], 0, 0, 0); __builtin_amdgcn_s_setprio(0); } while (0)
#define PG8_WAIT_V(n) asm volatile("s_waitcnt vmcnt(" #n ")" ::: "memory")
#define PG8_WAIT_L(n) asm volatile("s_waitcnt lgkmcnt(" #n ")" ::: "memory")
#define PG8_BAR __builtin_amdgcn_s_barrier()
#define PG8_SCHED __builtin_amdgcn_sched_barrier(0)
    Unit cur, nxt; int ui = 0;
    if (!S.next(0, cur)) return;
    f32x4 acc[2][2][4][2];
#pragma unroll
    for (int a = 0; a < 2; ++a)
#pragma unroll
        for (int b = 0; b < 2; ++b)
#pragma unroll
            for (int m = 0; m < 4; ++m)
#pragma unroll
                for (int n = 0; n < 2; ++n) acc[a][b][m][n] = (f32x4){0.f, 0.f, 0.f, 0.f};
    bf16x8 At[4][2], B0[2][2], B1[2][2];
    const char* cA = (const char*)g.A + (size_t)cur.pm * tstep; const char* cB = (const char*)g.Bt + (size_t)cur.pn * tstep;
    S.a_ready(cur);
    if constexpr (SP2) {
        PG8_STAGE(PG8_SB(0, 0), cB, voffB); PG8_STAGE(PG8_SB(0, 1), cB + hstep, voffB); PG8_STAGE(PG8_SA(0, 0), cA, voffA); PG8_STAGE(PG8_SA(0, 1), cA + hstep, voffA);
        if (wr == 1) PG8_BAR;
        PG8_WAIT_V(2); PG8_BAR;
        PG8_STAGE(PG8_SB(1, 0), cB + kstep, voffB); PG8_STAGE(PG8_SA(1, 0), cA + kstep, voffA); PG8_STAGE(PG8_SB(1, 1), cB + hstep + kstep, voffB);
        PG8_WAIT_V(6); PG8_BAR;
    } else {
        PG8_STAGE(PG8_SB(0, 0), cB, voffB); PG8_STAGE(PG8_SA(0, 0), cA, voffA); PG8_STAGE(PG8_SB(0, 1), cB + hstep, voffB); PG8_STAGE(PG8_SA(0, 1), cA + hstep, voffA);
        if (wr == 1) PG8_BAR;
        PG8_WAIT_V(4); PG8_BAR;
        PG8_STAGE(PG8_SB(1, 0), cB + kstep, voffB); PG8_STAGE(PG8_SA(1, 0), cA + kstep, voffA); PG8_STAGE(PG8_SB(1, 1), cB + hstep + kstep, voffB);
        PG8_WAIT_V(6); PG8_BAR;
    }
    for (;;) {
        const bool has_next = S.next(ui + 1, nxt);
        const char* nA = has_next ? (const char*)g.A + (size_t)nxt.pm * tstep : cA; const char* nB = has_next ? (const char*)g.Bt + (size_t)nxt.pn * tstep : cB;
        for (int t = 0; t < nt; t += 2) {
            const bool last = (t == nt - 2);
            const char* a1 = cA + (size_t)(t + 1) * kstep;
            const char* a2 = last ? nA : cA + (size_t)(t + 2) * kstep; const char* b2 = last ? nB : cB + (size_t)(t + 2) * kstep;
            const char* a3 = a2 + kstep; const char* b3 = b2 + kstep;
            if (last && has_next) S.a_ready(nxt);
            if constexpr (SP2) {
            PG8_LDB(B0, 0, 0); PG8_LDB(B1, 0, 1); PG8_SCHED; PG8_LDA(At, 0, 0); PG8_STAGE(PG8_SA(1, 1), a1 + hstep, voffA);
            PG8_WAIT_V(8); PG8_WAIT_L(0); PG8_BAR; PG8_MMA(0, 0, At, B0); PG8_MMA(0, 1, At, B1); PG8_BAR; PG8_SCHED;
            PG8_LDA(At, 0, 1); PG8_STAGE(PG8_SB(0, 0), b2, voffB); PG8_STAGE(PG8_SB(0, 1), b2 + hstep, voffB); PG8_STAGE(PG8_SA(0, 0), a2, voffA);
            PG8_WAIT_V(8); PG8_WAIT_L(0); PG8_BAR; PG8_MMA(1, 0, At, B0); PG8_MMA(1, 1, At, B1); PG8_BAR; PG8_SCHED;
            PG8_LDB(B0, 1, 0); PG8_LDB(B1, 1, 1); PG8_SCHED; PG8_LDA(At, 1, 0); PG8_STAGE(PG8_SA(0, 1), a2 + hstep, voffA);
            PG8_WAIT_V(8); PG8_WAIT_L(0); PG8_BAR; PG8_MMA(0, 0, At, B0); PG8_MMA(0, 1, At, B1); PG8_BAR; PG8_SCHED;
            PG8_LDA(At, 1, 1); PG8_STAGE(PG8_SB(1, 0), b3, voffB); PG8_STAGE(PG8_SB(1, 1), b3 + hstep, voffB); PG8_STAGE(PG8_SA(1, 0), a3, voffA);
            PG8_WAIT_V(8); PG8_WAIT_L(0); PG8_BAR; PG8_MMA(1, 0, At, B0); PG8_MMA(1, 1, At, B1); PG8_BAR; PG8_SCHED;
            } else {
            PG8_LDB(B0, 0, 0); PG8_SCHED; PG8_LDA(At, 0, 0); PG8_STAGE(PG8_SA(1, 1), a1 + hstep, voffA);
            PG8_WAIT_L(8); PG8_BAR; PG8_WAIT_L(0); PG8_MMA(0, 0, At, B0); PG8_BAR; PG8_SCHED;
            PG8_LDB(B1, 0, 1); PG8_STAGE(PG8_SB(0, 0), b2, voffB);
            PG8_BAR; PG8_WAIT_L(0); PG8_MMA(0, 1, At, B1); PG8_BAR;
            PG8_LDA(At, 0, 1); PG8_STAGE(PG8_SA(0, 0), a2, voffA);
            PG8_BAR; PG8_WAIT_L(0); PG8_MMA(1, 0, At, B0); PG8_BAR; PG8_SCHED;
            PG8_STAGE(PG8_SB(0, 1), b2 + hstep, voffB);
            PG8_WAIT_V(6); PG8_BAR; PG8_MMA(1, 1, At, B1); PG8_BAR;
            PG8_LDB(B0, 1, 0); PG8_SCHED; PG8_LDA(At, 1, 0); PG8_STAGE(PG8_SA(0, 1), a2 + hstep, voffA);
            PG8_WAIT_L(8); PG8_BAR; PG8_WAIT_L(0); PG8_MMA(0, 0, At, B0); PG8_BAR; PG8_SCHED;
            PG8_LDB(B1, 1, 1); PG8_STAGE(PG8_SB(1, 0), b3, voffB);
            PG8_BAR; PG8_WAIT_L(0); PG8_MMA(0, 1, At, B1); PG8_BAR;
            PG8_LDA(At, 1, 1); PG8_STAGE(PG8_SA(1, 0), a3, voffA);
            PG8_BAR; PG8_WAIT_L(0); PG8_MMA(1, 0, At, B0); PG8_BAR; PG8_SCHED;
            PG8_STAGE(PG8_SB(1, 1), b3 + hstep, voffB);
            PG8_WAIT_V(6); PG8_BAR; PG8_MMA(1, 1, At, B1); PG8_BAR;
            }
        }
        if constexpr (ALIGN_EPI) { if (wr == 0) PG8_BAR; }
        if constexpr (!Epi::AFTER_DRAIN) { E(acc, cur, wr, wc, fr, fq); S.done(cur); }
        if (!has_next) break;
#pragma unroll
        for (int a = 0; a < 2; ++a)
#pragma unroll
            for (int b = 0; b < 2; ++b)
#pragma unroll
                for (int m = 0; m < 4; ++m)
#pragma unroll
                    for (int n = 0; n < 2; ++n) acc[a][b][m][n] = (f32x4){0.f, 0.f, 0.f, 0.f};
        cur = nxt; cA = nA; cB = nB; ++ui;
        if constexpr (ALIGN_EPI) { if (wr == 1) PG8_BAR; }
    }
    PG8_WAIT_V(0);
    if constexpr (!ALIGN_EPI) { if (wr == 0) PG8_BAR; }
    PG8_BAR;
#undef PG8_SA
#undef PG8_SB
#undef PG8_STAGE
#undef PG8_LDA
#undef PG8_LDB
#undef PG8_MMA
#undef PG8_WAIT_V
#undef PG8_WAIT_L
#undef PG8_BAR
#undef PG8_SCHED
}
}


#define XB_TMO      128
#define XB_XCNT(j)  (256  + 64 * (j))
#define XB_XSUB(j)  (1280 + 64 * (j))
#define XB_XGEN(j)  (2304 + 64 * (j))
#define XB_TOP      3328
#define XB_TOPGEN   3392
#define XCD_BAR_WORDS 3456
#define XB_SPIN_CAP (1u << 18)
__device__ __forceinline__ unsigned xb_ld(unsigned* p)              { return __hip_atomic_load(p, __ATOMIC_RELAXED, __HIP_MEMORY_SCOPE_AGENT); }
__device__ __forceinline__ unsigned xb_add(unsigned* p, unsigned v) { return __hip_atomic_fetch_add(p, v, __ATOMIC_RELAXED, __HIP_MEMORY_SCOPE_AGENT); }
__device__ __forceinline__ unsigned xb_xcc_id() { return (unsigned)__builtin_amdgcn_s_getreg((3 << 11) | 20) & 0xFu; }
#define XB_SPIN(cond, bar) do { unsigned _sp = 0; while (cond) { __builtin_amdgcn_s_sleep(1); \
    if ((++_sp & 255u) == 0u) { if (xb_ld(&(bar)[XB_TMO])) break; if (_sp > XB_SPIN_CAP) { atomicAdd(&(bar)[XB_TMO], 1u); break; } } } } while (0)
struct XcdBarrier { unsigned* bar; unsigned x; volatile LAS unsigned* st; };
__device__ __forceinline__ XcdBarrier xcd_barrier_post(unsigned* bar, volatile LAS unsigned* st) {
    XcdBarrier b; b.bar = bar; b.x = xb_xcc_id(); b.st = st;
    if (threadIdx.x == 0) (void)xb_add(&bar[XB_XCNT(b.x)], 1u);
    return b;
}
__device__ __forceinline__ void xcd_barrier_complete(unsigned* bar, unsigned x, unsigned& nloc, unsigned& nx) {
    const unsigned G = gridDim.x * gridDim.y * gridDim.z;
    unsigned sum, cnt, mine, sp = 0u;
    for (;;) {
        sum = 0u; cnt = 0u; mine = 0u;
#pragma unroll
        for (unsigned j = 0; j < 16; ++j) { const unsigned c = xb_ld(&bar[XB_XCNT(j)]); sum += c; cnt += (c > 0u) ? 1u : 0u; mine = (j == x) ? c : mine; }
        if (sum == G) break;
        __builtin_amdgcn_s_sleep(1);
        if ((++sp & 255u) == 0u) { if (xb_ld(&bar[XB_TMO])) break; if (sp > XB_SPIN_CAP) { atomicAdd(&bar[XB_TMO], 1u); break; } }
    }
    nloc = mine > 0u ? mine : 1u; nx = cnt > 0u ? cnt : 1u;
}
__device__ __forceinline__ void xcd_barrier(const XcdBarrier& b) {
    asm volatile("s_waitcnt vmcnt(0)" ::: "memory");
    __syncthreads();
    if (threadIdx.x == 0) {
        unsigned* bar = b.bar;
        __builtin_amdgcn_s_waitcnt(0);
        unsigned nloc = b.st[0], nx = b.st[1];
        if (nloc == 0u) { xcd_barrier_complete(bar, b.x, nloc, nx); b.st[0] = nloc; b.st[1] = nx; }
        const unsigned old = xb_add(&bar[XB_XSUB(b.x)], 1u);
        const unsigned gen = old / nloc;
        if (old + 1u == (gen + 1u) * nloc) {
            __builtin_amdgcn_fence(__ATOMIC_RELEASE, "agent");
            asm volatile("s_waitcnt vmcnt(0)" ::: "memory");
            const unsigned og = xb_add(&bar[XB_TOP], 1u);
            const unsigned tg = og / nx;
            if (og + 1u == (tg + 1u) * nx) xb_add(&bar[XB_TOPGEN], 1u);
            else XB_SPIN(xb_ld(&bar[XB_TOPGEN]) == tg, bar);
            __builtin_amdgcn_fence(__ATOMIC_ACQUIRE, "agent");
            xb_add(&bar[XB_XGEN(b.x)], 1u);
            asm volatile("s_waitcnt vmcnt(0)" ::: "memory");
        } else {
            XB_SPIN(xb_ld(&bar[XB_XGEN(b.x)]) == gen, bar);
            __builtin_amdgcn_fence(__ATOMIC_ACQUIRE, "agent");
            asm volatile("s_waitcnt vmcnt(0)" ::: "memory");
        }
    }
    __syncthreads();
}

__device__ unsigned g_bar_words[XCD_BAR_WORDS + 64];
#define XB_EXIT XCD_BAR_WORDS

#ifndef PG_ALIGN
#define PG_ALIGN true
#define PG_SP2 true
#endif
struct Args { const float* in[36]; float* out; unsigned char* ws; int ph_lo, ph_hi; };
#define LDS_WAIT() asm volatile("s_waitcnt lgkmcnt(0)" ::: "memory")
#define LDS_BARRIER() do { asm volatile("s_waitcnt lgkmcnt(0)" ::: "memory"); __builtin_amdgcn_s_barrier(); asm volatile("" ::: "memory"); } while (0)

DI int rowmap(int mode, int n) {
    if (mode == 1) { const int j = n < FF ? n : n - FF; return 256 * (j >> 7) + (n < FF ? 0 : 128) + (j & 127); }
    if (mode == 2) { if (n < 1024) return n; if (n < 1040) return n + 1024; return n - 16; }
    return n;
}
DI void p0_transpose_tile(const float* W, const float* gain, int K, int N, bf16_t* WT, int mode, float* scr, int item, int tid) {
    const int nblk = (N + 255) / 256, kb = item / nblk, nb = item % nblk, k0 = 64 * kb, n0 = 256 * nb;
    f32x4 v[8];
#pragma unroll
    for (int i = 0; i < 8; ++i) { const int c = tid + i * NTHREADS, row = c >> 6, n4 = (c & 63) * 4;
        v[i] = (n0 + n4 < N) ? __builtin_nontemporal_load((const f32x4*)(W + (size_t)(k0 + row) * N + n0 + n4)) : (f32x4){0.f, 0.f, 0.f, 0.f}; }
    __builtin_amdgcn_sched_barrier(0);
#pragma unroll
    for (int i = 0; i < 8; ++i) { const int c = tid + i * NTHREADS, row = c >> 6, n4 = (c & 63) * 4;
        f32x4 x = v[i]; if (gain) x = x * gain[k0 + row];
        *(f32x4*)(scr + row * 260 + (n4 ^ (((row >> 3) & 7) << 2))) = x; }
    __syncthreads();
#pragma unroll
    for (int i = 0; i < 4; ++i) { const int id = tid + i * NTHREADS, n = id >> 3, c = id & 7;
        const float* sp = scr + (8 * c) * 260 + (n ^ (c << 2));
        u32x4 o; o.x = pk2(sp[0 * 260], sp[1 * 260]); o.y = pk2(sp[2 * 260], sp[3 * 260]); o.z = pk2(sp[4 * 260], sp[5 * 260]); o.w = pk2(sp[6 * 260], sp[7 * 260]);
        if (n0 + n < N) *(u32x4*)(WT + (size_t)rowmap(mode, n0 + n) * K + k0 + 8 * c) = o; }
    __syncthreads();
}
DI void row_to_bf16_ssq(const float* xrow, bf16_t* orow, float* ssq_slot, int lane) {
    const f32x4* xr = (const f32x4*)xrow + lane;
    f32x4 v[4]; float s = 0.f;
#pragma unroll
    for (int j = 0; j < 4; ++j) { v[j] = __builtin_nontemporal_load(xr + 64 * j); s += (v[j].x * v[j].x + v[j].y * v[j].y) + (v[j].z * v[j].z + v[j].w * v[j].w); }
    s = wave_sum(s);
    unsigned long long* o8 = (unsigned long long*)orow + lane;
#pragma unroll
    for (int j = 0; j < 4; ++j) o8[64 * j] = (unsigned long long)pk2(v[j].x, v[j].y) | ((unsigned long long)pk2(v[j].z, v[j].w) << 32);
    if (lane == 0) *ssq_slot = s;
}
struct S5P { float dt, lr, li; };
DI S5P s5_par(const float* lre, const float* lim, const float* logdt, int g, int n) { S5P p; p.dt = expf(logdt[g]); p.lr = lre[g * 64 + n]; p.li = lim[g * 64 + n]; return p; }
DI f32x2 s5_pow(const S5P& p, int j) {
    const float mag = expf((float)j * (p.dt * p.lr)); float sn, cs; sincosf((float)j * (p.dt * p.li), &sn, &cs); return (f32x2){mag * cs, mag * sn};
}
DI f32x2 s5_coef(const S5P& p) {
    const f32x2 ab = s5_pow(p, 1); const float den = p.lr * p.lr + p.li * p.li;
    return (f32x2){((ab.x - 1.f) * p.lr + ab.y * p.li) / den, (ab.y * p.lr - (ab.x - 1.f) * p.li) / den};
}
DI f32x2 cmul(f32x2 a, f32x2 b) { return (f32x2){a.x * b.x - a.y * b.y, a.x * b.y + a.y * b.x}; }

template <int NT>
DI void gla_gate_cumsum(const float* zg, float* bb, float* seg, const float* wg, const float* bg, int h, int tid, const float (&wr)[16], float bias) {
    if constexpr (NT == 64) {
        const int d = tid & 63;
#pragma unroll
        for (int k = 0; k < 8; ++k) { const int t = (tid >> 6) + 8 * k; const f32x4* zp = (const f32x4*)(zg + t * 16); float s = bias;
#pragma unroll
            for (int r4 = 0; r4 < 4; ++r4) { const f32x4 z = zp[r4]; s += z[0] * wr[r4 * 4] + z[1] * wr[r4 * 4 + 1] + z[2] * wr[r4 * 4 + 2] + z[3] * wr[r4 * 4 + 3]; }
            bb[t * 65 + d] = logsigmoidf(s) * (1.f / 16.f); }
    } else {
    for (int i = tid; i < NT * 64; i += NTHREADS) { const int t = i >> 6, d = i & 63; float s = bg[h * 64 + d];
#pragma unroll
        for (int r = 0; r < 16; ++r) s += zg[t * 16 + r] * wg[r * 256 + h * 64 + d];
        bb[t * 65 + d] = logsigmoidf(s) * (1.f / 16.f); }
    }
    LDS_BARRIER();
    if constexpr (NT == 64) {
        const int d = tid & 63, sg = tid >> 6; float run = 0.f;
#pragma unroll
        for (int i = 0; i < 8; ++i) { run += bb[(sg * 8 + i) * 65 + d]; bb[(sg * 8 + i) * 65 + d] = run; }
        seg[sg * 64 + d] = run;
        LDS_BARRIER();
        float pre = 0.f;
        for (int j = 0; j < sg; ++j) pre += seg[j * 64 + d];
#pragma unroll
        for (int i = 0; i < 8; ++i) bb[(sg * 8 + i) * 65 + d] += pre;
    } else {
        if (tid < 64) { float run = 0.f;
#pragma unroll
            for (int t = 0; t < NT; ++t) { run += bb[t * 65 + tid]; bb[t * 65 + tid] = run; } }
    }
    LDS_BARRIER();
}


template <bool OUT_F32> struct SEpiResid {
    const bf16_t* base; bf16_t* hbo; float* outf; float* ssq; float alpha;
    typedef u32x4 Pre;
    DI Pre pre(int row, int col) const { return *(const u32x4*)(base + (size_t)row * D + col); }
    DI void operator()(int row, int col, const f32x4& a0, const f32x4& a1, int tid, const Pre& bw) const {
        f32x4 v0 = a0 * alpha, v1 = a1 * alpha;
        v0[0] += bflo(bw.x); v0[1] += bfhi(bw.x); v0[2] += bflo(bw.y); v0[3] += bfhi(bw.y); v1[0] += bflo(bw.z); v1[1] += bfhi(bw.z); v1[2] += bflo(bw.w); v1[3] += bfhi(bw.w);
        if constexpr (OUT_F32) { *(f32x4*)(outf + (size_t)row * D + col) = v0; *(f32x4*)(outf + (size_t)row * D + col + 4) = v1; }
        else {
            u32x4 w; w.x = pk2(v0[0], v0[1]); w.y = pk2(v0[2], v0[3]); w.z = pk2(v1[0], v1[1]); w.w = pk2(v1[2], v1[3]); *(u32x4*)(hbo + (size_t)row * D + col) = w;
            float sq = (v0[0] * v0[0] + v0[1] * v0[1]) + (v0[2] * v0[2] + v0[3] * v0[3]) + (v1[0] * v1[0] + v1[1] * v1[1]) + (v1[2] * v1[2] + v1[3] * v1[3]);
            sq += __shfl_xor(sq, 1); sq += __shfl_xor(sq, 2); sq += __shfl_xor(sq, 4); if ((tid & 7) == 0) atomicAdd(ssq + row, sq);
        }
    }
};
struct SEpiScaleBf16 {
    bf16_t* O; const float* ssq; float scale;
    typedef float Pre;
    DI Pre pre(int row, int) const { return ssq[row]; }
    DI void operator()(int row, int col, const f32x4& a0, const f32x4& a1, int, const Pre& sq) const {
        const float rs = rsqrtf(sq * (1.f / D) + EPS) * scale; const f32x4 v0 = a0 * rs, v1 = a1 * rs;
        u32x4 w; w.x = pk2(v0[0], v0[1]); w.y = pk2(v0[2], v0[3]); w.z = pk2(v1[0], v1[1]); w.w = pk2(v1[2], v1[3]); *(u32x4*)(O + (size_t)row * D + col) = w;
    }
};
template <class F>
DI void small_gemm(const bf16_t* A, const bf16_t* Bt, int K, float* red, int G, int bx, int wave, int tid, const F& epi) {
    const int lane = tid & 63, fr = lane & 15, fq = lane >> 4, kw = K >> 3, nsteps = kw >> 5;
    for (int tile = bx; tile < 256; tile += G) {
        const int row0 = (tile >> 4) * 64, col0 = (tile & 15) * 64;
        f32x4 acc[4][4];
#pragma unroll
        for (int i = 0; i < 4; ++i)
#pragma unroll
            for (int j = 0; j < 4; ++j) acc[i][j] = (f32x4){0.f, 0.f, 0.f, 0.f};
        const bf16_t* ap = A + (size_t)(row0 + fr) * K + wave * kw + fq * 8;
        const bf16_t* bp = Bt + (size_t)(col0 + fr) * K + wave * kw + fq * 8;
        for (int st0 = 0; st0 < nsteps; st0 += 4) {
            bf16x8 a[4][4], b[4][4];
#pragma unroll
            for (int s4 = 0; s4 < 4; ++s4) if (st0 + s4 < nsteps) {
#pragma unroll
                for (int i = 0; i < 4; ++i) { a[s4][i] = *(const bf16x8*)(ap + (size_t)i * 16 * K + (st0 + s4) * 32); b[s4][i] = *(const bf16x8*)(bp + (size_t)i * 16 * K + (st0 + s4) * 32); } }
            __builtin_amdgcn_sched_barrier(0);
#pragma unroll
            for (int s4 = 0; s4 < 4; ++s4) if (st0 + s4 < nsteps) {
#pragma unroll
                for (int i = 0; i < 4; ++i)
#pragma unroll
                    for (int j = 0; j < 4; ++j) acc[i][j] = __builtin_amdgcn_mfma_f32_16x16x32_bf16(b[s4][j], a[s4][i], acc[i][j], 0, 0, 0); }
            __builtin_amdgcn_sched_barrier(0);
        }
        const typename F::Pre epre = epi.pre(MP + row0 + (tid >> 3), col0 + (tid & 7) * 8);
        float* my = red + wave * (64 * 68);
#pragma unroll
        for (int i = 0; i < 4; ++i)
#pragma unroll
            for (int j = 0; j < 4; ++j) *(f32x4*)(my + (i * 16 + fr) * 68 + j * 16 + fq * 4) = acc[i][j];
        LDS_BARRIER();
        { const int row = tid >> 3, c8 = (tid & 7) * 8; f32x4 s0 = (f32x4){0.f, 0.f, 0.f, 0.f}, s1 = s0;
#pragma unroll
            for (int w = 0; w < 8; ++w) { const f32x4* p = (const f32x4*)(red + w * (64 * 68) + row * 68 + c8); s0 += p[0]; s1 += p[1]; }
            epi(MP + row0 + row, col0 + c8, s0, s1, tid, epre); }
        __syncthreads();
    }
}

__global__ void __launch_bounds__(NTHREADS, 2) hymba_fwd(Args args) {
    extern __shared__ __attribute__((aligned(16))) unsigned char lds[];
    cg::grid_group grid = cg::this_grid();
    const int tid0 = threadIdx.x, wave = __builtin_amdgcn_readfirstlane(tid0 >> 6);
    const int G = gridDim.x, bx = blockIdx.x;
    const int gw = bx * NWAVES + wave, NGW = G * NWAVES;
    const int NGT = G * NTHREADS;
#define PHASE_LOCALS int tid_l_ = tid0; asm volatile("" : "+v"(tid_l_)); const int tid = tid_l_, lane = tid & 63, gt = bx * NTHREADS + tid; (void)lane; (void)gt
    unsigned char* ws = args.ws;
    float* out = args.out;
    float* fl = (float*)lds;
    LAS unsigned char* ldsl = (LAS unsigned char*)lds;

    const float* x_prompt = args.in[0]; const float* x_sample = args.in[1]; const float* state_gla = args.in[2];
    const float* st_re = args.in[3]; const float* st_im = args.in[4]; const float* cache_k = args.in[5]; const float* cache_v = args.in[6];
    const float* mem_prompt = args.in[7];
    const float* w_gate = args.in[13]; const float* b_gate = args.in[14]; const float* g_gla_out = args.in[15];
    const float* s5_lre = args.in[16]; const float* s5_lim = args.in[17]; const float* s5_logdt = args.in[18];
    const float* s5_bre = args.in[19]; const float* s5_bim = args.in[20]; const float* s5_cre = args.in[21]; const float* s5_cim = args.in[22];
    const float* s5_d = args.in[23]; const float* s5_wglu = args.in[24]; const float* s5_bglu = args.in[25];
    const float* g_final = args.in[35];

    float* ssq = (float*)(ws + WS_SSQ);
    bf16_t* Wgu1 = (bf16_t*)(ws + WS_WGU1); bf16_t* Wd1 = (bf16_t*)(ws + WS_WD1); bf16_t* Win = (bf16_t*)(ws + WS_WIN); bf16_t* Wout = (bf16_t*)(ws + WS_WOUT);
    bf16_t* Wcq = (bf16_t*)(ws + WS_WCQ); bf16_t* Wckv = (bf16_t*)(ws + WS_WCKV); bf16_t* Wco = (bf16_t*)(ws + WS_WCO); bf16_t* Wgu2 = (bf16_t*)(ws + WS_WGU2); bf16_t* Wd2 = (bf16_t*)(ws + WS_WD2);
    bf16_t* EgT = (bf16_t*)(ws + WS_EGT); bf16_t* GTt = (bf16_t*)(ws + WS_GTT);
    bf16_t* memb = (bf16_t*)(ws + WS_MEMB); bf16_t* kb = (bf16_t*)(ws + WS_KB); bf16_t* vbT = (bf16_t*)(ws + WS_VBT);
    bf16_t* xb = (bf16_t*)(ws + WS_XB); bf16_t* hb = (bf16_t*)(ws + WS_HB); float* hres = (float*)(ws + WS_H);
    bf16_t* act = (bf16_t*)(ws + WS_ACT); bf16_t* Pb = (bf16_t*)(ws + WS_ACT);
    bf16_t* mix = (bf16_t*)(ws + WS_MIX); bf16_t* qb = (bf16_t*)(ws + WS_Q); bf16_t* ob = (bf16_t*)(ws + WS_O);
    bf16_t* glaD = (bf16_t*)(ws + WS_GLAD); float* glaDec = (float*)(ws + WS_GLADEC); bf16_t* glaS = (bf16_t*)(ws + WS_XB);
    float* glaB = (float*)(ws + WS_GLAB);
    bf16_t* s5e = (bf16_t*)(ws + WS_S5E); bf16_t* s5x = (bf16_t*)(ws + WS_S5X);

    const int lo = args.ph_lo, hi = args.ph_hi;
    constexpr int I_GU = 16 * 22, I_D = 44 * 4, I_IN = 16 * 9, I_SQ = 16 * 4, I_CKV = 16 * 8;
    constexpr int N_TL0 = I_GU + I_IN + I_CKV, N_TL1 = I_D, N_TL3 = I_GU + I_D + 3 * I_SQ;
    if (tid0 < 16) ((LAS unsigned*)(ldsl + LDS_BARST))[tid0] = 0u;
    __syncthreads();
    const XcdBarrier xbar = xcd_barrier_post(g_bar_words, (volatile LAS unsigned*)(ldsl + LDS_BARST));
    if (lo < 0) grid.sync();
#ifndef PHASE_MASK
#define PHASE_MASK 0xffffffffu
#endif
#define IN(k) (((PHASE_MASK >> (k)) & 1u) && lo <= (k) && (k) < hi)
#ifndef REPEAT_MASK
#define REPEAT_MASK 0u
#endif
#define PHASE(k) if (IN(k)) for (int rep_ = 0; rep_ < 1 + (int)((REPEAT_MASK >> (k)) & 1u); ++rep_)
#define PHASE_G(k) if (IN(k))
#define GREP(k) (1 + (int)((REPEAT_MASK >> (k)) & 1u))
#define SUBREP(bit) for (int sr_ = 0; sr_ < 1 + (int)((REPEAT_MASK >> (bit)) & 1u); ++sr_)
#define REP_SYNC() do { if (rep_) xcd_barrier(xbar); } while (0)
#ifndef PROBE_T_LO
#define PROBE_T_LO (-1)
#define PROBE_T_HI (-1)
#endif
#define STAMP(k) do { if (PROBE_T_LO >= 0 && ((k) == PROBE_T_LO || (k) == PROBE_T_HI) && bx == 0 && tid0 == 0) { ((volatile LAS unsigned long long*)(ldsl + LDS_BARST + 16))[(k) == PROBE_T_HI ? 1 : 0] = __builtin_amdgcn_s_memrealtime(); } } while (0)
#define SEAM(k) do { if (IN(k) && IN((k) + 1)) xcd_barrier(xbar); STAMP((k) + 1); } while (0)

    STAMP(0);
    PHASE(0) {
        REP_SYNC();
        PHASE_LOCALS;
#define TL_0(r_) do { int r = (r_); if (r < I_GU) { p0_transpose_tile(args.in[9], args.in[8], D, NGU, Wgu1, 1, fl, r, tid); break; } r -= I_GU; \
            if (r < I_IN) { p0_transpose_tile(args.in[12], args.in[11], D, NIN, Win, 2, fl, r, tid); break; } r -= I_IN; \
            p0_transpose_tile(args.in[30], args.in[28], D, 2 * D, Wckv, 0, fl, r, tid); } while (0)
#define TL_1(r_) do { p0_transpose_tile(args.in[10], nullptr, FF, D, Wd1, 0, fl, (r_), tid); } while (0)
#define TL_3(r_) do { int r = (r_); if (r < I_GU) { p0_transpose_tile(args.in[33], args.in[32], D, NGU, Wgu2, 1, fl, r, tid); break; } r -= I_GU; \
            if (r < I_D) { p0_transpose_tile(args.in[34], nullptr, FF, D, Wd2, 0, fl, r, tid); break; } r -= I_D; \
            if (r < I_SQ) { p0_transpose_tile(args.in[26], nullptr, D, D, Wout, 0, fl, r, tid); break; } r -= I_SQ; \
            if (r < I_SQ) { p0_transpose_tile(args.in[29], args.in[27], D, D, Wcq, 0, fl, r, tid); break; } r -= I_SQ; \
            p0_transpose_tile(args.in[31], nullptr, D, D, Wco, 0, fl, r, tid); } while (0)
        for (int it = bx; it < N_TL0; it += G) TL_0(it);
        if (G != 256) { for (int it = bx; it < N_TL1; it += G) TL_1(it); for (int it = bx; it < N_TL3; it += G) TL_3(it); }
        STAMP(120);
        for (int i = gt; i < (NINP - NIN) * D / 8; i += NGT) ((u32x4*)(Win + (size_t)NIN * D))[i] = (u32x4){0u, 0u, 0u, 0u};
        for (int i = gt; i < 4 * M; i += NGT) ssq[SSQ_H1 + i] = 0.f;
        for (int m4 = gw; m4 < M / 4; m4 += NGW) {
            const int m = 4 * m4; const float* xr = m < MP ? x_prompt + (size_t)m * D : x_sample + (size_t)(m - MP) * D;
            const f32x4* xp = (const f32x4*)xr + lane; f32x4 v[16];
#pragma unroll
            for (int j = 0; j < 16; ++j) v[j] = __builtin_nontemporal_load(xp + 64 * j);
            __builtin_amdgcn_sched_barrier(0);
            unsigned long long* o8 = (unsigned long long*)(xb + (size_t)m * D) + lane;
#pragma unroll
            for (int r = 0; r < 4; ++r) { float sq = 0.f;
#pragma unroll
                for (int j = 0; j < 4; ++j) { const f32x4 a = v[r * 4 + j]; sq += (a.x * a.x + a.y * a.y) + (a.z * a.z + a.w * a.w); o8[64 * (r * 4 + j)] = (unsigned long long)pk2(a.x, a.y) | ((unsigned long long)pk2(a.z, a.w) << 32); }
                sq = wave_sum(sq); if (lane == 0) ssq[SSQ_X + m + r] = sq; }
        }
        STAMP(121);
        for (int m = gw; m < MEMR; m += NGW) row_to_bf16_ssq(mem_prompt + (size_t)m * D, memb + (size_t)m * D, ssq + SSQ_MEM + m, lane);
        STAMP(122);
        __syncthreads();
        for (int p = bx; p < 256; p += G) {
            const int g = p & 31, sub = p >> 5;
            f32x2* pw = (f32x2*)fl; f32x2* cf = pw + 64 * 9;
            { const int n = tid >> 3, j = tid & 7; const S5P sp = s5_par(s5_lre, s5_lim, s5_logdt, g, n);
              pw[n * 9 + j] = s5_pow(sp, j); if (j == 7) pw[n * 9 + 8] = s5_pow(sp, 8); if (j == 1) cf[n] = s5_coef(sp); }
            __syncthreads();
            if (tid < 256) {
                const int pp = tid >> 4, part = tid & 15, j = sub;
                float a[16];
#pragma unroll
                for (int i = 0; i < 16; ++i) a[i] = 0.f;
#pragma unroll
                for (int i = 0; i < 4; ++i) { const int n = part * 4 + i;
                    const f32x2 c = (f32x2){s5_cre[(g * 16 + pp) * 64 + n], s5_cim[(g * 16 + pp) * 64 + n]};
                    const f32x2 cc = cmul(cmul(c, pw[n * 9 + j]), cf[n]);
                    const f32x4* br = (const f32x4*)(s5_bre + (g * 64 + n) * 16); const f32x4* bi = (const f32x4*)(s5_bim + (g * 64 + n) * 16);
#pragma unroll
                    for (int q4 = 0; q4 < 4; ++q4) { const f32x4 r4 = br[q4], i4 = bi[q4];
#pragma unroll
                        for (int e = 0; e < 4; ++e) a[q4 * 4 + e] += cc.x * r4[e] - cc.y * i4[e]; } }
#pragma unroll
                for (int i = 0; i < 16; ++i) a[i] = row16_sum(a[i]);
                if (part < 8 - j) { const int t = j + part, sx = part;
                    u32x4* dst = (u32x4*)(GTt + (size_t)(g * 128 + t * 16 + pp) * 256 + 128 + sx * 16);
                    dst[0] = (u32x4){pk2(a[0], a[1]), pk2(a[2], a[3]), pk2(a[4], a[5]), pk2(a[6], a[7])};
                    dst[1] = (u32x4){pk2(a[8], a[9]), pk2(a[10], a[11]), pk2(a[12], a[13]), pk2(a[14], a[15])}; }
            } else if (tid < 320) {
                const int q = sub * 64 + (tid - 256), n = q >> 3, sx = q & 7;
                const f32x2 mm = cmul(pw[n * 9 + 7 - sx], cf[n]);
                unsigned wre[8], wim[8];
#pragma unroll
                for (int pp = 0; pp < 8; ++pp) {
                    const f32x2 b0 = (f32x2){s5_bre[(g * 64 + n) * 16 + 2 * pp], s5_bim[(g * 64 + n) * 16 + 2 * pp]}, b1 = (f32x2){s5_bre[(g * 64 + n) * 16 + 2 * pp + 1], s5_bim[(g * 64 + n) * 16 + 2 * pp + 1]};
                    const f32x2 v0 = cmul(mm, b0), v1 = cmul(mm, b1);
                    wre[pp] = pk2(v0.x, v1.x); wim[pp] = pk2(v0.y, v1.y);
                }
                u32x4* dre = (u32x4*)(EgT + ((size_t)(g * 128 + n) * 128 + sx * 16)); u32x4* dim = (u32x4*)(EgT + ((size_t)(g * 128 + 64 + n) * 128 + sx * 16));
                dre[0] = (u32x4){wre[0], wre[1], wre[2], wre[3]}; dre[1] = (u32x4){wre[4], wre[5], wre[6], wre[7]};
                dim[0] = (u32x4){wim[0], wim[1], wim[2], wim[3]}; dim[1] = (u32x4){wim[4], wim[5], wim[6], wim[7]};
            } else if (tid < 384) {
                const int q = sub * 64 + (tid - 320), t = q >> 6, n = q & 63;
                const f32x2 pwt = pw[n * 9 + t + 1];
#pragma unroll
                for (int pp = 0; pp < 16; ++pp) {
                    const f32x2 c = (f32x2){s5_cre[(g * 16 + pp) * 64 + n], s5_cim[(g * 16 + pp) * 64 + n]};
                    const f32x2 v = cmul(c, pwt);
                    bf16_t* dst = GTt + (size_t)(g * 128 + t * 16 + pp) * 256;
                    dst[n] = (bf16_t)f2bf(v.x); dst[64 + n] = (bf16_t)f2bf(-v.y);
                }
            } else {
                const int pair = (tid - 384) >> 4, pp = (tid - 384) & 15;
                if (sub >= 1 && pair < 8 - sub) { const int t = pair, sx = pair + sub;
                    u32x4* dst = (u32x4*)(GTt + (size_t)(g * 128 + t * 16 + pp) * 256 + 128 + sx * 16);
                    dst[0] = (u32x4){0u, 0u, 0u, 0u}; dst[1] = (u32x4){0u, 0u, 0u, 0u}; }
            }
            __syncthreads();
        }
    }
    SEAM(0);

    for (int i_ = 0; i_ < 20 * (int)((REPEAT_MASK >> 23) & 1u); ++i_) xcd_barrier(xbar);
    PHASE_G(1) {
        pg8::Gemm g{xb, Wgu1, M, NGU, D}; pg8::StaticOrder S; S.init(M, NGU, G, bx, GREP(1));
        pg8::EpiSwiGLU E{act, FF, ssq + SSQ_X};
        pg8::gemm_phase<pg8::EpiSwiGLU, pg8::StaticOrder, PG_ALIGN, PG_SP2>(ldsl, g, S, E);
        if (G == 256 && bx >= 216) { const int tid = tid0; for (int it = bx - 216; it < N_TL1; it += 40) TL_1(it); }
    }
    SEAM(1);
    PHASE_G(2) {
        pg8::Gemm g{act, Wd1, MP, D, FF}; pg8::StaticOrder S; S.init(MP, D, G, bx);
        pg8::EpiResid<false> E{xb, hb, nullptr, ssq + SSQ_H1, 0.5f};
        pg8::gemm_phase<pg8::EpiResid<false>, pg8::StaticOrder, PG_ALIGN, PG_SP2>(ldsl, g, S, E);
        SEpiResid<false> SE{xb, hb, nullptr, ssq + SSQ_H1, 0.5f};
        small_gemm(act + (size_t)MP * FF, Wd1, FF, fl, G, bx, wave, tid0, SE);
    }
    SEAM(2);
    PHASE_G(3) {
        { pg8::Gemm g{hb, Win, M, NINP, D}; pg8::StaticOrder S; S.init(M, NINP, G, bx, GREP(3));
          pg8::EpiScaleBf16 E{Pb, NINP, ssq + SSQ_H1, 1.f};
          pg8::gemm_phase<pg8::EpiScaleBf16, pg8::StaticOrder, PG_ALIGN, PG_SP2>(ldsl, g, S, E); }
        { pg8::Gemm g{memb, Wckv, MEMR, 2 * D, D}; pg8::StaticOrder S; S.init(MEMR, 2 * D, G, (bx + 64) % G);
          pg8::EpiMemKV E{out + O_MKP, out + O_MVP, kb, vbT, ssq + SSQ_MEM};
          pg8::gemm_phase<pg8::EpiMemKV, pg8::StaticOrder, PG_ALIGN, PG_SP2>(ldsl, g, S, E); }
        if (G == 256 && bx >= 100 && bx < 192) { const int tid = tid0; for (int it = bx - 100; it < N_TL3; it += 92) TL_3(it); }
    }
    SEAM(3);

    PHASE(4) {
        REP_SYNC();
        PHASE_LOCALS;
        SUBREP(16)
        {
            float* zg = fl; float* kk = zg + 64 * 16; float* vv = kk + 64 * 65; float* bb = vv + 64 * 129; float* seg = bb + 64 * 65;
            bf16_t* kkb = (bf16_t*)kk; bf16_t* vvb = (bf16_t*)vv;
            const int fr = lane & 15, fq = lane >> 4;
            u32x4 zw = (u32x4){0u, 0u, 0u, 0u}, kn = zw, vw[2] = {zw, zw};
#define GLA_A_LOAD(u_) do { const int bh_ = (u_) >> 5, c_ = (u_) & 31; const size_t rr_ = (size_t)(bh_ >> 2) * 2048 + c_ * 64; const int h_ = bh_ & 3; \
                if (tid < 128) zw = *(const u32x4*)(Pb + (rr_ + (tid >> 1)) * NINP + PC_ZG + (tid & 1) * 8); \
                kn = *(const u32x4*)(Pb + (rr_ + (tid >> 3)) * NINP + PC_K + h_ * 64 + (tid & 7) * 8); \
                _Pragma("unroll") for (int i_ = 0; i_ < 2; ++i_) { const int ch_ = tid + i_ * 512; vw[i_] = *(const u32x4*)(Pb + (rr_ + (ch_ >> 4)) * NINP + PC_V + h_ * 128 + (ch_ & 15) * 8); } } while (0)
            float gwr[16]; float gbias = 0.f; int hcur = -1;
#pragma unroll
            for (int r = 0; r < 16; ++r) gwr[r] = 0.f;
            if (bx < 1024) GLA_A_LOAD(bx);
            for (int unit = bx; unit < 1024; unit += G) {
                const int bh = unit >> 5, c = unit & 31, b = bh >> 2, h = bh & 3;
                const size_t r0 = (size_t)b * 2048 + c * 64; (void)r0; (void)b; (void)c;
                if (tid < 128) { const int t = tid >> 1, hf = tid & 1; const u32x4 w = zw;
                    float* z = zg + t * 16 + hf * 8; z[0] = bflo(w.x); z[1] = bfhi(w.x); z[2] = bflo(w.y); z[3] = bfhi(w.y); z[4] = bflo(w.z); z[5] = bfhi(w.z); z[6] = bflo(w.w); z[7] = bfhi(w.w); }
                const u32x4 kw = kn;
#pragma unroll
                for (int i = 0; i < 2; ++i) { const int ch = tid + i * 512, t = ch >> 4, c8 = ch & 15; *(u32x4*)(vvb + t * 136 + c8 * 8) = vw[i]; }
                if (unit + G < 1024) GLA_A_LOAD(unit + G);
                if (h != hcur) { const int dd = tid & 63; gbias = b_gate[h * 64 + dd];
#pragma unroll
                    for (int r = 0; r < 16; ++r) gwr[r] = w_gate[r * 256 + h * 64 + dd];
                    hcur = h; }
                LDS_BARRIER();
                gla_gate_cumsum<64>(zg, bb, seg, w_gate, b_gate, h, tid, gwr, gbias);
                { const int t = tid >> 3, d0 = (tid & 7) * 8; const float* bt = bb + t * 65 + d0; float* gb = glaB + (size_t)unit * 4096 + t * 64 + d0;
                    *(f32x4*)gb = (f32x4){bt[0], bt[1], bt[2], bt[3]}; *(f32x4*)(gb + 4) = (f32x4){bt[4], bt[5], bt[6], bt[7]}; }
                { const int t = tid >> 3, d0 = (tid & 7) * 8; const float* bl = bb + 63 * 65 + d0; const float* bt = bb + t * 65 + d0; float z[8];
                    z[0] = bflo(kw.x) * __expf(bl[0] - bt[0]); z[1] = bfhi(kw.x) * __expf(bl[1] - bt[1]); z[2] = bflo(kw.y) * __expf(bl[2] - bt[2]); z[3] = bfhi(kw.y) * __expf(bl[3] - bt[3]);
                    z[4] = bflo(kw.z) * __expf(bl[4] - bt[4]); z[5] = bfhi(kw.z) * __expf(bl[5] - bt[5]); z[6] = bflo(kw.w) * __expf(bl[6] - bt[6]); z[7] = bfhi(kw.w) * __expf(bl[7] - bt[7]);
                    *(u32x4*)(kkb + t * 72 + d0) = (u32x4){pk2(z[0], z[1]), pk2(z[2], z[3]), pk2(z[4], z[5]), pk2(z[6], z[7])}; }
                LDS_BARRIER();
                {
                    f32x4 acc[4];
#pragma unroll
                    for (int db = 0; db < 4; ++db) acc[db] = (f32x4){0.f, 0.f, 0.f, 0.f};
                    const unsigned va0 = (unsigned)(size_t)vvb + (unsigned)(((fq * 8 + (fr >> 2)) * 136 + wave * 16 + (fr & 3) * 4) * 2);
                    const unsigned ka0 = (unsigned)(size_t)kkb + (unsigned)(((fq * 8 + (fr >> 2)) * 72 + (fr & 3) * 4) * 2);
#pragma unroll
                    for (int ks = 0; ks < 2; ++ks) {
                        const unsigned va = va0 + (unsigned)(ks * 32 * 136 * 2), ka = ka0 + (unsigned)(ks * 32 * 72 * 2);
                        u32x2 v0, v1, k00, k01, k10, k11, k20, k21, k30, k31;
                        asm volatile("ds_read_b64_tr_b16 %0, %10\n\tds_read_b64_tr_b16 %1, %10 offset:1088\n\t"
                                     "ds_read_b64_tr_b16 %2, %11\n\tds_read_b64_tr_b16 %3, %11 offset:576\n\t"
                                     "ds_read_b64_tr_b16 %4, %11 offset:32\n\tds_read_b64_tr_b16 %5, %11 offset:608\n\t"
                                     "ds_read_b64_tr_b16 %6, %11 offset:64\n\tds_read_b64_tr_b16 %7, %11 offset:640\n\t"
                                     "ds_read_b64_tr_b16 %8, %11 offset:96\n\tds_read_b64_tr_b16 %9, %11 offset:672\n\ts_waitcnt lgkmcnt(0)"
                                     : "=&v"(v0), "=&v"(v1), "=&v"(k00), "=&v"(k01), "=&v"(k10), "=&v"(k11), "=&v"(k20), "=&v"(k21), "=&v"(k30), "=&v"(k31) : "v"(va), "v"(ka) : "memory");
                        const bf16x8 vp = __builtin_bit_cast(bf16x8, ((u32x4){v0.x, v0.y, v1.x, v1.y}));
                        acc[0] = __builtin_amdgcn_mfma_f32_16x16x32_bf16(__builtin_bit_cast(bf16x8, ((u32x4){k00.x, k00.y, k01.x, k01.y})), vp, acc[0], 0, 0, 0);
                        acc[1] = __builtin_amdgcn_mfma_f32_16x16x32_bf16(__builtin_bit_cast(bf16x8, ((u32x4){k10.x, k10.y, k11.x, k11.y})), vp, acc[1], 0, 0, 0);
                        acc[2] = __builtin_amdgcn_mfma_f32_16x16x32_bf16(__builtin_bit_cast(bf16x8, ((u32x4){k20.x, k20.y, k21.x, k21.y})), vp, acc[2], 0, 0, 0);
                        acc[3] = __builtin_amdgcn_mfma_f32_16x16x32_bf16(__builtin_bit_cast(bf16x8, ((u32x4){k30.x, k30.y, k31.x, k31.y})), vp, acc[3], 0, 0, 0);
                    }
                    bf16_t* dp = glaD + (size_t)unit * 8192 + (size_t)(wave * 16 + fr) * 64 + fq * 4;
#pragma unroll
                    for (int db = 0; db < 4; ++db) { u32x2 w2; w2.x = pk2(acc[db][0], acc[db][1]); w2.y = pk2(acc[db][2], acc[db][3]); *(u32x2*)(dp + db * 16) = w2; }
                }
                if (tid < 64) glaDec[unit * 64 + tid] = __expf(bb[63 * 65 + tid]);
                LDS_BARRIER();
            }
        }
#undef GLA_A_LOAD
        STAMP(104);
        SUBREP(17)
        {
            constexpr int SU = 11520;
            for (int unit0 = bx; unit0 < 512; unit0 += 2 * G) {
                const int nu = (unit0 + G < 512) ? 2 : 1;
                f32x4 s0r[2][4]; unsigned rw_pre[2] = {0u, 0u};
                const f32x2 gg_pre = *(const f32x2*)(g_gla_out + lane * 2);
#pragma unroll
                for (int u = 0; u < 2; ++u) {
#pragma unroll
                    for (int i = 0; i < 4; ++i) s0r[u][i] = (f32x4){0.f, 0.f, 0.f, 0.f};
                    if (u < nu) {
                        const int unit = unit0 + u * G, b = unit >> 2, h = unit & 3; const size_t r0 = (size_t)MP + b * 8;
                        float* zg = fl + u * SU; float* qq = zg + 128; float* kk = qq + 520; float* vv = kk + 1040;
                        if (tid < 128) { const int t = tid >> 4, r = tid & 15; zg[t * 16 + r] = bf2f(Pb[(r0 + t) * NINP + PC_ZG + r]); }
                        { const int t = tid >> 6, d = tid & 63; qq[t * 65 + d] = bf2f(Pb[(r0 + t) * NINP + PC_Q + h * 64 + d]); kk[t * 65 + d] = bf2f(Pb[(r0 + t) * NINP + PC_K + h * 64 + d]); }
#pragma unroll
                        for (int i = 0; i < 2; ++i) { const int idx = tid + i * 512, t = idx >> 7, e = idx & 127; vv[t * 128 + e] = bf2f(Pb[(r0 + t) * NINP + PC_V + h * 128 + e]); }
                        { const f32x4* sp = (const f32x4*)(state_gla + (size_t)unit * 8192);
#pragma unroll
                            for (int i = 0; i < 4; ++i) s0r[u][i] = __builtin_nontemporal_load(sp + tid + i * 512); }
                        rw_pre[u] = *(const unsigned*)(Pb + (r0 + wave) * NINP + PC_R + h * 128 + lane * 2);
                    }
                }
                LDS_BARRIER();
#pragma unroll
                for (int u = 0; u < 2; ++u) if (u < nu) {
                    const int h = (unit0 + u * G) & 3; const float* zg = fl + u * SU; float* bb = fl + u * SU + 2712;
                    const int t = tid >> 6, d = tid & 63; float sgt = b_gate[h * 64 + d];
#pragma unroll
                    for (int r = 0; r < 16; ++r) sgt += zg[t * 16 + r] * w_gate[r * 256 + h * 64 + d];
                    bb[t * 65 + d] = logsigmoidf(sgt) * (1.f / 16.f);
                }
                LDS_BARRIER();
                if (tid < 64 * nu) { float* bb = fl + (tid >> 6) * SU + 2712; const int d = tid & 63; float run = 0.f;
#pragma unroll
                    for (int t = 0; t < 8; ++t) { run += bb[t * 65 + d]; bb[t * 65 + d] = run; } }
                LDS_BARRIER();
#pragma unroll
                for (int u = 0; u < 2; ++u) if (u < nu) {
                    float* qq = fl + u * SU + 128; float* kk = qq + 520; float* kt = kk + 520; const float* bb = fl + u * SU + 2712;
                    const int t = tid >> 6, d = tid & 63; const float bt = bb[t * 65 + d], b7 = bb[7 * 65 + d]; const float kv = kk[t * 65 + d];
                    qq[t * 65 + d] *= __expf(bt) * 0.125f; kk[t * 65 + d] = kv * __expf(-bt); kt[t * 65 + d] = kv * __expf(b7 - bt);
                }
                LDS_BARRIER();
                {
                    const int u = tid >> 8, pr = (tid >> 2) & 63, t = pr >> 3, sx = pr & 7, sg4 = tid & 3;
                    const float* qq = fl + u * SU + 128; const float* kk = qq + 520; float* sc = fl + u * SU + 3232;
                    float a = 0.f;
                    if (u < nu && sx <= t) {
#pragma unroll
                        for (int d = 0; d < 16; ++d) a += qq[t * 65 + sg4 * 16 + d] * kk[sx * 65 + sg4 * 16 + d]; }
                    a += __shfl_xor(a, 1); a += __shfl_xor(a, 2);
                    if (u < nu && sg4 == 0) sc[t * 8 + sx] = a;
                }
#pragma unroll
                for (int u = 0; u < 2; ++u) if (u < nu) { f32x4* dp = (f32x4*)(fl + u * SU + 3296);
#pragma unroll
                    for (int i = 0; i < 4; ++i) dp[tid + i * 512] = s0r[u][i]; }
                LDS_BARRIER();
#pragma unroll
                for (int u = 0; u < 2; ++u) if (u < nu) {
                    const int unit = unit0 + u * G, b = unit >> 2, h = unit & 3; const size_t r0 = (size_t)MP + b * 8;
                    const float* qq = fl + u * SU + 128; const float* kt = qq + 1040; const float* vv = qq + 1560; const float* bb = fl + u * SU + 2712; const float* sc = fl + u * SU + 3232; const float* S0 = fl + u * SU + 3296;
                    {
                        const int t = wave, e0 = lane * 2; float o0 = 0.f, o1 = 0.f;
#pragma unroll 1
                        for (int d0 = 0; d0 < 64; d0 += 8) {
                            float qd[8]; f32x2 sv[8];
#pragma unroll
                            for (int j = 0; j < 8; ++j) { qd[j] = qq[t * 65 + d0 + j]; sv[j] = *(const f32x2*)(S0 + (d0 + j) * 128 + e0); }
#pragma unroll
                            for (int j = 0; j < 8; ++j) { o0 += qd[j] * sv[j].x; o1 += qd[j] * sv[j].y; }
                            __builtin_amdgcn_sched_barrier(0);
                        }
                        { float wv[8]; f32x2 vx[8];
#pragma unroll
                          for (int sx = 0; sx < 8; ++sx) { wv[sx] = sx <= t ? sc[t * 8 + sx] : 0.f; vx[sx] = *(const f32x2*)(vv + sx * 128 + e0); }
#pragma unroll
                          for (int sx = 0; sx < 8; ++sx) { o0 += wv[sx] * vx[sx].x; o1 += wv[sx] * vx[sx].y; } }
                        const float ss = wave_sum(o0 * o0 + o1 * o1); const float rs = rsqrtf(ss * (1.f / 128.f) + EPS);
                        const unsigned rw = rw_pre[u];
                        const float y0 = o0 * rs * gg_pre.x * siluf(bflo(rw)), y1 = o1 * rs * gg_pre.y * siluf(bfhi(rw));
                        *(unsigned*)(mix + (r0 + t) * D + h * 128 + e0) = pk2(y0, y1);
                    }
                    {
                        const int e4 = (tid & 31) * 4, dg = (tid >> 5) * 4;
                        f32x4 a[4];
#pragma unroll
                        for (int i = 0; i < 4; ++i) a[i] = *(const f32x4*)(S0 + (dg + i) * 128 + e4) * __expf(bb[7 * 65 + dg + i]);
#pragma unroll
                        for (int sx = 0; sx < 8; ++sx) { const f32x4 vr = *(const f32x4*)(vv + sx * 128 + e4);
#pragma unroll
                            for (int i = 0; i < 4; ++i) a[i] += vr * kt[sx * 65 + dg + i]; }
                        float* dp = out + O_GLAS + (size_t)unit * 8192 + dg * 128 + e4;
#pragma unroll
                        for (int i = 0; i < 4; ++i) __builtin_nontemporal_store(a[i], (f32x4*)(dp + i * 128));
                    }
                }
                LDS_BARRIER();
            }
        }
        STAMP(105);
        SUBREP(18)
        for (int p = bx; p < 256; p += G) {
            const int g = p & 31, fr = lane & 15, fq = lane >> 4;
            bf16_t* Es = (bf16_t*)lds;
            { u32x4 st_[4];
#pragma unroll
              for (int j = 0; j < 4; ++j) { const int ch = tid + j * NTHREADS; st_[j] = *(const u32x4*)(EgT + (size_t)(g * 128 + (ch >> 4)) * 128 + (ch & 15) * 8); }
#pragma unroll
              for (int j = 0; j < 4; ++j) { const int ch = tid + j * NTHREADS; *(u32x4*)(Es + (ch >> 4) * 136 + (ch & 15) * 8) = st_[j]; } }
            __syncthreads();
            for (int j = wave; j < 16; j += 8) {
                const int rb = (p >> 5) + 8 * j; const int R0 = rb * 16;
                bf16x8 a[4];
#pragma unroll
                for (int ks = 0; ks < 4; ++ks) a[ks] = *(const bf16x8*)(Pb + ((size_t)(R0 + fr) * 8 + ks * 2 + (fq >> 1)) * NINP + PC_U + g * 16 + (fq & 1) * 8);
                __builtin_amdgcn_sched_barrier(0);
                f32x4 acc[8];
#pragma unroll
                for (int nb = 0; nb < 8; ++nb) acc[nb] = (f32x4){0.f, 0.f, 0.f, 0.f};
#pragma unroll
                for (int ks = 0; ks < 4; ++ks)
                {
#pragma unroll
                    for (int nb = 0; nb < 8; ++nb) { const bf16x8 bfr = *(const bf16x8*)(Es + (nb * 16 + fr) * 136 + ks * 32 + fq * 8);
                        acc[nb] = __builtin_amdgcn_mfma_f32_16x16x32_bf16(bfr, a[ks], acc[nb], 0, 0, 0); }
                    __builtin_amdgcn_sched_barrier(0); }
#pragma unroll
                for (int nb = 0; nb < 8; ++nb) { u32x2 w2; w2.x = pk2(acc[nb][0], acc[nb][1]); w2.y = pk2(acc[nb][2], acc[nb][3]);
                    *(u32x2*)(s5e + ((size_t)(R0 + fr) * 32 + g) * 128 + nb * 16 + fq * 4) = w2; }
            }
            {
                const int R0 = ((p >> 5) + 128) * 16, nb = wave;
                f32x4 acc1 = (f32x4){0.f, 0.f, 0.f, 0.f};
#pragma unroll
                for (int ks = 0; ks < 4; ++ks) { const bf16x8 av = *(const bf16x8*)(Pb + ((size_t)(R0 + fr) * 8 + ks * 2 + (fq >> 1)) * NINP + PC_U + g * 16 + (fq & 1) * 8);
                    const bf16x8 bfr = *(const bf16x8*)(Es + (nb * 16 + fr) * 136 + ks * 32 + fq * 8); acc1 = __builtin_amdgcn_mfma_f32_16x16x32_bf16(bfr, av, acc1, 0, 0, 0); }
                u32x2 w2; w2.x = pk2(acc1[0], acc1[1]); w2.y = pk2(acc1[2], acc1[3]);
                *(u32x2*)(s5e + ((size_t)(R0 + fr) * 32 + g) * 128 + nb * 16 + fq * 4) = w2;
            }
            __syncthreads();
        }
    }
    STAMP(108);
    SEAM(4);

    PHASE(5) {
        REP_SYNC();
        PHASE_LOCALS;
        const bool s5s_two = (NGT * 2 == 128 * 32 * 64);
        float s5s_xr[2] = {0.f, 0.f}, s5s_xi[2] = {0.f, 0.f}, s5s_ldt[2] = {0.f, 0.f}, s5s_lr[2] = {0.f, 0.f}, s5s_li[2] = {0.f, 0.f}; bf16_t s5s_er[2] = {0, 0}, s5s_ei[2] = {0, 0};
        if (s5s_two) {
#pragma unroll
            for (int k = 0; k < 2; ++k) { const int idx = gt + k * NGT, b = idx >> 11, g = (idx >> 6) & 31, n = idx & 63; const size_t o = ((size_t)(2048 + b) * 32 + g) * 128;
                s5s_xr[k] = st_re[idx]; s5s_xi[k] = st_im[idx]; s5s_ldt[k] = s5_logdt[g]; s5s_lr[k] = s5_lre[g * 64 + n]; s5s_li[k] = s5_lim[g * 64 + n]; s5s_er[k] = s5e[o + n]; s5s_ei[k] = s5e[o + 64 + n]; }
        }
        for (int idx = gt; idx < 32 * 4096; idx += NGT) {
            const int bh = idx >> 12, pe = idx & 4095, d = (pe & 31) * 2, e = pe >> 5;
            unsigned Dv[32]; f32x2 dc[32];
#pragma unroll
            for (int c = 0; c < 32; ++c) { const int unit = bh * 32 + c; Dv[c] = *(const unsigned*)(glaD + (size_t)unit * 8192 + e * 64 + d); dc[c] = *(const f32x2*)(glaDec + unit * 64 + d); }
            __builtin_amdgcn_sched_barrier(0);
            float S0 = 0.f, S1 = 0.f;
#pragma unroll
            for (int c = 0; c < 32; ++c) { *(unsigned*)(glaS + (size_t)(bh * 32 + c) * 8192 + e * 64 + d) = pk2(S0, S1); S0 = dc[c].x * S0 + bflo(Dv[c]); S1 = dc[c].y * S1 + bfhi(Dv[c]); }
            out[O_GLAP + (size_t)bh * 8192 + d * 128 + e] = S0; out[O_GLAP + (size_t)bh * 8192 + (d + 1) * 128 + e] = S1;
        }
        STAMP(115);
        for (int it = bx; it < 256; it += G) {
            const int b = it >> 5, g = it & 31, n = tid & 63, sgm = wave;
            const S5P p = s5_par(s5_lre, s5_lim, s5_logdt, g, n); const f32x2 a8 = s5_pow(p, 8);
            f32x2 a256 = a8;
#pragma unroll
            for (int i = 0; i < 5; ++i) a256 = cmul(a256, a256);
            float er[32], ei[32];
            const size_t o0 = (((size_t)b * 256 + sgm * 32) * 32 + g) * 128;
#pragma unroll
            for (int i = 0; i < 32; ++i) { er[i] = bf2f(s5e[o0 + (size_t)i * 4096 + n]); ei[i] = bf2f(s5e[o0 + (size_t)i * 4096 + 64 + n]); }
            __builtin_amdgcn_sched_barrier(0);
            float yr = 0.f, yi = 0.f;
#pragma unroll
            for (int i = 0; i < 32; ++i) { const float pr = yr, pi = yi; yr = a8.x * pr - a8.y * pi + er[i]; yi = a8.x * pi + a8.y * pr + ei[i]; er[i] = pr; ei[i] = pi; }
            fl[sgm * 64 + n] = yr; fl[512 + sgm * 64 + n] = yi;
            __syncthreads();
            float xr = 0.f, xi = 0.f;
            for (int j = 0; j < sgm; ++j) { const float tr = fl[j * 64 + n], ti = fl[512 + j * 64 + n]; const float nr = a256.x * xr - a256.y * xi + tr, ni = a256.x * xi + a256.y * xr + ti; xr = nr; xi = ni; }
            f32x2 pw = (f32x2){1.f, 0.f};
#pragma unroll
            for (int i = 0; i < 32; ++i) {
                s5x[o0 + (size_t)i * 4096 + n] = (bf16_t)f2bf(er[i] + pw.x * xr - pw.y * xi); s5x[o0 + (size_t)i * 4096 + 64 + n] = (bf16_t)f2bf(ei[i] + pw.x * xi + pw.y * xr);
                pw = cmul(pw, a8);
            }
            if (sgm == 7) { out[O_REP + (b * 32 + g) * 64 + n] = yr + a256.x * xr - a256.y * xi; out[O_IMP + (b * 32 + g) * 64 + n] = yi + a256.x * xi + a256.y * xr; }
            __syncthreads();
        }
        STAMP(116);
        if (s5s_two) {
#pragma unroll
            for (int k = 0; k < 2; ++k) { const int idx = gt + k * NGT, b = idx >> 11, g = (idx >> 6) & 31, n = idx & 63; const size_t o = ((size_t)(2048 + b) * 32 + g) * 128;
                S5P p; p.dt = expf(s5s_ldt[k]); p.lr = s5s_lr[k]; p.li = s5s_li[k]; const f32x2 a8 = s5_pow(p, 8);
                const float xr = s5s_xr[k], xi = s5s_xi[k];
                s5x[o + n] = (bf16_t)f2bf(xr); s5x[o + 64 + n] = (bf16_t)f2bf(xi);
                out[O_RES + idx] = a8.x * xr - a8.y * xi + bf2f(s5s_er[k]); out[O_IMS + idx] = a8.x * xi + a8.y * xr + bf2f(s5s_ei[k]); }
        } else
        for (int idx = gt; idx < 128 * 32 * 64; idx += NGT) {
            const int b = idx >> 11, g = (idx >> 6) & 31, n = idx & 63;
            const S5P p = s5_par(s5_lre, s5_lim, s5_logdt, g, n); const f32x2 a8 = s5_pow(p, 8);
            const float xr = st_re[idx], xi = st_im[idx];
            const size_t R = 2048 + b; const size_t o = (R * 32 + g) * 128;
            s5x[o + n] = (bf16_t)f2bf(xr); s5x[o + 64 + n] = (bf16_t)f2bf(xi);
            out[O_RES + idx] = a8.x * xr - a8.y * xi + bf2f(s5e[o + n]); out[O_IMS + idx] = a8.x * xi + a8.y * xr + bf2f(s5e[o + 64 + n]);
        }
    }
    SEAM(5);

    PHASE(6) {
        REP_SYNC();
        PHASE_LOCALS;
        SUBREP(19)
        {
            float* vv = fl; float* ot = vv + 64 * 129; float* red = ot + 64 * 132;
            bf16_t* qq = (bf16_t*)(red + 512); bf16_t* kk = qq + 64 * 72; bf16_t* sc = kk + 64 * 72;
            const int fr = lane & 15, fq = lane >> 4;
            u32x4 kn = (u32x4){0u, 0u, 0u, 0u}, qn = kn, vw[2] = {kn, kn}, rn[2] = {kn, kn}; f32x4 bn[2] = {(f32x4){0.f, 0.f, 0.f, 0.f}, (f32x4){0.f, 0.f, 0.f, 0.f}};
#define GLA_C_LOAD(u_) do { const int bh_ = (u_) >> 5, c_ = (u_) & 31; const size_t rr_ = (size_t)(bh_ >> 2) * 2048 + c_ * 64; const int h_ = bh_ & 3; \
                kn = *(const u32x4*)(Pb + (rr_ + (tid >> 3)) * NINP + PC_K + h_ * 64 + (tid & 7) * 8); \
                qn = *(const u32x4*)(Pb + (rr_ + (tid >> 3)) * NINP + PC_Q + h_ * 64 + (tid & 7) * 8); \
                bn[0] = *(const f32x4*)(glaB + (size_t)(u_) * 4096 + (tid >> 3) * 64 + (tid & 7) * 8); bn[1] = *(const f32x4*)(glaB + (size_t)(u_) * 4096 + (tid >> 3) * 64 + (tid & 7) * 8 + 4); \
                rn[0] = *(const u32x4*)(Pb + (rr_ + (tid >> 3)) * NINP + PC_R + h_ * 128 + (tid & 7) * 16); rn[1] = *(const u32x4*)(Pb + (rr_ + (tid >> 3)) * NINP + PC_R + h_ * 128 + (tid & 7) * 16 + 8); \
                _Pragma("unroll") for (int i_ = 0; i_ < 2; ++i_) { const int ch_ = tid + i_ * 512; vw[i_] = *(const u32x4*)(Pb + (rr_ + (ch_ >> 4)) * NINP + PC_V + h_ * 128 + (ch_ & 15) * 8); } } while (0)
            f32x4 ggo[4];
#pragma unroll
            for (int i = 0; i < 4; ++i) ggo[i] = *(const f32x4*)(g_gla_out + (tid & 7) * 16 + i * 4);
            if (bx < 1024) GLA_C_LOAD(bx);
            for (int unit = bx; unit < 1024; unit += G) {
                const int bh = unit >> 5, c = unit & 31, b = bh >> 2, h = bh & 3;
                const size_t r0 = (size_t)b * 2048 + c * 64;
                const u32x4 kw = kn, qw = qn, rw0 = rn[0], rw1 = rn[1]; const f32x4 bt0 = bn[0], bt1 = bn[1];
#pragma unroll
                for (int i = 0; i < 2; ++i) { const int ch = tid + i * 512, t = ch >> 4, c8 = ch & 15; const u32x4 w = vw[i];
                    float* z = vv + t * 129 + c8 * 8; z[0] = bflo(w.x); z[1] = bfhi(w.x); z[2] = bflo(w.y); z[3] = bfhi(w.y); z[4] = bflo(w.z); z[5] = bfhi(w.z); z[6] = bflo(w.w); z[7] = bfhi(w.w); }
                bf16x8 bS[2];
                { const bf16_t* sp = glaS + (size_t)unit * 8192 + (size_t)(wave * 16 + fr) * 64 + fq * 8; bS[0] = *(const bf16x8*)sp; bS[1] = *(const bf16x8*)(sp + 32); }
                if (unit + G < 1024) GLA_C_LOAD(unit + G);
                {
                    const int t = tid >> 3, d0 = (tid & 7) * 8;
                    float eb[8];
#pragma unroll
                    for (int j = 0; j < 4; ++j) { eb[j] = __expf(bt0[j]); eb[4 + j] = __expf(bt1[j]); }
                    u32x4 qo, ko;
                    qo.x = pk2(bflo(qw.x) * eb[0] * 0.125f, bfhi(qw.x) * eb[1] * 0.125f); qo.y = pk2(bflo(qw.y) * eb[2] * 0.125f, bfhi(qw.y) * eb[3] * 0.125f);
                    qo.z = pk2(bflo(qw.z) * eb[4] * 0.125f, bfhi(qw.z) * eb[5] * 0.125f); qo.w = pk2(bflo(qw.w) * eb[6] * 0.125f, bfhi(qw.w) * eb[7] * 0.125f);
#pragma unroll
                    for (int j = 0; j < 8; ++j) eb[j] = __builtin_amdgcn_rcpf(eb[j]);
                    ko.x = pk2(bflo(kw.x) * eb[0], bfhi(kw.x) * eb[1]); ko.y = pk2(bflo(kw.y) * eb[2], bfhi(kw.y) * eb[3]);
                    ko.z = pk2(bflo(kw.z) * eb[4], bfhi(kw.z) * eb[5]); ko.w = pk2(bflo(kw.w) * eb[6], bfhi(kw.w) * eb[7]);
                    *(u32x4*)(qq + t * 72 + d0) = qo; *(u32x4*)(kk + t * 72 + d0) = ko;
                }
                LDS_BARRIER();
                {
                    const int tb = wave >> 1;
#pragma unroll
                    for (int i = 0; i < 2; ++i) {
                        const int sb = (wave & 1) * 2 + i;
                        f32x4 a = (f32x4){0.f, 0.f, 0.f, 0.f};
                        if (sb <= tb) {
#pragma unroll
                            for (int ks = 0; ks < 2; ++ks) { const bf16x8 af = *(const bf16x8*)(qq + (tb * 16 + fr) * 72 + ks * 32 + fq * 8), bf = *(const bf16x8*)(kk + (sb * 16 + fr) * 72 + ks * 32 + fq * 8);
                                a = __builtin_amdgcn_mfma_f32_16x16x32_bf16(af, bf, a, 0, 0, 0); }
                            if (sb == tb) {
#pragma unroll
                                for (int r = 0; r < 4; ++r) if (fr > fq * 4 + r) a[r] = 0.f;
                            }
                        }
#pragma unroll
                        for (int r = 0; r < 4; ++r) sc[(tb * 16 + fq * 4 + r) * 72 + sb * 16 + fr] = (bf16_t)f2bf(a[r]);
                    }
                }
                LDS_BARRIER();
                {
                    bf16x8 bV[2];
#pragma unroll
                    for (int ks = 0; ks < 2; ++ks) {
                        float av[8];
#pragma unroll
                        for (int j = 0; j < 8; ++j) av[j] = vv[(ks * 32 + fq * 8 + j) * 129 + wave * 16 + fr];
                        const u32x4 pv = (u32x4){pk2(av[0], av[1]), pk2(av[2], av[3]), pk2(av[4], av[5]), pk2(av[6], av[7])}; bV[ks] = __builtin_bit_cast(bf16x8, pv);
                    }
                    f32x4 oa[4];
#pragma unroll
                    for (int tb = 0; tb < 4; ++tb) {
                        oa[tb] = (f32x4){0.f, 0.f, 0.f, 0.f};
#pragma unroll
                        for (int ks = 0; ks < 2; ++ks) {
                            const bf16x8 aq = *(const bf16x8*)(qq + (tb * 16 + fr) * 72 + ks * 32 + fq * 8), as = *(const bf16x8*)(sc + (tb * 16 + fr) * 72 + ks * 32 + fq * 8);
                            oa[tb] = __builtin_amdgcn_mfma_f32_16x16x32_bf16(aq, bS[ks], oa[tb], 0, 0, 0);
                            oa[tb] = __builtin_amdgcn_mfma_f32_16x16x32_bf16(as, bV[ks], oa[tb], 0, 0, 0);
                        }
                    }
#pragma unroll
                    for (int tb = 0; tb < 4; ++tb)
#pragma unroll
                        for (int r = 0; r < 4; ++r) { const int t = tb * 16 + fq * 4 + r; ot[t * 132 + wave * 16 + fr] = oa[tb][r];
                            const float q2 = row16_sum(oa[tb][r] * oa[tb][r]); if (fr == 0) red[t * 8 + wave] = q2; }
                }
                LDS_BARRIER();
                {
                    const int t = tid >> 3, e0 = (tid & 7) * 16;
                    const f32x4 s0 = *(const f32x4*)(red + t * 8), s1 = *(const f32x4*)(red + t * 8 + 4);
                    const float rs = rsqrtf((((s0[0] + s0[1]) + (s0[2] + s0[3])) + ((s1[0] + s1[1]) + (s1[2] + s1[3]))) * (1.f / 128.f) + EPS);
                    u32x4* mp = (u32x4*)(mix + (r0 + t) * D + h * 128 + e0); const f32x4* op = (const f32x4*)(ot + t * 132 + e0);
#pragma unroll
                    for (int hf = 0; hf < 2; ++hf) { const u32x4 rw = hf ? rw1 : rw0; const f32x4 x0 = op[hf * 2] * rs * ggo[hf * 2], x1 = op[hf * 2 + 1] * rs * ggo[hf * 2 + 1];
                        u32x4 w; w.x = pk2(x0[0] * siluf(bflo(rw.x)), x0[1] * siluf(bfhi(rw.x))); w.y = pk2(x0[2] * siluf(bflo(rw.y)), x0[3] * siluf(bfhi(rw.y)));
                        w.z = pk2(x1[0] * siluf(bflo(rw.z)), x1[1] * siluf(bfhi(rw.z))); w.w = pk2(x1[2] * siluf(bflo(rw.w)), x1[3] * siluf(bfhi(rw.w))); mp[hf] = w; }
                }
                LDS_BARRIER();
            }
        }
#undef GLA_C_LOAD
        STAMP(106);
        SUBREP(20)
        for (int p = bx; p < 256; p += G) {
            const int g = p & 31, fr = lane & 15, fq = lane >> 4;
            bf16_t* Gs = (bf16_t*)lds;
            { u32x4 st_[8];
#pragma unroll
              for (int j = 0; j < 8; ++j) { const int ch = tid + j * NTHREADS; st_[j] = *(const u32x4*)(GTt + (size_t)(g * 128 + (ch >> 5)) * 256 + (ch & 31) * 8); }
#pragma unroll
              for (int j = 0; j < 8; ++j) { const int ch = tid + j * NTHREADS; *(u32x4*)(Gs + (ch >> 5) * 264 + (ch & 31) * 8) = st_[j]; } }
            bf16x4 wA;
#pragma unroll
            for (int i = 0; i < 4; ++i) wA[i] = (short)f2bf(s5_wglu[(g * 16 + fq * 4 + i) * 16 + fr]);
            const f32x4 dsk = *(const f32x4*)(s5_d + g * 16 + fq * 4), bgl = *(const f32x4*)(s5_bglu + g * 16 + fq * 4);
            __syncthreads();
            for (int j = wave; j < 16; j += 8) {
                const int rb = (p >> 5) + 8 * j; const int R0 = rb * 16;
                bf16x8 a[8];
#pragma unroll
                for (int ks = 0; ks < 4; ++ks) a[ks] = *(const bf16x8*)(s5x + ((size_t)(R0 + fr) * 32 + g) * 128 + ks * 32 + fq * 8);
#pragma unroll
                for (int ks = 0; ks < 4; ++ks) a[4 + ks] = *(const bf16x8*)(Pb + ((size_t)(R0 + fr) * 8 + ks * 2 + (fq >> 1)) * NINP + PC_U + g * 16 + (fq & 1) * 8);
                u32x2 uws[8];
#pragma unroll
                for (int nb = 0; nb < 8; ++nb) uws[nb] = *(const u32x2*)(Pb + ((size_t)(R0 + fr) * 8 + nb) * NINP + PC_U + g * 16 + fq * 4);
                __builtin_amdgcn_sched_barrier(0);
                f32x4 acc[8];
#pragma unroll
                for (int nb = 0; nb < 8; ++nb) acc[nb] = (f32x4){0.f, 0.f, 0.f, 0.f};
                bf16x8 bn[8];
#pragma unroll
                for (int nb = 0; nb < 8; ++nb) bn[nb] = *(const bf16x8*)(Gs + (nb * 16 + fr) * 264 + fq * 8);
#pragma unroll
                for (int ks = 0; ks < 8; ++ks)
                {
                    bf16x8 bc[8];
#pragma unroll
                    for (int nb = 0; nb < 8; ++nb) bc[nb] = bn[nb];
                    if (ks < 7) {
#pragma unroll
                        for (int nb = 0; nb < 8; ++nb) bn[nb] = *(const bf16x8*)(Gs + (nb * 16 + fr) * 264 + (ks + 1) * 32 + fq * 8); }
#pragma unroll
                    for (int nb = 0; nb < 8; ++nb) acc[nb] = __builtin_amdgcn_mfma_f32_16x16x32_bf16(bc[nb], a[ks], acc[nb], 0, 0, 0);
                    __builtin_amdgcn_sched_barrier(0); }
#pragma unroll
                for (int nb = 0; nb < 8; ++nb) {
                    const size_t row = (size_t)(R0 + fr) * 8 + nb;
                    const u32x2 uw = uws[nb];
                    f32x4 z;
                    z[0] = gelu_tanh(acc[nb][0] + dsk[0] * bflo(uw.x)); z[1] = gelu_tanh(acc[nb][1] + dsk[1] * bfhi(uw.x));
                    z[2] = gelu_tanh(acc[nb][2] + dsk[2] * bflo(uw.y)); z[3] = gelu_tanh(acc[nb][3] + dsk[3] * bfhi(uw.y));
                    const u32x2 zp = (u32x2){pk2(z[0], z[1]), pk2(z[2], z[3])};
                    const f32x4 pre = __builtin_amdgcn_mfma_f32_16x16x16bf16_1k(wA, __builtin_bit_cast(bf16x4, zp), bgl, 0, 0, 0);
                    u32x2 o; o.x = pk2(z[0] * sigmoidf_fast(pre[0]), z[1] * sigmoidf_fast(pre[1])); o.y = pk2(z[2] * sigmoidf_fast(pre[2]), z[3] * sigmoidf_fast(pre[3]));
                    *(u32x2*)(mix + row * D + 512 + g * 16 + fq * 4) = o;
                }
            }
            {
                const int R0 = ((p >> 5) + 128) * 16, nb = wave;
                bf16x8 a[8];
#pragma unroll
                for (int ks = 0; ks < 4; ++ks) a[ks] = *(const bf16x8*)(s5x + ((size_t)(R0 + fr) * 32 + g) * 128 + ks * 32 + fq * 8);
#pragma unroll
                for (int ks = 0; ks < 4; ++ks) a[4 + ks] = *(const bf16x8*)(Pb + ((size_t)(R0 + fr) * 8 + ks * 2 + (fq >> 1)) * NINP + PC_U + g * 16 + (fq & 1) * 8);
                f32x4 acc1 = (f32x4){0.f, 0.f, 0.f, 0.f};
#pragma unroll
                for (int ks = 0; ks < 8; ++ks) { const bf16x8 bfr = *(const bf16x8*)(Gs + (nb * 16 + fr) * 264 + ks * 32 + fq * 8); acc1 = __builtin_amdgcn_mfma_f32_16x16x32_bf16(bfr, a[ks], acc1, 0, 0, 0); }
                const size_t row = (size_t)(R0 + fr) * 8 + nb;
                const u32x2 uw = *(const u32x2*)(Pb + row * NINP + PC_U + g * 16 + fq * 4);
                f32x4 z;
                z[0] = gelu_tanh(acc1[0] + dsk[0] * bflo(uw.x)); z[1] = gelu_tanh(acc1[1] + dsk[1] * bfhi(uw.x));
                z[2] = gelu_tanh(acc1[2] + dsk[2] * bflo(uw.y)); z[3] = gelu_tanh(acc1[3] + dsk[3] * bfhi(uw.y));
                const u32x2 zp = (u32x2){pk2(z[0], z[1]), pk2(z[2], z[3])};
                const f32x4 pre = __builtin_amdgcn_mfma_f32_16x16x16bf16_1k(wA, __builtin_bit_cast(bf16x4, zp), bgl, 0, 0, 0);
                u32x2 o; o.x = pk2(z[0] * sigmoidf_fast(pre[0]), z[1] * sigmoidf_fast(pre[1])); o.y = pk2(z[2] * sigmoidf_fast(pre[2]), z[3] * sigmoidf_fast(pre[3]));
                *(u32x2*)(mix + row * D + 512 + g * 16 + fq * 4) = o;
            }
            __syncthreads();
        }
    }
    STAMP(107);
    SEAM(6);

    PHASE_G(7) {
        pg8::Gemm g{mix, Wout, MP, D, D}; pg8::StaticOrder S; S.init(MP, D, G, bx);
        pg8::EpiResid<false> E{hb, hb, nullptr, ssq + SSQ_H2, 1.f};
        pg8::gemm_phase<pg8::EpiResid<false>, pg8::StaticOrder, PG_ALIGN, PG_SP2>(ldsl, g, S, E);
        SEpiResid<false> SE{hb, hb, nullptr, ssq + SSQ_H2, 1.f};
        small_gemm(mix + (size_t)MP * D, Wout, D, fl, G, bx, wave, tid0, SE);
    }
    SEAM(7);
    PHASE_G(8) {
        pg8::Gemm g{hb, Wcq, MP, D, D}; pg8::StaticOrder S; S.init(MP, D, G, bx, GREP(8));
        pg8::EpiScaleBf16 E{qb, D, ssq + SSQ_H2, 0.0625f};
        pg8::gemm_phase<pg8::EpiScaleBf16, pg8::StaticOrder, PG_ALIGN, PG_SP2>(ldsl, g, S, E);
        SEpiScaleBf16 SE{qb, ssq + SSQ_H2, 0.0625f};
        SUBREP(22)
        small_gemm(hb + (size_t)MP * D, Wcq, D, fl, G, bx, wave, tid0, SE);
    }
    SEAM(8);

    PHASE(9) {
        REP_SYNC();
        PHASE_LOCALS;
        constexpr int QS = 264;
        bf16_t* Qs = (bf16_t*)lds; bf16_t* Ps = Qs + 64 * QS; float* redmax = (float*)(Ps + 64 * QS); float* redsum = redmax + 64 * 8;
        const int fr = lane & 15, fq = lane >> 4, w = wave;
#pragma unroll 1
        for (int pass_ = 0; pass_ < 2; ++pass_) {
        if ((pass_ ^ (bx & 1)) == 0) {
        {
            bf16_t* T = (bf16_t*)lds;
            const int fr = lane & 15, fq = lane >> 4;
            SUBREP(24)
            for (int it0 = bx; it0 < 256; it0 += G) {
                const int item = (G == 256) ? ((it0 & 7) * 32 + (it0 >> 3)) : it0;
                const int bh = item >> 3, b = bh >> 2, h = bh & 3;
                const size_t row0 = (size_t)b * 2048 + (item & 7) * 256 + wave * 32;
                { const bf16_t* kg = kb + (size_t)b * 256 * D + h * 256;
                  int tc = wave * 64 + lane; asm volatile("" : "+v"(tc)); const unsigned cp_g = (unsigned)(((tc >> 5) * D + (tc & 31) * 8) * 2), cp_l = (unsigned)(((tc >> 5) * 264 + (tc & 31) * 8) * 2);
#pragma unroll
                  for (int j8 = 0; j8 < 2; ++j8) {
#pragma unroll
                      for (int jj = 0; jj < 8; ++jj) { const int j = j8 * 8 + jj; const char* kj = (const char*)(kg + (size_t)j * 16 * D); *(u32x4*)((char*)T + cp_l + j * (16 * 264 * 2)) = *(const u32x4*)(kj + cp_g); }
                      __builtin_amdgcn_sched_barrier(0); } }
                __syncthreads();
                u32x4 vpre[8];
                { const bf16_t* vg = vbT + ((size_t)b * D + h * 256) * 256;
                  int tc = wave * 64 + lane; asm volatile("" : "+v"(tc)); const unsigned cp_v = (unsigned)(((tc >> 5) * 256 + (tc & 31) * 8) * 2);
#pragma unroll
                  for (int j = 0; j < 8; ++j) { const char* vj = (const char*)(vg + (size_t)j * 16 * 256); vpre[j] = *(const u32x4*)(vj + cp_v); } }
                u32x2 pk[2][16];
                float mrun[2] = {0.f, 0.f}, lrun[2] = {0.f, 0.f}, alpha0[2] = {1.f, 1.f};
                unsigned qlo = (unsigned)(fr * D + fq * 8); asm volatile("" : "+v"(qlo));
                const bf16_t* qp0 = (qb + row0 * D + h * 256) + qlo; const bf16_t* qp1 = qp0 + 16 * D;
#pragma unroll
                for (int hf = 0; hf < 2; ++hf) {
                    f32x4 sT[2][8];
#pragma unroll
                    for (int c = 0; c < 2; ++c)
#pragma unroll
                        for (int k8 = 0; k8 < 8; ++k8) sT[c][k8] = (f32x4){0.f, 0.f, 0.f, 0.f};
                    bf16x8 qn0 = *(const bf16x8*)qp0, qn1 = *(const bf16x8*)qp1;
                    int lo_k = fr * 264 + fq * 8; asm volatile("" : "+v"(lo_k));
                    const bf16_t* Th = T + hf * (128 * 264) + lo_k;
                    bf16x8 afn[4];
#pragma unroll
                    for (int kq = 0; kq < 4; ++kq) afn[kq] = *(const bf16x8*)(Th + kq * (16 * 264));
#pragma unroll
                    for (int ks = 0; ks < 8; ++ks) {
                        const bf16x8 q0 = qn0, q1 = qn1;
                        if (ks < 7) { qn0 = *(const bf16x8*)(qp0 + (ks + 1) * 32); qn1 = *(const bf16x8*)(qp1 + (ks + 1) * 32); }
#pragma unroll
                        for (int k4 = 0; k4 < 2; ++k4) {
                            bf16x8 af[4];
#pragma unroll
                            for (int kq = 0; kq < 4; ++kq) af[kq] = afn[kq];
                            if (!(ks == 7 && k4 == 1)) { const int nks = k4 ? ks + 1 : ks, nk4 = k4 ^ 1;
#pragma unroll
                                for (int kq = 0; kq < 4; ++kq) afn[kq] = *(const bf16x8*)(Th + (nk4 * 4 + kq) * (16 * 264) + nks * 32); }
#pragma unroll
                            for (int kq = 0; kq < 4; ++kq) { const int k8 = k4 * 4 + kq;
                                sT[0][k8] = __builtin_amdgcn_mfma_f32_16x16x32_bf16(af[kq], q0, sT[0][k8], 0, 0, 0);
                                sT[1][k8] = __builtin_amdgcn_mfma_f32_16x16x32_bf16(af[kq], q1, sT[1][k8], 0, 0, 0); }
                            __builtin_amdgcn_sched_barrier(0); }
                    }
#pragma unroll
                    for (int c = 0; c < 2; ++c) {
                        float mx = sT[c][0][0];
#pragma unroll
                        for (int k8 = 0; k8 < 8; ++k8) mx = fmaxf(fmaxf(fmaxf(mx, sT[c][k8][0]), fmaxf(sT[c][k8][1], sT[c][k8][2])), sT[c][k8][3]);
                        mx = fmaxf(mx, __shfl_xor(mx, 16)); mx = fmaxf(mx, __shfl_xor(mx, 32));
                        if (hf == 1) { const float mnew = fmaxf(mrun[c], mx); alpha0[c] = __expf(mrun[c] - mnew); mx = mnew; }
                        float sm = 0.f;
#pragma unroll
                        for (int k8 = 0; k8 < 8; ++k8) { const float p0 = __expf(sT[c][k8][0] - mx), p1 = __expf(sT[c][k8][1] - mx), p2 = __expf(sT[c][k8][2] - mx), p3 = __expf(sT[c][k8][3] - mx);
                            sm += (p0 + p1) + (p2 + p3); pk[c][hf * 8 + k8] = (u32x2){pk2(p0, p1), pk2(p2, p3)}; }
                        sm += __shfl_xor(sm, 16); sm += __shfl_xor(sm, 32);
                        lrun[c] = lrun[c] * alpha0[c] + sm; mrun[c] = mx;
                    }
                }
                __syncthreads();
                { const bf16_t* vg = vbT + ((size_t)b * D + h * 256) * 256;
                  int tc = wave * 64 + lane; asm volatile("" : "+v"(tc)); const unsigned cp_l = (unsigned)(((tc >> 5) * 264 + (tc & 31) * 8) * 2), cp_v = (unsigned)(((tc >> 5) * 256 + (tc & 31) * 8) * 2);
                  u32x4 vlate[8];
#pragma unroll
                  for (int j = 0; j < 8; ++j) { const char* vj = (const char*)(vg + (size_t)(8 + j) * 16 * 256); vlate[j] = *(const u32x4*)(vj + cp_v); }
#pragma unroll
                  for (int j = 0; j < 8; ++j) *(u32x4*)((char*)T + cp_l + j * (16 * 264 * 2)) = vpre[j];
#pragma unroll
                  for (int j = 0; j < 8; ++j) *(u32x4*)((char*)T + cp_l + (8 + j) * (16 * 264 * 2)) = vlate[j]; }
                __syncthreads();
                float* park = fl + (256 * 264 * 2) / 4 + tid;
                park[0] = alpha0[0]; park[512] = alpha0[1]; park[1024] = 1.f / lrun[0]; park[1536] = 1.f / lrun[1];
                unsigned olo = (unsigned)(fr * D + fq * 4); asm volatile("" : "+v"(olo));
                bf16_t* op0 = (ob + row0 * D + h * 256) + olo; bf16_t* op1 = op0 + 16 * D;
#pragma unroll
                for (int dh = 0; dh < 2; ++dh) {
                    f32x4 oT[2][8];
#pragma unroll
                    for (int c = 0; c < 2; ++c)
#pragma unroll
                        for (int d8 = 0; d8 < 8; ++d8) oT[c][d8] = (f32x4){0.f, 0.f, 0.f, 0.f};
                    int lo_v = fr * 264 + fq * 4; asm volatile("" : "+v"(lo_v));
                    const bf16_t* Tv = T + dh * (128 * 264) + lo_v;
                    u32x2 vln[4], vhn[4];
#pragma unroll
                    for (int dq = 0; dq < 4; ++dq) { const bf16_t* tp = Tv + dq * (16 * 264); vln[dq] = *(const u32x2*)tp; vhn[dq] = *(const u32x2*)(tp + 16); }
#pragma unroll
                    for (int kk = 0; kk < 8; ++kk) {
                        if (kk == 4) {
#pragma unroll
                            for (int d8 = 0; d8 < 8; ++d8) { oT[0][d8] = oT[0][d8] * park[0]; oT[1][d8] = oT[1][d8] * park[512]; }
                        }
                        const u32x4 pw0 = (u32x4){pk[0][2 * kk].x, pk[0][2 * kk].y, pk[0][2 * kk + 1].x, pk[0][2 * kk + 1].y};
                        const u32x4 pw1 = (u32x4){pk[1][2 * kk].x, pk[1][2 * kk].y, pk[1][2 * kk + 1].x, pk[1][2 * kk + 1].y};
                        const bf16x8 pb0 = __builtin_bit_cast(bf16x8, pw0), pb1 = __builtin_bit_cast(bf16x8, pw1);
#pragma unroll
                        for (int d4 = 0; d4 < 2; ++d4) {
                            bf16x8 av[4];
#pragma unroll
                            for (int dq = 0; dq < 4; ++dq) { const u32x4 av4 = (u32x4){vln[dq].x, vln[dq].y, vhn[dq].x, vhn[dq].y}; av[dq] = __builtin_bit_cast(bf16x8, av4); }
                            if (!(kk == 7 && d4 == 1)) { const int nkk = d4 ? kk + 1 : kk, nd4 = d4 ^ 1;
#pragma unroll
                                for (int dq = 0; dq < 4; ++dq) { const bf16_t* tp = Tv + (nd4 * 4 + dq) * (16 * 264) + nkk * 32; vln[dq] = *(const u32x2*)tp; vhn[dq] = *(const u32x2*)(tp + 16); } }
#pragma unroll
                            for (int dq = 0; dq < 4; ++dq) { const int d8 = d4 * 4 + dq;
                                oT[0][d8] = __builtin_amdgcn_mfma_f32_16x16x32_bf16(av[dq], pb0, oT[0][d8], 0, 0, 0);
                                oT[1][d8] = __builtin_amdgcn_mfma_f32_16x16x32_bf16(av[dq], pb1, oT[1][d8], 0, 0, 0); }
                            __builtin_amdgcn_sched_barrier(0); }
                    }
                    const float inv0 = park[1024], inv1 = park[1536];
#pragma unroll
                    for (int d8 = 0; d8 < 8; ++d8) {
                        u32x2 w0, w1; w0.x = pk2(oT[0][d8][0] * inv0, oT[0][d8][1] * inv0); w0.y = pk2(oT[0][d8][2] * inv0, oT[0][d8][3] * inv0);
                        w1.x = pk2(oT[1][d8][0] * inv1, oT[1][d8][1] * inv1); w1.y = pk2(oT[1][d8][2] * inv1, oT[1][d8][3] * inv1);
                        *(u32x2*)(op0 + (dh * 8 + d8) * 16) = w0; *(u32x2*)(op1 + (dh * 8 + d8) * 16) = w1; }
                }
                __syncthreads();
            }
        }
        } else {
        STAMP(109);
        {
            bf16_t* Ts = (bf16_t*)lds; bf16_t* Qs16 = Ts + 128 * 264; bf16_t* Ps16 = Qs16 + 16 * 264; float* rmax = (float*)(Ps16 + 16 * 264); float* rsum = rmax + 128;
            int tid_s_ = wave * 64 + (int)__builtin_amdgcn_mbcnt_hi(~0u, __builtin_amdgcn_mbcnt_lo(~0u, 0u)); asm volatile("" : "+v"(tid_s_));
            SUBREP(25)
            for (int unit = 1024 + bx; unit < 1536; unit += G) {
                const int tid = tid_s_, lane = tid & 63, fr = lane & 15, fq = lane >> 4;
                const int u2 = unit - 1024, h = u2 & 3, b = u2 >> 2; const size_t r0 = (size_t)MP + b * 8;
                const float* kg = cache_k + ((size_t)b * 256 + (tid >> 6)) * D + h * 256 + (tid & 63) * 4;
                const float* vg = cache_v + ((size_t)b * 256 + (tid >> 6)) * D + h * 256 + (tid & 63) * 4;
                bf16_t* tdst = Ts + (tid >> 6) * 264 + (tid & 63) * 4;
                f32x4 st[16];
#pragma unroll
                for (int i = 0; i < 16; ++i) st[i] = __builtin_nontemporal_load((const f32x4*)(kg + (size_t)i * 8 * D));
                __builtin_amdgcn_sched_barrier(0);
                { const int row = tid >> 5, c8 = tid & 31; u32x4 v = (u32x4){0u, 0u, 0u, 0u};
                  if (row < 8) v = *(const u32x4*)(qb + (r0 + row) * D + h * 256 + c8 * 8);
                  *(u32x4*)(Qs16 + row * 264 + c8 * 8) = v; }
                f32x4 sa[2];
#pragma unroll
                for (int hv = 0; hv < 2; ++hv) {
                    {
                        const float* nx = hv == 0 ? kg + (size_t)128 * D : vg;
#pragma unroll
                        for (int i = 0; i < 16; ++i) { u32x2 w2; w2.x = pk2(st[i][0], st[i][1]); w2.y = pk2(st[i][2], st[i][3]); *(u32x2*)(tdst + i * 8 * 264) = w2;
                            st[i] = __builtin_nontemporal_load((const f32x4*)(nx + (size_t)i * 8 * D)); }
                    }
                    LDS_BARRIER();
                    f32x4 acc = (f32x4){0.f, 0.f, 0.f, 0.f};
#pragma unroll
                    for (int ks = 0; ks < 8; ++ks) { const bf16x8 af = *(const bf16x8*)(Qs16 + fr * 264 + ks * 32 + fq * 8), bf = *(const bf16x8*)(Ts + (w * 16 + fr) * 264 + ks * 32 + fq * 8);
                        acc = __builtin_amdgcn_mfma_f32_16x16x32_bf16(af, bf, acc, 0, 0, 0); }
                    sa[hv] = acc;
                    LDS_BARRIER();
                }
#pragma unroll
                for (int r = 0; r < 4; ++r) { const float mx = row16_max(fmaxf(sa[0][r], sa[1][r])); if (fr == 0) rmax[(fq * 4 + r) * 8 + w] = mx; }
                LDS_BARRIER();
#pragma unroll
                for (int r = 0; r < 4; ++r) { const int q = fq * 4 + r; const f32x4 m0 = *(const f32x4*)(rmax + q * 8), m1 = *(const f32x4*)(rmax + q * 8 + 4);
                    const float mx = fmaxf(fmaxf(fmaxf(m0[0], m0[1]), fmaxf(m0[2], m0[3])), fmaxf(fmaxf(m1[0], m1[1]), fmaxf(m1[2], m1[3])));
                    const float p0 = __expf(sa[0][r] - mx), p1 = __expf(sa[1][r] - mx);
                    Ps16[q * 264 + w * 16 + fr] = (bf16_t)f2bf(p0); Ps16[q * 264 + 128 + w * 16 + fr] = (bf16_t)f2bf(p1);
                    const float sm = row16_sum(p0 + p1); if (fr == 0) rsum[q * 8 + w] = sm; }
                f32x4 oa0 = (f32x4){0.f, 0.f, 0.f, 0.f}, oa1 = oa0;
#pragma unroll
                for (int hv = 0; hv < 2; ++hv) {
#pragma unroll
                    for (int i = 0; i < 16; ++i) { u32x2 w2; w2.x = pk2(st[i][0], st[i][1]); w2.y = pk2(st[i][2], st[i][3]); *(u32x2*)(tdst + i * 8 * 264) = w2;
                        if (hv == 0) st[i] = __builtin_nontemporal_load((const f32x4*)(vg + (size_t)(128 + i * 8) * D)); }
                    LDS_BARRIER();
                    const unsigned gsa = (unsigned)(size_t)Ts + (unsigned)(((fq * 8 + (fr >> 2)) * 264 + w * 32 + (fr & 3) * 4) * 2);
                    u32x2 tv[16];
                    asm volatile("ds_read_b64_tr_b16 %0, %16\n\t"
                                 "ds_read_b64_tr_b16 %1, %16 offset:2112\n\t"
                                 "ds_read_b64_tr_b16 %2, %16 offset:32\n\t"
                                 "ds_read_b64_tr_b16 %3, %16 offset:2144\n\t"
                                 "ds_read_b64_tr_b16 %4, %16 offset:16896\n\t"
                                 "ds_read_b64_tr_b16 %5, %16 offset:19008\n\t"
                                 "ds_read_b64_tr_b16 %6, %16 offset:16928\n\t"
                                 "ds_read_b64_tr_b16 %7, %16 offset:19040\n\t"
                                 "ds_read_b64_tr_b16 %8, %16 offset:33792\n\t"
                                 "ds_read_b64_tr_b16 %9, %16 offset:35904\n\t"
                                 "ds_read_b64_tr_b16 %10, %16 offset:33824\n\t"
                                 "ds_read_b64_tr_b16 %11, %16 offset:35936\n\t"
                                 "ds_read_b64_tr_b16 %12, %16 offset:50688\n\t"
                                 "ds_read_b64_tr_b16 %13, %16 offset:52800\n\t"
                                 "ds_read_b64_tr_b16 %14, %16 offset:50720\n\t"
                                 "ds_read_b64_tr_b16 %15, %16 offset:52832\n\t"
                                 "s_waitcnt lgkmcnt(0)"
                                 : "=&v"(tv[0]), "=&v"(tv[1]), "=&v"(tv[2]), "=&v"(tv[3]), "=&v"(tv[4]), "=&v"(tv[5]), "=&v"(tv[6]), "=&v"(tv[7]), "=&v"(tv[8]), "=&v"(tv[9]), "=&v"(tv[10]), "=&v"(tv[11]), "=&v"(tv[12]), "=&v"(tv[13]), "=&v"(tv[14]), "=&v"(tv[15]) : "v"(gsa) : "memory");
#pragma unroll
                    for (int ksl = 0; ksl < 4; ++ksl) {
                        const bf16x8 af = *(const bf16x8*)(Ps16 + fr * 264 + (hv * 4 + ksl) * 32 + fq * 8);
                        const u32x4 b0 = (u32x4){tv[4 * ksl].x, tv[4 * ksl].y, tv[4 * ksl + 1].x, tv[4 * ksl + 1].y};
                        const u32x4 b1 = (u32x4){tv[4 * ksl + 2].x, tv[4 * ksl + 2].y, tv[4 * ksl + 3].x, tv[4 * ksl + 3].y};
                        oa0 = __builtin_amdgcn_mfma_f32_16x16x32_bf16(af, __builtin_bit_cast(bf16x8, b0), oa0, 0, 0, 0);
                        oa1 = __builtin_amdgcn_mfma_f32_16x16x32_bf16(af, __builtin_bit_cast(bf16x8, b1), oa1, 0, 0, 0);
                    }
                    LDS_BARRIER();
                    if (hv == 1) {
#pragma unroll
                        for (int r = 0; r < 4; ++r) { const int q = fq * 4 + r; if (q < 8) {
                            const f32x4 s0 = *(const f32x4*)(rsum + q * 8), s1 = *(const f32x4*)(rsum + q * 8 + 4);
                            const float inv = 1.f / (((s0[0] + s0[1]) + (s0[2] + s0[3])) + ((s1[0] + s1[1]) + (s1[2] + s1[3])));
                            bf16_t* op = ob + (r0 + q) * D + h * 256 + w * 32 + fr;
                            op[0] = (bf16_t)f2bf(oa0[r] * inv); op[16] = (bf16_t)f2bf(oa1[r] * inv); } }
                    }
                }
                LDS_BARRIER();
            }
        }
            }
        }
    }
    SEAM(9);

    PHASE_G(10) {
        pg8::Gemm g{ob, Wco, MP, D, D}; pg8::StaticOrder S; S.init(MP, D, G, bx);
        pg8::EpiResid<false> E{hb, hb, nullptr, ssq + SSQ_H3, 1.f};
        pg8::gemm_phase<pg8::EpiResid<false>, pg8::StaticOrder, PG_ALIGN, PG_SP2>(ldsl, g, S, E);
        SEpiResid<false> SE{hb, hb, nullptr, ssq + SSQ_H3, 1.f};
        small_gemm(ob + (size_t)MP * D, Wco, D, fl, G, bx, wave, tid0, SE);
    }
    SEAM(10);
    PHASE_G(11) {
        pg8::Gemm g{hb, Wgu2, M, NGU, D}; pg8::StaticOrder S; S.init(M, NGU, G, bx, GREP(11));
        pg8::EpiSwiGLU E{act, FF, ssq + SSQ_H3};
        pg8::gemm_phase<pg8::EpiSwiGLU, pg8::StaticOrder, PG_ALIGN, PG_SP2>(ldsl, g, S, E);
    }
    SEAM(11);
    PHASE_G(12) {
        pg8::Gemm g{act, Wd2, MP, D, FF}; pg8::StaticOrder S; S.init(MP, D, G, bx, GREP(12));
        pg8::EpiResid<false> E{hb, qb, nullptr, ssq + SSQ_Y, 0.5f};
        pg8::gemm_phase<pg8::EpiResid<false>, pg8::StaticOrder, PG_ALIGN, PG_SP2>(ldsl, g, S, E);
        STAMP(140);
        SEpiResid<false> SE{hb, qb, nullptr, ssq + SSQ_Y, 0.5f};
        SUBREP(21)
        small_gemm(act + (size_t)MP * FF, Wd2, FF, fl, G, bx, wave, tid0, SE);
    }
    SEAM(12);
    PHASE(13) {
        REP_SYNC();
        PHASE_LOCALS;
        for (int ch = gt; ch < M * (D / 8); ch += NGT) {
            const int row = ch >> 7, c8 = (ch & 127) * 8;
            const u32x4 w = __builtin_nontemporal_load((const u32x4*)(qb + (size_t)row * D + c8));
            const float rs = rsqrtf(ssq[SSQ_Y + row] * (1.f / D) + EPS);
            const f32x4 g0 = *(const f32x4*)(g_final + c8), g1 = *(const f32x4*)(g_final + c8 + 4);
            f32x4 o0, o1; o0[0] = bflo(w.x) * rs * g0[0]; o0[1] = bfhi(w.x) * rs * g0[1]; o0[2] = bflo(w.y) * rs * g0[2]; o0[3] = bfhi(w.y) * rs * g0[3];
            o1[0] = bflo(w.z) * rs * g1[0]; o1[1] = bfhi(w.z) * rs * g1[1]; o1[2] = bflo(w.w) * rs * g1[2]; o1[3] = bfhi(w.w) * rs * g1[3];
            f32x4* op = (f32x4*)(out + O_Y + (size_t)row * D + c8); __builtin_nontemporal_store(o0, op); __builtin_nontemporal_store(o1, op + 1);
        }
    }
    if (PROBE_T_LO >= 0) {
        xcd_barrier(xbar); STAMP(14);
        if (bx == 0) {
            if (tid0 == 0) { volatile LAS unsigned long long* tp_ = (volatile LAS unsigned long long*)(ldsl + LDS_BARST + 16); ((volatile float*)lds)[0] = 1.f + (float)(tp_[1] - tp_[0]) * 1e-5f; }
            __syncthreads();
            const float sc_ = ((volatile float*)lds)[0];
            for (int i = tid0; i < 128 * 32 * 64; i += NTHREADS) out[O_RES + i] *= sc_;
        }
    }
    __syncthreads();
    if (tid0 == 0) { const unsigned old_ = xb_add(&g_bar_words[XB_EXIT], 1u); ((volatile LAS unsigned*)(ldsl + LDS_BARST))[8] = (old_ + 1u == (unsigned)G) ? 1u : 0u; }
    __syncthreads();
    if (((volatile LAS unsigned*)(ldsl + LDS_BARST))[8]) { for (int i = tid0; i < XCD_BAR_WORDS + 64; i += NTHREADS) __hip_atomic_store(&g_bar_words[i], 0u, __ATOMIC_RELAXED, __HIP_MEMORY_SCOPE_AGENT); }
#undef IN
#undef SEAM
}

extern "C" void kernel_launch(void* const* d_in, const int* in_sizes, int n_in, void* d_out, int out_size, void* d_ws, size_t ws_size, hipStream_t stream) {
    static int grid = 0;
    if (grid == 0) {
        if (n_in != 36 || (size_t)out_size != O_TOTAL || ws_size < WS_END) { fprintf(stderr, "kernel_launch: unexpected shapes (n_in %d, out %d, ws %zu)\n", n_in, out_size, ws_size); grid = -1; return; }
        int dev = 0, cus = 0, per_cu = 0;
        hipGetDevice(&dev); hipDeviceGetAttribute(&cus, hipDeviceAttributeMultiprocessorCount, dev);
        hipFuncSetAttribute((const void*)hymba_fwd, hipFuncAttributeMaxDynamicSharedMemorySize, LDS_BYTES);
        hipOccupancyMaxActiveBlocksPerMultiprocessor(&per_cu, (const void*)hymba_fwd, NTHREADS, LDS_BYTES);
        if (per_cu < 1) { fprintf(stderr, "kernel_launch: occupancy query says %d blocks per CU\n", per_cu); per_cu = 1; }
        grid = cus;
        (void)hipGetLastError();
    }
    if (grid < 0) return;
    Args a{};
    for (int i = 0; i < 36; ++i) a.in[i] = (const float*)d_in[i];
    a.out = (float*)d_out; a.ws = (unsigned char*)d_ws; a.ph_lo = 0; a.ph_hi = 14;
    void* params[] = {&a};
    hipError_t e = hipLaunchCooperativeKernel((const void*)hymba_fwd, dim3(grid), dim3(NTHREADS), params, LDS_BYTES, stream);
    if (e != hipSuccess) fprintf(stderr, "kernel_launch: cooperative launch failed: %s (grid %d)\n", hipGetErrorString(e), grid);
}
```
